# Optimizing an MI355X kernel written in HIP

```python
import jax
import jax.numpy as jnp
from jax import lax
import numpy as np

D_MODEL = 1024
BATCH = 4
SEQ = 4096
DEPTH = 2

GRID_W = 64
CTX_LEN = 256
HEAD_DIM = 64
RET_HEADS = 8
NA_HEADS = 8
RET_W = RET_HEADS * HEAD_DIM
NA_W = NA_HEADS * HEAD_DIM
MIX_W = RET_W + NA_W
AB_KV_W = 2 * RET_W + 2 * NA_W
AB_IN_W = AB_KV_W + 2 * RET_W + NA_W
RET_CHUNK = 128
NA_ROWS = 8
NA_COLS = 16
ROPE_BASE = 10000.0
SGU_CHUNK = 128
SGU_GROUPS = 8
SGU_W = 3 * D_MODEL
N_EXPERTS = 16
N_GROUPS = 4
EXPERTS_PER_GROUP = N_EXPERTS // N_GROUPS
GROUP_SCORE_K = 2
TOP_K = 2
EXPERT_W = 512
N_EVEN = (DEPTH + 1) // 2
N_ODD = DEPTH // 2
EPS = 1e-6

kernel_name = 'hybrid_retention_natten_sgu_moe_dit'


def rms_norm(x, g):
    xf = x.astype(jnp.float32)
    y = xf * lax.rsqrt(jnp.mean(xf * xf, axis=-1, keepdims=True) + EPS)
    return (y * g.astype(jnp.float32)).astype(x.dtype)


def modulate(h, shift, scale):
    return h * (1 + scale[:, None, :]) + shift[:, None, :]


def split_heads(t, n_heads):
    b, l, _ = t.shape
    return t.reshape(b, l, n_heads, HEAD_DIM).transpose(0, 2, 1, 3)


def merge_heads(t):
    b, h, l, d = t.shape
    return t.transpose(0, 2, 1, 3).reshape(b, l, h * d)


def rope_2d(t, rows, cols):
    half = HEAD_DIM // 2
    quarter = half // 2
    inv_freq = ROPE_BASE ** (-jnp.arange(quarter, dtype=jnp.float32) / quarter)

    def rotate(u, pos):
        ang = pos.astype(jnp.float32)[:, None] * inv_freq
        cos, sin = jnp.cos(ang).astype(u.dtype), jnp.sin(ang).astype(u.dtype)
        u1, u2 = u[..., :quarter], u[..., quarter:]
        return jnp.concatenate([u1 * cos - u2 * sin, u1 * sin + u2 * cos], axis=-1)

    return jnp.concatenate([rotate(t[..., :half], rows), rotate(t[..., half:], cols)], axis=-1)


def retention_chunkwise(q, k, v, log_gamma, s0):
    b, h, l, d = q.shape
    n = l // RET_CHUNK
    lg = log_gamma.astype(jnp.float32)
    pos = jnp.arange(RET_CHUNK, dtype=jnp.float32)
    diff = pos[:, None] - pos[None, :]
    intra = jnp.where(diff >= 0, jnp.exp(lg[:, None, None] * jnp.maximum(diff, 0.0)), 0.0)
    q_decay = jnp.exp(lg[:, None] * (pos + 1.0))[..., None]
    k_decay = jnp.exp(lg[:, None] * (RET_CHUNK - 1.0 - pos))[..., None]
    chunk_decay = jnp.exp(lg * RET_CHUNK)[:, None, None]

    def to_chunks(t):
        return t.astype(jnp.float32).reshape(b, h, n, RET_CHUNK, d).transpose(2, 0, 1, 3, 4)

    def step(s, qkv):
        qi, ki, vi = qkv
        scores = jnp.einsum('bhid,bhjd->bhij', qi, ki) * intra
        o = jnp.einsum('bhij,bhje->bhie', scores, vi) + jnp.einsum('bhid,bhde->bhie', qi, s) * q_decay
        s = s * chunk_decay + jnp.einsum('bhjd,bhje->bhde', ki * k_decay, vi)
        return s, o

    _, o = lax.scan(step, s0.astype(jnp.float32), (to_chunks(q), to_chunks(k), to_chunks(v)))
    return o.transpose(1, 2, 0, 3, 4).reshape(b, h, l, d).astype(q.dtype)


def retention_context_states(k, v, log_gamma):
    kf, vf = k.astype(jnp.float32), v.astype(jnp.float32)
    n = k.shape[2]
    m = jnp.arange(n, dtype=jnp.float32)
    w_fwd = jnp.exp(log_gamma[0][:, None] * (n - 1.0 - m))
    w_bwd = jnp.exp(log_gamma[1][:, None] * m)
    s_fwd = jnp.einsum('bhnd,hn,bhne->bhde', kf, w_fwd, vf)
    s_bwd = jnp.einsum('bhnd,hn,bhne->bhde', kf, w_bwd, vf)
    return s_fwd, s_bwd


def bidir_retention(q, k, v, log_gamma, s_fwd, s_bwd):
    fwd = retention_chunkwise(q, k, v, log_gamma[0], s_fwd)
    bwd = retention_chunkwise(q[:, :, ::-1], k[:, :, ::-1], v[:, :, ::-1], log_gamma[1], s_bwd)[:, :, ::-1]
    return fwd + bwd


def neighbourhood_attention(q, k, v, k_ctx, v_ctx, rpb):
    b, h, l, d = q.shape
    rows = l // GRID_W
    kr = min(NA_ROWS, rows)
    qg = q.reshape(b, h, rows, GRID_W, d)
    kg = k.reshape(b, h, rows, GRID_W, d)
    vg = v.reshape(b, h, rows, GRID_W, d)
    col_pos = jnp.arange(GRID_W)
    col_idx = jnp.clip(col_pos - NA_COLS // 2, 0, GRID_W - NA_COLS)[:, None] + jnp.arange(NA_COLS)
    col_bias_idx = col_idx - col_pos[:, None] + (NA_COLS - 1)
    n_loc = kr * NA_COLS

    def row_block(r):
        r0 = jnp.clip(r - kr // 2, 0, rows - kr)
        k_rows = lax.dynamic_slice_in_dim(kg, r0, kr, axis=2)
        v_rows = lax.dynamic_slice_in_dim(vg, r0, kr, axis=2)
        q_r = lax.dynamic_index_in_dim(qg, r, axis=2, keepdims=False)
        k_win = k_rows[:, :, :, col_idx]
        v_win = v_rows[:, :, :, col_idx]
        row_bias_idx = r0 + jnp.arange(kr) - r + (NA_ROWS - 1)
        bias = rpb[:, row_bias_idx][:, :, col_bias_idx].transpose(0, 2, 1, 3)
        s_loc = jnp.einsum('bhwd,bhrwcd->bhwrc', q_r, k_win) + bias
        s_ctx = jnp.einsum('bhwd,bhnd->bhwn', q_r, k_ctx)
        s = jnp.concatenate([s_loc.reshape(b, h, GRID_W, n_loc), s_ctx], axis=-1).astype(jnp.float32)
        p = jax.nn.softmax(s, axis=-1).astype(q.dtype)
        p_loc = p[..., :n_loc].reshape(b, h, GRID_W, kr, NA_COLS)
        p_ctx = p[..., n_loc:]
        return jnp.einsum('bhwrc,bhrwcd->bhwd', p_loc, v_win) + jnp.einsum('bhwn,bhnd->bhwd', p_ctx, v_ctx)

    out = lax.map(row_block, jnp.arange(rows))
    return out.transpose(1, 2, 0, 3, 4).reshape(b, h, l, d)


def retention_na_mixer(h, h_ctx, rows, cols, w_in, w_out, ret_theta, ret_g, q_g, k_g, rpb, ctx_out):
    scale = HEAD_DIM ** -0.5
    kv, rest = jnp.split(h @ w_in, [AB_KV_W], axis=-1)
    r_k, r_v, n_k, n_v = [split_heads(t, RET_HEADS) for t in jnp.split(kv, 4, axis=-1)]
    r_q, r_gate, n_q = jnp.split(rest, 3, axis=-1)
    proj_c = h_ctx @ (w_in if ctx_out else w_in[:, :AB_KV_W])
    rc_k, rc_v, nc_k, nc_v = [split_heads(t, RET_HEADS) for t in jnp.split(proj_c[..., :AB_KV_W], 4, axis=-1)]

    log_gamma = -jax.nn.softplus(ret_theta.astype(jnp.float32))
    rc_k = rc_k * scale
    s_fwd, s_bwd = retention_context_states(rc_k, rc_v, log_gamma)
    q = rope_2d(split_heads(r_q, RET_HEADS), rows, cols)
    k = rope_2d(r_k, rows, cols) * scale
    o = bidir_retention(q, k, r_v, log_gamma, s_fwd, s_bwd)
    ret = merge_heads(rms_norm(o, ret_g)) * jax.nn.silu(r_gate)

    kc_n = rms_norm(nc_k, k_g)
    qn = rms_norm(split_heads(n_q, NA_HEADS), q_g) * scale
    na = merge_heads(neighbourhood_attention(qn, rms_norm(n_k, k_g), n_v, kc_n, nc_v, rpb))
    y = jnp.concatenate([ret, na], axis=-1) @ w_out
    if not ctx_out:
        return y, None

    rc_q, rc_gate, nc_q = jnp.split(proj_c[..., AB_KV_W:], 3, axis=-1)
    zeros = jnp.zeros(s_fwd.shape, jnp.float32)
    o_c = bidir_retention(split_heads(rc_q, RET_HEADS), rc_k, rc_v, log_gamma, zeros, zeros)
    ret_c = merge_heads(rms_norm(o_c, ret_g)) * jax.nn.silu(rc_gate)
    qn_c = rms_norm(split_heads(nc_q, NA_HEADS), q_g) * scale
    p = jax.nn.softmax(jnp.einsum('bhqd,bhkd->bhqk', qn_c, kc_n).astype(jnp.float32), axis=-1).astype(h.dtype)
    na_c = merge_heads(jnp.einsum('bhqk,bhkd->bhqd', p, nc_v))
    y_ctx = jnp.concatenate([ret_c, na_c], axis=-1) @ w_out
    return y, y_ctx


def spatial_gating_unit(h, w_in, b_in, norm_g, w_s, b_s, w_out):
    b, l, _ = h.shape
    z = jax.nn.gelu(h @ w_in + b_in)
    u, v = jnp.split(z, 2, axis=-1)
    v = rms_norm(v, norm_g)
    vg = v.reshape(b, l // SGU_CHUNK, SGU_CHUNK, SGU_GROUPS, SGU_W // SGU_GROUPS)
    mixed = jnp.einsum('gij,bnjgc->bnigc', w_s, vg) + b_s.T[:, :, None]
    return (u * mixed.reshape(b, l, SGU_W)) @ w_out


def moe(h, router_w, router_bias, w_gate, w_up, w_down):
    affinity = jax.nn.sigmoid((h @ router_w).astype(jnp.float32))
    sel = affinity + router_bias.astype(jnp.float32)
    grouped = sel.reshape(*sel.shape[:-1], N_GROUPS, EXPERTS_PER_GROUP)
    group_score = lax.top_k(grouped, GROUP_SCORE_K)[0].sum(axis=-1)
    best = jnp.argmax(group_score, axis=-1)
    in_group = (jnp.arange(N_EXPERTS) // EXPERTS_PER_GROUP) == best[..., None]
    _, top_idx = lax.top_k(jnp.where(in_group, sel, -jnp.inf), TOP_K)
    w = jnp.take_along_axis(affinity, top_idx, axis=-1)
    w = w / jnp.sum(w, axis=-1, keepdims=True)
    combine = jnp.sum(jax.nn.one_hot(top_idx, N_EXPERTS, dtype=jnp.float32) * w[..., None], axis=-2).astype(h.dtype)
    out = jnp.zeros_like(h)
    for e in range(N_EXPERTS):
        y = (jax.nn.silu(h @ w_gate[e]) * (h @ w_up[e])) @ w_down[e]
        out = out + combine[..., e:e + 1] * y
    return out


def setup_inputs(seed: int = 0) -> dict:
    key = jax.random.key(seed)
    ks = jax.random.split(key, 26)
    f32 = jnp.float32
    D = D_MODEL

    def nrm(k, shape, scale):
        return jax.random.normal(k, shape, f32) * scale

    theta0 = np.log(np.expm1(-np.log(1.0 - 2.0 ** (-5.0 - np.arange(RET_HEADS))))).astype(np.float32)
    return {
        'x': nrm(ks[0], (BATCH, SEQ, D), 1.0),
        'c': nrm(ks[1], (BATCH, D), 1.0),
        'ctx': nrm(ks[2], (BATCH, CTX_LEN, D), 1.0),
        'c_ctx': nrm(ks[3], (D,), 1.0),
        'ada_w': nrm(ks[4], (DEPTH, D, 6 * D), 0.5 * D ** -0.5),
        'ada_b': nrm(ks[5], (DEPTH, 6 * D), 0.02),
        'norm_mix_g': 1.0 + nrm(ks[6], (DEPTH, D), 0.05),
        'norm_ffn_g': 1.0 + nrm(ks[7], (DEPTH, D), 0.05),
        'router_w': nrm(ks[8], (D, N_EXPERTS), D ** -0.5),
        'router_bias': nrm(ks[9], (N_EXPERTS,), 0.01),
        'moe_w_gate': nrm(ks[10], (DEPTH, N_EXPERTS, D, EXPERT_W), D ** -0.5),
        'moe_w_up': nrm(ks[11], (DEPTH, N_EXPERTS, D, EXPERT_W), D ** -0.5),
        'moe_w_down': nrm(ks[12], (DEPTH, N_EXPERTS, EXPERT_W, D), EXPERT_W ** -0.5),
        'ab_w_in': nrm(ks[13], (N_EVEN, D, AB_IN_W), D ** -0.5),
        'ab_w_out': nrm(ks[14], (N_EVEN, MIX_W, D), MIX_W ** -0.5),
        'ret_decay': jnp.asarray(theta0) + nrm(ks[15], (N_EVEN, 2, RET_HEADS), 0.05),
        'ret_norm_g': 1.0 + nrm(ks[16], (N_EVEN, HEAD_DIM), 0.05),
        'na_q_g': 1.0 + nrm(ks[17], (N_EVEN, HEAD_DIM), 0.05),
        'na_k_g': 1.0 + nrm(ks[18], (N_EVEN, HEAD_DIM), 0.05),
        'na_rpb': nrm(ks[19], (N_EVEN, NA_HEADS, 2 * NA_ROWS - 1, 2 * NA_COLS - 1), 0.02),
        'sgu_w_in': nrm(ks[20], (N_ODD, D, 2 * SGU_W), D ** -0.5),
        'sgu_b_in': nrm(ks[21], (N_ODD, 2 * SGU_W), 0.02),
        'sgu_norm_g': 1.0 + nrm(ks[22], (N_ODD, SGU_W), 0.05),
        'sgu_w_s': nrm(ks[23], (N_ODD, SGU_GROUPS, SGU_CHUNK, SGU_CHUNK), SGU_CHUNK ** -0.5),
        'sgu_b_s': 1.0 + nrm(ks[24], (N_ODD, SGU_GROUPS, SGU_CHUNK), 0.02),
        'sgu_w_out': nrm(ks[25], (N_ODD, SGU_W, D), SGU_W ** -0.5),
    }


def reference(x, c, ctx, c_ctx, ada_w, ada_b, norm_mix_g, norm_ffn_g, router_w, router_bias,
              moe_w_gate, moe_w_up, moe_w_down, ab_w_in, ab_w_out, ret_decay, ret_norm_g,
              na_q_g, na_k_g, na_rpb, sgu_w_in, sgu_b_in, sgu_norm_g, sgu_w_s, sgu_b_s, sgu_w_out):
    seq = x.shape[1]
    t = jnp.arange(seq)
    rows, cols = t // GRID_W, t % GRID_W
    silu_c = jax.nn.silu(c)
    silu_cc = jax.nn.silu(c_ctx)[None]
    for l in range(DEPTH):
        even = l % 2 == 0
        i = l // 2
        ctx_out = any(j % 2 == 0 for j in range(l + 1, DEPTH))
        sh_m, sc_m, g_m, sh_f, sc_f, g_f = jnp.split(silu_c @ ada_w[l] + ada_b[l], 6, axis=-1)
        h = modulate(rms_norm(x, norm_mix_g[l]), sh_m, sc_m)
        if even or ctx_out:
            n_mod = 6 if ctx_out else 2
            mod_c = jnp.split(silu_cc @ ada_w[l][:, :n_mod * D_MODEL] + ada_b[l][:n_mod * D_MODEL], n_mod, axis=-1)
            h_ctx = modulate(rms_norm(ctx, norm_mix_g[l]), mod_c[0], mod_c[1])
        if even:
            y, y_ctx = retention_na_mixer(h, h_ctx, rows, cols, ab_w_in[i], ab_w_out[i], ret_decay[i],
                                          ret_norm_g[i], na_q_g[i], na_k_g[i], na_rpb[i], ctx_out)
        else:
            sgu_args = (sgu_w_in[i], sgu_b_in[i], sgu_norm_g[i], sgu_w_s[i], sgu_b_s[i], sgu_w_out[i])
            y = spatial_gating_unit(h, *sgu_args)
            y_ctx = spatial_gating_unit(h_ctx, *sgu_args) if ctx_out else None
        x = x + g_m[:, None, :] * y
        h_f = modulate(rms_norm(x, norm_ffn_g[l]), sh_f, sc_f)
        x = x + g_f[:, None, :] * moe(h_f, router_w, router_bias, moe_w_gate[l], moe_w_up[l], moe_w_down[l])
        if ctx_out:
            ctx = ctx + mod_c[2][:, None, :] * y_ctx
            hc_f = modulate(rms_norm(ctx, norm_ffn_g[l]), mod_c[3], mod_c[4])
            ctx = ctx + mod_c[5][:, None, :] * moe(hc_f, router_w, router_bias, moe_w_gate[l], moe_w_up[l], moe_w_down[l])
    return x
```

```cpp
#include <hip/hip_runtime.h>
#include <cstdio>
#include <cstdint>

#ifndef MK_ONE_LAUNCH
#define MK_ONE_LAUNCH 1
#endif

constexpr int D = 1024, NB = 4, SEQ = 4096, NTOK = NB * SEQ, CTXL = 256, NCTX = NB * CTXL, NROW = NTOK + NCTX;
constexpr int HD = 64, NH = 8, HW = NH * HD;
constexpr int ABW = 3584;
constexpr int SGW = 3072;
constexpr int NE = 16, EW = 512;
constexpr float EPS = 1e-6f;
constexpr int NWAVES = 8, NTHREADS = 512;

constexpr size_t MiB = 1u << 20;
constexpr size_t WS_CTL = 0, CTL_ZERO_BYTES = 1 * MiB;
constexpr size_t WS_MOD = 1 * MiB;
constexpr size_t WS_ROUTE = 2 * MiB;
constexpr size_t WS_VSS = 4 * MiB;
constexpr size_t WS_WB = 8 * MiB;
constexpr size_t WS_H = 132 * MiB;
constexpr size_t WS_A = 166 * MiB;
constexpr size_t WS_END = 358 * MiB;
constexpr size_t A_RK = 0, A_RV = 17 * MiB, A_NK = 34 * MiB, A_NV = 51 * MiB, A_RQ = 68 * MiB, A_GT = 84 * MiB, A_NQ = 100 * MiB, A_MIX = 116 * MiB, A_SST = 148 * MiB;
constexpr size_t A_ACT = 0, A_Y = 36 * MiB;
constexpr size_t A_U = 0, A_V = 96 * MiB;

constexpr int CW_BAR = 4096;
constexpr int CW_CNT = 8192;

typedef unsigned short bf16;
typedef unsigned u32x4 __attribute__((ext_vector_type(4)));
typedef float f32x4 __attribute__((ext_vector_type(4)));
#define LAS __attribute__((address_space(3)))
#define RLX_AGENT __ATOMIC_RELAXED, __HIP_MEMORY_SCOPE_AGENT

__device__ __forceinline__ unsigned f2bf(float f) { unsigned u = __builtin_bit_cast(unsigned, f); return (u + 0x7fffu + ((u >> 16) & 1u)) >> 16; }
__device__ __forceinline__ float bf2f(unsigned h) { return __builtin_bit_cast(float, h << 16); }
__device__ __forceinline__ unsigned pk2(float lo, float hi) { return f2bf(lo) | (f2bf(hi) << 16); }
__device__ __forceinline__ float siluf(float v) { return v / (1.f + __expf(-v)); }
__device__ __forceinline__ float gelu_tanh(float v) { const float u = 0.7978845608028654f * (v + 0.044715f * v * v * v); return 0.5f * v * (1.f + tanhf(u)); }
__device__ __forceinline__ float wave_sum(float v) {
#pragma unroll
    for (int o = 1; o < 64; o <<= 1) v += __shfl_xor(v, o);
    return v;
}

#define XB_TMO      128
#define XB_XCNT(j)  (256  + 64 * (j))
#define XB_XSUB(j)  (1280 + 64 * (j))
#define XB_XGEN(j)  (2304 + 64 * (j))
#define XB_TOP      3328
#define XB_TOPGEN   3392
#define XCD_BAR_WORDS 3456
#define XB_SPIN_CAP (1u << 18)
__device__ __forceinline__ unsigned xb_ld(unsigned* p)              { return __hip_atomic_load(p, __ATOMIC_RELAXED, __HIP_MEMORY_SCOPE_AGENT); }
__device__ __forceinline__ unsigned xb_add(unsigned* p, unsigned v) { return __hip_atomic_fetch_add(p, v, __ATOMIC_RELAXED, __HIP_MEMORY_SCOPE_AGENT); }
__device__ __forceinline__ unsigned xb_xcc_id() { return (unsigned)__builtin_amdgcn_s_getreg((3 << 11) | 20) & 0xFu; }
#define XB_SPIN(cond, bar) do { unsigned _sp = 0; while (cond) { __builtin_amdgcn_s_sleep(1); \
    if ((++_sp & 255u) == 0u) { if (xb_ld(&(bar)[XB_TMO])) break; if (_sp > XB_SPIN_CAP) { atomicAdd(&(bar)[XB_TMO], 1u); break; } } } } while (0)
struct XcdBarrier { unsigned* bar; unsigned x; volatile LAS unsigned* st; };
__device__ __forceinline__ XcdBarrier xcd_barrier_post(unsigned* bar, volatile LAS unsigned* st) {
    XcdBarrier b; b.bar = bar; b.x = xb_xcc_id(); b.st = st;
    if (threadIdx.x == 0) (void)xb_add(&bar[XB_XCNT(b.x)], 1u);
    return b;
}
__device__ __forceinline__ void xcd_barrier_complete(unsigned* bar, unsigned x, unsigned& nloc, unsigned& nx) {
    const unsigned G = gridDim.x * gridDim.y * gridDim.z;
    unsigned sum, cnt, mine, sp = 0u;
    for (;;) {
        sum = 0u; cnt = 0u; mine = 0u;
#pragma unroll
        for (unsigned j = 0; j < 16; ++j) { const unsigned c = xb_ld(&bar[XB_XCNT(j)]); sum += c; cnt += (c > 0u) ? 1u : 0u; mine = (j == x) ? c : mine; }
        if (sum == G) break;
        __builtin_amdgcn_s_sleep(1);
        if ((++sp & 255u) == 0u) { if (xb_ld(&bar[XB_TMO])) break; if (sp > XB_SPIN_CAP) { atomicAdd(&bar[XB_TMO], 1u); break; } }
    }
    nloc = mine > 0u ? mine : 1u; nx = cnt > 0u ? cnt : 1u;
}
__device__ __forceinline__ void xcd_barrier(const XcdBarrier& b) {
    asm volatile("s_waitcnt vmcnt(0)" ::: "memory");
    __syncthreads();
    if (threadIdx.x == 0) {
        unsigned* bar = b.bar;
        __builtin_amdgcn_s_waitcnt(0);
        unsigned nloc = b.st[0], nx = b.st[1];
        if (nloc == 0u) { xcd_barrier_complete(bar, b.x, nloc, nx); b.st[0] = nloc; b.st[1] = nx; }
        const unsigned old = xb_add(&bar[XB_XSUB(b.x)], 1u);
        const unsigned gen = old / nloc;
        if (old + 1u == (gen + 1u) * nloc) {
            __builtin_amdgcn_fence(__ATOMIC_RELEASE, "agent");
            asm volatile("s_waitcnt vmcnt(0)" ::: "memory");
            const unsigned og = xb_add(&bar[XB_TOP], 1u);
            const unsigned tg = og / nx;
            if (og + 1u == (tg + 1u) * nx) xb_add(&bar[XB_TOPGEN], 1u);
            else XB_SPIN(xb_ld(&bar[XB_TOPGEN]) == tg, bar);
            __builtin_amdgcn_fence(__ATOMIC_ACQUIRE, "agent");
            xb_add(&bar[XB_XGEN(b.x)], 1u);
            asm volatile("s_waitcnt vmcnt(0)" ::: "memory");
        } else {
            XB_SPIN(xb_ld(&bar[XB_XGEN(b.x)]) == gen, bar);
            __builtin_amdgcn_fence(__ATOMIC_ACQUIRE, "agent");
            asm volatile("s_waitcnt vmcnt(0)" ::: "memory");
        }
    }
    __syncthreads();
}

constexpr int LDS_BYTES = 147456;
constexpr int LDSCTL_OFF = 131072, MISC_OFF = LDSCTL_OFF + 320;

struct Args { const float* in[26]; float* out; unsigned char* ws; int ph_lo, ph_hi, li, pad; };

struct Frame {
    LAS unsigned char* lds;
    int tid, lane, wave, gw, ngw;
    const float* in[26];
    float* out; unsigned char* ws;
    unsigned* ctl;
    float *MOD, *MODC, *ROPE;
    int* LIST; float* WT; float* VSS;
    bf16* H; unsigned char* A;
};
enum { I_X = 0, I_C, I_CTX, I_CCTX, I_ADAW, I_ADAB, I_NMG, I_NFG, I_RW, I_RB, I_WG, I_WU, I_WD, I_WIN, I_WOUT, I_RDEC, I_RNG, I_QG, I_KG, I_RPB, I_SWIN, I_SBIN, I_SNG, I_SWS, I_SBS, I_SWOUT };

template <int NC> __device__ __forceinline__ void naive_dot(const bf16* arow, const float* W, int ldw, int K, float (&acc)[NC]) {
#pragma unroll 1
    for (int k = 0; k < K; k += 2) {
        const unsigned a2 = *(const unsigned*)(arow + k);
        const float a0 = bf2f(a2 & 0xffffu), a1 = bf2f(a2 >> 16);
        const float* w = W + (size_t)k * ldw;
#pragma unroll
        for (int j = 0; j < NC; ++j) acc[j] = __builtin_fmaf(a0, w[j], acc[j]);
        asm volatile("" ::: "memory");
        w += ldw;
#pragma unroll
        for (int j = 0; j < NC; ++j) acc[j] = __builtin_fmaf(a1, w[j], acc[j]);
        asm volatile("" ::: "memory");
    }
}
template <int NC> __device__ __forceinline__ void store_row_bf16(bf16* dst, const float (&v)[NC]) {
#pragma unroll
    for (int j = 0; j < NC; j += 8) { u32x4 w; w.x = pk2(v[j], v[j + 1]); w.y = pk2(v[j + 2], v[j + 3]); w.z = pk2(v[j + 4], v[j + 5]); w.w = pk2(v[j + 6], v[j + 7]); *(u32x4*)(dst + j) = w; }
}

__device__ __forceinline__ void ph_mod(Frame& F) {
    const int gt = F.gw * 64 + F.lane, ngt = F.ngw * 64;
    for (int it = gt; it < 2 * 6144; it += ngt) {
        const int l = it / 6144, n = it % 6144;
        const float* W = F.in[I_ADAW] + (size_t)l * D * 6144 + n;
        float a0 = 0.f, a1 = 0.f, a2 = 0.f, a3 = 0.f, a4 = 0.f;
        const float* c = F.in[I_C]; const float* cc = F.in[I_CCTX];
        for (int k = 0; k < D; ++k) { const float w = W[(size_t)k * 6144];
            a0 += siluf(c[k]) * w; a1 += siluf(c[D + k]) * w; a2 += siluf(c[2 * D + k]) * w; a3 += siluf(c[3 * D + k]) * w; a4 += siluf(cc[k]) * w; }
        const float bb = F.in[I_ADAB][l * 6144 + n];
        F.MOD[(l * 4 + 0) * 6144 + n] = a0 + bb; F.MOD[(l * 4 + 1) * 6144 + n] = a1 + bb; F.MOD[(l * 4 + 2) * 6144 + n] = a2 + bb; F.MOD[(l * 4 + 3) * 6144 + n] = a3 + bb;
        if (l == 0 && n < 2048) F.MODC[n] = a4 + bb;
    }
    for (int it = gt; it < 64 * 16; it += ngt) {
        const int pos = it >> 4, j = it & 15;
        const float inv = powf(10000.0f, -(float)j / 16.0f);
        const float ang = (float)pos * inv;
        F.ROPE[it * 2] = cosf(ang); F.ROPE[it * 2 + 1] = sinf(ang);
    }
}

__device__ __forceinline__ void norm_row(Frame& F, const float* xrow, const float* g, const float* sh, const float* sc, bf16* hrow) {
    const f32x4* xr = (const f32x4*)xrow + F.lane;
    f32x4 v[4]; float s = 0.f;
#pragma unroll
    for (int j = 0; j < 4; ++j) { v[j] = xr[64 * j]; s += (v[j].x * v[j].x + v[j].y * v[j].y) + (v[j].z * v[j].z + v[j].w * v[j].w); }
    const float rstd = rsqrtf(wave_sum(s) * (1.f / D) + EPS);
    unsigned long long* o8 = (unsigned long long*)hrow + F.lane;
#pragma unroll
    for (int j = 0; j < 4; ++j) {
        const f32x4 gg = ((const f32x4*)g)[F.lane + 64 * j], s1 = ((const f32x4*)sh)[F.lane + 64 * j], s2 = ((const f32x4*)sc)[F.lane + 64 * j];
        const f32x4 y = (v[j] * rstd * gg) * (s2 + 1.f) + s1;
        o8[64 * j] = (unsigned long long)pk2(y.x, y.y) | ((unsigned long long)pk2(y.z, y.w) << 32);
    }
}
__device__ __forceinline__ void ph_norm0(Frame& F) {
    for (int r = F.gw; r < NROW; r += F.ngw) {
        if (r < NTOK) { const int b = r >> 12; norm_row(F, F.in[I_X] + (size_t)r * D, F.in[I_NMG], F.MOD + (0 * 4 + b) * 6144, F.MOD + (0 * 4 + b) * 6144 + D, F.H + (size_t)r * D); }
        else norm_row(F, F.in[I_CTX] + (size_t)(r - NTOK) * D, F.in[I_NMG], F.MODC, F.MODC + D, F.H + (size_t)r * D);
    }
}

__device__ __forceinline__ void ph_inproj_naive(Frame& F) {
    const float* W = F.in[I_WIN];
    for (int it = F.gw; it < 272 * 56; it += F.ngw) {
        const int rg = it / 56, u = it % 56; if (rg >= 256 && u >= 32) continue;
        const int row = rg * 64 + F.lane;
        float acc[64];
#pragma unroll
        for (int j = 0; j < 64; ++j) acc[j] = 0.f;
        naive_dot<64>(F.H + (size_t)row * D, W + u * 64, ABW, D, acc);
        const int t = u >> 3, h = u & 7;
        if ((t == 0 || t == 4) && row < NTOK) {
            const int tt = row & 4095, pr = tt >> 6, pc = tt & 63;
#pragma unroll
            for (int j = 0; j < 16; ++j) {
                const float c1 = F.ROPE[(pr * 16 + j) * 2], s1 = F.ROPE[(pr * 16 + j) * 2 + 1], c2 = F.ROPE[(pc * 16 + j) * 2], s2 = F.ROPE[(pc * 16 + j) * 2 + 1];
                const float a = acc[j], b = acc[j + 16], c = acc[32 + j], d = acc[48 + j];
                acc[j] = a * c1 - b * s1; acc[j + 16] = a * s1 + b * c1; acc[32 + j] = c * c2 - d * s2; acc[48 + j] = c * s2 + d * c2;
            }
        }
        if (t == 0) {
#pragma unroll
            for (int j = 0; j < 64; ++j) acc[j] *= 0.125f;
        }
        if (t == 2 || t == 6) {
            float ss = 0.f;
#pragma unroll
            for (int j = 0; j < 64; ++j) ss += acc[j] * acc[j];
            const float r = rsqrtf(ss * (1.f / 64.f) + EPS) * (t == 6 ? 0.125f : 1.f);
            const float* g = t == 2 ? F.in[I_KG] : F.in[I_QG];
#pragma unroll
            for (int j = 0; j < 64; ++j) acc[j] = acc[j] * r * g[j];
        }
        if (t == 5) {
#pragma unroll
            for (int j = 0; j < 64; ++j) acc[j] = siluf(acc[j]);
        }
        const size_t off_t = t < 4 ? (size_t)t * 17 * MiB : (size_t)(68 + (t - 4) * 16) * MiB;
        bf16* dst = (bf16*)(F.A + off_t) + (size_t)row * HW + h * 64;
        store_row_bf16<64>(dst, acc);
    }
}

__device__ __forceinline__ float ret_gamma_log(Frame& F, int dir, int h) {
    const float th = F.in[I_RDEC][dir * 8 + h];
    return -(th > 0.f ? th + log1pf(__expf(-th)) : log1pf(__expf(th)));
}
__device__ __forceinline__ void ph_scan_naive(Frame& F) {
    const bf16* RK = (const bf16*)(F.A + A_RK); const bf16* RV = (const bf16*)(F.A + A_RV); bf16* SST = (bf16*)(F.A + A_SST);
    const int gt = F.gw * 64 + F.lane, ngt = F.ngw * 64;
    for (int it = gt; it < 64 * 4096; it += ngt) {
        const int bhd = it >> 12, ed = it & 4095, e = ed >> 6, d = ed & 63;
        const int dir = bhd & 1, h = (bhd >> 1) & 7, b = bhd >> 4;
        const float gam = __expf(ret_gamma_log(F, dir, h));
        float S = 0.f;
        bf16* sst = SST + ((size_t)((b * 8 + h) * 2 + dir) * 32) * 4096 + ed;
        for (int n = 0; n < CTXL; ++n) { const int nn = dir ? (CTXL - 1 - n) : n; const size_t row = NTOK + b * CTXL + nn;
            S = gam * S + bf2f(RK[row * HW + h * 64 + d]) * bf2f(RV[row * HW + h * 64 + e]); }
        for (int n = 0; n < SEQ; ++n) { const int t = dir ? (SEQ - 1 - n) : n; const size_t row = (size_t)b * SEQ + t;
            if ((n & 127) == 0) sst[(size_t)(t >> 7) * 4096] = (bf16)f2bf(S);
            S = gam * S + bf2f(RK[row * HW + h * 64 + d]) * bf2f(RV[row * HW + h * 64 + e]); }
    }
}
__device__ __forceinline__ void ph_na_naive(Frame& F) {
    const bf16* NK = (const bf16*)(F.A + A_NK); const bf16* NV = (const bf16*)(F.A + A_NV); const bf16* NQ = (const bf16*)(F.A + A_NQ); bf16* MIX = (bf16*)(F.A + A_MIX);
    const int gt = F.gw * 64 + F.lane, ngt = F.ngw * 64;
    for (int it = gt; it < NB * NH * SEQ; it += ngt) {
        const int t = it & 4095, h = (it >> 12) & 7, b = it >> 15;
        const int r = t >> 6, c = t & 63;
        int r0 = r - 4; r0 = r0 < 0 ? 0 : (r0 > 56 ? 56 : r0); int c0 = c - 8; c0 = c0 < 0 ? 0 : (c0 > 48 ? 48 : c0);
        const size_t qrow = (size_t)b * SEQ + t;
        unsigned q[32]; float o[64];
#pragma unroll
        for (int j = 0; j < 32; ++j) q[j] = *(const unsigned*)(NQ + qrow * HW + h * 64 + 2 * j);
#pragma unroll
        for (int j = 0; j < 64; ++j) o[j] = 0.f;
        float m = -1e30f, l = 0.f;
        const float* rpb = F.in[I_RPB] + h * 15 * 31;
#pragma unroll 1
        for (int kk = 0; kk < 384; ++kk) {
            size_t krow; float bias = 0.f;
            if (kk < 128) { const int kr = r0 + (kk >> 4), kc = c0 + (kk & 15); krow = (size_t)b * SEQ + kr * 64 + kc; bias = rpb[(kr - r + 7) * 31 + (kc - c + 15)]; }
            else krow = NTOK + b * CTXL + (kk - 128);
            float s = 0.f;
#pragma unroll
            for (int j = 0; j < 64; j += 2) { const unsigned w = *(const unsigned*)(NK + krow * HW + h * 64 + j); s += bf2f(q[j >> 1] & 0xffffu) * bf2f(w & 0xffffu) + bf2f(q[j >> 1] >> 16) * bf2f(w >> 16); }
            s += bias;
            asm volatile("" ::: "memory");
            const float mn = fmaxf(m, s), al = __expf(m - mn), p = __expf(s - mn);
            l = l * al + p; m = mn;
#pragma unroll
            for (int j = 0; j < 64; j += 2) { const unsigned w = *(const unsigned*)(NV + krow * HW + h * 64 + j); o[j] = o[j] * al + p * bf2f(w & 0xffffu); o[j + 1] = o[j + 1] * al + p * bf2f(w >> 16); }
        }
        const float il = 1.f / l;
#pragma unroll
        for (int j = 0; j < 64; ++j) o[j] *= il;
        store_row_bf16<64>(MIX + qrow * D + 512 + h * 64, o);
    }
}
__device__ __forceinline__ void ph_retout_naive(Frame& F) {
    const bf16* RK = (const bf16*)(F.A + A_RK); const bf16* RV = (const bf16*)(F.A + A_RV); const bf16* RQ = (const bf16*)(F.A + A_RQ); const bf16* GT = (const bf16*)(F.A + A_GT);
    const bf16* SST = (const bf16*)(F.A + A_SST); bf16* MIX = (bf16*)(F.A + A_MIX);
    const int gt = F.gw * 64 + F.lane, ngt = F.ngw * 64;
    for (int it = gt; it < NB * NH * SEQ * 2; it += ngt) {
        const int hf = it & 1, t = (it >> 1) & 4095, h = (it >> 13) & 7, b = it >> 16;
        const int i = t & 127, ch = t >> 7;
        const size_t qrow = (size_t)b * SEQ + t;
        const float lgf = ret_gamma_log(F, 0, h), lgb = ret_gamma_log(F, 1, h);
        unsigned q[32]; float o[32];
#pragma unroll
        for (int j = 0; j < 32; ++j) q[j] = *(const unsigned*)(RQ + qrow * HW + h * 64 + 2 * j);
#pragma unroll
        for (int j = 0; j < 32; ++j) o[j] = 0.f;
#pragma unroll 1
        for (int jj = 0; jj < 128; ++jj) {
            const size_t krow = (size_t)b * SEQ + ch * 128 + jj;
            float s = 0.f;
#pragma unroll
            for (int j = 0; j < 64; j += 2) { const unsigned w = *(const unsigned*)(RK + krow * HW + h * 64 + j); s += bf2f(q[j >> 1] & 0xffffu) * bf2f(w & 0xffffu) + bf2f(q[j >> 1] >> 16) * bf2f(w >> 16); }
            asm volatile("" ::: "memory");
            const float wgt = jj < i ? __expf(lgf * (float)(i - jj)) : (jj > i ? __expf(lgb * (float)(jj - i)) : 2.f);
            s *= wgt;
#pragma unroll
            for (int j = 0; j < 32; j += 2) { const unsigned w = *(const unsigned*)(RV + krow * HW + h * 64 + hf * 32 + j); o[j] += s * bf2f(w & 0xffffu); o[j + 1] += s * bf2f(w >> 16); }
            asm volatile("" ::: "memory");
        }
        const float qf = __expf(lgf * (float)(i + 1)), qb = __expf(lgb * (float)(128 - i));
        const bf16* Sf = SST + ((size_t)((b * 8 + h) * 2 + 0) * 32 + ch) * 4096 + hf * 32 * 64; const bf16* Sb = SST + ((size_t)((b * 8 + h) * 2 + 1) * 32 + ch) * 4096 + hf * 32 * 64;
#pragma unroll 1
        for (int d = 0; d < 64; ++d) {
            const float qd = bf2f(RQ[qrow * HW + h * 64 + d]); const float qfd = qf * qd, qbd = qb * qd;
#pragma unroll
            for (int e = 0; e < 32; ++e) o[e] += qfd * bf2f(Sf[e * 64 + d]) + qbd * bf2f(Sb[e * 64 + d]);
            asm volatile("" ::: "memory");
        }
        float ss = 0.f;
#pragma unroll
        for (int j = 0; j < 32; ++j) ss += o[j] * o[j];
        ss += __shfl_xor(ss, 1);
        const float rs = rsqrtf(ss * (1.f / 64.f) + EPS);
        const float* g = F.in[I_RNG] + hf * 32;
#pragma unroll
        for (int j = 0; j < 32; j += 2) { const unsigned w = *(const unsigned*)(GT + qrow * HW + h * 64 + hf * 32 + j); o[j] = o[j] * rs * g[j] * bf2f(w & 0xffffu); o[j + 1] = o[j + 1] * rs * g[j + 1] * bf2f(w >> 16); }
        store_row_bf16<32>(MIX + qrow * D + h * 64 + hf * 32, o);
    }
}
__device__ __forceinline__ void ph_gemm_res_naive(Frame& F, const bf16* A, int lda, int K, const float* W, const float* base, const float* gate  ) {
    for (int it = F.gw; it < 256 * 16; it += F.ngw) {
        const int rg = it >> 4, u = it & 15, row = rg * 64 + F.lane, b = row >> 12;
        float acc[64];
#pragma unroll
        for (int j = 0; j < 64; ++j) acc[j] = 0.f;
        naive_dot<64>(A + (size_t)row * lda, W + u * 64, D, K, acc);
        const float* gp = gate + b * 6144 + u * 64; const float* bp = base + (size_t)row * D + u * 64; float* op = F.out + (size_t)row * D + u * 64;
#pragma unroll
        for (int j = 0; j < 64; j += 4) { const f32x4 bv = *(const f32x4*)(bp + j), gv = *(const f32x4*)(gp + j);
            *(f32x4*)(op + j) = bv + gv * (f32x4){acc[j], acc[j + 1], acc[j + 2], acc[j + 3]}; }
    }
}
__device__ __forceinline__ void ph_route(Frame& F, int l) {
    LAS float* rw = (LAS float*)F.lds;
    for (int i = F.tid; i < D * NE; i += NTHREADS) rw[i] = F.in[I_RW][i];
    __syncthreads();
    unsigned* cnt = F.ctl + CW_CNT + l * 1024;
    for (int r = F.gw; r < NTOK; r += F.ngw) {
        const int b = r >> 12;
        const float* g = F.in[I_NFG] + l * D; const float* sh = F.MOD + (l * 4 + b) * 6144 + 3 * D; const float* sc = F.MOD + (l * 4 + b) * 6144 + 4 * D;
        const f32x4* xr = (const f32x4*)(F.out + (size_t)r * D) + F.lane;
        f32x4 v[4]; float s = 0.f;
#pragma unroll
        for (int j = 0; j < 4; ++j) { v[j] = xr[64 * j]; s += (v[j].x * v[j].x + v[j].y * v[j].y) + (v[j].z * v[j].z + v[j].w * v[j].w); }
        const float rstd = rsqrtf(wave_sum(s) * (1.f / D) + EPS);
        unsigned long long* o8 = (unsigned long long*)(F.H + (size_t)r * D) + F.lane;
        float lg[16];
#pragma unroll
        for (int e = 0; e < 16; ++e) lg[e] = 0.f;
#pragma unroll
        for (int j = 0; j < 4; ++j) {
            const f32x4 gg = ((const f32x4*)g)[F.lane + 64 * j], s1 = ((const f32x4*)sh)[F.lane + 64 * j], s2 = ((const f32x4*)sc)[F.lane + 64 * j];
            const f32x4 y = (v[j] * rstd * gg) * (s2 + 1.f) + s1;
            o8[64 * j] = (unsigned long long)pk2(y.x, y.y) | ((unsigned long long)pk2(y.z, y.w) << 32);
            const int k0 = (F.lane + 64 * j) * 4;
#pragma unroll
            for (int i = 0; i < 4; ++i) { const float yv = y[i];
#pragma unroll
                for (int e4 = 0; e4 < 4; ++e4) { const f32x4 w = *(const LAS f32x4*)(rw + (k0 + i) * 16 + e4 * 4);
                    lg[e4 * 4] += yv * w.x; lg[e4 * 4 + 1] += yv * w.y; lg[e4 * 4 + 2] += yv * w.z; lg[e4 * 4 + 3] += yv * w.w; }
                asm volatile("" ::: "memory"); }
        }
#pragma unroll
        for (int e = 0; e < 16; ++e) lg[e] = wave_sum(lg[e]);
        if (F.lane == 0) {
            float aff[16], sel[16];
#pragma unroll
            for (int e = 0; e < 16; ++e) { aff[e] = 1.f / (1.f + __expf(-lg[e])); sel[e] = aff[e] + F.in[I_RB][e]; }
            int best = 0; float bs = -1e30f;
#pragma unroll
            for (int gI = 0; gI < 4; ++gI) {
                float m1 = -1e30f, m2 = -1e30f;
#pragma unroll
                for (int i = 0; i < 4; ++i) { const float x = sel[gI * 4 + i]; if (x > m1) { m2 = m1; m1 = x; } else if (x > m2) m2 = x; }
                const float sc2 = m1 + m2; if (sc2 > bs) { bs = sc2; best = gI; }
            }
            int i1 = 0, i2 = 0; float m1 = -1e30f, m2 = -1e30f, a1 = 0.f, a2 = 0.f;
#pragma unroll
            for (int gI = 0; gI < 4; ++gI)
#pragma unroll
                for (int i = 0; i < 4; ++i) { if (gI == best) { const float x = sel[gI * 4 + i]; const float a = aff[gI * 4 + i]; const int id = gI * 4 + i;
                    if (x > m1) { m2 = m1; i2 = i1; a2 = a1; m1 = x; i1 = id; a1 = a; } else if (x > m2) { m2 = x; i2 = id; a2 = a; } } }
            const float inv = 1.f / (a1 + a2);
            const unsigned p1 = __hip_atomic_fetch_add(cnt + i1 * 64, 1u, RLX_AGENT), p2 = __hip_atomic_fetch_add(cnt + i2 * 64, 1u, RLX_AGENT);
            F.LIST[i1 * 16384 + p1] = 2 * r; F.LIST[i2 * 16384 + p2] = 2 * r + 1;
            F.WT[2 * r] = a1 * inv; F.WT[2 * r + 1] = a2 * inv;
        }
    }
    __syncthreads();
}
struct Seg { int cnt[16]; int base[16]; };
__device__ __forceinline__ void load_seg(Frame& F, int l, int (&cnt)[16], int (&base)[16]) {
    int acc = 0;
#pragma unroll
    for (int e = 0; e < 16; ++e) { cnt[e] = (int)__hip_atomic_load(F.ctl + CW_CNT + l * 1024 + e * 64, RLX_AGENT); base[e] = acc; acc += (cnt[e] + 255) & ~255; }
}
__device__ __forceinline__ void ph_moe_gu_naive(Frame& F, int l) {
    int cnt[16], base[16]; load_seg(F, l, cnt, base);
    bf16* ACT = (bf16*)(F.A + A_ACT);
    int tot = 0;
#pragma unroll
    for (int i = 0; i < 16; ++i) tot += (cnt[i] + 63) >> 6;
    for (int it = F.gw; it < tot * 16; it += F.ngw) {
        const int gi_all = it >> 4, u = it & 15;
        int ee = 0, gs = 0;
#pragma unroll
        for (int i = 0, cum = 0; i < 16; ++i) { cum += (cnt[i] + 63) >> 6; if (gi_all >= cum) { gs = cum; ee = i + 1; } }
        int ce = 0, be = 0;
#pragma unroll
        for (int i = 0; i < 16; ++i) if (i == ee) { ce = cnt[i]; be = base[i]; }
        const int pos = (gi_all - gs) * 64 + F.lane; const bool valid = pos < ce;
        const int ent = F.LIST[ee * 16384 + (valid ? pos : 0)]; const int tok = ent >> 1;
        float ag[32], au[32];
#pragma unroll
        for (int j = 0; j < 32; ++j) { ag[j] = 0.f; au[j] = 0.f; }
        const float* Wg = F.in[I_WG] + ((size_t)(l * NE + ee) * D) * EW + u * 32; const float* Wu = F.in[I_WU] + ((size_t)(l * NE + ee) * D) * EW + u * 32;
        naive_dot<32>(F.H + (size_t)tok * D, Wg, EW, D, ag);
        naive_dot<32>(F.H + (size_t)tok * D, Wu, EW, D, au);
#pragma unroll
        for (int j = 0; j < 32; ++j) ag[j] = siluf(ag[j]) * au[j];
        if (valid) store_row_bf16<32>(ACT + (size_t)(be + pos) * EW + u * 32, ag);
    }
}
__device__ __forceinline__ void ph_moe_dn_naive(Frame& F, int l) {
    int cnt[16], base[16]; load_seg(F, l, cnt, base);
    const bf16* ACT = (const bf16*)(F.A + A_ACT); bf16* Y = (bf16*)(F.A + A_Y);
    int tot = 0;
#pragma unroll
    for (int i = 0; i < 16; ++i) tot += (cnt[i] + 63) >> 6;
    for (int it = F.gw; it < tot * 16; it += F.ngw) {
        const int gi_all = it >> 4, u = it & 15;
        int ee = 0, gs = 0;
#pragma unroll
        for (int i = 0, cum = 0; i < 16; ++i) { cum += (cnt[i] + 63) >> 6; if (gi_all >= cum) { gs = cum; ee = i + 1; } }
        int ce = 0, be = 0;
#pragma unroll
        for (int i = 0; i < 16; ++i) if (i == ee) { ce = cnt[i]; be = base[i]; }
        const int pos = (gi_all - gs) * 64 + F.lane; const bool valid = pos < ce;
        const int ent = F.LIST[ee * 16384 + (valid ? pos : 0)];
        float acc[64];
#pragma unroll
        for (int j = 0; j < 64; ++j) acc[j] = 0.f;
        const float* Wd = F.in[I_WD] + ((size_t)(l * NE + ee) * EW) * D + u * 64;
        naive_dot<64>(ACT + (size_t)(be + (valid ? pos : 0)) * EW, Wd, D, EW, acc);
        const float w = F.WT[ent];
#pragma unroll
        for (int j = 0; j < 64; ++j) acc[j] *= w;
        if (valid) store_row_bf16<64>(Y + (size_t)ent * D + u * 64, acc);
    }
}
__device__ __forceinline__ void ph_combine(Frame& F, int l, bool do_norm) {
    const bf16* Y = (const bf16*)(F.A + A_Y);
    for (int r = F.gw; r < NTOK; r += F.ngw) {
        const int b = r >> 12;
        const float* gf = F.MOD + (l * 4 + b) * 6144 + 5 * D;
        f32x4* xr = (f32x4*)(F.out + (size_t)r * D) + F.lane;
        const unsigned long long* ya = (const unsigned long long*)(Y + (size_t)(2 * r) * D) + F.lane; const unsigned long long* yb = (const unsigned long long*)(Y + (size_t)(2 * r + 1) * D) + F.lane;
        f32x4 v[4]; float s = 0.f;
#pragma unroll
        for (int j = 0; j < 4; ++j) {
            const unsigned long long a = ya[64 * j], bq = yb[64 * j];
            const f32x4 yy = { bf2f((unsigned)a & 0xffffu) + bf2f((unsigned)bq & 0xffffu), bf2f(((unsigned)a) >> 16) + bf2f(((unsigned)bq) >> 16),
                               bf2f((unsigned)(a >> 32) & 0xffffu) + bf2f((unsigned)(bq >> 32) & 0xffffu), bf2f((unsigned)(a >> 48)) + bf2f((unsigned)(bq >> 48)) };
            v[j] = xr[64 * j] + ((const f32x4*)gf)[F.lane + 64 * j] * yy;
            xr[64 * j] = v[j];
            s += (v[j].x * v[j].x + v[j].y * v[j].y) + (v[j].z * v[j].z + v[j].w * v[j].w);
        }
        if (do_norm) {
            const float rstd = rsqrtf(wave_sum(s) * (1.f / D) + EPS);
            const float* g = F.in[I_NMG] + (l + 1) * D; const float* sh = F.MOD + ((l + 1) * 4 + b) * 6144; const float* sc = sh + D;
            unsigned long long* o8 = (unsigned long long*)(F.H + (size_t)r * D) + F.lane;
#pragma unroll
            for (int j = 0; j < 4; ++j) {
                const f32x4 gg = ((const f32x4*)g)[F.lane + 64 * j], s1 = ((const f32x4*)sh)[F.lane + 64 * j], s2 = ((const f32x4*)sc)[F.lane + 64 * j];
                const f32x4 y = (v[j] * rstd * gg) * (s2 + 1.f) + s1;
                o8[64 * j] = (unsigned long long)pk2(y.x, y.y) | ((unsigned long long)pk2(y.z, y.w) << 32);
            }
        }
    }
}
__device__ __forceinline__ void ph_sguin_naive(Frame& F) {
    bf16* U = (bf16*)(F.A + A_U); bf16* V = (bf16*)(F.A + A_V);
    for (int it = F.gw; it < 256 * 96; it += F.ngw) {
        const int rg = it / 96, u = it % 96, row = rg * 64 + F.lane;
        float acc[64];
#pragma unroll
        for (int j = 0; j < 64; ++j) acc[j] = 0.f;
        naive_dot<64>(F.H + (size_t)row * D, F.in[I_SWIN] + u * 64, 2 * SGW, D, acc);
        const float* bi = F.in[I_SBIN] + u * 64; float ss = 0.f;
#pragma unroll
        for (int j = 0; j < 64; ++j) { acc[j] = gelu_tanh(acc[j] + bi[j]); ss += acc[j] * acc[j]; }
        if (u < 48) store_row_bf16<64>(U + (size_t)row * SGW + u * 64, acc);
        else { store_row_bf16<64>(V + (size_t)row * SGW + (u - 48) * 64, acc); F.VSS[(size_t)row * 48 + (u - 48)] = ss; }
    }
}
__device__ __forceinline__ void ph_sgumix_naive(Frame& F) {
    bf16* U = (bf16*)(F.A + A_U); const bf16* V = (const bf16*)(F.A + A_V);
    LAS float* rs = (LAS float*)F.lds;
    for (int bc = blockIdx.x; bc < NB * 32; bc += gridDim.x) {
        const size_t row0 = (size_t)bc * 128;
        __syncthreads();
        if (F.tid < 128) { float s = 0.f; for (int j = 0; j < 48; ++j) s += F.VSS[(row0 + F.tid) * 48 + j]; rs[F.tid] = rsqrtf(s * (1.f / SGW) + EPS); }
        __syncthreads();
        for (int o = F.tid; o < 128 * SGW; o += NTHREADS) {
            const int i = o / SGW, c = o % SGW, g = c / 384;
            const float* ws = F.in[I_SWS] + ((size_t)g * 128 + i) * 128;
            float acc = 0.f;
            for (int j = 0; j < 128; ++j) acc += ws[j] * (bf2f(V[(row0 + j) * SGW + c]) * rs[j]);
            const float mixed = acc * F.in[I_SNG][c] + F.in[I_SBS][g * 128 + i];
            const size_t idx = (row0 + i) * SGW + c;
            U[idx] = (bf16)f2bf(bf2f(U[idx]) * mixed);
        }
    }
    __syncthreads();
}

constexpr int NPHASE = 18;
__global__ void __launch_bounds__(NTHREADS, 2) fwd_kernel(Args args) {
    extern __shared__ __attribute__((aligned(16))) unsigned char lds[];
    Frame F;
    F.lds = (LAS unsigned char*)lds;
    F.tid = threadIdx.x; F.lane = F.tid & 63; F.wave = __builtin_amdgcn_readfirstlane(F.tid >> 6);
    F.gw = blockIdx.x * NWAVES + F.wave; F.ngw = gridDim.x * NWAVES;
#pragma unroll
    for (int i = 0; i < 26; ++i) F.in[i] = args.in[i];
    F.out = args.out; F.ws = args.ws;
    F.ctl = (unsigned*)(args.ws + WS_CTL);
    F.MOD = (float*)(args.ws + WS_MOD); F.MODC = F.MOD + 2 * 4 * 6144; F.ROPE = F.MODC + 2048;
    F.LIST = (int*)(args.ws + WS_ROUTE); F.WT = (float*)(args.ws + WS_ROUTE + 1 * MiB);
    F.VSS = (float*)(args.ws + WS_VSS);
    F.H = (bf16*)(args.ws + WS_H); F.A = args.ws + WS_A;
    volatile LAS unsigned* MISC = (volatile LAS unsigned*)(F.lds + MISC_OFF);
    for (int u = F.tid; u < (LDS_BYTES - LDSCTL_OFF) / 4; u += NTHREADS) ((LAS unsigned*)(F.lds + LDSCTL_OFF))[u] = 0u;
    __syncthreads();
    XcdBarrier bar; bar.bar = F.ctl + CW_BAR; bar.x = 0; bar.st = nullptr;
    if (MK_ONE_LAUNCH) bar = xcd_barrier_post(F.ctl + CW_BAR, MISC + 8);
    const int lo = args.ph_lo, hi = args.ph_hi;
#define IN(k) (lo <= (k) && (k) < hi)
#ifdef ONLY_PHASE
#define PHON(k) ((k) == ONLY_PHASE)
#else
#define PHON(k) true
#endif
#define SEAM(k) do { if (IN(k) && IN((k) + 1)) xcd_barrier(bar); } while (0)
    if (PHON(0) && IN(0)) { ph_mod(F); } SEAM(0);
    if (PHON(1) && IN(1)) { ph_norm0(F); } SEAM(1);
    if (PHON(2) && IN(2)) { ph_inproj_naive(F); } SEAM(2);
    if (PHON(3) && IN(3)) { ph_scan_naive(F); ph_na_naive(F); } SEAM(3);
    if (PHON(4) && IN(4)) { ph_retout_naive(F); } SEAM(4);
    if (PHON(5) && IN(5)) { ph_gemm_res_naive(F, (const bf16*)(F.A + A_MIX), D, D, F.in[I_WOUT], F.in[I_X], F.MOD + 2 * D); } SEAM(5);
    if (PHON(6) && IN(6)) { ph_route(F, 0); } SEAM(6);
    if (PHON(7) && IN(7)) { ph_moe_gu_naive(F, 0); } SEAM(7);
    if (PHON(8) && IN(8)) { ph_moe_dn_naive(F, 0); } SEAM(8);
    if (PHON(9) && IN(9)) { ph_combine(F, 0, true); } SEAM(9);
    if (PHON(10) && IN(10)) { ph_sguin_naive(F); } SEAM(10);
    if (PHON(11) && IN(11)) { ph_sgumix_naive(F); } SEAM(11);
    if (PHON(12) && IN(12)) { ph_gemm_res_naive(F, (const bf16*)(F.A + A_U), SGW, SGW, F.in[I_SWOUT], F.out, F.MOD + 4 * 6144 + 2 * D); } SEAM(12);
    if (PHON(13) && IN(13)) { ph_route(F, 1); } SEAM(13);
    if (PHON(14) && IN(14)) { ph_moe_gu_naive(F, 1); } SEAM(14);
    if (PHON(15) && IN(15)) { ph_moe_dn_naive(F, 1); } SEAM(15);
    if (PHON(16) && IN(16)) { ph_combine(F, 1, false); }
#undef IN
#undef SEAM
}

extern "C" void kernel_launch(void* const* d_in, const int* in_sizes, int n_in, void* d_out, int out_size, void* d_ws, size_t ws_size, hipStream_t stream) {
    static int grid = 0;
    if (grid == 0) {
        if (n_in != 26 || out_size != NTOK * D || ws_size < WS_END) { fprintf(stderr, "kernel_launch: unexpected shapes n_in %d out %d ws %zu (need %zu)\n", n_in, out_size, ws_size, (size_t)WS_END); grid = -1; return; }
        int dev = 0, cus = 0, per_cu = 0;
        hipGetDevice(&dev); hipDeviceGetAttribute(&cus, hipDeviceAttributeMultiprocessorCount, dev);
        hipFuncSetAttribute((const void*)fwd_kernel, hipFuncAttributeMaxDynamicSharedMemorySize, LDS_BYTES);
        hipOccupancyMaxActiveBlocksPerMultiprocessor(&per_cu, (const void*)fwd_kernel, NTHREADS, LDS_BYTES);
        (void)hipGetLastError();
        if (per_cu < 1) { fprintf(stderr, "kernel_launch: occupancy query says %d blocks/CU\n", per_cu); per_cu = 1; }
        grid = cus;
    }
    if (grid < 0) return;
    hipMemsetAsync((char*)d_ws + WS_CTL, 0, CTL_ZERO_BYTES, stream);
    Args a{};
    for (int i = 0; i < 26; ++i) a.in[i] = (const float*)d_in[i];
    a.out = (float*)d_out; a.ws = (unsigned char*)d_ws;
#if MK_ONE_LAUNCH
    a.ph_lo = 0; a.ph_hi = 17; a.li = 0;
    void* kargs[] = { &a };
    hipError_t e = hipLaunchCooperativeKernel((const void*)fwd_kernel, dim3(grid), dim3(NTHREADS), kargs, LDS_BYTES, stream);
    if (e != hipSuccess) fprintf(stderr, "cooperative launch failed: %s\n", hipGetErrorString(e));
#else
    for (int p = 0; p < 17; ++p) { a.ph_lo = p; a.ph_hi = p + 1; a.li = p; hipLaunchKernelGGL(fwd_kernel, dim3(grid), dim3(NTHREADS), LDS_BYTES, stream, a); }
#endif
}
```

```cpp
#include <hip/hip_runtime.h>
#include <cstdio>
#include <cstdint>

#ifndef NV_INPROJ
#define NV_INPROJ 0
#endif
#ifndef NV_OUTPROJ
#define NV_OUTPROJ 0
#endif
#ifndef NV_MOEGU
#define NV_MOEGU 0
#endif
#ifndef NV_MOEDN
#define NV_MOEDN 0
#endif
#ifndef NV_SGUIN
#define NV_SGUIN 0
#endif
#ifndef NV_SGUOUT
#define NV_SGUOUT 0
#endif
#ifndef MK_ONE_LAUNCH
#define MK_ONE_LAUNCH 1
#endif

constexpr int D = 1024, NB = 4, SEQ = 4096, NTOK = NB * SEQ, CTXL = 256, NCTX = NB * CTXL, NROW = NTOK + NCTX;
constexpr int HD = 64, NH = 8, HW = NH * HD;
constexpr int ABW = 3584;
constexpr int SGW = 3072;
constexpr int NE = 16, EW = 512;
constexpr float EPS = 1e-6f;
constexpr int NWAVES = 8, NTHREADS = 512;

constexpr size_t MiB = 1u << 20;
constexpr size_t WS_CTL = 0, CTL_ZERO_BYTES = 1 * MiB;
constexpr size_t WS_MOD = 1 * MiB;
constexpr size_t WS_ROUTE = 2 * MiB;
constexpr size_t WS_VSS = 4 * MiB;
constexpr size_t WS_WB = 8 * MiB;
constexpr size_t WS_H = 132 * MiB;
constexpr size_t WS_A = 166 * MiB;
constexpr size_t WS_END = 358 * MiB;
constexpr size_t A_RK = 0, A_RV = 17 * MiB, A_NK = 34 * MiB, A_NV = 51 * MiB, A_RQ = 68 * MiB, A_GT = 84 * MiB, A_NQ = 100 * MiB, A_MIX = 116 * MiB, A_SST = 148 * MiB;
constexpr size_t A_ACT = 0, A_Y = 36 * MiB;
constexpr size_t A_U = 0, A_V = 96 * MiB;

constexpr int CW_BAR = 4096;
constexpr int CW_CNT = 8192;

typedef unsigned short bf16;
typedef unsigned u32x4 __attribute__((ext_vector_type(4)));
typedef float f32x4 __attribute__((ext_vector_type(4)));
#define LAS __attribute__((address_space(3)))
#define RLX_AGENT __ATOMIC_RELAXED, __HIP_MEMORY_SCOPE_AGENT

__device__ __forceinline__ unsigned f2bf(float f) { unsigned u = __builtin_bit_cast(unsigned, f); return (u + 0x7fffu + ((u >> 16) & 1u)) >> 16; }
__device__ __forceinline__ float bf2f(unsigned h) { return __builtin_bit_cast(float, h << 16); }
__device__ __forceinline__ unsigned pk2(float lo, float hi) { return f2bf(lo) | (f2bf(hi) << 16); }
__device__ __forceinline__ float siluf(float v) { return v / (1.f + __expf(-v)); }
__device__ __forceinline__ float gelu_tanh(float v) { const float u = 0.7978845608028654f * (v + 0.044715f * v * v * v); return 0.5f * v * (1.f + tanhf(u)); }
__device__ __forceinline__ float wave_sum(float v) {
#pragma unroll
    for (int o = 1; o < 64; o <<= 1) v += __shfl_xor(v, o);
    return v;
}

#define XB_TMO      128
#define XB_XCNT(j)  (256  + 64 * (j))
#define XB_XSUB(j)  (1280 + 64 * (j))
#define XB_XGEN(j)  (2304 + 64 * (j))
#define XB_TOP      3328
#define XB_TOPGEN   3392
#define XCD_BAR_WORDS 3456
#define XB_SPIN_CAP (1u << 18)
__device__ __forceinline__ unsigned xb_ld(unsigned* p)              { return __hip_atomic_load(p, __ATOMIC_RELAXED, __HIP_MEMORY_SCOPE_AGENT); }
__device__ __forceinline__ unsigned xb_add(unsigned* p, unsigned v) { return __hip_atomic_fetch_add(p, v, __ATOMIC_RELAXED, __HIP_MEMORY_SCOPE_AGENT); }
__device__ __forceinline__ unsigned xb_xcc_id() { return (unsigned)__builtin_amdgcn_s_getreg((3 << 11) | 20) & 0xFu; }
#define XB_SPIN(cond, bar) do { unsigned _sp = 0; while (cond) { __builtin_amdgcn_s_sleep(1); \
    if ((++_sp & 255u) == 0u) { if (xb_ld(&(bar)[XB_TMO])) break; if (_sp > XB_SPIN_CAP) { atomicAdd(&(bar)[XB_TMO], 1u); break; } } } } while (0)
struct XcdBarrier { unsigned* bar; unsigned x; volatile LAS unsigned* st; };
__device__ __forceinline__ XcdBarrier xcd_barrier_post(unsigned* bar, volatile LAS unsigned* st) {
    XcdBarrier b; b.bar = bar; b.x = xb_xcc_id(); b.st = st;
    if (threadIdx.x == 0) (void)xb_add(&bar[XB_XCNT(b.x)], 1u);
    return b;
}
__device__ __forceinline__ void xcd_barrier_complete(unsigned* bar, unsigned x, unsigned& nloc, unsigned& nx) {
    const unsigned G = gridDim.x * gridDim.y * gridDim.z;
    unsigned sum, cnt, mine, sp = 0u;
    for (;;) {
        sum = 0u; cnt = 0u; mine = 0u;
#pragma unroll
        for (unsigned j = 0; j < 16; ++j) { const unsigned c = xb_ld(&bar[XB_XCNT(j)]); sum += c; cnt += (c > 0u) ? 1u : 0u; mine = (j == x) ? c : mine; }
        if (sum == G) break;
        __builtin_amdgcn_s_sleep(1);
        if ((++sp & 255u) == 0u) { if (xb_ld(&bar[XB_TMO])) break; if (sp > XB_SPIN_CAP) { atomicAdd(&bar[XB_TMO], 1u); break; } }
    }
    nloc = mine > 0u ? mine : 1u; nx = cnt > 0u ? cnt : 1u;
}
__device__ __forceinline__ void xcd_barrier(const XcdBarrier& b) {
    asm volatile("s_waitcnt vmcnt(0)" ::: "memory");
    __syncthreads();
    if (threadIdx.x == 0) {
        unsigned* bar = b.bar;
        __builtin_amdgcn_s_waitcnt(0);
        unsigned nloc = b.st[0], nx = b.st[1];
        if (nloc == 0u) { xcd_barrier_complete(bar, b.x, nloc, nx); b.st[0] = nloc; b.st[1] = nx; }
        const unsigned old = xb_add(&bar[XB_XSUB(b.x)], 1u);
        const unsigned gen = old / nloc;
        if (old + 1u == (gen + 1u) * nloc) {
            __builtin_amdgcn_fence(__ATOMIC_RELEASE, "agent");
            asm volatile("s_waitcnt vmcnt(0)" ::: "memory");
            const unsigned og = xb_add(&bar[XB_TOP], 1u);
            const unsigned tg = og / nx;
            if (og + 1u == (tg + 1u) * nx) xb_add(&bar[XB_TOPGEN], 1u);
            else XB_SPIN(xb_ld(&bar[XB_TOPGEN]) == tg, bar);
            __builtin_amdgcn_fence(__ATOMIC_ACQUIRE, "agent");
            xb_add(&bar[XB_XGEN(b.x)], 1u);
            asm volatile("s_waitcnt vmcnt(0)" ::: "memory");
        } else {
            XB_SPIN(xb_ld(&bar[XB_XGEN(b.x)]) == gen, bar);
            __builtin_amdgcn_fence(__ATOMIC_ACQUIRE, "agent");
            asm volatile("s_waitcnt vmcnt(0)" ::: "memory");
        }
    }
    __syncthreads();
}

constexpr int LDS_BYTES = 147456;
constexpr int LDSCTL_OFF = 131072, MISC_OFF = LDSCTL_OFF + 320;

struct Args { const float* in[26]; float* out; unsigned char* ws; int ph_lo, ph_hi, li, pad; };

struct Frame {
    LAS unsigned char* lds;
    int tid, lane, wave, gw, ngw;
    const float* in[26];
    float* out; unsigned char* ws;
    unsigned* ctl;
    float *MOD, *MODC, *ROPE;
    int* LIST; float* WT; float* VSS;
    bf16* H; unsigned char* A;
};
enum { I_X = 0, I_C, I_CTX, I_CCTX, I_ADAW, I_ADAB, I_NMG, I_NFG, I_RW, I_RB, I_WG, I_WU, I_WD, I_WIN, I_WOUT, I_RDEC, I_RNG, I_QG, I_KG, I_RPB, I_SWIN, I_SBIN, I_SNG, I_SWS, I_SBS, I_SWOUT };

template <int NC> __device__ __forceinline__ void naive_dot(const bf16* arow, const float* W, int ldw, int K, float (&acc)[NC]) {
#pragma unroll 1
    for (int k = 0; k < K; k += 2) {
        const unsigned a2 = *(const unsigned*)(arow + k);
        const float a0 = bf2f(a2 & 0xffffu), a1 = bf2f(a2 >> 16);
        const float* w = W + (size_t)k * ldw;
#pragma unroll
        for (int j = 0; j < NC; ++j) acc[j] = __builtin_fmaf(a0, w[j], acc[j]);
        asm volatile("" ::: "memory");
        w += ldw;
#pragma unroll
        for (int j = 0; j < NC; ++j) acc[j] = __builtin_fmaf(a1, w[j], acc[j]);
        asm volatile("" ::: "memory");
    }
}
template <int NC> __device__ __forceinline__ void store_row_bf16(bf16* dst, const float (&v)[NC]) {
#pragma unroll
    for (int j = 0; j < NC; j += 8) { u32x4 w; w.x = pk2(v[j], v[j + 1]); w.y = pk2(v[j + 2], v[j + 3]); w.z = pk2(v[j + 4], v[j + 5]); w.w = pk2(v[j + 6], v[j + 7]); *(u32x4*)(dst + j) = w; }
}

__device__ __forceinline__ void ph_mod(Frame& F) {
    const int gt = F.gw * 64 + F.lane, ngt = F.ngw * 64;
    for (int it = gt; it < 2 * 6144; it += ngt) {
        const int l = it / 6144, n = it % 6144;
        const float* W = F.in[I_ADAW] + (size_t)l * D * 6144 + n;
        float a0 = 0.f, a1 = 0.f, a2 = 0.f, a3 = 0.f, a4 = 0.f;
        const float* c = F.in[I_C]; const float* cc = F.in[I_CCTX];
        for (int k = 0; k < D; ++k) { const float w = W[(size_t)k * 6144];
            a0 += siluf(c[k]) * w; a1 += siluf(c[D + k]) * w; a2 += siluf(c[2 * D + k]) * w; a3 += siluf(c[3 * D + k]) * w; a4 += siluf(cc[k]) * w; }
        const float bb = F.in[I_ADAB][l * 6144 + n];
        F.MOD[(l * 4 + 0) * 6144 + n] = a0 + bb; F.MOD[(l * 4 + 1) * 6144 + n] = a1 + bb; F.MOD[(l * 4 + 2) * 6144 + n] = a2 + bb; F.MOD[(l * 4 + 3) * 6144 + n] = a3 + bb;
        if (l == 0 && n < 2048) F.MODC[n] = a4 + bb;
    }
    for (int it = gt; it < 64 * 16; it += ngt) {
        const int pos = it >> 4, j = it & 15;
        const float inv = powf(10000.0f, -(float)j / 16.0f);
        const float ang = (float)pos * inv;
        F.ROPE[it * 2] = cosf(ang); F.ROPE[it * 2 + 1] = sinf(ang);
    }
}

__device__ __forceinline__ void norm_row(Frame& F, const float* xrow, const float* g, const float* sh, const float* sc, bf16* hrow) {
    const f32x4* xr = (const f32x4*)xrow + F.lane;
    f32x4 v[4]; float s = 0.f;
#pragma unroll
    for (int j = 0; j < 4; ++j) { v[j] = xr[64 * j]; s += (v[j].x * v[j].x + v[j].y * v[j].y) + (v[j].z * v[j].z + v[j].w * v[j].w); }
    const float rstd = rsqrtf(wave_sum(s) * (1.f / D) + EPS);
    unsigned long long* o8 = (unsigned long long*)hrow + F.lane;
#pragma unroll
    for (int j = 0; j < 4; ++j) {
        const f32x4 gg = ((const f32x4*)g)[F.lane + 64 * j], s1 = ((const f32x4*)sh)[F.lane + 64 * j], s2 = ((const f32x4*)sc)[F.lane + 64 * j];
        const f32x4 y = (v[j] * rstd * gg) * (s2 + 1.f) + s1;
        o8[64 * j] = (unsigned long long)pk2(y.x, y.y) | ((unsigned long long)pk2(y.z, y.w) << 32);
    }
}
__device__ __forceinline__ void ph_norm0(Frame& F) {
    for (int r = F.gw; r < NROW; r += F.ngw) {
        if (r < NTOK) { const int b = r >> 12; norm_row(F, F.in[I_X] + (size_t)r * D, F.in[I_NMG], F.MOD + (0 * 4 + b) * 6144, F.MOD + (0 * 4 + b) * 6144 + D, F.H + (size_t)r * D); }
        else norm_row(F, F.in[I_CTX] + (size_t)(r - NTOK) * D, F.in[I_NMG], F.MODC, F.MODC + D, F.H + (size_t)r * D);
    }
}

__device__ __forceinline__ void ph_inproj_naive(Frame& F) {
    const float* W = F.in[I_WIN];
    for (int it = F.gw; it < 272 * 56; it += F.ngw) {
        const int rg = it / 56, u = it % 56; if (rg >= 256 && u >= 32) continue;
        const int row = rg * 64 + F.lane;
        float acc[64];
#pragma unroll
        for (int j = 0; j < 64; ++j) acc[j] = 0.f;
        naive_dot<64>(F.H + (size_t)row * D, W + u * 64, ABW, D, acc);
        const int t = u >> 3, h = u & 7;
        if ((t == 0 || t == 4) && row < NTOK) {
            const int tt = row & 4095, pr = tt >> 6, pc = tt & 63;
#pragma unroll
            for (int j = 0; j < 16; ++j) {
                const float c1 = F.ROPE[(pr * 16 + j) * 2], s1 = F.ROPE[(pr * 16 + j) * 2 + 1], c2 = F.ROPE[(pc * 16 + j) * 2], s2 = F.ROPE[(pc * 16 + j) * 2 + 1];
                const float a = acc[j], b = acc[j + 16], c = acc[32 + j], d = acc[48 + j];
                acc[j] = a * c1 - b * s1; acc[j + 16] = a * s1 + b * c1; acc[32 + j] = c * c2 - d * s2; acc[48 + j] = c * s2 + d * c2;
            }
        }
        if (t == 0) {
#pragma unroll
            for (int j = 0; j < 64; ++j) acc[j] *= 0.125f;
        }
        if (t == 2 || t == 6) {
            float ss = 0.f;
#pragma unroll
            for (int j = 0; j < 64; ++j) ss += acc[j] * acc[j];
            const float r = rsqrtf(ss * (1.f / 64.f) + EPS) * (t == 6 ? 0.125f : 1.f);
            const float* g = t == 2 ? F.in[I_KG] : F.in[I_QG];
#pragma unroll
            for (int j = 0; j < 64; ++j) acc[j] = acc[j] * r * g[j];
        }
        if (t == 5) {
#pragma unroll
            for (int j = 0; j < 64; ++j) acc[j] = siluf(acc[j]);
        }
        const size_t off_t = t < 4 ? (size_t)t * 17 * MiB : (size_t)(68 + (t - 4) * 16) * MiB;
        bf16* dst = (bf16*)(F.A + off_t) + (size_t)row * HW + h * 64;
        store_row_bf16<64>(dst, acc);
    }
}

__device__ __forceinline__ float ret_gamma_log(Frame& F, int dir, int h) {
    const float th = F.in[I_RDEC][dir * 8 + h];
    return -(th > 0.f ? th + log1pf(__expf(-th)) : log1pf(__expf(th)));
}
__device__ __forceinline__ void ph_scan_naive(Frame& F) {
    const bf16* RK = (const bf16*)(F.A + A_RK); const bf16* RV = (const bf16*)(F.A + A_RV); bf16* SST = (bf16*)(F.A + A_SST);
    const int gt = F.gw * 64 + F.lane, ngt = F.ngw * 64;
    for (int it = gt; it < 64 * 4096; it += ngt) {
        const int bhd = it >> 12, ed = it & 4095, e = ed >> 6, d = ed & 63;
        const int dir = bhd & 1, h = (bhd >> 1) & 7, b = bhd >> 4;
        const float gam = __expf(ret_gamma_log(F, dir, h));
        float S = 0.f;
        bf16* sst = SST + ((size_t)((b * 8 + h) * 2 + dir) * 32) * 4096 + ed;
        for (int n = 0; n < CTXL; ++n) { const int nn = dir ? (CTXL - 1 - n) : n; const size_t row = NTOK + b * CTXL + nn;
            S = gam * S + bf2f(RK[row * HW + h * 64 + d]) * bf2f(RV[row * HW + h * 64 + e]); }
        for (int n = 0; n < SEQ; ++n) { const int t = dir ? (SEQ - 1 - n) : n; const size_t row = (size_t)b * SEQ + t;
            if ((n & 127) == 0) sst[(size_t)(t >> 7) * 4096] = (bf16)f2bf(S);
            S = gam * S + bf2f(RK[row * HW + h * 64 + d]) * bf2f(RV[row * HW + h * 64 + e]); }
    }
}
__device__ __forceinline__ void ph_na_naive(Frame& F) {
    const bf16* NK = (const bf16*)(F.A + A_NK); const bf16* NV = (const bf16*)(F.A + A_NV); const bf16* NQ = (const bf16*)(F.A + A_NQ); bf16* MIX = (bf16*)(F.A + A_MIX);
    const int gt = F.gw * 64 + F.lane, ngt = F.ngw * 64;
    for (int it = gt; it < NB * NH * SEQ; it += ngt) {
        const int t = it & 4095, h = (it >> 12) & 7, b = it >> 15;
        const int r = t >> 6, c = t & 63;
        int r0 = r - 4; r0 = r0 < 0 ? 0 : (r0 > 56 ? 56 : r0); int c0 = c - 8; c0 = c0 < 0 ? 0 : (c0 > 48 ? 48 : c0);
        const size_t qrow = (size_t)b * SEQ + t;
        unsigned q[32]; float o[64];
#pragma unroll
        for (int j = 0; j < 32; ++j) q[j] = *(const unsigned*)(NQ + qrow * HW + h * 64 + 2 * j);
#pragma unroll
        for (int j = 0; j < 64; ++j) o[j] = 0.f;
        float m = -1e30f, l = 0.f;
        const float* rpb = F.in[I_RPB] + h * 15 * 31;
#pragma unroll 1
        for (int kk = 0; kk < 384; ++kk) {
            size_t krow; float bias = 0.f;
            if (kk < 128) { const int kr = r0 + (kk >> 4), kc = c0 + (kk & 15); krow = (size_t)b * SEQ + kr * 64 + kc; bias = rpb[(kr - r + 7) * 31 + (kc - c + 15)]; }
            else krow = NTOK + b * CTXL + (kk - 128);
            float s = 0.f;
#pragma unroll
            for (int j = 0; j < 64; j += 2) { const unsigned w = *(const unsigned*)(NK + krow * HW + h * 64 + j); s += bf2f(q[j >> 1] & 0xffffu) * bf2f(w & 0xffffu) + bf2f(q[j >> 1] >> 16) * bf2f(w >> 16); }
            s += bias;
            asm volatile("" ::: "memory");
            const float mn = fmaxf(m, s), al = __expf(m - mn), p = __expf(s - mn);
            l = l * al + p; m = mn;
#pragma unroll
            for (int j = 0; j < 64; j += 2) { const unsigned w = *(const unsigned*)(NV + krow * HW + h * 64 + j); o[j] = o[j] * al + p * bf2f(w & 0xffffu); o[j + 1] = o[j + 1] * al + p * bf2f(w >> 16); }
        }
        const float il = 1.f / l;
#pragma unroll
        for (int j = 0; j < 64; ++j) o[j] *= il;
        store_row_bf16<64>(MIX + qrow * D + 512 + h * 64, o);
    }
}
__device__ __forceinline__ void ph_retout_naive(Frame& F) {
    const bf16* RK = (const bf16*)(F.A + A_RK); const bf16* RV = (const bf16*)(F.A + A_RV); const bf16* RQ = (const bf16*)(F.A + A_RQ); const bf16* GT = (const bf16*)(F.A + A_GT);
    const bf16* SST = (const bf16*)(F.A + A_SST); bf16* MIX = (bf16*)(F.A + A_MIX);
    const int gt = F.gw * 64 + F.lane, ngt = F.ngw * 64;
    for (int it = gt; it < NB * NH * SEQ * 2; it += ngt) {
        const int hf = it & 1, t = (it >> 1) & 4095, h = (it >> 13) & 7, b = it >> 16;
        const int i = t & 127, ch = t >> 7;
        const size_t qrow = (size_t)b * SEQ + t;
        const float lgf = ret_gamma_log(F, 0, h), lgb = ret_gamma_log(F, 1, h);
        unsigned q[32]; float o[32];
#pragma unroll
        for (int j = 0; j < 32; ++j) q[j] = *(const unsigned*)(RQ + qrow * HW + h * 64 + 2 * j);
#pragma unroll
        for (int j = 0; j < 32; ++j) o[j] = 0.f;
#pragma unroll 1
        for (int jj = 0; jj < 128; ++jj) {
            const size_t krow = (size_t)b * SEQ + ch * 128 + jj;
            float s = 0.f;
#pragma unroll
            for (int j = 0; j < 64; j += 2) { const unsigned w = *(const unsigned*)(RK + krow * HW + h * 64 + j); s += bf2f(q[j >> 1] & 0xffffu) * bf2f(w & 0xffffu) + bf2f(q[j >> 1] >> 16) * bf2f(w >> 16); }
            asm volatile("" ::: "memory");
            const float wgt = jj < i ? __expf(lgf * (float)(i - jj)) : (jj > i ? __expf(lgb * (float)(jj - i)) : 2.f);
            s *= wgt;
#pragma unroll
            for (int j = 0; j < 32; j += 2) { const unsigned w = *(const unsigned*)(RV + krow * HW + h * 64 + hf * 32 + j); o[j] += s * bf2f(w & 0xffffu); o[j + 1] += s * bf2f(w >> 16); }
            asm volatile("" ::: "memory");
        }
        const float qf = __expf(lgf * (float)(i + 1)), qb = __expf(lgb * (float)(128 - i));
        const bf16* Sf = SST + ((size_t)((b * 8 + h) * 2 + 0) * 32 + ch) * 4096 + hf * 32 * 64; const bf16* Sb = SST + ((size_t)((b * 8 + h) * 2 + 1) * 32 + ch) * 4096 + hf * 32 * 64;
#pragma unroll 1
        for (int d = 0; d < 64; ++d) {
            const float qd = bf2f(RQ[qrow * HW + h * 64 + d]); const float qfd = qf * qd, qbd = qb * qd;
#pragma unroll
            for (int e = 0; e < 32; ++e) o[e] += qfd * bf2f(Sf[e * 64 + d]) + qbd * bf2f(Sb[e * 64 + d]);
            asm volatile("" ::: "memory");
        }
        float ss = 0.f;
#pragma unroll
        for (int j = 0; j < 32; ++j) ss += o[j] * o[j];
        ss += __shfl_xor(ss, 1);
        const float rs = rsqrtf(ss * (1.f / 64.f) + EPS);
        const float* g = F.in[I_RNG] + hf * 32;
#pragma unroll
        for (int j = 0; j < 32; j += 2) { const unsigned w = *(const unsigned*)(GT + qrow * HW + h * 64 + hf * 32 + j); o[j] = o[j] * rs * g[j] * bf2f(w & 0xffffu); o[j + 1] = o[j + 1] * rs * g[j + 1] * bf2f(w >> 16); }
        store_row_bf16<32>(MIX + qrow * D + h * 64 + hf * 32, o);
    }
}
__device__ __forceinline__ void ph_gemm_res_naive(Frame& F, const bf16* A, int lda, int K, const float* W, const float* base, const float* gate  ) {
    for (int it = F.gw; it < 256 * 16; it += F.ngw) {
        const int rg = it >> 4, u = it & 15, row = rg * 64 + F.lane, b = row >> 12;
        float acc[64];
#pragma unroll
        for (int j = 0; j < 64; ++j) acc[j] = 0.f;
        naive_dot<64>(A + (size_t)row * lda, W + u * 64, D, K, acc);
        const float* gp = gate + b * 6144 + u * 64; const float* bp = base + (size_t)row * D + u * 64; float* op = F.out + (size_t)row * D + u * 64;
#pragma unroll
        for (int j = 0; j < 64; j += 4) { const f32x4 bv = *(const f32x4*)(bp + j), gv = *(const f32x4*)(gp + j);
            *(f32x4*)(op + j) = bv + gv * (f32x4){acc[j], acc[j + 1], acc[j + 2], acc[j + 3]}; }
    }
}
__device__ __forceinline__ void ph_route(Frame& F, int l) {
    LAS float* rw = (LAS float*)F.lds;
    for (int i = F.tid; i < D * NE; i += NTHREADS) rw[i] = F.in[I_RW][i];
    __syncthreads();
    unsigned* cnt = F.ctl + CW_CNT + l * 1024;
    for (int r = F.gw; r < NTOK; r += F.ngw) {
        const int b = r >> 12;
        const float* g = F.in[I_NFG] + l * D; const float* sh = F.MOD + (l * 4 + b) * 6144 + 3 * D; const float* sc = F.MOD + (l * 4 + b) * 6144 + 4 * D;
        const f32x4* xr = (const f32x4*)(F.out + (size_t)r * D) + F.lane;
        f32x4 v[4]; float s = 0.f;
#pragma unroll
        for (int j = 0; j < 4; ++j) { v[j] = xr[64 * j]; s += (v[j].x * v[j].x + v[j].y * v[j].y) + (v[j].z * v[j].z + v[j].w * v[j].w); }
        const float rstd = rsqrtf(wave_sum(s) * (1.f / D) + EPS);
        unsigned long long* o8 = (unsigned long long*)(F.H + (size_t)r * D) + F.lane;
        float lg[16];
#pragma unroll
        for (int e = 0; e < 16; ++e) lg[e] = 0.f;
#pragma unroll
        for (int j = 0; j < 4; ++j) {
            const f32x4 gg = ((const f32x4*)g)[F.lane + 64 * j], s1 = ((const f32x4*)sh)[F.lane + 64 * j], s2 = ((const f32x4*)sc)[F.lane + 64 * j];
            const f32x4 y = (v[j] * rstd * gg) * (s2 + 1.f) + s1;
            o8[64 * j] = (unsigned long long)pk2(y.x, y.y) | ((unsigned long long)pk2(y.z, y.w) << 32);
            const int k0 = (F.lane + 64 * j) * 4;
#pragma unroll
            for (int i = 0; i < 4; ++i) { const float yv = y[i];
#pragma unroll
                for (int e4 = 0; e4 < 4; ++e4) { const f32x4 w = *(const LAS f32x4*)(rw + (k0 + i) * 16 + e4 * 4);
                    lg[e4 * 4] += yv * w.x; lg[e4 * 4 + 1] += yv * w.y; lg[e4 * 4 + 2] += yv * w.z; lg[e4 * 4 + 3] += yv * w.w; }
                asm volatile("" ::: "memory"); }
        }
#pragma unroll
        for (int e = 0; e < 16; ++e) lg[e] = wave_sum(lg[e]);
        if (F.lane == 0) {
            float aff[16], sel[16];
#pragma unroll
            for (int e = 0; e < 16; ++e) { aff[e] = 1.f / (1.f + __expf(-lg[e])); sel[e] = aff[e] + F.in[I_RB][e]; }
            int best = 0; float bs = -1e30f;
#pragma unroll
            for (int gI = 0; gI < 4; ++gI) {
                float m1 = -1e30f, m2 = -1e30f;
#pragma unroll
                for (int i = 0; i < 4; ++i) { const float x = sel[gI * 4 + i]; if (x > m1) { m2 = m1; m1 = x; } else if (x > m2) m2 = x; }
                const float sc2 = m1 + m2; if (sc2 > bs) { bs = sc2; best = gI; }
            }
            int i1 = 0, i2 = 0; float m1 = -1e30f, m2 = -1e30f, a1 = 0.f, a2 = 0.f;
#pragma unroll
            for (int gI = 0; gI < 4; ++gI)
#pragma unroll
                for (int i = 0; i < 4; ++i) { if (gI == best) { const float x = sel[gI * 4 + i]; const float a = aff[gI * 4 + i]; const int id = gI * 4 + i;
                    if (x > m1) { m2 = m1; i2 = i1; a2 = a1; m1 = x; i1 = id; a1 = a; } else if (x > m2) { m2 = x; i2 = id; a2 = a; } } }
            const float inv = 1.f / (a1 + a2);
            const unsigned p1 = __hip_atomic_fetch_add(cnt + i1 * 64, 1u, RLX_AGENT), p2 = __hip_atomic_fetch_add(cnt + i2 * 64, 1u, RLX_AGENT);
            F.LIST[i1 * 16384 + p1] = 2 * r; F.LIST[i2 * 16384 + p2] = 2 * r + 1;
            F.WT[2 * r] = a1 * inv; F.WT[2 * r + 1] = a2 * inv;
        }
    }
    __syncthreads();
}
struct Seg { int cnt[16]; int base[16]; };
__device__ __forceinline__ void load_seg(Frame& F, int l, int (&cnt)[16], int (&base)[16]) {
    int acc = 0;
#pragma unroll
    for (int e = 0; e < 16; ++e) { cnt[e] = (int)__hip_atomic_load(F.ctl + CW_CNT + l * 1024 + e * 64, RLX_AGENT); base[e] = acc; acc += (cnt[e] + 255) & ~255; }
}
__device__ __forceinline__ void ph_moe_gu_naive(Frame& F, int l) {
    int cnt[16], base[16]; load_seg(F, l, cnt, base);
    bf16* ACT = (bf16*)(F.A + A_ACT);
    int tot = 0;
#pragma unroll
    for (int i = 0; i < 16; ++i) tot += (cnt[i] + 63) >> 6;
    for (int it = F.gw; it < tot * 16; it += F.ngw) {
        const int gi_all = it >> 4, u = it & 15;
        int ee = 0, gs = 0;
#pragma unroll
        for (int i = 0, cum = 0; i < 16; ++i) { cum += (cnt[i] + 63) >> 6; if (gi_all >= cum) { gs = cum; ee = i + 1; } }
        int ce = 0, be = 0;
#pragma unroll
        for (int i = 0; i < 16; ++i) if (i == ee) { ce = cnt[i]; be = base[i]; }
        const int pos = (gi_all - gs) * 64 + F.lane; const bool valid = pos < ce;
        const int ent = F.LIST[ee * 16384 + (valid ? pos : 0)]; const int tok = ent >> 1;
        float ag[32], au[32];
#pragma unroll
        for (int j = 0; j < 32; ++j) { ag[j] = 0.f; au[j] = 0.f; }
        const float* Wg = F.in[I_WG] + ((size_t)(l * NE + ee) * D) * EW + u * 32; const float* Wu = F.in[I_WU] + ((size_t)(l * NE + ee) * D) * EW + u * 32;
        naive_dot<32>(F.H + (size_t)tok * D, Wg, EW, D, ag);
        naive_dot<32>(F.H + (size_t)tok * D, Wu, EW, D, au);
#pragma unroll
        for (int j = 0; j < 32; ++j) ag[j] = siluf(ag[j]) * au[j];
        if (valid) store_row_bf16<32>(ACT + (size_t)(be + pos) * EW + u * 32, ag);
    }
}
__device__ __forceinline__ void ph_moe_dn_naive(Frame& F, int l) {
    int cnt[16], base[16]; load_seg(F, l, cnt, base);
    const bf16* ACT = (const bf16*)(F.A + A_ACT); bf16* Y = (bf16*)(F.A + A_Y);
    int tot = 0;
#pragma unroll
    for (int i = 0; i < 16; ++i) tot += (cnt[i] + 63) >> 6;
    for (int it = F.gw; it < tot * 16; it += F.ngw) {
        const int gi_all = it >> 4, u = it & 15;
        int ee = 0, gs = 0;
#pragma unroll
        for (int i = 0, cum = 0; i < 16; ++i) { cum += (cnt[i] + 63) >> 6; if (gi_all >= cum) { gs = cum; ee = i + 1; } }
        int ce = 0, be = 0;
#pragma unroll
        for (int i = 0; i < 16; ++i) if (i == ee) { ce = cnt[i]; be = base[i]; }
        const int pos = (gi_all - gs) * 64 + F.lane; const bool valid = pos < ce;
        const int ent = F.LIST[ee * 16384 + (valid ? pos : 0)];
        float acc[64];
#pragma unroll
        for (int j = 0; j < 64; ++j) acc[j] = 0.f;
        const float* Wd = F.in[I_WD] + ((size_t)(l * NE + ee) * EW) * D + u * 64;
        naive_dot<64>(ACT + (size_t)(be + (valid ? pos : 0)) * EW, Wd, D, EW, acc);
        const float w = F.WT[ent];
#pragma unroll
        for (int j = 0; j < 64; ++j) acc[j] *= w;
        if (valid) store_row_bf16<64>(Y + (size_t)ent * D + u * 64, acc);
    }
}
__device__ __forceinline__ void ph_combine(Frame& F, int l, bool do_norm) {
    const bf16* Y = (const bf16*)(F.A + A_Y);
    for (int r = F.gw; r < NTOK; r += F.ngw) {
        const int b = r >> 12;
        const float* gf = F.MOD + (l * 4 + b) * 6144 + 5 * D;
        f32x4* xr = (f32x4*)(F.out + (size_t)r * D) + F.lane;
        const unsigned long long* ya = (const unsigned long long*)(Y + (size_t)(2 * r) * D) + F.lane; const unsigned long long* yb = (const unsigned long long*)(Y + (size_t)(2 * r + 1) * D) + F.lane;
        f32x4 v[4]; float s = 0.f;
#pragma unroll
        for (int j = 0; j < 4; ++j) {
            const unsigned long long a = ya[64 * j], bq = yb[64 * j];
            const f32x4 yy = { bf2f((unsigned)a & 0xffffu) + bf2f((unsigned)bq & 0xffffu), bf2f(((unsigned)a) >> 16) + bf2f(((unsigned)bq) >> 16),
                               bf2f((unsigned)(a >> 32) & 0xffffu) + bf2f((unsigned)(bq >> 32) & 0xffffu), bf2f((unsigned)(a >> 48)) + bf2f((unsigned)(bq >> 48)) };
            v[j] = xr[64 * j] + ((const f32x4*)gf)[F.lane + 64 * j] * yy;
            xr[64 * j] = v[j];
            s += (v[j].x * v[j].x + v[j].y * v[j].y) + (v[j].z * v[j].z + v[j].w * v[j].w);
        }
        if (do_norm) {
            const float rstd = rsqrtf(wave_sum(s) * (1.f / D) + EPS);
            const float* g = F.in[I_NMG] + (l + 1) * D; const float* sh = F.MOD + ((l + 1) * 4 + b) * 6144; const float* sc = sh + D;
            unsigned long long* o8 = (unsigned long long*)(F.H + (size_t)r * D) + F.lane;
#pragma unroll
            for (int j = 0; j < 4; ++j) {
                const f32x4 gg = ((const f32x4*)g)[F.lane + 64 * j], s1 = ((const f32x4*)sh)[F.lane + 64 * j], s2 = ((const f32x4*)sc)[F.lane + 64 * j];
                const f32x4 y = (v[j] * rstd * gg) * (s2 + 1.f) + s1;
                o8[64 * j] = (unsigned long long)pk2(y.x, y.y) | ((unsigned long long)pk2(y.z, y.w) << 32);
            }
        }
    }
}
__device__ __forceinline__ void ph_sguin_naive(Frame& F) {
    bf16* U = (bf16*)(F.A + A_U); bf16* V = (bf16*)(F.A + A_V);
    for (int it = F.gw; it < 256 * 96; it += F.ngw) {
        const int rg = it / 96, u = it % 96, row = rg * 64 + F.lane;
        float acc[64];
#pragma unroll
        for (int j = 0; j < 64; ++j) acc[j] = 0.f;
        naive_dot<64>(F.H + (size_t)row * D, F.in[I_SWIN] + u * 64, 2 * SGW, D, acc);
        const float* bi = F.in[I_SBIN] + u * 64; float ss = 0.f;
#pragma unroll
        for (int j = 0; j < 64; ++j) { acc[j] = gelu_tanh(acc[j] + bi[j]); ss += acc[j] * acc[j]; }
        if (u < 48) store_row_bf16<64>(U + (size_t)row * SGW + u * 64, acc);
        else { store_row_bf16<64>(V + (size_t)row * SGW + (u - 48) * 64, acc); F.VSS[(size_t)row * 48 + (u - 48)] = ss; }
    }
}
__device__ __forceinline__ void ph_sgumix_naive(Frame& F) {
    bf16* U = (bf16*)(F.A + A_U); const bf16* V = (const bf16*)(F.A + A_V);
    LAS float* rs = (LAS float*)F.lds;
    for (int bc = blockIdx.x; bc < NB * 32; bc += gridDim.x) {
        const size_t row0 = (size_t)bc * 128;
        __syncthreads();
        if (F.tid < 128) { float s = 0.f; for (int j = 0; j < 48; ++j) s += F.VSS[(row0 + F.tid) * 48 + j]; rs[F.tid] = rsqrtf(s * (1.f / SGW) + EPS); }
        __syncthreads();
        for (int o = F.tid; o < 128 * SGW; o += NTHREADS) {
            const int i = o / SGW, c = o % SGW, g = c / 384;
            const float* ws = F.in[I_SWS] + ((size_t)g * 128 + i) * 128;
            float acc = 0.f;
            for (int j = 0; j < 128; ++j) acc += ws[j] * (bf2f(V[(row0 + j) * SGW + c]) * rs[j]);
            const float mixed = acc * F.in[I_SNG][c] + F.in[I_SBS][g * 128 + i];
            const size_t idx = (row0 + i) * SGW + c;
            U[idx] = (bf16)f2bf(bf2f(U[idx]) * mixed);
        }
    }
    __syncthreads();
}


namespace pg8 {
typedef short bf16x8 __attribute__((ext_vector_type(8)));
constexpr int BM = 256, BK = 64, HALF = 128, HTB = HALF * BK * 2, STAGE_BYTES = 8 * HTB;
__host__ __device__ __forceinline__ int lds_byte(int r, int c) { const int st = (r >> 4) * 2 + (c >> 5), rr = r & 15, cc = c & 31, ob = rr * 64 + cc * 2; return st * 1024 + (ob ^ (((ob >> 9) & 1) << 5)); }
__host__ __device__ __forceinline__ void stage_rc(int b, int& R, int& C) { const int st = b / 1024, sb = b % 1024, swz = sb ^ (((sb >> 9) & 1) << 5); R = (st >> 1) * 16 + swz / 64; C = (st & 1) * 32 + (swz % 64) / 2; }
struct Unit { int pm, pn; const char* Ab; const char* Bb; int x0, x1, x2; };
__device__ __forceinline__ unsigned cvt_pk_bf16(float lo, float hi) { unsigned r; asm volatile("v_cvt_pk_bf16_f32 %0, %1, %2" : "=v"(r) : "v"(lo), "v"(hi)); return r; }

template <class Sched, class Epi, bool ALIGN_EPI>
__device__ __forceinline__ void gemm_phase(LAS unsigned char* lds, const int K, const Sched& S, const Epi& E) {
    const int tid = threadIdx.x, wid = __builtin_amdgcn_readfirstlane(tid >> 6), lane = tid & 63, wr = wid >> 2, wc = wid & 3, fr = lane & 15, fq = lane >> 4;
    const int nt = K / BK;
    int Rs[2], Cs[2]; unsigned voffB[2];
#pragma unroll
    for (int i = 0; i < 2; ++i) { stage_rc(tid * 16 + i * 8192, Rs[i], Cs[i]); voffB[i] = (unsigned)(Rs[i] * K + Cs[i]) * 2u; }
    const size_t kstep = (size_t)(BK * 2);
    const size_t hstep = (size_t)HALF * K * 2;
    const unsigned ldsw = (unsigned)wid * 1024u;
    const int aoff = lds_byte(wr * 64 + fr, fq * 8), boff = lds_byte(wc * 32 + fr, fq * 8);
#define PG8_SA(b, h) (((b) * 2 + (h)) * HTB)
#define PG8_SB(b, h) ((4 + (b) * 2 + (h)) * HTB)
#define PG8_STAGE(bufoff, gbase, voff) do { _Pragma("unroll") for (int _i = 0; _i < 2; ++_i) \
        __builtin_amdgcn_global_load_lds((const unsigned*)((const char*)(gbase) + (voff)[_i]), (LAS unsigned*)(lds + (bufoff) + ldsw + _i * 8192), 16, 0, 0); } while (0)
#define PG8_LDA(dst, b, h) do { _Pragma("unroll") for (int m = 0; m < 4; ++m) _Pragma("unroll") for (int k = 0; k < 2; ++k) dst[m][k] = *(const LAS bf16x8*)(lds + PG8_SA(b, h) + aoff + m * 2048 + k * 1024); } while (0)
#define PG8_LDB(dst, b, h) do { _Pragma("unroll") for (int n = 0; n < 2; ++n) _Pragma("unroll") for (int k = 0; k < 2; ++k) dst[n][k] = *(const LAS bf16x8*)(lds + PG8_SB(b, h) + boff + n * 2048 + k * 1024); } while (0)
#define PG8_MMA(ai, bj, At, Bt) do { __builtin_amdgcn_s_setprio(1); _Pragma("unroll") for (int m = 0; m < 4; ++m) _Pragma("unroll") for (int n = 0; n < 2; ++n) _Pragma("unroll") for (int k = 0; k < 2; ++k) \
        acc[ai][bj][m][n] = __builtin_amdgcn_mfma_f32_16x16x32_bf16(Bt[n][k], At[m][k], acc[ai][bj][m][n], 0, 0, 0); __builtin_amdgcn_s_setprio(0); } while (0)
#define PG8_WAIT_V(n) asm volatile("s_waitcnt vmcnt(" #n ")" ::: "memory")
#define PG8_WAIT_L(n) asm volatile("s_waitcnt lgkmcnt(" #n ")" ::: "memory")
#define PG8_BAR __builtin_amdgcn_s_barrier()
#define PG8_SCHED __builtin_amdgcn_sched_barrier(0)
    Unit cur, nxt; int ui = 0;
    if (!S.next(0, cur)) return;
    unsigned vA[2][2], nvA[2][2];
    S.arows(cur, vA, Rs, Cs);
    f32x4 acc[2][2][4][2];
#pragma unroll
    for (int a = 0; a < 2; ++a)
#pragma unroll
        for (int b = 0; b < 2; ++b)
#pragma unroll
            for (int m = 0; m < 4; ++m)
#pragma unroll
                for (int n = 0; n < 2; ++n) acc[a][b][m][n] = (f32x4){0.f, 0.f, 0.f, 0.f};
    bf16x8 At[4][2], B0[2][2], B1[2][2];
    const char* cA = cur.Ab; const char* cB = cur.Bb;
    PG8_STAGE(PG8_SB(0, 0), cB, voffB); PG8_STAGE(PG8_SB(0, 1), cB + hstep, voffB); PG8_STAGE(PG8_SA(0, 0), cA, vA[0]); PG8_STAGE(PG8_SA(0, 1), cA, vA[1]);
    if (wr == 1) PG8_BAR;
    PG8_WAIT_V(2); PG8_BAR;
    PG8_STAGE(PG8_SB(1, 0), cB + kstep, voffB); PG8_STAGE(PG8_SA(1, 0), cA + kstep, vA[0]); PG8_STAGE(PG8_SB(1, 1), cB + hstep + kstep, voffB);
    PG8_WAIT_V(6); PG8_BAR;
    for (;;) {
        const bool has_next = S.next(ui + 1, nxt);
        if (has_next) S.arows(nxt, nvA, Rs, Cs); else { nvA[0][0] = vA[0][0]; nvA[0][1] = vA[0][1]; nvA[1][0] = vA[1][0]; nvA[1][1] = vA[1][1]; }
        const char* nA = has_next ? nxt.Ab : cA; const char* nB = has_next ? nxt.Bb : cB;
        for (int t = 0; t < nt; t += 2) {
            const bool last = (t == nt - 2);
            const char* a1 = cA + (size_t)(t + 1) * kstep;
            const char* a2 = last ? nA : cA + (size_t)(t + 2) * kstep; const char* b2 = last ? nB : cB + (size_t)(t + 2) * kstep;
            const char* a3 = a2 + kstep; const char* b3 = b2 + kstep;
            unsigned w0[2], w1[2];
            w0[0] = last ? nvA[0][0] : vA[0][0]; w0[1] = last ? nvA[0][1] : vA[0][1]; w1[0] = last ? nvA[1][0] : vA[1][0]; w1[1] = last ? nvA[1][1] : vA[1][1];
            PG8_LDB(B0, 0, 0); PG8_LDB(B1, 0, 1); PG8_SCHED; PG8_LDA(At, 0, 0); PG8_STAGE(PG8_SA(1, 1), a1, vA[1]);
            PG8_WAIT_V(8); PG8_WAIT_L(0); PG8_BAR; PG8_MMA(0, 0, At, B0); PG8_MMA(0, 1, At, B1); PG8_BAR; PG8_SCHED;
            PG8_LDA(At, 0, 1); PG8_STAGE(PG8_SB(0, 0), b2, voffB); PG8_STAGE(PG8_SB(0, 1), b2 + hstep, voffB); PG8_STAGE(PG8_SA(0, 0), a2, w0);
            PG8_WAIT_V(8); PG8_WAIT_L(0); PG8_BAR; PG8_MMA(1, 0, At, B0); PG8_MMA(1, 1, At, B1); PG8_BAR; PG8_SCHED;
            PG8_LDB(B0, 1, 0); PG8_LDB(B1, 1, 1); PG8_SCHED; PG8_LDA(At, 1, 0); PG8_STAGE(PG8_SA(0, 1), a2, w1);
            PG8_WAIT_V(8); PG8_WAIT_L(0); PG8_BAR; PG8_MMA(0, 0, At, B0); PG8_MMA(0, 1, At, B1); PG8_BAR; PG8_SCHED;
            PG8_LDA(At, 1, 1); PG8_STAGE(PG8_SB(1, 0), b3, voffB); PG8_STAGE(PG8_SB(1, 1), b3 + hstep, voffB); PG8_STAGE(PG8_SA(1, 0), a3, w0);
            PG8_WAIT_V(8); PG8_WAIT_L(0); PG8_BAR; PG8_MMA(1, 0, At, B0); PG8_MMA(1, 1, At, B1); PG8_BAR; PG8_SCHED;
        }
        if constexpr (ALIGN_EPI) { if (wr == 0) PG8_BAR; }
        E(acc, cur, wr, wc, fr, fq);
        if (!has_next) break;
#pragma unroll
        for (int a = 0; a < 2; ++a)
#pragma unroll
            for (int b = 0; b < 2; ++b)
#pragma unroll
                for (int m = 0; m < 4; ++m)
#pragma unroll
                    for (int n = 0; n < 2; ++n) acc[a][b][m][n] = (f32x4){0.f, 0.f, 0.f, 0.f};
        cur = nxt; cA = nA; cB = nB; ++ui;
        vA[0][0] = nvA[0][0]; vA[0][1] = nvA[0][1]; vA[1][0] = nvA[1][0]; vA[1][1] = nvA[1][1];
        if constexpr (ALIGN_EPI) { if (wr == 1) PG8_BAR; }
    }
    PG8_WAIT_V(0);
    if constexpr (!ALIGN_EPI) { if (wr == 0) PG8_BAR; }
    PG8_BAR;
#undef PG8_SA
#undef PG8_SB
#undef PG8_STAGE
#undef PG8_LDA
#undef PG8_LDB
#undef PG8_MMA
#undef PG8_WAIT_V
#undef PG8_WAIT_L
#undef PG8_BAR
#undef PG8_SCHED
}
}

constexpr size_t WB_WIN = 0;
constexpr size_t WB_WOUT = WB_WIN + (size_t)ABW * D * 2;
constexpr size_t WB_SWIN = WB_WOUT + (size_t)D * D * 2;
constexpr size_t WB_SWOUT = WB_SWIN + (size_t)2 * SGW * D * 2;
constexpr size_t WB_GU = WB_SWOUT + (size_t)D * SGW * 2;
constexpr size_t WB_DN = WB_GU + (size_t)2 * NE * 1024 * D * 2;
constexpr size_t WB_WS = WB_DN + (size_t)2 * NE * D * EW * 2;
constexpr size_t WB_END = WB_WS + (size_t)8 * 128 * 128 * 2;
static_assert(WB_END <= 124 * MiB, "bf16 weights fit");

__device__ __forceinline__ int slot_of(int mode, int c) {
    if (mode == 0) { const int bj = (c >> 7) & 1, wc = (c >> 5) & 3, fq = (c >> 3) & 3, nn = (c >> 2) & 1, rg = c & 3; return 128 * bj + 32 * wc + 16 * nn + 4 * fq + rg; }
    if (mode == 1) { const int wc = (c >> 6) & 3, bj = (c >> 5) & 1, nn = (c >> 4) & 1, fq = (c >> 2) & 3, rg = c & 3; return 128 * bj + 32 * wc + 16 * nn + 4 * fq + rg; }
    const int wc = (c >> 6) & 3, bj = (c >> 5) & 1, fq = (c >> 3) & 3, nn = (c >> 2) & 1, rg = c & 3; return 128 * bj + 32 * wc + 16 * nn + 4 * fq + rg;
}
template <class RowFn> __device__ __forceinline__ void conv_item(const float* W, int ldw, int k0, int n0, bf16* WT, int Kp, LAS float* scr, int lane, const RowFn& rowfn) {
    f32x4 v[8];
#pragma unroll
    for (int i = 0; i < 8; ++i) { const int kk = 8 * i + (lane >> 3); v[i] = *(const f32x4*)(W + (size_t)(k0 + kk) * ldw + n0 + 4 * (lane & 7)); }
#pragma unroll
    for (int i = 0; i < 8; ++i) { const int kk = 8 * i + (lane >> 3); LAS float* p = scr + kk * 33 + 4 * (lane & 7); p[0] = v[i].x; p[1] = v[i].y; p[2] = v[i].z; p[3] = v[i].w; }
    asm volatile("s_waitcnt lgkmcnt(0)" ::: "memory");
    const int c = lane & 7;
#pragma unroll
    for (int j = 0; j < 4; ++j) { const int n = (lane >> 3) + 8 * j; const LAS float* sp = scr + (8 * c) * 33 + n;
        u32x4 o; o.x = pk2(sp[0 * 33], sp[1 * 33]); o.y = pk2(sp[2 * 33], sp[3 * 33]); o.z = pk2(sp[4 * 33], sp[5 * 33]); o.w = pk2(sp[6 * 33], sp[7 * 33]);
        *(u32x4*)(WT + (size_t)rowfn(n0 + n) * Kp + k0 + 8 * c) = o; }
    asm volatile("s_waitcnt lgkmcnt(0)" ::: "memory");
}
__device__ __forceinline__ void ph_convert(Frame& F) {
    LAS float* scr = (LAS float*)(F.lds + F.wave * 16384);
    bf16* WB = (bf16*)(F.ws + WS_WB);
    constexpr int I_1 = 16 * 112, I_2 = 16 * 32, I_3 = 16 * 192, I_4 = 48 * 32, I_5 = 32 * 512, I_6 = 32 * 256, I_7 = 8 * 128 * 128 / 512;
    constexpr int NIT = I_1 + I_2 + I_3 + I_4 + I_5 + I_6 + I_7;
    for (int it = F.gw; it < NIT; it += F.ngw) {
        int r = it;
        if (r < I_1) { const int kb = r / 112, nb = r % 112, n0 = nb * 32; const int tile = n0 >> 8, ty = tile >> 1; const int mode = (ty == 0 || ty == 4) ? 1 : 2;
            conv_item(F.in[I_WIN], ABW, kb * 64, n0, (bf16*)((char*)WB + WB_WIN), D, scr, F.lane, [=](int n) { return (n & ~255) + slot_of(mode, n & 255); }); continue; } r -= I_1;
        if (r < I_2) { const int kb = r / 32, nb = r % 32;
            conv_item(F.in[I_WOUT], D, kb * 64, nb * 32, (bf16*)((char*)WB + WB_WOUT), D, scr, F.lane, [=](int n) { return (n & ~255) + slot_of(0, n & 255); }); continue; } r -= I_2;
        if (r < I_3) { const int kb = r / 192, nb = r % 192;
            conv_item(F.in[I_SWIN], 2 * SGW, kb * 64, nb * 32, (bf16*)((char*)WB + WB_SWIN), D, scr, F.lane, [=](int n) { return (n & ~255) + slot_of(0, n & 255); }); continue; } r -= I_3;
        if (r < I_4) { const int kb = r / 32, nb = r % 32;
            conv_item(F.in[I_SWOUT], D, kb * 64, nb * 32, (bf16*)((char*)WB + WB_SWOUT), SGW, scr, F.lane, [=](int n) { return (n & ~255) + slot_of(0, n & 255); }); continue; } r -= I_4;
        if (r < I_5) { const int le = r / 512, q = r % 512, which = q >> 8, kb = (q & 255) / 16, nb = q % 16;
            const float* W = (which ? F.in[I_WU] : F.in[I_WG]) + (size_t)le * D * EW;
            conv_item(W, EW, kb * 64, nb * 32, (bf16*)((char*)WB + WB_GU) + (size_t)le * 1024 * D, D, scr, F.lane,
                      [=](int j) { const int w = j & 127; return (j >> 7) * 256 + 128 * which + 32 * ((w >> 5) & 3) + 16 * ((w >> 2) & 1) + 4 * ((w >> 3) & 3) + (w & 3); }); continue; } r -= I_5;
        if (r < I_6) { const int le = r / 256, q = r % 256, kb = q / 32, nb = q % 32;
            conv_item(F.in[I_WD] + (size_t)le * EW * D, D, kb * 64, nb * 32, (bf16*)((char*)WB + WB_DN) + (size_t)le * D * EW, EW, scr, F.lane, [=](int n) { return (n & ~255) + slot_of(0, n & 255); }); continue; } r -= I_6;
        {
            const float* src = F.in[I_SWS] + (size_t)r * 512 + F.lane * 8; const f32x4 a = *(const f32x4*)src, b = *(const f32x4*)(src + 4);
            u32x4 o; o.x = pk2(a.x, a.y); o.y = pk2(a.z, a.w); o.z = pk2(b.x, b.y); o.w = pk2(b.z, b.w);
            *(u32x4*)((bf16*)((char*)WB + WB_WS) + (size_t)r * 512 + F.lane * 8) = o; }
    }
}

struct DenseSched {
    const char* A; const char* Bt; int K, nM, nN, G, c, nwg, xM0, xN, nx;
    __device__ __forceinline__ bool next(int i, pg8::Unit& u) const {
        const int L = i * G + c; if (L >= nwg + nx) return false;
        if (L < nwg) { int wgid = L; { const int q = nwg / 8, r = nwg % 8, xcd = wgid % 8, off = wgid / 8; wgid = (xcd < r ? xcd * (q + 1) : r * (q + 1) + (xcd - r) * q) + off; }
            const int nig = 8 * nN, gid = wgid / nig, fm = gid * 8, gsz = (nM - fm) < 8 ? (nM - fm) : 8;
            u.pm = fm + ((wgid % nig) % gsz); u.pn = (wgid % nig) / gsz; }
        else { const int j = L - nwg; u.pm = xM0 + j / xN; u.pn = j % xN; }
        u.Ab = A; u.Bb = Bt + (size_t)u.pn * 256 * K * 2; u.x0 = 0; u.x1 = 0; u.x2 = 0; return true;
    }
    __device__ __forceinline__ void arows(const pg8::Unit& u, unsigned (&v)[2][2], const int (&R)[2], const int (&C)[2]) const {
#pragma unroll
        for (int h = 0; h < 2; ++h)
#pragma unroll
            for (int i = 0; i < 2; ++i) v[h][i] = (unsigned)((u.pm * 256 + h * 128 + R[i]) * K + C[i]) * 2u;
    }
};
struct MoeSched {
    const char* A; const char* Bt; int K, G, c, total; const LAS int* tab; const int* LIST; int gather;
    __device__ __forceinline__ bool next(int i, pg8::Unit& u) const {
        const int L = i * G + c; if (L >= total) return false;
        const int rt = L >> 2; u.pn = L & 3; int ee = 0;
#pragma unroll
        for (int e = 0; e < 16; ++e) { if (tab[e * 4] <= rt && tab[e * 4 + 1] > 0) ee = e; }
        u.pm = rt - tab[ee * 4]; u.x0 = ee; u.x1 = tab[ee * 4 + 1]; u.x2 = tab[ee * 4 + 2];
        u.Ab = A; u.Bb = Bt + ((size_t)ee * 1024 + u.pn * 256) * K * 2; return true;
    }
    __device__ __forceinline__ void arows(const pg8::Unit& u, unsigned (&v)[2][2], const int (&R)[2], const int (&C)[2]) const {
#pragma unroll
        for (int h = 0; h < 2; ++h)
#pragma unroll
            for (int i = 0; i < 2; ++i) { const int pos = u.pm * 256 + h * 128 + R[i]; int row;
                if (gather) { const int ent = LIST[u.x0 * 16384 + (pos < u.x1 ? pos : u.pm * 256)]; row = ent >> 1; } else row = u.x2 + pos;
                v[h][i] = (unsigned)(row * K + C[i]) * 2u; }
    }
};

typedef unsigned u32x2 __attribute__((ext_vector_type(2)));
struct EpiInproj {
    unsigned char* Areg; const float* ROPE; const float* kg; const float* qg;
    __device__ __forceinline__ void operator()(f32x4 (&acc)[2][2][4][2], const pg8::Unit& u, int wr, int wc, int fr, int fq) const {
        const int ty = u.pn >> 1, head = (u.pn & 1) * 4 + wc;
        const size_t off_t = ty < 4 ? (size_t)ty * 17 * MiB : (size_t)(68 + (ty - 4) * 16) * MiB;
        bf16* dst = (bf16*)(Areg + off_t);
        const int row0 = u.pm * 256 + wr * 64 + fr;
        if (ty == 0 || ty == 4) {
            const float sc = ty == 0 ? 0.125f : 1.f;
#pragma unroll
            for (int ai = 0; ai < 2; ++ai)
#pragma unroll
                for (int m = 0; m < 4; ++m) { const int row = row0 + ai * 128 + m * 16; const int tt = row & 4095; const bool lat = row < NTOK;
#pragma unroll
                    for (int bj = 0; bj < 2; ++bj) { const int pos = bj ? (tt & 63) : (tt >> 6);
                        f32x4 u1 = acc[ai][bj][m][0], u2 = acc[ai][bj][m][1];
                        if (lat) { const f32x4 cs0 = *(const f32x4*)(ROPE + (pos * 16 + 4 * fq) * 2), cs1 = *(const f32x4*)(ROPE + (pos * 16 + 4 * fq) * 2 + 4);
                            const f32x4 co = { cs0.x, cs0.z, cs1.x, cs1.z }, si = { cs0.y, cs0.w, cs1.y, cs1.w };
                            const f32x4 a = u1 * co - u2 * si, b = u1 * si + u2 * co; u1 = a; u2 = b; }
                        u1 = u1 * sc; u2 = u2 * sc;
                        bf16* p = dst + (size_t)row * HW + head * 64 + 32 * bj + 4 * fq;
                        u32x2 w; w.x = pg8::cvt_pk_bf16(u1.x, u1.y); w.y = pg8::cvt_pk_bf16(u1.z, u1.w); *(u32x2*)p = w;
                        w.x = pg8::cvt_pk_bf16(u2.x, u2.y); w.y = pg8::cvt_pk_bf16(u2.z, u2.w); *(u32x2*)(p + 16) = w; } }
        } else {
            const bool nrm = (ty == 2 || ty == 6);
            f32x4 g[2][2];
            if (nrm) { const float* gp = ty == 2 ? kg : qg;
#pragma unroll
                for (int bj = 0; bj < 2; ++bj)
#pragma unroll
                    for (int n = 0; n < 2; ++n) g[bj][n] = *(const f32x4*)(gp + 32 * bj + 8 * fq + 4 * n) * (ty == 6 ? 0.125f : 1.f); }
#pragma unroll
            for (int ai = 0; ai < 2; ++ai)
#pragma unroll
                for (int m = 0; m < 4; ++m) { const int row = row0 + ai * 128 + m * 16;
                    f32x4 v[2][2];
#pragma unroll
                    for (int bj = 0; bj < 2; ++bj)
#pragma unroll
                        for (int n = 0; n < 2; ++n) v[bj][n] = acc[ai][bj][m][n];
                    if (nrm) { float ss = 0.f;
#pragma unroll
                        for (int bj = 0; bj < 2; ++bj)
#pragma unroll
                            for (int n = 0; n < 2; ++n) ss += (v[bj][n].x * v[bj][n].x + v[bj][n].y * v[bj][n].y) + (v[bj][n].z * v[bj][n].z + v[bj][n].w * v[bj][n].w);
                        ss += __shfl_xor(ss, 16); ss += __shfl_xor(ss, 32);
                        const float rs = rsqrtf(ss * (1.f / 64.f) + EPS);
#pragma unroll
                        for (int bj = 0; bj < 2; ++bj)
#pragma unroll
                            for (int n = 0; n < 2; ++n) v[bj][n] = v[bj][n] * rs * g[bj][n]; }
                    if (ty == 5) {
#pragma unroll
                        for (int bj = 0; bj < 2; ++bj)
#pragma unroll
                            for (int n = 0; n < 2; ++n)
#pragma unroll
                                for (int q = 0; q < 4; ++q) v[bj][n][q] = siluf(v[bj][n][q]); }
#pragma unroll
                    for (int bj = 0; bj < 2; ++bj) { u32x4 w; w.x = pg8::cvt_pk_bf16(v[bj][0].x, v[bj][0].y); w.y = pg8::cvt_pk_bf16(v[bj][0].z, v[bj][0].w); w.z = pg8::cvt_pk_bf16(v[bj][1].x, v[bj][1].y); w.w = pg8::cvt_pk_bf16(v[bj][1].z, v[bj][1].w);
                        *(u32x4*)(dst + (size_t)row * HW + head * 64 + 32 * bj + 8 * fq) = w; } }
        }
    }
};
struct EpiRes {
    const float* base; float* out; const float* gate;
    __device__ __forceinline__ void operator()(f32x4 (&acc)[2][2][4][2], const pg8::Unit& u, int wr, int wc, int fr, int fq) const {
        const int b = u.pm >> 4, col0 = u.pn * 256 + wc * 32 + 8 * fq, row0 = u.pm * 256 + wr * 64 + fr;
        f32x4 gv[2][2];
#pragma unroll
        for (int bj = 0; bj < 2; ++bj)
#pragma unroll
            for (int n = 0; n < 2; ++n) gv[bj][n] = *(const f32x4*)(gate + b * 6144 + col0 + bj * 128 + 4 * n);
#pragma unroll
        for (int ai = 0; ai < 2; ++ai)
#pragma unroll
            for (int m = 0; m < 4; ++m) { const size_t off = (size_t)(row0 + ai * 128 + m * 16) * D + col0;
#pragma unroll
                for (int bj = 0; bj < 2; ++bj)
#pragma unroll
                    for (int n = 0; n < 2; ++n) { const f32x4 bs = *(const f32x4*)(base + off + bj * 128 + 4 * n); *(f32x4*)(out + off + bj * 128 + 4 * n) = bs + gv[bj][n] * acc[ai][bj][m][n]; } }
    }
};
__device__ __forceinline__ float gelu_fast(float v) { const float u2 = -2.302208198f * (v + 0.044715f * v * v * v); return v * __builtin_amdgcn_rcpf(1.f + __builtin_amdgcn_exp2f(u2)); }
struct EpiSguIn {
    bf16* U; bf16* V; const float* bias; float* VSS;
    __device__ __forceinline__ void operator()(f32x4 (&acc)[2][2][4][2], const pg8::Unit& u, int wr, int wc, int fr, int fq) const {
        const int col0 = u.pn * 256 + wc * 32 + 8 * fq, row0 = u.pm * 256 + wr * 64 + fr; const bool isv = u.pn >= 12;
        bf16* dstb = isv ? V + (col0 - SGW) : U + col0;
        f32x4 bv[2][2];
#pragma unroll
        for (int bj = 0; bj < 2; ++bj)
#pragma unroll
            for (int n = 0; n < 2; ++n) bv[bj][n] = *(const f32x4*)(bias + col0 + bj * 128 + 4 * n);
#pragma unroll
        for (int ai = 0; ai < 2; ++ai)
#pragma unroll
            for (int m = 0; m < 4; ++m) { const int row = row0 + ai * 128 + m * 16; float ss = 0.f;
#pragma unroll
                for (int bj = 0; bj < 2; ++bj) { f32x4 z0 = acc[ai][bj][m][0] + bv[bj][0], z1 = acc[ai][bj][m][1] + bv[bj][1];
#pragma unroll
                    for (int q = 0; q < 4; ++q) { z0[q] = gelu_fast(z0[q]); z1[q] = gelu_fast(z1[q]); }
                    ss += (z0.x * z0.x + z0.y * z0.y) + (z0.z * z0.z + z0.w * z0.w) + (z1.x * z1.x + z1.y * z1.y) + (z1.z * z1.z + z1.w * z1.w);
                    u32x4 w; w.x = pg8::cvt_pk_bf16(z0.x, z0.y); w.y = pg8::cvt_pk_bf16(z0.z, z0.w); w.z = pg8::cvt_pk_bf16(z1.x, z1.y); w.w = pg8::cvt_pk_bf16(z1.z, z1.w);
                    *(u32x4*)(dstb + (size_t)row * SGW + bj * 128) = w; }
                if (isv) { ss += __shfl_xor(ss, 16); ss += __shfl_xor(ss, 32); if (fq == 0) VSS[(size_t)row * 48 + (u.pn - 12) * 4 + wc] = ss; } }
    }
};
struct EpiMoeGU {
    bf16* ACT;
    __device__ __forceinline__ void operator()(f32x4 (&acc)[2][2][4][2], const pg8::Unit& u, int wr, int wc, int fr, int fq) const {
        const int col0 = u.pn * 128 + wc * 32 + 8 * fq, row0 = u.x2 + u.pm * 256 + wr * 64 + fr;
#pragma unroll
        for (int ai = 0; ai < 2; ++ai)
#pragma unroll
            for (int m = 0; m < 4; ++m) { f32x4 a0 = acc[ai][0][m][0], a1 = acc[ai][0][m][1]; const f32x4 b0 = acc[ai][1][m][0], b1 = acc[ai][1][m][1];
#pragma unroll
                for (int q = 0; q < 4; ++q) { a0[q] = a0[q] * __builtin_amdgcn_rcpf(1.f + __builtin_amdgcn_exp2f(-1.44269504f * a0[q])) * b0[q]; a1[q] = a1[q] * __builtin_amdgcn_rcpf(1.f + __builtin_amdgcn_exp2f(-1.44269504f * a1[q])) * b1[q]; }
                u32x4 w; w.x = pg8::cvt_pk_bf16(a0.x, a0.y); w.y = pg8::cvt_pk_bf16(a0.z, a0.w); w.z = pg8::cvt_pk_bf16(a1.x, a1.y); w.w = pg8::cvt_pk_bf16(a1.z, a1.w);
                *(u32x4*)(ACT + (size_t)(row0 + ai * 128 + m * 16) * EW + col0) = w; }
    }
};
struct EpiMoeDn {
    bf16* Y; const int* LIST; const float* WT;
    __device__ __forceinline__ void operator()(f32x4 (&acc)[2][2][4][2], const pg8::Unit& u, int wr, int wc, int fr, int fq) const {
        const int col0 = u.pn * 256 + wc * 32 + 8 * fq;
#pragma unroll
        for (int ai = 0; ai < 2; ++ai)
#pragma unroll
            for (int m = 0; m < 4; ++m) { const int pos = u.pm * 256 + ai * 128 + wr * 64 + m * 16 + fr;
                if (pos < u.x1) { const int ent = LIST[u.x0 * 16384 + pos]; const float w8 = WT[ent];
#pragma unroll
                    for (int bj = 0; bj < 2; ++bj) { const f32x4 a0 = acc[ai][bj][m][0] * w8, a1 = acc[ai][bj][m][1] * w8;
                        u32x4 w; w.x = pg8::cvt_pk_bf16(a0.x, a0.y); w.y = pg8::cvt_pk_bf16(a0.z, a0.w); w.z = pg8::cvt_pk_bf16(a1.x, a1.y); w.w = pg8::cvt_pk_bf16(a1.z, a1.w);
                        *(u32x4*)(Y + (size_t)ent * D + col0 + bj * 128) = w; } } }
    }
};
__device__ __forceinline__ int moe_tab(Frame& F, int l, LAS int* tab) {
    __syncthreads();
    if (F.tid == 0) { int tiles = 0, base = 0;
        for (int e = 0; e < 16; ++e) { const int c = (int)__hip_atomic_load(F.ctl + CW_CNT + l * 1024 + e * 64, RLX_AGENT); tab[e * 4] = tiles; tab[e * 4 + 1] = c; tab[e * 4 + 2] = base; tab[e * 4 + 3] = 0; tiles += (c + 255) >> 8; base += (c + 255) & ~255; }
        tab[64] = tiles; }
    __syncthreads();
    return tab[64];
}


__device__ __forceinline__ void ph_mod2(Frame& F) {
    LAS float* sv = (LAS float*)F.lds; LAS float* red = sv + 5 * 1024;
    for (int i = F.tid; i < 5 * 1024; i += NTHREADS) { const int r = i >> 10, k = i & 1023; const float c = r < 4 ? F.in[I_C][r * 1024 + k] : F.in[I_CCTX][k]; sv[i] = siluf(c); }
    __syncthreads();
    for (int item = blockIdx.x; item < 192; item += gridDim.x) {
        const int l = item / 96, n0 = (item % 96) * 64, k0 = F.wave * 128;
        const float* W = F.in[I_ADAW] + (size_t)l * D * 6144 + n0 + F.lane + (size_t)k0 * 6144;
        float a0 = 0.f, a1 = 0.f, a2 = 0.f, a3 = 0.f, a4 = 0.f;
#pragma unroll 16
        for (int k = 0; k < 128; ++k) { const float w = W[(size_t)k * 6144];
            a0 += sv[k0 + k] * w; a1 += sv[1024 + k0 + k] * w; a2 += sv[2048 + k0 + k] * w; a3 += sv[3072 + k0 + k] * w; a4 += sv[4096 + k0 + k] * w; }
        red[(F.wave * 5 + 0) * 64 + F.lane] = a0; red[(F.wave * 5 + 1) * 64 + F.lane] = a1; red[(F.wave * 5 + 2) * 64 + F.lane] = a2; red[(F.wave * 5 + 3) * 64 + F.lane] = a3; red[(F.wave * 5 + 4) * 64 + F.lane] = a4;
        __syncthreads();
        if (F.wave < 5) { const int r = F.wave; float sacc = 0.f;
#pragma unroll
            for (int w = 0; w < 8; ++w) sacc += red[(w * 5 + r) * 64 + F.lane];
            sacc += F.in[I_ADAB][l * 6144 + n0 + F.lane];
            if (r < 4) F.MOD[(l * 4 + r) * 6144 + n0 + F.lane] = sacc; else if (l == 0 && n0 < 2048) F.MODC[n0 + F.lane] = sacc; }
        __syncthreads();
    }
    const int gt = F.gw * 64 + F.lane, ngt = F.ngw * 64;
    for (int it = gt; it < 64 * 16; it += ngt) {
        const int pos = it >> 4, j = it & 15;
        const float inv = powf(10000.0f, -(float)j / 16.0f);
        const float ang = (float)pos * inv;
        F.ROPE[it * 2] = cosf(ang); F.ROPE[it * 2 + 1] = sinf(ang);
    }
}
__device__ __forceinline__ void ph_inproj(Frame& F) {
    const DenseSched S{(const char*)F.H, (const char*)(F.ws + WS_WB + WB_WIN), D, 64, 14, (int)gridDim.x, (int)blockIdx.x, 64 * 14, 64, 8, 32};
    const EpiInproj E{F.A, F.ROPE, F.in[I_KG], F.in[I_QG]};
    pg8::gemm_phase<DenseSched, EpiInproj, true>(F.lds, D, S, E);
}
__device__ __forceinline__ void ph_outproj(Frame& F) {
    const DenseSched S{(const char*)(F.A + A_MIX), (const char*)(F.ws + WS_WB + WB_WOUT), D, 64, 4, (int)gridDim.x, (int)blockIdx.x, 64 * 4, 0, 1, 0};
    const EpiRes E{F.in[I_X], F.out, F.MOD + 2 * D};
    pg8::gemm_phase<DenseSched, EpiRes, false>(F.lds, D, S, E);
}
__device__ __forceinline__ void ph_sguin(Frame& F) {
    const DenseSched S{(const char*)F.H, (const char*)(F.ws + WS_WB + WB_SWIN), D, 64, 24, (int)gridDim.x, (int)blockIdx.x, 64 * 24, 0, 1, 0};
    const EpiSguIn E{(bf16*)(F.A + A_U), (bf16*)(F.A + A_V), F.in[I_SBIN], F.VSS};
    pg8::gemm_phase<DenseSched, EpiSguIn, true>(F.lds, D, S, E);
}
__device__ __forceinline__ void ph_sguout(Frame& F) {
    const DenseSched S{(const char*)(F.A + A_U), (const char*)(F.ws + WS_WB + WB_SWOUT), SGW, 64, 4, (int)gridDim.x, (int)blockIdx.x, 64 * 4, 0, 1, 0};
    const EpiRes E{F.out, F.out, F.MOD + 4 * 6144 + 2 * D};
    pg8::gemm_phase<DenseSched, EpiRes, false>(F.lds, SGW, S, E);
}
constexpr int TAB_OFF = LDSCTL_OFF + 1024;
__device__ __forceinline__ void ph_moe_gu(Frame& F, int l) {
    LAS int* tab = (LAS int*)(F.lds + TAB_OFF);
    const int tiles = moe_tab(F, l, tab);
    const MoeSched S{(const char*)F.H, (const char*)(F.ws + WS_WB + WB_GU) + (size_t)l * NE * 1024 * D * 2, D, (int)gridDim.x, (int)blockIdx.x, tiles * 4, tab, F.LIST, 1};
    const EpiMoeGU E{(bf16*)(F.A + A_ACT)};
    pg8::gemm_phase<MoeSched, EpiMoeGU, true>(F.lds, D, S, E);
}
__device__ __forceinline__ void ph_moe_dn(Frame& F, int l) {
    LAS int* tab = (LAS int*)(F.lds + TAB_OFF);
    const int tiles = moe_tab(F, l, tab);
    const MoeSched S{(const char*)(F.A + A_ACT), (const char*)(F.ws + WS_WB + WB_DN) + (size_t)l * NE * D * EW * 2, EW, (int)gridDim.x, (int)blockIdx.x, tiles * 4, tab, F.LIST, 0};
    const EpiMoeDn E{(bf16*)(F.A + A_Y), F.LIST, F.WT};
    pg8::gemm_phase<MoeSched, EpiMoeDn, true>(F.lds, EW, S, E);
}

constexpr int NPHASE = 18;
__global__ void __launch_bounds__(NTHREADS, 2) fwd_kernel(Args args) {
    extern __shared__ __attribute__((aligned(16))) unsigned char lds[];
    Frame F;
    F.lds = (LAS unsigned char*)lds;
    F.tid = threadIdx.x; F.lane = F.tid & 63; F.wave = __builtin_amdgcn_readfirstlane(F.tid >> 6);
    F.gw = blockIdx.x * NWAVES + F.wave; F.ngw = gridDim.x * NWAVES;
#pragma unroll
    for (int i = 0; i < 26; ++i) F.in[i] = args.in[i];
    F.out = args.out; F.ws = args.ws;
    F.ctl = (unsigned*)(args.ws + WS_CTL);
    F.MOD = (float*)(args.ws + WS_MOD); F.MODC = F.MOD + 2 * 4 * 6144; F.ROPE = F.MODC + 2048;
    F.LIST = (int*)(args.ws + WS_ROUTE); F.WT = (float*)(args.ws + WS_ROUTE + 1 * MiB);
    F.VSS = (float*)(args.ws + WS_VSS);
    F.H = (bf16*)(args.ws + WS_H); F.A = args.ws + WS_A;
    volatile LAS unsigned* MISC = (volatile LAS unsigned*)(F.lds + MISC_OFF);
    for (int u = F.tid; u < (LDS_BYTES - LDSCTL_OFF) / 4; u += NTHREADS) ((LAS unsigned*)(F.lds + LDSCTL_OFF))[u] = 0u;
    __syncthreads();
    XcdBarrier bar; bar.bar = F.ctl + CW_BAR; bar.x = 0; bar.st = nullptr;
    if (MK_ONE_LAUNCH) bar = xcd_barrier_post(F.ctl + CW_BAR, MISC + 8);
    const int lo = args.ph_lo, hi = args.ph_hi;
#define IN(k) (lo <= (k) && (k) < hi)
#ifdef ONLY_PHASE
#define PHON(k) ((k) == ONLY_PHASE)
#else
#define PHON(k) true
#endif
#define SEAM(k) do { if (IN(k) && IN((k) + 1)) xcd_barrier(bar); } while (0)
    if (PHON(0) && IN(0)) { ph_mod2(F); __syncthreads(); ph_convert(F); } SEAM(0);
    if (PHON(1) && IN(1)) { ph_norm0(F); } SEAM(1);
    if (PHON(2) && IN(2)) { if (NV_INPROJ) ph_inproj_naive(F); else ph_inproj(F); } SEAM(2);
    if (PHON(3) && IN(3)) { ph_scan_naive(F); ph_na_naive(F); } SEAM(3);
    if (PHON(4) && IN(4)) { ph_retout_naive(F); } SEAM(4);
    if (PHON(5) && IN(5)) { if (NV_OUTPROJ) ph_gemm_res_naive(F, (const bf16*)(F.A + A_MIX), D, D, F.in[I_WOUT], F.in[I_X], F.MOD + 2 * D); else ph_outproj(F); } SEAM(5);
    if (PHON(6) && IN(6)) { ph_route(F, 0); } SEAM(6);
    if (PHON(7) && IN(7)) { if (NV_MOEGU) ph_moe_gu_naive(F, 0); else ph_moe_gu(F, 0); } SEAM(7);
    if (PHON(8) && IN(8)) { if (NV_MOEDN) ph_moe_dn_naive(F, 0); else ph_moe_dn(F, 0); } SEAM(8);
    if (PHON(9) && IN(9)) { ph_combine(F, 0, true); } SEAM(9);
    if (PHON(10) && IN(10)) { if (NV_SGUIN) ph_sguin_naive(F); else ph_sguin(F); } SEAM(10);
    if (PHON(11) && IN(11)) { ph_sgumix_naive(F); } SEAM(11);
    if (PHON(12) && IN(12)) { if (NV_SGUOUT) ph_gemm_res_naive(F, (const bf16*)(F.A + A_U), SGW, SGW, F.in[I_SWOUT], F.out, F.MOD + 4 * 6144 + 2 * D); else ph_sguout(F); } SEAM(12);
    if (PHON(13) && IN(13)) { ph_route(F, 1); } SEAM(13);
    if (PHON(14) && IN(14)) { if (NV_MOEGU) ph_moe_gu_naive(F, 1); else ph_moe_gu(F, 1); } SEAM(14);
    if (PHON(15) && IN(15)) { if (NV_MOEDN) ph_moe_dn_naive(F, 1); else ph_moe_dn(F, 1); } SEAM(15);
    if (PHON(16) && IN(16)) { ph_combine(F, 1, false); }
#undef IN
#undef SEAM
}

extern "C" void kernel_launch(void* const* d_in, const int* in_sizes, int n_in, void* d_out, int out_size, void* d_ws, size_t ws_size, hipStream_t stream) {
    static int grid = 0;
    if (grid == 0) {
        if (n_in != 26 || out_size != NTOK * D || ws_size < WS_END) { fprintf(stderr, "kernel_launch: unexpected shapes n_in %d out %d ws %zu (need %zu)\n", n_in, out_size, ws_size, (size_t)WS_END); grid = -1; return; }
        int dev = 0, cus = 0, per_cu = 0;
        hipGetDevice(&dev); hipDeviceGetAttribute(&cus, hipDeviceAttributeMultiprocessorCount, dev);
        hipFuncSetAttribute((const void*)fwd_kernel, hipFuncAttributeMaxDynamicSharedMemorySize, LDS_BYTES);
        hipOccupancyMaxActiveBlocksPerMultiprocessor(&per_cu, (const void*)fwd_kernel, NTHREADS, LDS_BYTES);
        (void)hipGetLastError();
        if (per_cu < 1) { fprintf(stderr, "kernel_launch: occupancy query says %d blocks/CU\n", per_cu); per_cu = 1; }
        grid = cus;
    }
    if (grid < 0) return;
    hipMemsetAsync((char*)d_ws + WS_CTL, 0, CTL_ZERO_BYTES, stream);
    Args a{};
    for (int i = 0; i < 26; ++i) a.in[i] = (const float*)d_in[i];
    a.out = (float*)d_out; a.ws = (unsigned char*)d_ws;
#if MK_ONE_LAUNCH
    a.ph_lo = 0; a.ph_hi = 17; a.li = 0;
    void* kargs[] = { &a };
    hipError_t e = hipLaunchCooperativeKernel((const void*)fwd_kernel, dim3(grid), dim3(NTHREADS), kargs, LDS_BYTES, stream);
    if (e != hipSuccess) fprintf(stderr, "cooperative launch failed: %s\n", hipGetErrorString(e));
#else
    for (int p = 0; p < 17; ++p) { a.ph_lo = p; a.ph_hi = p + 1; a.li = p; hipLaunchKernelGGL(fwd_kernel, dim3(grid), dim3(NTHREADS), LDS_BYTES, stream, a); }
#endif
}
```

```cpp
#include <hip/hip_runtime.h>
#include <cstdio>
#include <cstdint>

#ifndef NV_INPROJ
#define NV_INPROJ 0
#endif
#ifndef NV_OUTPROJ
#define NV_OUTPROJ 0
#endif
#ifndef NV_MOEGU
#define NV_MOEGU 0
#endif
#ifndef NV_MOEDN
#define NV_MOEDN 0
#endif
#ifndef NV_SGUIN
#define NV_SGUIN 0
#endif
#ifndef NV_SGUOUT
#define NV_SGUOUT 0
#endif
#ifndef NV_NA
#define NV_NA 0
#endif
#ifndef NV_RET
#define NV_RET 0
#endif
#ifndef NV_SGUMIX
#define NV_SGUMIX 0
#endif
#ifndef MK_ONE_LAUNCH
#define MK_ONE_LAUNCH 1
#endif

constexpr int D = 1024, NB = 4, SEQ = 4096, NTOK = NB * SEQ, CTXL = 256, NCTX = NB * CTXL, NROW = NTOK + NCTX;
constexpr int HD = 64, NH = 8, HW = NH * HD;
constexpr int ABW = 3584;
constexpr int SGW = 3072;
constexpr int NE = 16, EW = 512;
constexpr float EPS = 1e-6f;
constexpr int NWAVES = 8, NTHREADS = 512;

constexpr size_t MiB = 1u << 20;
constexpr size_t WS_CTL = 0, CTL_ZERO_BYTES = 1 * MiB;
constexpr size_t WS_MOD = 1 * MiB;
constexpr size_t WS_ROUTE = 2 * MiB;
constexpr size_t WS_VSS = 4 * MiB;
constexpr size_t WS_WB = 8 * MiB;
constexpr size_t WS_H = 132 * MiB;
constexpr size_t WS_A = 166 * MiB;
constexpr size_t WS_END = 358 * MiB;
constexpr size_t A_RK = 0, A_RV = 17 * MiB, A_NK = 34 * MiB, A_NV = 51 * MiB, A_RQ = 68 * MiB, A_GT = 84 * MiB, A_NQ = 100 * MiB, A_MIX = 116 * MiB, A_SST = 148 * MiB;
constexpr size_t A_ACT = 0, A_Y = 36 * MiB;
constexpr size_t A_U = 0, A_V = 96 * MiB;

constexpr int CW_BAR = 4096;
constexpr int CW_CNT = 8192;

typedef unsigned short bf16;
typedef unsigned u32x4 __attribute__((ext_vector_type(4)));
typedef float f32x4 __attribute__((ext_vector_type(4)));
#define LAS __attribute__((address_space(3)))
#define RLX_AGENT __ATOMIC_RELAXED, __HIP_MEMORY_SCOPE_AGENT

__device__ __forceinline__ unsigned f2bf(float f) { unsigned u = __builtin_bit_cast(unsigned, f); return (u + 0x7fffu + ((u >> 16) & 1u)) >> 16; }
__device__ __forceinline__ float bf2f(unsigned h) { return __builtin_bit_cast(float, h << 16); }
__device__ __forceinline__ unsigned pk2(float lo, float hi) { return f2bf(lo) | (f2bf(hi) << 16); }
__device__ __forceinline__ float siluf(float v) { return v / (1.f + __expf(-v)); }
__device__ __forceinline__ float gelu_tanh(float v) { const float u = 0.7978845608028654f * (v + 0.044715f * v * v * v); return 0.5f * v * (1.f + tanhf(u)); }
__device__ __forceinline__ float wave_sum(float v) {
#pragma unroll
    for (int o = 1; o < 64; o <<= 1) v += __shfl_xor(v, o);
    return v;
}

#define XB_TMO      128
#define XB_XCNT(j)  (256  + 64 * (j))
#define XB_XSUB(j)  (1280 + 64 * (j))
#define XB_XGEN(j)  (2304 + 64 * (j))
#define XB_TOP      3328
#define XB_TOPGEN   3392
#define XCD_BAR_WORDS 3456
#define XB_SPIN_CAP (1u << 18)
__device__ __forceinline__ unsigned xb_ld(unsigned* p)              { return __hip_atomic_load(p, __ATOMIC_RELAXED, __HIP_MEMORY_SCOPE_AGENT); }
__device__ __forceinline__ unsigned xb_add(unsigned* p, unsigned v) { return __hip_atomic_fetch_add(p, v, __ATOMIC_RELAXED, __HIP_MEMORY_SCOPE_AGENT); }
__device__ __forceinline__ unsigned xb_xcc_id() { return (unsigned)__builtin_amdgcn_s_getreg((3 << 11) | 20) & 0xFu; }
#define XB_SPIN(cond, bar) do { unsigned _sp = 0; while (cond) { __builtin_amdgcn_s_sleep(1); \
    if ((++_sp & 255u) == 0u) { if (xb_ld(&(bar)[XB_TMO])) break; if (_sp > XB_SPIN_CAP) { atomicAdd(&(bar)[XB_TMO], 1u); break; } } } } while (0)
struct XcdBarrier { unsigned* bar; unsigned x; volatile LAS unsigned* st; };
__device__ __forceinline__ XcdBarrier xcd_barrier_post(unsigned* bar, volatile LAS unsigned* st) {
    XcdBarrier b; b.bar = bar; b.x = xb_xcc_id(); b.st = st;
    if (threadIdx.x == 0) (void)xb_add(&bar[XB_XCNT(b.x)], 1u);
    return b;
}
__device__ __forceinline__ void xcd_barrier_complete(unsigned* bar, unsigned x, unsigned& nloc, unsigned& nx) {
    const unsigned G = gridDim.x * gridDim.y * gridDim.z;
    unsigned sum, cnt, mine, sp = 0u;
    for (;;) {
        sum = 0u; cnt = 0u; mine = 0u;
#pragma unroll
        for (unsigned j = 0; j < 16; ++j) { const unsigned c = xb_ld(&bar[XB_XCNT(j)]); sum += c; cnt += (c > 0u) ? 1u : 0u; mine = (j == x) ? c : mine; }
        if (sum == G) break;
        __builtin_amdgcn_s_sleep(1);
        if ((++sp & 255u) == 0u) { if (xb_ld(&bar[XB_TMO])) break; if (sp > XB_SPIN_CAP) { atomicAdd(&bar[XB_TMO], 1u); break; } }
    }
    nloc = mine > 0u ? mine : 1u; nx = cnt > 0u ? cnt : 1u;
}
__device__ __forceinline__ void xcd_barrier(const XcdBarrier& b) {
    asm volatile("s_waitcnt vmcnt(0)" ::: "memory");
    __syncthreads();
    if (threadIdx.x == 0) {
        unsigned* bar = b.bar;
        __builtin_amdgcn_s_waitcnt(0);
        unsigned nloc = b.st[0], nx = b.st[1];
        if (nloc == 0u) { xcd_barrier_complete(bar, b.x, nloc, nx); b.st[0] = nloc; b.st[1] = nx; }
        const unsigned old = xb_add(&bar[XB_XSUB(b.x)], 1u);
        const unsigned gen = old / nloc;
        if (old + 1u == (gen + 1u) * nloc) {
            __builtin_amdgcn_fence(__ATOMIC_RELEASE, "agent");
            asm volatile("s_waitcnt vmcnt(0)" ::: "memory");
            const unsigned og = xb_add(&bar[XB_TOP], 1u);
            const unsigned tg = og / nx;
            if (og + 1u == (tg + 1u) * nx) xb_add(&bar[XB_TOPGEN], 1u);
            else XB_SPIN(xb_ld(&bar[XB_TOPGEN]) == tg, bar);
            __builtin_amdgcn_fence(__ATOMIC_ACQUIRE, "agent");
            xb_add(&bar[XB_XGEN(b.x)], 1u);
            asm volatile("s_waitcnt vmcnt(0)" ::: "memory");
        } else {
            XB_SPIN(xb_ld(&bar[XB_XGEN(b.x)]) == gen, bar);
            __builtin_amdgcn_fence(__ATOMIC_ACQUIRE, "agent");
            asm volatile("s_waitcnt vmcnt(0)" ::: "memory");
        }
    }
    __syncthreads();
}

constexpr int LDS_BYTES = 147456;
constexpr int LDSCTL_OFF = 131072, MISC_OFF = LDSCTL_OFF + 320;

struct Args { const float* in[26]; float* out; unsigned char* ws; int ph_lo, ph_hi, li, pad; };

struct Frame {
    LAS unsigned char* lds;
    int tid, lane, wave, gw, ngw;
    const float* in[26];
    float* out; unsigned char* ws;
    unsigned* ctl;
    float *MOD, *MODC, *ROPE;
    int* LIST; float* WT; float* VSS;
    bf16* H; unsigned char* A;
};
enum { I_X = 0, I_C, I_CTX, I_CCTX, I_ADAW, I_ADAB, I_NMG, I_NFG, I_RW, I_RB, I_WG, I_WU, I_WD, I_WIN, I_WOUT, I_RDEC, I_RNG, I_QG, I_KG, I_RPB, I_SWIN, I_SBIN, I_SNG, I_SWS, I_SBS, I_SWOUT };

template <int NC> __device__ __forceinline__ void naive_dot(const bf16* arow, const float* W, int ldw, int K, float (&acc)[NC]) {
#pragma unroll 1
    for (int k = 0; k < K; k += 2) {
        const unsigned a2 = *(const unsigned*)(arow + k);
        const float a0 = bf2f(a2 & 0xffffu), a1 = bf2f(a2 >> 16);
        const float* w = W + (size_t)k * ldw;
#pragma unroll
        for (int j = 0; j < NC; ++j) acc[j] = __builtin_fmaf(a0, w[j], acc[j]);
        asm volatile("" ::: "memory");
        w += ldw;
#pragma unroll
        for (int j = 0; j < NC; ++j) acc[j] = __builtin_fmaf(a1, w[j], acc[j]);
        asm volatile("" ::: "memory");
    }
}
template <int NC> __device__ __forceinline__ void store_row_bf16(bf16* dst, const float (&v)[NC]) {
#pragma unroll
    for (int j = 0; j < NC; j += 8) { u32x4 w; w.x = pk2(v[j], v[j + 1]); w.y = pk2(v[j + 2], v[j + 3]); w.z = pk2(v[j + 4], v[j + 5]); w.w = pk2(v[j + 6], v[j + 7]); *(u32x4*)(dst + j) = w; }
}

__device__ __forceinline__ void ph_mod(Frame& F) {
    const int gt = F.gw * 64 + F.lane, ngt = F.ngw * 64;
    for (int it = gt; it < 2 * 6144; it += ngt) {
        const int l = it / 6144, n = it % 6144;
        const float* W = F.in[I_ADAW] + (size_t)l * D * 6144 + n;
        float a0 = 0.f, a1 = 0.f, a2 = 0.f, a3 = 0.f, a4 = 0.f;
        const float* c = F.in[I_C]; const float* cc = F.in[I_CCTX];
        for (int k = 0; k < D; ++k) { const float w = W[(size_t)k * 6144];
            a0 += siluf(c[k]) * w; a1 += siluf(c[D + k]) * w; a2 += siluf(c[2 * D + k]) * w; a3 += siluf(c[3 * D + k]) * w; a4 += siluf(cc[k]) * w; }
        const float bb = F.in[I_ADAB][l * 6144 + n];
        F.MOD[(l * 4 + 0) * 6144 + n] = a0 + bb; F.MOD[(l * 4 + 1) * 6144 + n] = a1 + bb; F.MOD[(l * 4 + 2) * 6144 + n] = a2 + bb; F.MOD[(l * 4 + 3) * 6144 + n] = a3 + bb;
        if (l == 0 && n < 2048) F.MODC[n] = a4 + bb;
    }
    for (int it = gt; it < 64 * 16; it += ngt) {
        const int pos = it >> 4, j = it & 15;
        const float inv = powf(10000.0f, -(float)j / 16.0f);
        const float ang = (float)pos * inv;
        F.ROPE[it * 2] = cosf(ang); F.ROPE[it * 2 + 1] = sinf(ang);
    }
}

__device__ __forceinline__ void norm_row(Frame& F, const float* xrow, const float* g, const float* sh, const float* sc, bf16* hrow) {
    const f32x4* xr = (const f32x4*)xrow + F.lane;
    f32x4 v[4]; float s = 0.f;
#pragma unroll
    for (int j = 0; j < 4; ++j) { v[j] = xr[64 * j]; s += (v[j].x * v[j].x + v[j].y * v[j].y) + (v[j].z * v[j].z + v[j].w * v[j].w); }
    const float rstd = rsqrtf(wave_sum(s) * (1.f / D) + EPS);
    unsigned long long* o8 = (unsigned long long*)hrow + F.lane;
#pragma unroll
    for (int j = 0; j < 4; ++j) {
        const f32x4 gg = ((const f32x4*)g)[F.lane + 64 * j], s1 = ((const f32x4*)sh)[F.lane + 64 * j], s2 = ((const f32x4*)sc)[F.lane + 64 * j];
        const f32x4 y = (v[j] * rstd * gg) * (s2 + 1.f) + s1;
        o8[64 * j] = (unsigned long long)pk2(y.x, y.y) | ((unsigned long long)pk2(y.z, y.w) << 32);
    }
}
__device__ __forceinline__ void ph_norm0(Frame& F) {
    for (int r = F.gw; r < NROW; r += F.ngw) {
        if (r < NTOK) { const int b = r >> 12; norm_row(F, F.in[I_X] + (size_t)r * D, F.in[I_NMG], F.MOD + (0 * 4 + b) * 6144, F.MOD + (0 * 4 + b) * 6144 + D, F.H + (size_t)r * D); }
        else norm_row(F, F.in[I_CTX] + (size_t)(r - NTOK) * D, F.in[I_NMG], F.MODC, F.MODC + D, F.H + (size_t)r * D);
    }
}

__device__ __forceinline__ void ph_inproj_naive(Frame& F) {
    const float* W = F.in[I_WIN];
    for (int it = F.gw; it < 272 * 56; it += F.ngw) {
        const int rg = it / 56, u = it % 56; if (rg >= 256 && u >= 32) continue;
        const int row = rg * 64 + F.lane;
        float acc[64];
#pragma unroll
        for (int j = 0; j < 64; ++j) acc[j] = 0.f;
        naive_dot<64>(F.H + (size_t)row * D, W + u * 64, ABW, D, acc);
        const int t = u >> 3, h = u & 7;
        if ((t == 0 || t == 4) && row < NTOK) {
            const int tt = row & 4095, pr = tt >> 6, pc = tt & 63;
#pragma unroll
            for (int j = 0; j < 16; ++j) {
                const float c1 = F.ROPE[(pr * 16 + j) * 2], s1 = F.ROPE[(pr * 16 + j) * 2 + 1], c2 = F.ROPE[(pc * 16 + j) * 2], s2 = F.ROPE[(pc * 16 + j) * 2 + 1];
                const float a = acc[j], b = acc[j + 16], c = acc[32 + j], d = acc[48 + j];
                acc[j] = a * c1 - b * s1; acc[j + 16] = a * s1 + b * c1; acc[32 + j] = c * c2 - d * s2; acc[48 + j] = c * s2 + d * c2;
            }
        }
        if (t == 0) {
#pragma unroll
            for (int j = 0; j < 64; ++j) acc[j] *= 0.125f;
        }
        if (t == 2 || t == 6) {
            float ss = 0.f;
#pragma unroll
            for (int j = 0; j < 64; ++j) ss += acc[j] * acc[j];
            const float r = rsqrtf(ss * (1.f / 64.f) + EPS) * (t == 6 ? 0.125f : 1.f);
            const float* g = t == 2 ? F.in[I_KG] : F.in[I_QG];
#pragma unroll
            for (int j = 0; j < 64; ++j) acc[j] = acc[j] * r * g[j];
        }
        if (t == 5) {
#pragma unroll
            for (int j = 0; j < 64; ++j) acc[j] = siluf(acc[j]);
        }
        const size_t off_t = t < 4 ? (size_t)t * 17 * MiB : (size_t)(68 + (t - 4) * 16) * MiB;
        bf16* dst = (bf16*)(F.A + off_t) + (size_t)row * HW + h * 64;
        store_row_bf16<64>(dst, acc);
    }
}

__device__ __forceinline__ float ret_gamma_log(Frame& F, int dir, int h) {
    const float th = F.in[I_RDEC][dir * 8 + h];
    return -(th > 0.f ? th + log1pf(__expf(-th)) : log1pf(__expf(th)));
}
__device__ __forceinline__ void ph_scan_naive(Frame& F) {
    const bf16* RK = (const bf16*)(F.A + A_RK); const bf16* RV = (const bf16*)(F.A + A_RV); bf16* SST = (bf16*)(F.A + A_SST);
    const int gt = F.gw * 64 + F.lane, ngt = F.ngw * 64;
    for (int it = gt; it < 64 * 4096; it += ngt) {
        const int bhd = it >> 12, ed = it & 4095, e = ed >> 6, d = ed & 63;
        const int dir = bhd & 1, h = (bhd >> 1) & 7, b = bhd >> 4;
        const float gam = __expf(ret_gamma_log(F, dir, h));
        float S = 0.f;
        bf16* sst = SST + ((size_t)((b * 8 + h) * 2 + dir) * 32) * 4096 + ed;
        for (int n = 0; n < CTXL; ++n) { const int nn = dir ? (CTXL - 1 - n) : n; const size_t row = NTOK + b * CTXL + nn;
            S = gam * S + bf2f(RK[row * HW + h * 64 + d]) * bf2f(RV[row * HW + h * 64 + e]); }
        for (int n = 0; n < SEQ; ++n) { const int t = dir ? (SEQ - 1 - n) : n; const size_t row = (size_t)b * SEQ + t;
            if ((n & 127) == 0) sst[(size_t)(t >> 7) * 4096] = (bf16)f2bf(S);
            S = gam * S + bf2f(RK[row * HW + h * 64 + d]) * bf2f(RV[row * HW + h * 64 + e]); }
    }
}
__device__ __forceinline__ void ph_na_naive(Frame& F) {
    const bf16* NK = (const bf16*)(F.A + A_NK); const bf16* NV = (const bf16*)(F.A + A_NV); const bf16* NQ = (const bf16*)(F.A + A_NQ); bf16* MIX = (bf16*)(F.A + A_MIX);
    const int gt = F.gw * 64 + F.lane, ngt = F.ngw * 64;
    for (int it = gt; it < NB * NH * SEQ; it += ngt) {
        const int t = it & 4095, h = (it >> 12) & 7, b = it >> 15;
        const int r = t >> 6, c = t & 63;
        int r0 = r - 4; r0 = r0 < 0 ? 0 : (r0 > 56 ? 56 : r0); int c0 = c - 8; c0 = c0 < 0 ? 0 : (c0 > 48 ? 48 : c0);
        const size_t qrow = (size_t)b * SEQ + t;
        unsigned q[32]; float o[64];
#pragma unroll
        for (int j = 0; j < 32; ++j) q[j] = *(const unsigned*)(NQ + qrow * HW + h * 64 + 2 * j);
#pragma unroll
        for (int j = 0; j < 64; ++j) o[j] = 0.f;
        float m = -1e30f, l = 0.f;
        const float* rpb = F.in[I_RPB] + h * 15 * 31;
#pragma unroll 1
        for (int kk = 0; kk < 384; ++kk) {
            size_t krow; float bias = 0.f;
            if (kk < 128) { const int kr = r0 + (kk >> 4), kc = c0 + (kk & 15); krow = (size_t)b * SEQ + kr * 64 + kc; bias = rpb[(kr - r + 7) * 31 + (kc - c + 15)]; }
            else krow = NTOK + b * CTXL + (kk - 128);
            float s = 0.f;
#pragma unroll
            for (int j = 0; j < 64; j += 2) { const unsigned w = *(const unsigned*)(NK + krow * HW + h * 64 + j); s += bf2f(q[j >> 1] & 0xffffu) * bf2f(w & 0xffffu) + bf2f(q[j >> 1] >> 16) * bf2f(w >> 16); }
            s += bias;
            asm volatile("" ::: "memory");
            const float mn = fmaxf(m, s), al = __expf(m - mn), p = __expf(s - mn);
            l = l * al + p; m = mn;
#pragma unroll
            for (int j = 0; j < 64; j += 2) { const unsigned w = *(const unsigned*)(NV + krow * HW + h * 64 + j); o[j] = o[j] * al + p * bf2f(w & 0xffffu); o[j + 1] = o[j + 1] * al + p * bf2f(w >> 16); }
        }
        const float il = 1.f / l;
#pragma unroll
        for (int j = 0; j < 64; ++j) o[j] *= il;
        store_row_bf16<64>(MIX + qrow * D + 512 + h * 64, o);
    }
}
__device__ __forceinline__ void ph_retout_naive(Frame& F) {
    const bf16* RK = (const bf16*)(F.A + A_RK); const bf16* RV = (const bf16*)(F.A + A_RV); const bf16* RQ = (const bf16*)(F.A + A_RQ); const bf16* GT = (const bf16*)(F.A + A_GT);
    const bf16* SST = (const bf16*)(F.A + A_SST); bf16* MIX = (bf16*)(F.A + A_MIX);
    const int gt = F.gw * 64 + F.lane, ngt = F.ngw * 64;
    for (int it = gt; it < NB * NH * SEQ * 2; it += ngt) {
        const int hf = it & 1, t = (it >> 1) & 4095, h = (it >> 13) & 7, b = it >> 16;
        const int i = t & 127, ch = t >> 7;
        const size_t qrow = (size_t)b * SEQ + t;
        const float lgf = ret_gamma_log(F, 0, h), lgb = ret_gamma_log(F, 1, h);
        unsigned q[32]; float o[32];
#pragma unroll
        for (int j = 0; j < 32; ++j) q[j] = *(const unsigned*)(RQ + qrow * HW + h * 64 + 2 * j);
#pragma unroll
        for (int j = 0; j < 32; ++j) o[j] = 0.f;
#pragma unroll 1
        for (int jj = 0; jj < 128; ++jj) {
            const size_t krow = (size_t)b * SEQ + ch * 128 + jj;
            float s = 0.f;
#pragma unroll
            for (int j = 0; j < 64; j += 2) { const unsigned w = *(const unsigned*)(RK + krow * HW + h * 64 + j); s += bf2f(q[j >> 1] & 0xffffu) * bf2f(w & 0xffffu) + bf2f(q[j >> 1] >> 16) * bf2f(w >> 16); }
            asm volatile("" ::: "memory");
            const float wgt = jj < i ? __expf(lgf * (float)(i - jj)) : (jj > i ? __expf(lgb * (float)(jj - i)) : 2.f);
            s *= wgt;
#pragma unroll
            for (int j = 0; j < 32; j += 2) { const unsigned w = *(const unsigned*)(RV + krow * HW + h * 64 + hf * 32 + j); o[j] += s * bf2f(w & 0xffffu); o[j + 1] += s * bf2f(w >> 16); }
            asm volatile("" ::: "memory");
        }
        const float qf = __expf(lgf * (float)(i + 1)), qb = __expf(lgb * (float)(128 - i));
        const bf16* Sf = SST + ((size_t)((b * 8 + h) * 2 + 0) * 32 + ch) * 4096 + hf * 32 * 64; const bf16* Sb = SST + ((size_t)((b * 8 + h) * 2 + 1) * 32 + ch) * 4096 + hf * 32 * 64;
#pragma unroll 1
        for (int d = 0; d < 64; ++d) {
            const float qd = bf2f(RQ[qrow * HW + h * 64 + d]); const float qfd = qf * qd, qbd = qb * qd;
#pragma unroll
            for (int e = 0; e < 32; ++e) o[e] += qfd * bf2f(Sf[e * 64 + d]) + qbd * bf2f(Sb[e * 64 + d]);
            asm volatile("" ::: "memory");
        }
        float ss = 0.f;
#pragma unroll
        for (int j = 0; j < 32; ++j) ss += o[j] * o[j];
        ss += __shfl_xor(ss, 1);
        const float rs = rsqrtf(ss * (1.f / 64.f) + EPS);
        const float* g = F.in[I_RNG] + hf * 32;
#pragma unroll
        for (int j = 0; j < 32; j += 2) { const unsigned w = *(const unsigned*)(GT + qrow * HW + h * 64 + hf * 32 + j); o[j] = o[j] * rs * g[j] * bf2f(w & 0xffffu); o[j + 1] = o[j + 1] * rs * g[j + 1] * bf2f(w >> 16); }
        store_row_bf16<32>(MIX + qrow * D + h * 64 + hf * 32, o);
    }
}
__device__ __forceinline__ void ph_gemm_res_naive(Frame& F, const bf16* A, int lda, int K, const float* W, const float* base, const float* gate  ) {
    for (int it = F.gw; it < 256 * 16; it += F.ngw) {
        const int rg = it >> 4, u = it & 15, row = rg * 64 + F.lane, b = row >> 12;
        float acc[64];
#pragma unroll
        for (int j = 0; j < 64; ++j) acc[j] = 0.f;
        naive_dot<64>(A + (size_t)row * lda, W + u * 64, D, K, acc);
        const float* gp = gate + b * 6144 + u * 64; const float* bp = base + (size_t)row * D + u * 64; float* op = F.out + (size_t)row * D + u * 64;
#pragma unroll
        for (int j = 0; j < 64; j += 4) { const f32x4 bv = *(const f32x4*)(bp + j), gv = *(const f32x4*)(gp + j);
            *(f32x4*)(op + j) = bv + gv * (f32x4){acc[j], acc[j + 1], acc[j + 2], acc[j + 3]}; }
    }
}
__device__ __forceinline__ void ph_route(Frame& F, int l) {
    LAS float* rw = (LAS float*)F.lds;
    for (int i = F.tid; i < D * NE; i += NTHREADS) rw[i] = F.in[I_RW][i];
    __syncthreads();
    unsigned* cnt = F.ctl + CW_CNT + l * 1024;
    for (int r = F.gw; r < NTOK; r += F.ngw) {
        const int b = r >> 12;
        const float* g = F.in[I_NFG] + l * D; const float* sh = F.MOD + (l * 4 + b) * 6144 + 3 * D; const float* sc = F.MOD + (l * 4 + b) * 6144 + 4 * D;
        const f32x4* xr = (const f32x4*)(F.out + (size_t)r * D) + F.lane;
        f32x4 v[4]; float s = 0.f;
#pragma unroll
        for (int j = 0; j < 4; ++j) { v[j] = xr[64 * j]; s += (v[j].x * v[j].x + v[j].y * v[j].y) + (v[j].z * v[j].z + v[j].w * v[j].w); }
        const float rstd = rsqrtf(wave_sum(s) * (1.f / D) + EPS);
        unsigned long long* o8 = (unsigned long long*)(F.H + (size_t)r * D) + F.lane;
        float lg[16];
#pragma unroll
        for (int e = 0; e < 16; ++e) lg[e] = 0.f;
#pragma unroll
        for (int j = 0; j < 4; ++j) {
            const f32x4 gg = ((const f32x4*)g)[F.lane + 64 * j], s1 = ((const f32x4*)sh)[F.lane + 64 * j], s2 = ((const f32x4*)sc)[F.lane + 64 * j];
            const f32x4 y = (v[j] * rstd * gg) * (s2 + 1.f) + s1;
            o8[64 * j] = (unsigned long long)pk2(y.x, y.y) | ((unsigned long long)pk2(y.z, y.w) << 32);
            const int k0 = (F.lane + 64 * j) * 4;
#pragma unroll
            for (int i = 0; i < 4; ++i) { const float yv = y[i];
#pragma unroll
                for (int e4 = 0; e4 < 4; ++e4) { const f32x4 w = *(const LAS f32x4*)(rw + (k0 + i) * 16 + e4 * 4);
                    lg[e4 * 4] += yv * w.x; lg[e4 * 4 + 1] += yv * w.y; lg[e4 * 4 + 2] += yv * w.z; lg[e4 * 4 + 3] += yv * w.w; }
                asm volatile("" ::: "memory"); }
        }
#pragma unroll
        for (int e = 0; e < 16; ++e) lg[e] = wave_sum(lg[e]);
        if (F.lane == 0) {
            float aff[16], sel[16];
#pragma unroll
            for (int e = 0; e < 16; ++e) { aff[e] = 1.f / (1.f + __expf(-lg[e])); sel[e] = aff[e] + F.in[I_RB][e]; }
            int best = 0; float bs = -1e30f;
#pragma unroll
            for (int gI = 0; gI < 4; ++gI) {
                float m1 = -1e30f, m2 = -1e30f;
#pragma unroll
                for (int i = 0; i < 4; ++i) { const float x = sel[gI * 4 + i]; if (x > m1) { m2 = m1; m1 = x; } else if (x > m2) m2 = x; }
                const float sc2 = m1 + m2; if (sc2 > bs) { bs = sc2; best = gI; }
            }
            int i1 = 0, i2 = 0; float m1 = -1e30f, m2 = -1e30f, a1 = 0.f, a2 = 0.f;
#pragma unroll
            for (int gI = 0; gI < 4; ++gI)
#pragma unroll
                for (int i = 0; i < 4; ++i) { if (gI == best) { const float x = sel[gI * 4 + i]; const float a = aff[gI * 4 + i]; const int id = gI * 4 + i;
                    if (x > m1) { m2 = m1; i2 = i1; a2 = a1; m1 = x; i1 = id; a1 = a; } else if (x > m2) { m2 = x; i2 = id; a2 = a; } } }
            const float inv = 1.f / (a1 + a2);
            const unsigned p1 = __hip_atomic_fetch_add(cnt + i1 * 64, 1u, RLX_AGENT), p2 = __hip_atomic_fetch_add(cnt + i2 * 64, 1u, RLX_AGENT);
            F.LIST[i1 * 16384 + p1] = 2 * r; F.LIST[i2 * 16384 + p2] = 2 * r + 1;
            F.WT[2 * r] = a1 * inv; F.WT[2 * r + 1] = a2 * inv;
        }
    }
    __syncthreads();
}
struct Seg { int cnt[16]; int base[16]; };
__device__ __forceinline__ void load_seg(Frame& F, int l, int (&cnt)[16], int (&base)[16]) {
    int acc = 0;
#pragma unroll
    for (int e = 0; e < 16; ++e) { cnt[e] = (int)__hip_atomic_load(F.ctl + CW_CNT + l * 1024 + e * 64, RLX_AGENT); base[e] = acc; acc += (cnt[e] + 255) & ~255; }
}
__device__ __forceinline__ void ph_moe_gu_naive(Frame& F, int l) {
    int cnt[16], base[16]; load_seg(F, l, cnt, base);
    bf16* ACT = (bf16*)(F.A + A_ACT);
    int tot = 0;
#pragma unroll
    for (int i = 0; i < 16; ++i) tot += (cnt[i] + 63) >> 6;
    for (int it = F.gw; it < tot * 16; it += F.ngw) {
        const int gi_all = it >> 4, u = it & 15;
        int ee = 0, gs = 0;
#pragma unroll
        for (int i = 0, cum = 0; i < 16; ++i) { cum += (cnt[i] + 63) >> 6; if (gi_all >= cum) { gs = cum; ee = i + 1; } }
        int ce = 0, be = 0;
#pragma unroll
        for (int i = 0; i < 16; ++i) if (i == ee) { ce = cnt[i]; be = base[i]; }
        const int pos = (gi_all - gs) * 64 + F.lane; const bool valid = pos < ce;
        const int ent = F.LIST[ee * 16384 + (valid ? pos : 0)]; const int tok = ent >> 1;
        float ag[32], au[32];
#pragma unroll
        for (int j = 0; j < 32; ++j) { ag[j] = 0.f; au[j] = 0.f; }
        const float* Wg = F.in[I_WG] + ((size_t)(l * NE + ee) * D) * EW + u * 32; const float* Wu = F.in[I_WU] + ((size_t)(l * NE + ee) * D) * EW + u * 32;
        naive_dot<32>(F.H + (size_t)tok * D, Wg, EW, D, ag);
        naive_dot<32>(F.H + (size_t)tok * D, Wu, EW, D, au);
#pragma unroll
        for (int j = 0; j < 32; ++j) ag[j] = siluf(ag[j]) * au[j];
        if (valid) store_row_bf16<32>(ACT + (size_t)(be + pos) * EW + u * 32, ag);
    }
}
__device__ __forceinline__ void ph_moe_dn_naive(Frame& F, int l) {
    int cnt[16], base[16]; load_seg(F, l, cnt, base);
    const bf16* ACT = (const bf16*)(F.A + A_ACT); bf16* Y = (bf16*)(F.A + A_Y);
    int tot = 0;
#pragma unroll
    for (int i = 0; i < 16; ++i) tot += (cnt[i] + 63) >> 6;
    for (int it = F.gw; it < tot * 16; it += F.ngw) {
        const int gi_all = it >> 4, u = it & 15;
        int ee = 0, gs = 0;
#pragma unroll
        for (int i = 0, cum = 0; i < 16; ++i) { cum += (cnt[i] + 63) >> 6; if (gi_all >= cum) { gs = cum; ee = i + 1; } }
        int ce = 0, be = 0;
#pragma unroll
        for (int i = 0; i < 16; ++i) if (i == ee) { ce = cnt[i]; be = base[i]; }
        const int pos = (gi_all - gs) * 64 + F.lane; const bool valid = pos < ce;
        const int ent = F.LIST[ee * 16384 + (valid ? pos : 0)];
        float acc[64];
#pragma unroll
        for (int j = 0; j < 64; ++j) acc[j] = 0.f;
        const float* Wd = F.in[I_WD] + ((size_t)(l * NE + ee) * EW) * D + u * 64;
        naive_dot<64>(ACT + (size_t)(be + (valid ? pos : 0)) * EW, Wd, D, EW, acc);
        const float w = F.WT[ent];
#pragma unroll
        for (int j = 0; j < 64; ++j) acc[j] *= w;
        if (valid) store_row_bf16<64>(Y + (size_t)ent * D + u * 64, acc);
    }
}
__device__ __forceinline__ void ph_combine(Frame& F, int l, bool do_norm) {
    const bf16* Y = (const bf16*)(F.A + A_Y);
    for (int r = F.gw; r < NTOK; r += F.ngw) {
        const int b = r >> 12;
        const float* gf = F.MOD + (l * 4 + b) * 6144 + 5 * D;
        f32x4* xr = (f32x4*)(F.out + (size_t)r * D) + F.lane;
        const unsigned long long* ya = (const unsigned long long*)(Y + (size_t)(2 * r) * D) + F.lane; const unsigned long long* yb = (const unsigned long long*)(Y + (size_t)(2 * r + 1) * D) + F.lane;
        f32x4 v[4]; float s = 0.f;
#pragma unroll
        for (int j = 0; j < 4; ++j) {
            const unsigned long long a = ya[64 * j], bq = yb[64 * j];
            const f32x4 yy = { bf2f((unsigned)a & 0xffffu) + bf2f((unsigned)bq & 0xffffu), bf2f(((unsigned)a) >> 16) + bf2f(((unsigned)bq) >> 16),
                               bf2f((unsigned)(a >> 32) & 0xffffu) + bf2f((unsigned)(bq >> 32) & 0xffffu), bf2f((unsigned)(a >> 48)) + bf2f((unsigned)(bq >> 48)) };
            v[j] = xr[64 * j] + ((const f32x4*)gf)[F.lane + 64 * j] * yy;
            xr[64 * j] = v[j];
            s += (v[j].x * v[j].x + v[j].y * v[j].y) + (v[j].z * v[j].z + v[j].w * v[j].w);
        }
        if (do_norm) {
            const float rstd = rsqrtf(wave_sum(s) * (1.f / D) + EPS);
            const float* g = F.in[I_NMG] + (l + 1) * D; const float* sh = F.MOD + ((l + 1) * 4 + b) * 6144; const float* sc = sh + D;
            unsigned long long* o8 = (unsigned long long*)(F.H + (size_t)r * D) + F.lane;
#pragma unroll
            for (int j = 0; j < 4; ++j) {
                const f32x4 gg = ((const f32x4*)g)[F.lane + 64 * j], s1 = ((const f32x4*)sh)[F.lane + 64 * j], s2 = ((const f32x4*)sc)[F.lane + 64 * j];
                const f32x4 y = (v[j] * rstd * gg) * (s2 + 1.f) + s1;
                o8[64 * j] = (unsigned long long)pk2(y.x, y.y) | ((unsigned long long)pk2(y.z, y.w) << 32);
            }
        }
    }
}
__device__ __forceinline__ void ph_sguin_naive(Frame& F) {
    bf16* U = (bf16*)(F.A + A_U); bf16* V = (bf16*)(F.A + A_V);
    for (int it = F.gw; it < 256 * 96; it += F.ngw) {
        const int rg = it / 96, u = it % 96, row = rg * 64 + F.lane;
        float acc[64];
#pragma unroll
        for (int j = 0; j < 64; ++j) acc[j] = 0.f;
        naive_dot<64>(F.H + (size_t)row * D, F.in[I_SWIN] + u * 64, 2 * SGW, D, acc);
        const float* bi = F.in[I_SBIN] + u * 64; float ss = 0.f;
#pragma unroll
        for (int j = 0; j < 64; ++j) { acc[j] = gelu_tanh(acc[j] + bi[j]); ss += acc[j] * acc[j]; }
        if (u < 48) store_row_bf16<64>(U + (size_t)row * SGW + u * 64, acc);
        else { store_row_bf16<64>(V + (size_t)row * SGW + (u - 48) * 64, acc); F.VSS[(size_t)row * 48 + (u - 48)] = ss; }
    }
}
__device__ __forceinline__ void ph_sgumix_naive(Frame& F) {
    bf16* U = (bf16*)(F.A + A_U); const bf16* V = (const bf16*)(F.A + A_V);
    LAS float* rs = (LAS float*)F.lds;
    for (int bc = blockIdx.x; bc < NB * 32; bc += gridDim.x) {
        const size_t row0 = (size_t)bc * 128;
        __syncthreads();
        if (F.tid < 128) { float s = 0.f; for (int j = 0; j < 48; ++j) s += F.VSS[(row0 + F.tid) * 48 + j]; rs[F.tid] = rsqrtf(s * (1.f / SGW) + EPS); }
        __syncthreads();
        for (int o = F.tid; o < 128 * SGW; o += NTHREADS) {
            const int i = o / SGW, c = o % SGW, g = c / 384;
            const float* ws = F.in[I_SWS] + ((size_t)g * 128 + i) * 128;
            float acc = 0.f;
            for (int j = 0; j < 128; ++j) acc += ws[j] * (bf2f(V[(row0 + j) * SGW + c]) * rs[j]);
            const float mixed = acc * F.in[I_SNG][c] + F.in[I_SBS][g * 128 + i];
            const size_t idx = (row0 + i) * SGW + c;
            U[idx] = (bf16)f2bf(bf2f(U[idx]) * mixed);
        }
    }
    __syncthreads();
}


namespace pg8 {
typedef short bf16x8 __attribute__((ext_vector_type(8)));
constexpr int BM = 256, BK = 64, HALF = 128, HTB = HALF * BK * 2, STAGE_BYTES = 8 * HTB;
__host__ __device__ __forceinline__ int lds_byte(int r, int c) { const int st = (r >> 4) * 2 + (c >> 5), rr = r & 15, cc = c & 31, ob = rr * 64 + cc * 2; return st * 1024 + (ob ^ (((ob >> 9) & 1) << 5)); }
__host__ __device__ __forceinline__ void stage_rc(int b, int& R, int& C) { const int st = b / 1024, sb = b % 1024, swz = sb ^ (((sb >> 9) & 1) << 5); R = (st >> 1) * 16 + swz / 64; C = (st & 1) * 32 + (swz % 64) / 2; }
struct Unit { int pm, pn; const char* Ab; const char* Bb; int x0, x1, x2; };
__device__ __forceinline__ unsigned cvt_pk_bf16(float lo, float hi) { unsigned r; asm volatile("v_cvt_pk_bf16_f32 %0, %1, %2" : "=v"(r) : "v"(lo), "v"(hi)); return r; }

template <class Sched, class Epi, bool ALIGN_EPI>
__device__ __forceinline__ void gemm_phase(LAS unsigned char* lds, const int K, const Sched& S, const Epi& E) {
    const int tid = threadIdx.x, wid = __builtin_amdgcn_readfirstlane(tid >> 6), lane = tid & 63, wr = wid >> 2, wc = wid & 3, fr = lane & 15, fq = lane >> 4;
    const int nt = K / BK;
    int Rs[2], Cs[2]; unsigned voffB[2];
#pragma unroll
    for (int i = 0; i < 2; ++i) { stage_rc(tid * 16 + i * 8192, Rs[i], Cs[i]); voffB[i] = (unsigned)(Rs[i] * K + Cs[i]) * 2u; }
    const size_t kstep = (size_t)(BK * 2);
    const size_t hstep = (size_t)HALF * K * 2;
    const unsigned ldsw = (unsigned)wid * 1024u;
    const int aoff = lds_byte(wr * 64 + fr, fq * 8), boff = lds_byte(wc * 32 + fr, fq * 8);
#define PG8_SA(b, h) (((b) * 2 + (h)) * HTB)
#define PG8_SB(b, h) ((4 + (b) * 2 + (h)) * HTB)
#define PG8_STAGE(bufoff, gbase, voff) do { _Pragma("unroll") for (int _i = 0; _i < 2; ++_i) \
        __builtin_amdgcn_global_load_lds((const unsigned*)((const char*)(gbase) + (voff)[_i]), (LAS unsigned*)(lds + (bufoff) + ldsw + _i * 8192), 16, 0, 0); } while (0)
#define PG8_LDA(dst, b, h) do { _Pragma("unroll") for (int m = 0; m < 4; ++m) _Pragma("unroll") for (int k = 0; k < 2; ++k) dst[m][k] = *(const LAS bf16x8*)(lds + PG8_SA(b, h) + aoff + m * 2048 + k * 1024); } while (0)
#define PG8_LDB(dst, b, h) do { _Pragma("unroll") for (int n = 0; n < 2; ++n) _Pragma("unroll") for (int k = 0; k < 2; ++k) dst[n][k] = *(const LAS bf16x8*)(lds + PG8_SB(b, h) + boff + n * 2048 + k * 1024); } while (0)
#define PG8_MMA(ai, bj, At, Bt) do { __builtin_amdgcn_s_setprio(1); _Pragma("unroll") for (int m = 0; m < 4; ++m) _Pragma("unroll") for (int n = 0; n < 2; ++n) _Pragma("unroll") for (int k = 0; k < 2; ++k) \
        acc[ai][bj][m][n] = __builtin_amdgcn_mfma_f32_16x16x32_bf16(Bt[n][k], At[m][k], acc[ai][bj][m][n], 0, 0, 0); __builtin_amdgcn_s_setprio(0); } while (0)
#define PG8_WAIT_V(n) asm volatile("s_waitcnt vmcnt(" #n ")" ::: "memory")
#define PG8_WAIT_L(n) asm volatile("s_waitcnt lgkmcnt(" #n ")" ::: "memory")
#define PG8_BAR __builtin_amdgcn_s_barrier()
#define PG8_SCHED __builtin_amdgcn_sched_barrier(0)
    Unit cur, nxt; int ui = 0;
    if (!S.next(0, cur)) return;
    unsigned vA[2][2], nvA[2][2];
    S.arows(cur, vA, Rs, Cs);
    f32x4 acc[2][2][4][2];
#pragma unroll
    for (int a = 0; a < 2; ++a)
#pragma unroll
        for (int b = 0; b < 2; ++b)
#pragma unroll
            for (int m = 0; m < 4; ++m)
#pragma unroll
                for (int n = 0; n < 2; ++n) acc[a][b][m][n] = (f32x4){0.f, 0.f, 0.f, 0.f};
    bf16x8 At[4][2], B0[2][2], B1[2][2];
    const char* cA = cur.Ab; const char* cB = cur.Bb;
    PG8_STAGE(PG8_SB(0, 0), cB, voffB); PG8_STAGE(PG8_SB(0, 1), cB + hstep, voffB); PG8_STAGE(PG8_SA(0, 0), cA, vA[0]); PG8_STAGE(PG8_SA(0, 1), cA, vA[1]);
    if (wr == 1) PG8_BAR;
    PG8_WAIT_V(2); PG8_BAR;
    PG8_STAGE(PG8_SB(1, 0), cB + kstep, voffB); PG8_STAGE(PG8_SA(1, 0), cA + kstep, vA[0]); PG8_STAGE(PG8_SB(1, 1), cB + hstep + kstep, voffB);
    PG8_WAIT_V(6); PG8_BAR;
    for (;;) {
        const bool has_next = S.next(ui + 1, nxt);
        if (has_next) S.arows(nxt, nvA, Rs, Cs); else { nvA[0][0] = vA[0][0]; nvA[0][1] = vA[0][1]; nvA[1][0] = vA[1][0]; nvA[1][1] = vA[1][1]; }
        const char* nA = has_next ? nxt.Ab : cA; const char* nB = has_next ? nxt.Bb : cB;
        for (int t = 0; t < nt; t += 2) {
            const bool last = (t == nt - 2);
            const char* a1 = cA + (size_t)(t + 1) * kstep;
            const char* a2 = last ? nA : cA + (size_t)(t + 2) * kstep; const char* b2 = last ? nB : cB + (size_t)(t + 2) * kstep;
            const char* a3 = a2 + kstep; const char* b3 = b2 + kstep;
            unsigned w0[2], w1[2];
            w0[0] = last ? nvA[0][0] : vA[0][0]; w0[1] = last ? nvA[0][1] : vA[0][1]; w1[0] = last ? nvA[1][0] : vA[1][0]; w1[1] = last ? nvA[1][1] : vA[1][1];
            PG8_LDB(B0, 0, 0); PG8_LDB(B1, 0, 1); PG8_SCHED; PG8_LDA(At, 0, 0); PG8_STAGE(PG8_SA(1, 1), a1, vA[1]);
            PG8_WAIT_V(8); PG8_WAIT_L(0); PG8_BAR; PG8_MMA(0, 0, At, B0); PG8_MMA(0, 1, At, B1); PG8_BAR; PG8_SCHED;
            PG8_LDA(At, 0, 1); PG8_STAGE(PG8_SB(0, 0), b2, voffB); PG8_STAGE(PG8_SB(0, 1), b2 + hstep, voffB); PG8_STAGE(PG8_SA(0, 0), a2, w0);
            PG8_WAIT_V(8); PG8_WAIT_L(0); PG8_BAR; PG8_MMA(1, 0, At, B0); PG8_MMA(1, 1, At, B1); PG8_BAR; PG8_SCHED;
            PG8_LDB(B0, 1, 0); PG8_LDB(B1, 1, 1); PG8_SCHED; PG8_LDA(At, 1, 0); PG8_STAGE(PG8_SA(0, 1), a2, w1);
            PG8_WAIT_V(8); PG8_WAIT_L(0); PG8_BAR; PG8_MMA(0, 0, At, B0); PG8_MMA(0, 1, At, B1); PG8_BAR; PG8_SCHED;
            PG8_LDA(At, 1, 1); PG8_STAGE(PG8_SB(1, 0), b3, voffB); PG8_STAGE(PG8_SB(1, 1), b3 + hstep, voffB); PG8_STAGE(PG8_SA(1, 0), a3, w0);
            PG8_WAIT_V(8); PG8_WAIT_L(0); PG8_BAR; PG8_MMA(1, 0, At, B0); PG8_MMA(1, 1, At, B1); PG8_BAR; PG8_SCHED;
        }
        if constexpr (ALIGN_EPI) { if (wr == 0) PG8_BAR; }
        E(acc, cur, wr, wc, fr, fq);
        if (!has_next) break;
#pragma unroll
        for (int a = 0; a < 2; ++a)
#pragma unroll
            for (int b = 0; b < 2; ++b)
#pragma unroll
                for (int m = 0; m < 4; ++m)
#pragma unroll
                    for (int n = 0; n < 2; ++n) acc[a][b][m][n] = (f32x4){0.f, 0.f, 0.f, 0.f};
        cur = nxt; cA = nA; cB = nB; ++ui;
        vA[0][0] = nvA[0][0]; vA[0][1] = nvA[0][1]; vA[1][0] = nvA[1][0]; vA[1][1] = nvA[1][1];
        if constexpr (ALIGN_EPI) { if (wr == 1) PG8_BAR; }
    }
    PG8_WAIT_V(0);
    if constexpr (!ALIGN_EPI) { if (wr == 0) PG8_BAR; }
    PG8_BAR;
#undef PG8_SA
#undef PG8_SB
#undef PG8_STAGE
#undef PG8_LDA
#undef PG8_LDB
#undef PG8_MMA
#undef PG8_WAIT_V
#undef PG8_WAIT_L
#undef PG8_BAR
#undef PG8_SCHED
}
}

constexpr size_t WB_WIN = 0;
constexpr size_t WB_WOUT = WB_WIN + (size_t)ABW * D * 2;
constexpr size_t WB_SWIN = WB_WOUT + (size_t)D * D * 2;
constexpr size_t WB_SWOUT = WB_SWIN + (size_t)2 * SGW * D * 2;
constexpr size_t WB_GU = WB_SWOUT + (size_t)D * SGW * 2;
constexpr size_t WB_DN = WB_GU + (size_t)2 * NE * 1024 * D * 2;
constexpr size_t WB_WS = WB_DN + (size_t)2 * NE * D * EW * 2;
constexpr size_t WB_END = WB_WS + (size_t)8 * 128 * 128 * 2;
static_assert(WB_END <= 124 * MiB, "bf16 weights fit");

__device__ __forceinline__ int slot_of(int mode, int c) {
    if (mode == 0) { const int bj = (c >> 7) & 1, wc = (c >> 5) & 3, fq = (c >> 3) & 3, nn = (c >> 2) & 1, rg = c & 3; return 128 * bj + 32 * wc + 16 * nn + 4 * fq + rg; }
    if (mode == 1) { const int wc = (c >> 6) & 3, bj = (c >> 5) & 1, nn = (c >> 4) & 1, fq = (c >> 2) & 3, rg = c & 3; return 128 * bj + 32 * wc + 16 * nn + 4 * fq + rg; }
    const int wc = (c >> 6) & 3, bj = (c >> 5) & 1, fq = (c >> 3) & 3, nn = (c >> 2) & 1, rg = c & 3; return 128 * bj + 32 * wc + 16 * nn + 4 * fq + rg;
}
template <class RowFn> __device__ __forceinline__ void conv_item(const float* W, int ldw, int k0, int n0, bf16* WT, int Kp, LAS float* scr, int lane, const RowFn& rowfn) {
    f32x4 v[8];
#pragma unroll
    for (int i = 0; i < 8; ++i) { const int kk = 8 * i + (lane >> 3); v[i] = *(const f32x4*)(W + (size_t)(k0 + kk) * ldw + n0 + 4 * (lane & 7)); }
#pragma unroll
    for (int i = 0; i < 8; ++i) { const int kk = 8 * i + (lane >> 3); LAS float* p = scr + kk * 33 + 4 * (lane & 7); p[0] = v[i].x; p[1] = v[i].y; p[2] = v[i].z; p[3] = v[i].w; }
    asm volatile("s_waitcnt lgkmcnt(0)" ::: "memory");
    const int c = lane & 7;
#pragma unroll
    for (int j = 0; j < 4; ++j) { const int n = (lane >> 3) + 8 * j; const LAS float* sp = scr + (8 * c) * 33 + n;
        u32x4 o; o.x = pk2(sp[0 * 33], sp[1 * 33]); o.y = pk2(sp[2 * 33], sp[3 * 33]); o.z = pk2(sp[4 * 33], sp[5 * 33]); o.w = pk2(sp[6 * 33], sp[7 * 33]);
        *(u32x4*)(WT + (size_t)rowfn(n0 + n) * Kp + k0 + 8 * c) = o; }
    asm volatile("s_waitcnt lgkmcnt(0)" ::: "memory");
}
__device__ __forceinline__ void ph_convert(Frame& F) {
    LAS float* scr = (LAS float*)(F.lds + F.wave * 16384);
    bf16* WB = (bf16*)(F.ws + WS_WB);
    constexpr int I_1 = 16 * 112, I_2 = 16 * 32, I_3 = 16 * 192, I_4 = 48 * 32, I_5 = 32 * 512, I_6 = 32 * 256, I_7 = 8 * 128 * 128 / 512;
    constexpr int NIT = I_1 + I_2 + I_3 + I_4 + I_5 + I_6 + I_7;
    for (int it = F.gw; it < NIT; it += F.ngw) {
        int r = it;
        if (r < I_1) { const int kb = r / 112, nb = r % 112, n0 = nb * 32; const int tile = n0 >> 8, ty = tile >> 1; const int mode = (ty == 0 || ty == 4) ? 1 : 2;
            conv_item(F.in[I_WIN], ABW, kb * 64, n0, (bf16*)((char*)WB + WB_WIN), D, scr, F.lane, [=](int n) { return (n & ~255) + slot_of(mode, n & 255); }); continue; } r -= I_1;
        if (r < I_2) { const int kb = r / 32, nb = r % 32;
            conv_item(F.in[I_WOUT], D, kb * 64, nb * 32, (bf16*)((char*)WB + WB_WOUT), D, scr, F.lane, [=](int n) { return (n & ~255) + slot_of(0, n & 255); }); continue; } r -= I_2;
        if (r < I_3) { const int kb = r / 192, nb = r % 192;
            conv_item(F.in[I_SWIN], 2 * SGW, kb * 64, nb * 32, (bf16*)((char*)WB + WB_SWIN), D, scr, F.lane, [=](int n) { return (n & ~255) + slot_of(0, n & 255); }); continue; } r -= I_3;
        if (r < I_4) { const int kb = r / 32, nb = r % 32;
            conv_item(F.in[I_SWOUT], D, kb * 64, nb * 32, (bf16*)((char*)WB + WB_SWOUT), SGW, scr, F.lane, [=](int n) { return (n & ~255) + slot_of(0, n & 255); }); continue; } r -= I_4;
        if (r < I_5) { const int le = r / 512, q = r % 512, which = q >> 8, kb = (q & 255) / 16, nb = q % 16;
            const float* W = (which ? F.in[I_WU] : F.in[I_WG]) + (size_t)le * D * EW;
            conv_item(W, EW, kb * 64, nb * 32, (bf16*)((char*)WB + WB_GU) + (size_t)le * 1024 * D, D, scr, F.lane,
                      [=](int j) { const int w = j & 127; return (j >> 7) * 256 + 128 * which + 32 * ((w >> 5) & 3) + 16 * ((w >> 2) & 1) + 4 * ((w >> 3) & 3) + (w & 3); }); continue; } r -= I_5;
        if (r < I_6) { const int le = r / 256, q = r % 256, kb = q / 32, nb = q % 32;
            conv_item(F.in[I_WD] + (size_t)le * EW * D, D, kb * 64, nb * 32, (bf16*)((char*)WB + WB_DN) + (size_t)le * D * EW, EW, scr, F.lane, [=](int n) { return (n & ~255) + slot_of(0, n & 255); }); continue; } r -= I_6;
        {
            const float* src = F.in[I_SWS] + (size_t)r * 512 + F.lane * 8; const f32x4 a = *(const f32x4*)src, b = *(const f32x4*)(src + 4);
            u32x4 o; o.x = pk2(a.x, a.y); o.y = pk2(a.z, a.w); o.z = pk2(b.x, b.y); o.w = pk2(b.z, b.w);
            *(u32x4*)((bf16*)((char*)WB + WB_WS) + (size_t)r * 512 + F.lane * 8) = o; }
    }
}

struct DenseSched {
    const char* A; const char* Bt; int K, nM, nN, G, c, nwg, xM0, xN, nx;
    __device__ __forceinline__ bool next(int i, pg8::Unit& u) const {
        const int L = i * G + c; if (L >= nwg + nx) return false;
        if (L < nwg) { int wgid = L; { const int q = nwg / 8, r = nwg % 8, xcd = wgid % 8, off = wgid / 8; wgid = (xcd < r ? xcd * (q + 1) : r * (q + 1) + (xcd - r) * q) + off; }
            const int nig = 8 * nN, gid = wgid / nig, fm = gid * 8, gsz = (nM - fm) < 8 ? (nM - fm) : 8;
            u.pm = fm + ((wgid % nig) % gsz); u.pn = (wgid % nig) / gsz; }
        else { const int j = L - nwg; u.pm = xM0 + j / xN; u.pn = j % xN; }
        u.Ab = A; u.Bb = Bt + (size_t)u.pn * 256 * K * 2; u.x0 = 0; u.x1 = 0; u.x2 = 0; return true;
    }
    __device__ __forceinline__ void arows(const pg8::Unit& u, unsigned (&v)[2][2], const int (&R)[2], const int (&C)[2]) const {
#pragma unroll
        for (int h = 0; h < 2; ++h)
#pragma unroll
            for (int i = 0; i < 2; ++i) v[h][i] = (unsigned)((u.pm * 256 + h * 128 + R[i]) * K + C[i]) * 2u;
    }
};
struct MoeSched {
    const char* A; const char* Bt; int K, G, c, total; const LAS int* tab; const int* LIST; int gather;
    __device__ __forceinline__ bool next(int i, pg8::Unit& u) const {
        const int L = i * G + c; if (L >= total) return false;
        const int rt = L >> 2; u.pn = L & 3; int ee = 0;
#pragma unroll
        for (int e = 0; e < 16; ++e) { if (tab[e * 4] <= rt && tab[e * 4 + 1] > 0) ee = e; }
        u.pm = rt - tab[ee * 4]; u.x0 = ee; u.x1 = tab[ee * 4 + 1]; u.x2 = tab[ee * 4 + 2];
        u.Ab = A; u.Bb = Bt + ((size_t)ee * 1024 + u.pn * 256) * K * 2; return true;
    }
    __device__ __forceinline__ void arows(const pg8::Unit& u, unsigned (&v)[2][2], const int (&R)[2], const int (&C)[2]) const {
#pragma unroll
        for (int h = 0; h < 2; ++h)
#pragma unroll
            for (int i = 0; i < 2; ++i) { const int pos = u.pm * 256 + h * 128 + R[i]; int row;
                if (gather) { const int ent = LIST[u.x0 * 16384 + (pos < u.x1 ? pos : u.pm * 256)]; row = ent >> 1; } else row = u.x2 + pos;
                v[h][i] = (unsigned)(row * K + C[i]) * 2u; }
    }
};

typedef unsigned u32x2 __attribute__((ext_vector_type(2)));
struct EpiInproj {
    unsigned char* Areg; const float* ROPE; const float* kg; const float* qg;
    __device__ __forceinline__ void operator()(f32x4 (&acc)[2][2][4][2], const pg8::Unit& u, int wr, int wc, int fr, int fq) const {
        const int ty = u.pn >> 1, head = (u.pn & 1) * 4 + wc;
        const size_t off_t = ty < 4 ? (size_t)ty * 17 * MiB : (size_t)(68 + (ty - 4) * 16) * MiB;
        bf16* dst = (bf16*)(Areg + off_t);
        const int row0 = u.pm * 256 + wr * 64 + fr;
        if (ty == 0 || ty == 4) {
            const float sc = ty == 0 ? 0.125f : 1.f;
#pragma unroll
            for (int ai = 0; ai < 2; ++ai)
#pragma unroll
                for (int m = 0; m < 4; ++m) { const int row = row0 + ai * 128 + m * 16; const int tt = row & 4095; const bool lat = row < NTOK;
#pragma unroll
                    for (int bj = 0; bj < 2; ++bj) { const int pos = bj ? (tt & 63) : (tt >> 6);
                        f32x4 u1 = acc[ai][bj][m][0], u2 = acc[ai][bj][m][1];
                        if (lat) { const f32x4 cs0 = *(const f32x4*)(ROPE + (pos * 16 + 4 * fq) * 2), cs1 = *(const f32x4*)(ROPE + (pos * 16 + 4 * fq) * 2 + 4);
                            const f32x4 co = { cs0.x, cs0.z, cs1.x, cs1.z }, si = { cs0.y, cs0.w, cs1.y, cs1.w };
                            const f32x4 a = u1 * co - u2 * si, b = u1 * si + u2 * co; u1 = a; u2 = b; }
                        u1 = u1 * sc; u2 = u2 * sc;
                        bf16* p = dst + (size_t)row * HW + head * 64 + 32 * bj + 4 * fq;
                        u32x2 w; w.x = pg8::cvt_pk_bf16(u1.x, u1.y); w.y = pg8::cvt_pk_bf16(u1.z, u1.w); *(u32x2*)p = w;
                        w.x = pg8::cvt_pk_bf16(u2.x, u2.y); w.y = pg8::cvt_pk_bf16(u2.z, u2.w); *(u32x2*)(p + 16) = w; } }
        } else {
            const bool nrm = (ty == 2 || ty == 6);
            f32x4 g[2][2];
            if (nrm) { const float* gp = ty == 2 ? kg : qg;
#pragma unroll
                for (int bj = 0; bj < 2; ++bj)
#pragma unroll
                    for (int n = 0; n < 2; ++n) g[bj][n] = *(const f32x4*)(gp + 32 * bj + 8 * fq + 4 * n) * (ty == 6 ? 0.125f : 1.f); }
#pragma unroll
            for (int ai = 0; ai < 2; ++ai)
#pragma unroll
                for (int m = 0; m < 4; ++m) { const int row = row0 + ai * 128 + m * 16;
                    f32x4 v[2][2];
#pragma unroll
                    for (int bj = 0; bj < 2; ++bj)
#pragma unroll
                        for (int n = 0; n < 2; ++n) v[bj][n] = acc[ai][bj][m][n];
                    if (nrm) { float ss = 0.f;
#pragma unroll
                        for (int bj = 0; bj < 2; ++bj)
#pragma unroll
                            for (int n = 0; n < 2; ++n) ss += (v[bj][n].x * v[bj][n].x + v[bj][n].y * v[bj][n].y) + (v[bj][n].z * v[bj][n].z + v[bj][n].w * v[bj][n].w);
                        ss += __shfl_xor(ss, 16); ss += __shfl_xor(ss, 32);
                        const float rs = rsqrtf(ss * (1.f / 64.f) + EPS);
#pragma unroll
                        for (int bj = 0; bj < 2; ++bj)
#pragma unroll
                            for (int n = 0; n < 2; ++n) v[bj][n] = v[bj][n] * rs * g[bj][n]; }
                    if (ty == 5) {
#pragma unroll
                        for (int bj = 0; bj < 2; ++bj)
#pragma unroll
                            for (int n = 0; n < 2; ++n)
#pragma unroll
                                for (int q = 0; q < 4; ++q) v[bj][n][q] = siluf(v[bj][n][q]); }
#pragma unroll
                    for (int bj = 0; bj < 2; ++bj) { u32x4 w; w.x = pg8::cvt_pk_bf16(v[bj][0].x, v[bj][0].y); w.y = pg8::cvt_pk_bf16(v[bj][0].z, v[bj][0].w); w.z = pg8::cvt_pk_bf16(v[bj][1].x, v[bj][1].y); w.w = pg8::cvt_pk_bf16(v[bj][1].z, v[bj][1].w);
                        *(u32x4*)(dst + (size_t)row * HW + head * 64 + 32 * bj + 8 * fq) = w; } }
        }
    }
};
struct EpiRes {
    const float* base; float* out; const float* gate;
    __device__ __forceinline__ void operator()(f32x4 (&acc)[2][2][4][2], const pg8::Unit& u, int wr, int wc, int fr, int fq) const {
        const int b = u.pm >> 4, col0 = u.pn * 256 + wc * 32 + 8 * fq, row0 = u.pm * 256 + wr * 64 + fr;
        f32x4 gv[2][2];
#pragma unroll
        for (int bj = 0; bj < 2; ++bj)
#pragma unroll
            for (int n = 0; n < 2; ++n) gv[bj][n] = *(const f32x4*)(gate + b * 6144 + col0 + bj * 128 + 4 * n);
#pragma unroll
        for (int ai = 0; ai < 2; ++ai)
#pragma unroll
            for (int m = 0; m < 4; ++m) { const size_t off = (size_t)(row0 + ai * 128 + m * 16) * D + col0;
#pragma unroll
                for (int bj = 0; bj < 2; ++bj)
#pragma unroll
                    for (int n = 0; n < 2; ++n) { const f32x4 bs = *(const f32x4*)(base + off + bj * 128 + 4 * n); *(f32x4*)(out + off + bj * 128 + 4 * n) = bs + gv[bj][n] * acc[ai][bj][m][n]; } }
    }
};
__device__ __forceinline__ float gelu_fast(float v) { const float u2 = -2.302208198f * (v + 0.044715f * v * v * v); return v * __builtin_amdgcn_rcpf(1.f + __builtin_amdgcn_exp2f(u2)); }
struct EpiSguIn {
    bf16* U; bf16* V; const float* bias; float* VSS;
    __device__ __forceinline__ void operator()(f32x4 (&acc)[2][2][4][2], const pg8::Unit& u, int wr, int wc, int fr, int fq) const {
        const int col0 = u.pn * 256 + wc * 32 + 8 * fq, row0 = u.pm * 256 + wr * 64 + fr; const bool isv = u.pn >= 12;
        bf16* dstb = isv ? V + (col0 - SGW) : U + col0;
        f32x4 bv[2][2];
#pragma unroll
        for (int bj = 0; bj < 2; ++bj)
#pragma unroll
            for (int n = 0; n < 2; ++n) bv[bj][n] = *(const f32x4*)(bias + col0 + bj * 128 + 4 * n);
#pragma unroll
        for (int ai = 0; ai < 2; ++ai)
#pragma unroll
            for (int m = 0; m < 4; ++m) { const int row = row0 + ai * 128 + m * 16; float ss = 0.f;
#pragma unroll
                for (int bj = 0; bj < 2; ++bj) { f32x4 z0 = acc[ai][bj][m][0] + bv[bj][0], z1 = acc[ai][bj][m][1] + bv[bj][1];
#pragma unroll
                    for (int q = 0; q < 4; ++q) { z0[q] = gelu_fast(z0[q]); z1[q] = gelu_fast(z1[q]); }
                    ss += (z0.x * z0.x + z0.y * z0.y) + (z0.z * z0.z + z0.w * z0.w) + (z1.x * z1.x + z1.y * z1.y) + (z1.z * z1.z + z1.w * z1.w);
                    u32x4 w; w.x = pg8::cvt_pk_bf16(z0.x, z0.y); w.y = pg8::cvt_pk_bf16(z0.z, z0.w); w.z = pg8::cvt_pk_bf16(z1.x, z1.y); w.w = pg8::cvt_pk_bf16(z1.z, z1.w);
                    *(u32x4*)(dstb + (size_t)row * SGW + bj * 128) = w; }
                if (isv) { ss += __shfl_xor(ss, 16); ss += __shfl_xor(ss, 32); if (fq == 0) VSS[(size_t)row * 48 + (u.pn - 12) * 4 + wc] = ss; } }
    }
};
struct EpiMoeGU {
    bf16* ACT;
    __device__ __forceinline__ void operator()(f32x4 (&acc)[2][2][4][2], const pg8::Unit& u, int wr, int wc, int fr, int fq) const {
        const int col0 = u.pn * 128 + wc * 32 + 8 * fq, row0 = u.x2 + u.pm * 256 + wr * 64 + fr;
#pragma unroll
        for (int ai = 0; ai < 2; ++ai)
#pragma unroll
            for (int m = 0; m < 4; ++m) { f32x4 a0 = acc[ai][0][m][0], a1 = acc[ai][0][m][1]; const f32x4 b0 = acc[ai][1][m][0], b1 = acc[ai][1][m][1];
#pragma unroll
                for (int q = 0; q < 4; ++q) { a0[q] = a0[q] * __builtin_amdgcn_rcpf(1.f + __builtin_amdgcn_exp2f(-1.44269504f * a0[q])) * b0[q]; a1[q] = a1[q] * __builtin_amdgcn_rcpf(1.f + __builtin_amdgcn_exp2f(-1.44269504f * a1[q])) * b1[q]; }
                u32x4 w; w.x = pg8::cvt_pk_bf16(a0.x, a0.y); w.y = pg8::cvt_pk_bf16(a0.z, a0.w); w.z = pg8::cvt_pk_bf16(a1.x, a1.y); w.w = pg8::cvt_pk_bf16(a1.z, a1.w);
                *(u32x4*)(ACT + (size_t)(row0 + ai * 128 + m * 16) * EW + col0) = w; }
    }
};
struct EpiMoeDn {
    bf16* Y; const int* LIST; const float* WT;
    __device__ __forceinline__ void operator()(f32x4 (&acc)[2][2][4][2], const pg8::Unit& u, int wr, int wc, int fr, int fq) const {
        const int col0 = u.pn * 256 + wc * 32 + 8 * fq;
#pragma unroll
        for (int ai = 0; ai < 2; ++ai)
#pragma unroll
            for (int m = 0; m < 4; ++m) { const int pos = u.pm * 256 + ai * 128 + wr * 64 + m * 16 + fr;
                if (pos < u.x1) { const int ent = LIST[u.x0 * 16384 + pos]; const float w8 = WT[ent];
#pragma unroll
                    for (int bj = 0; bj < 2; ++bj) { const f32x4 a0 = acc[ai][bj][m][0] * w8, a1 = acc[ai][bj][m][1] * w8;
                        u32x4 w; w.x = pg8::cvt_pk_bf16(a0.x, a0.y); w.y = pg8::cvt_pk_bf16(a0.z, a0.w); w.z = pg8::cvt_pk_bf16(a1.x, a1.y); w.w = pg8::cvt_pk_bf16(a1.z, a1.w);
                        *(u32x4*)(Y + (size_t)ent * D + col0 + bj * 128) = w; } } }
    }
};
__device__ __forceinline__ int moe_tab(Frame& F, int l, LAS int* tab) {
    __syncthreads();
    if (F.tid == 0) { int tiles = 0, base = 0;
        for (int e = 0; e < 16; ++e) { const int c = (int)__hip_atomic_load(F.ctl + CW_CNT + l * 1024 + e * 64, RLX_AGENT); tab[e * 4] = tiles; tab[e * 4 + 1] = c; tab[e * 4 + 2] = base; tab[e * 4 + 3] = 0; tiles += (c + 255) >> 8; base += (c + 255) & ~255; }
        tab[64] = tiles; }
    __syncthreads();
    return tab[64];
}


typedef short bf16x8 __attribute__((ext_vector_type(8)));
typedef short s16x4 __attribute__((ext_vector_type(4)));
typedef short v4i16_t __attribute__((ext_vector_type(4)));
__device__ __forceinline__ s16x4 tr_read(const LAS unsigned char* p) { return __builtin_bit_cast(s16x4, __builtin_amdgcn_ds_read_tr16_b64_v4i16((LAS v4i16_t*)p)); }
__device__ __forceinline__ bf16x8 cat8(s16x4 a, s16x4 b) { return (bf16x8){a[0], a[1], a[2], a[3], b[0], b[1], b[2], b[3]}; }
__device__ __forceinline__ bf16x8 pk8(f32x4 a, f32x4 b) { u32x4 w; w.x = pg8::cvt_pk_bf16(a.x, a.y); w.y = pg8::cvt_pk_bf16(a.z, a.w); w.z = pg8::cvt_pk_bf16(b.x, b.y); w.w = pg8::cvt_pk_bf16(b.z, b.w); return __builtin_bit_cast(bf16x8, w); }
#define MFMA16(a, b, c) __builtin_amdgcn_mfma_f32_16x16x32_bf16((a), (b), (c), 0, 0, 0)
constexpr int VST = 144;
constexpr size_t A_KV = 148 * MiB;

__device__ __forceinline__ void ph_na(Frame& F) {
    const bf16* NK = (const bf16*)(F.A + A_NK); const bf16* NV = (const bf16*)(F.A + A_NV); const bf16* NQ = (const bf16*)(F.A + A_NQ); bf16* MIX = (bf16*)(F.A + A_MIX);
    LAS unsigned char* Vl = F.lds;
    LAS float* mrg = (LAS float*)(F.lds + 768 * VST);
    LAS float* rpbl = (LAS float*)(F.lds + 768 * VST + 4 * 1056 * 4);
    const int lane = F.lane, wave = F.wave, sb = wave & 3, half = wave >> 2, q16 = lane & 15, rq = lane >> 4;
    const int tq = (lane & 15) >> 2, tp = lane & 3;
    const float L2E = 1.44269504f;
    for (int tg = blockIdx.x; tg < 256; tg += gridDim.x) {
        const int bh = tg >> 3, b = bh >> 3, h = bh & 7, rbase = (tg & 7) * 8;
        __syncthreads();
#pragma unroll
        for (int pass = 0; pass < 4; ++pass) { const int n = pass * 64 + (F.tid >> 3), ch = F.tid & 7;
            *(LAS u32x4*)(Vl + (512 + n) * VST + ch * 16) = *(const u32x4*)(NV + ((size_t)(NTOK + b * CTXL + n)) * HW + h * 64 + ch * 8); }
        for (int i = F.tid; i < 465; i += NTHREADS) rpbl[i] = F.in[I_RPB][h * 465 + i];
        int lo = 0, hi = -1;
        for (int ti = 0; ti < 8; ++ti) {
            const int r = rbase + ti; int r0 = r - 4; r0 = r0 < 0 ? 0 : (r0 > 56 ? 56 : r0);
            __syncthreads();
            for (int kr = r0; kr <= r0 + 7; ++kr) if (kr < lo || kr > hi) { const int col = F.tid >> 3, ch = F.tid & 7;
                *(LAS u32x4*)(Vl + ((kr & 7) * 64 + col) * VST + ch * 16) = *(const u32x4*)(NV + ((size_t)(b * SEQ + kr * 64 + col)) * HW + h * 64 + ch * 8); }
            lo = r0; hi = r0 + 7;
            __syncthreads();
            const int c = 16 * sb + q16; const size_t qrow = (size_t)b * SEQ + r * 64 + c;
            const int w0 = sb == 0 ? 0 : (sb == 1 ? 8 : (sb == 2 ? 24 : 32));
            int c0 = c - 8; c0 = c0 < 0 ? 0 : (c0 > 48 ? 48 : c0);
            bf16x8 qf[2];
#pragma unroll
            for (int ks = 0; ks < 2; ++ks) qf[ks] = *(const bf16x8*)(NQ + qrow * HW + h * 64 + 8 * rq + 32 * ks);
            f32x4 sc[16];
#pragma unroll
            for (int lb = 0; lb < 8; ++lb) { const int kr = r0 + 4 * half + (lb >> 1), cb = w0 + 16 * (lb & 1);
                const bf16* kp = NK + ((size_t)(b * SEQ + kr * 64 + cb + q16)) * HW + h * 64 + 8 * rq;
                const bf16x8 k0 = *(const bf16x8*)kp, k1 = *(const bf16x8*)(kp + 32);
                f32x4 a = MFMA16(k0, qf[0], ((f32x4){0.f, 0.f, 0.f, 0.f})); a = MFMA16(k1, qf[1], a);
#pragma unroll
                for (int g = 0; g < 4; ++g) { const int kc = cb + 4 * rq + g; const bool valid = (kc >= c0) && (kc <= c0 + 15);
                    const int bi = valid ? ((kr - r + 7) * 31 + (kc - c + 15)) : 0;
                    a[g] = valid ? a[g] + rpbl[bi] : -1e30f; }
                sc[lb] = a; }
#pragma unroll
            for (int cb = 0; cb < 8; ++cb) { const int n = 128 * half + 16 * cb + q16;
                const bf16* kp = NK + ((size_t)(NTOK + b * CTXL + n)) * HW + h * 64 + 8 * rq;
                const bf16x8 k0 = *(const bf16x8*)kp, k1 = *(const bf16x8*)(kp + 32);
                f32x4 a = MFMA16(k0, qf[0], ((f32x4){0.f, 0.f, 0.f, 0.f})); a = MFMA16(k1, qf[1], a); sc[8 + cb] = a; }
            float m = -1e30f;
#pragma unroll
            for (int i = 0; i < 16; ++i) m = fmaxf(fmaxf(m, fmaxf(sc[i].x, sc[i].y)), fmaxf(sc[i].z, sc[i].w));
            m = fmaxf(m, __shfl_xor(m, 16)); m = fmaxf(m, __shfl_xor(m, 32));
            float l = 0.f;
#pragma unroll
            for (int i = 0; i < 16; ++i) {
#pragma unroll
                for (int g = 0; g < 4; ++g) { const float p = __builtin_amdgcn_exp2f((sc[i][g] - m) * L2E); sc[i][g] = p; l += p; } }
            l += __shfl_xor(l, 16); l += __shfl_xor(l, 32);
            f32x4 o[4];
#pragma unroll
            for (int eb = 0; eb < 4; ++eb) o[eb] = (f32x4){0.f, 0.f, 0.f, 0.f};
#pragma unroll
            for (int ks = 0; ks < 8; ++ks) {
                const bf16x8 pf = pk8(sc[2 * ks], sc[2 * ks + 1]);
                int rowA, rowB;
                if (ks < 4) { const int kr = r0 + 4 * half + ks; rowA = (kr & 7) * 64 + w0; rowB = rowA + 16; }
                else { rowA = 512 + 128 * half + 32 * (ks - 4); rowB = rowA + 16; }
                const LAS unsigned char* pa = Vl + (rowA + 4 * rq + tq) * VST + 8 * tp; const LAS unsigned char* pb = Vl + (rowB + 4 * rq + tq) * VST + 8 * tp;
#pragma unroll
                for (int eb = 0; eb < 4; ++eb) { const bf16x8 vf = cat8(tr_read(pa + 32 * eb), tr_read(pb + 32 * eb)); o[eb] = MFMA16(vf, pf, o[eb]); }
            }
            LAS float* mw = mrg + sb * 1056;
            if (half == 1) {
                if (rq == 0) { mw[q16] = m; mw[16 + q16] = l; }
#pragma unroll
                for (int eb = 0; eb < 4; ++eb)
#pragma unroll
                    for (int g = 0; g < 4; ++g) mw[32 + (16 * eb + 4 * rq + g) * 16 + q16] = o[eb][g];
            }
            __syncthreads();
            if (half == 0) {
                const float m2 = mw[q16], l2 = mw[16 + q16];
                const float mn = fmaxf(m, m2), a1 = __builtin_amdgcn_exp2f((m - mn) * L2E), a2 = __builtin_amdgcn_exp2f((m2 - mn) * L2E);
                const float inv = 1.f / (l * a1 + l2 * a2);
#pragma unroll
                for (int eb = 0; eb < 4; ++eb) { f32x4 v;
#pragma unroll
                    for (int g = 0; g < 4; ++g) v[g] = (o[eb][g] * a1 + mw[32 + (16 * eb + 4 * rq + g) * 16 + q16] * a2) * inv;
                    u32x2 w; w.x = pg8::cvt_pk_bf16(v.x, v.y); w.y = pg8::cvt_pk_bf16(v.z, v.w);
                    *(u32x2*)(MIX + qrow * D + 512 + h * 64 + 16 * eb + 4 * rq) = w; }
            }
        }
    }
    __syncthreads();
}

__device__ __forceinline__ void ph_kvstate(Frame& F) {
    const bf16* RK = (const bf16*)(F.A + A_RK); const bf16* RV = (const bf16*)(F.A + A_RV); float* KV = (float*)(F.A + A_KV);
    LAS unsigned char* Kt = F.lds; LAS unsigned char* Vf = F.lds + 128 * VST; LAS unsigned char* Vb = F.lds + 256 * VST;
    const int lane = F.lane, wave = F.wave, rq = lane >> 4, tq = (lane & 15) >> 2, tp = lane & 3, db = wave & 3, ep = wave >> 2;
    for (int it = blockIdx.x; it < NB * NH * 34; it += gridDim.x) {
        const int cc = it % 34, bh = it / 34, b = bh >> 3, h = bh & 7;
        const float lgf = ret_gamma_log(F, 0, h) * 1.44269504f, lgb = ret_gamma_log(F, 1, h) * 1.44269504f;
        const size_t row0 = cc < 32 ? (size_t)b * SEQ + cc * 128 : (size_t)NTOK + b * CTXL + (cc - 32) * 128;
        __syncthreads();
#pragma unroll
        for (int pass = 0; pass < 2; ++pass) { const int j = pass * 64 + (F.tid >> 3), ch = F.tid & 7;
            *(LAS u32x4*)(Kt + j * VST + ch * 16) = *(const u32x4*)(RK + (row0 + j) * HW + h * 64 + ch * 8);
            const u32x4 v = *(const u32x4*)(RV + (row0 + j) * HW + h * 64 + ch * 8);
            const float wf = __builtin_amdgcn_exp2f(lgf * (float)(127 - j)), wb = __builtin_amdgcn_exp2f(lgb * (float)j);
            const unsigned vv[4] = { v.x, v.y, v.z, v.w }; u32x4 of, ob; unsigned rf[4], rb[4];
#pragma unroll
            for (int q = 0; q < 4; ++q) { const float lo = bf2f(vv[q] & 0xffffu), hi = bf2f(vv[q] >> 16); rf[q] = pg8::cvt_pk_bf16(lo * wf, hi * wf); rb[q] = pg8::cvt_pk_bf16(lo * wb, hi * wb); }
            of.x = rf[0]; of.y = rf[1]; of.z = rf[2]; of.w = rf[3]; ob.x = rb[0]; ob.y = rb[1]; ob.z = rb[2]; ob.w = rb[3];
            *(LAS u32x4*)(Vf + j * VST + ch * 16) = of; *(LAS u32x4*)(Vb + j * VST + ch * 16) = ob; }
        __syncthreads();
        f32x4 acc[2][2];
#pragma unroll
        for (int d = 0; d < 2; ++d)
#pragma unroll
            for (int e = 0; e < 2; ++e) acc[d][e] = (f32x4){0.f, 0.f, 0.f, 0.f};
#pragma unroll
        for (int ks = 0; ks < 4; ++ks) {
            const int rbase = 32 * ks + 8 * rq + tq;
            const bf16x8 kf = cat8(tr_read(Kt + rbase * VST + (16 * db + 4 * tp) * 2), tr_read(Kt + (rbase + 4) * VST + (16 * db + 4 * tp) * 2));
#pragma unroll
            for (int e2 = 0; e2 < 2; ++e2) { const int eoff = (16 * (2 * ep + e2) + 4 * tp) * 2;
                const bf16x8 vf = cat8(tr_read(Vf + rbase * VST + eoff), tr_read(Vf + (rbase + 4) * VST + eoff));
                const bf16x8 vb = cat8(tr_read(Vb + rbase * VST + eoff), tr_read(Vb + (rbase + 4) * VST + eoff));
                acc[0][e2] = MFMA16(kf, vf, acc[0][e2]); acc[1][e2] = MFMA16(kf, vb, acc[1][e2]); }
        }
        float* kvp = KV + (size_t)it * 2 * 4096;
#pragma unroll
        for (int d = 0; d < 2; ++d)
#pragma unroll
            for (int e2 = 0; e2 < 2; ++e2) *(f32x4*)(kvp + d * 4096 + (16 * (2 * ep + e2) + (lane & 15)) * 64 + 16 * db + 4 * rq) = acc[d][e2];
    }
    __syncthreads();
}

__device__ __forceinline__ void ph_retout(Frame& F) {
    const bf16* RK = (const bf16*)(F.A + A_RK); const bf16* RV = (const bf16*)(F.A + A_RV); const bf16* RQ = (const bf16*)(F.A + A_RQ); const bf16* GT = (const bf16*)(F.A + A_GT);
    const float* KV = (const float*)(F.A + A_KV); bf16* MIX = (bf16*)(F.A + A_MIX);
    LAS unsigned char* Vl = F.lds;
    LAS unsigned char* SF = F.lds + 128 * VST;
    LAS unsigned char* SB = SF + 64 * VST;
    const int lane = F.lane, wave = F.wave, q16 = lane & 15, rq = lane >> 4, tq = (lane & 15) >> 2, tp = lane & 3;
    for (int g = blockIdx.x; g < 256; g += gridDim.x) {
        const int bh = g >> 3, b = bh >> 3, h = bh & 7, c0 = (g & 7) * 4;
        const float lnf = ret_gamma_log(F, 0, h), lnb = ret_gamma_log(F, 1, h);
        const float lgf = lnf * 1.44269504f, lgb = lnb * 1.44269504f;
        const float gf128 = __builtin_amdgcn_exp2f(lgf * 128.f), gb128 = __builtin_amdgcn_exp2f(lgb * 128.f);
        const float* kvb = KV + (size_t)bh * 34 * 2 * 4096 + F.tid * 8;
#define KVP(cc, dir) (kvb + ((size_t)(cc) * 2 + (dir)) * 4096)
        f32x4 sf0, sf1, sb0, sb1;
        { const f32x4 a0 = *(const f32x4*)KVP(32, 0), a1 = *(const f32x4*)(KVP(32, 0) + 4), b0 = *(const f32x4*)KVP(33, 0), b1 = *(const f32x4*)(KVP(33, 0) + 4);
          sf0 = a0 * gf128 + b0; sf1 = a1 * gf128 + b1; }
        for (int cp = 0; cp < c0; ++cp) { const f32x4 a0 = *(const f32x4*)KVP(cp, 0), a1 = *(const f32x4*)(KVP(cp, 0) + 4); sf0 = sf0 * gf128 + a0; sf1 = sf1 * gf128 + a1; }
        { const f32x4 a0 = *(const f32x4*)KVP(33, 1), a1 = *(const f32x4*)(KVP(33, 1) + 4), b0 = *(const f32x4*)KVP(32, 1), b1 = *(const f32x4*)(KVP(32, 1) + 4);
          sb0 = a0 * gb128 + b0; sb1 = a1 * gb128 + b1; }
        for (int cp = 31; cp >= c0 + 4; --cp) { const f32x4 a0 = *(const f32x4*)KVP(cp, 1), a1 = *(const f32x4*)(KVP(cp, 1) + 4); sb0 = sb0 * gb128 + a0; sb1 = sb1 * gb128 + a1; }
        __syncthreads();
        const int se = F.tid >> 3, sd = (F.tid & 7) * 8;
#pragma unroll
        for (int k = 3; k >= 0; --k) {
            *(LAS u32x4*)(SB + k * 64 * VST + se * VST + sd * 2) = __builtin_bit_cast(u32x4, pk8(sb0, sb1));
            if (k > 0) { const f32x4 a0 = *(const f32x4*)KVP(c0 + k, 1), a1 = *(const f32x4*)(KVP(c0 + k, 1) + 4); sb0 = sb0 * gb128 + a0; sb1 = sb1 * gb128 + a1; }
        }
        for (int k = 0; k < 4; ++k) {
            const int c = c0 + k; const size_t row0 = (size_t)b * SEQ + c * 128;
            __syncthreads();
            *(LAS u32x4*)(SF + se * VST + sd * 2) = __builtin_bit_cast(u32x4, pk8(sf0, sf1));
            { const f32x4 a0 = *(const f32x4*)KVP(c, 0), a1 = *(const f32x4*)(KVP(c, 0) + 4); sf0 = sf0 * gf128 + a0; sf1 = sf1 * gf128 + a1; }
#pragma unroll
            for (int pass = 0; pass < 2; ++pass) { const int j = pass * 64 + (F.tid >> 3), ch = F.tid & 7;
                *(LAS u32x4*)(Vl + j * VST + ch * 16) = *(const u32x4*)(RV + (row0 + j) * HW + h * 64 + ch * 8); }
            __syncthreads();
            const int i = 16 * wave + q16; const size_t qrow = row0 + i;
            bf16x8 qf[2];
#pragma unroll
            for (int ks = 0; ks < 2; ++ks) qf[ks] = *(const bf16x8*)(RQ + qrow * HW + h * 64 + 8 * rq + 32 * ks);
            f32x4 sc[8];
#pragma unroll
            for (int jb = 0; jb < 8; ++jb) { const bf16* kp = RK + (row0 + 16 * jb + q16) * HW + h * 64 + 8 * rq;
                const bf16x8 k0 = *(const bf16x8*)kp, k1 = *(const bf16x8*)(kp + 32);
                f32x4 a = MFMA16(k0, qf[0], ((f32x4){0.f, 0.f, 0.f, 0.f})); a = MFMA16(k1, qf[1], a);
#pragma unroll
                for (int gq = 0; gq < 4; ++gq) { const int j = 16 * jb + 4 * rq + gq;
                    const float wgt = j < i ? __builtin_amdgcn_exp2f(lgf * (float)(i - j)) : (j > i ? __builtin_amdgcn_exp2f(lgb * (float)(j - i)) : 2.f);
                    a[gq] *= wgt; }
                sc[jb] = a; }
            f32x4 o[4], tf[4], tb[4];
#pragma unroll
            for (int eb = 0; eb < 4; ++eb) { o[eb] = (f32x4){0.f, 0.f, 0.f, 0.f}; tf[eb] = o[eb]; tb[eb] = o[eb]; }
#pragma unroll
            for (int ks = 0; ks < 4; ++ks) {
                const bf16x8 pf = pk8(sc[2 * ks], sc[2 * ks + 1]);
                const LAS unsigned char* pa = Vl + (32 * ks + 4 * rq + tq) * VST + 8 * tp; const LAS unsigned char* pb = pa + 16 * VST;
#pragma unroll
                for (int eb = 0; eb < 4; ++eb) { const bf16x8 vf = cat8(tr_read(pa + 32 * eb), tr_read(pb + 32 * eb)); o[eb] = MFMA16(vf, pf, o[eb]); }
            }
#pragma unroll
            for (int eb = 0; eb < 4; ++eb)
#pragma unroll
                for (int ks = 0; ks < 2; ++ks) {
                    const bf16x8 s1 = *(const LAS bf16x8*)(SF + (16 * eb + q16) * VST + (8 * rq + 32 * ks) * 2);
                    const bf16x8 s2 = *(const LAS bf16x8*)(SB + k * 64 * VST + (16 * eb + q16) * VST + (8 * rq + 32 * ks) * 2);
                    tf[eb] = MFMA16(s1, qf[ks], tf[eb]); tb[eb] = MFMA16(s2, qf[ks], tb[eb]); }
            const float qfd = __builtin_amdgcn_exp2f(lgf * (float)(i + 1)), qbd = __builtin_amdgcn_exp2f(lgb * (float)(128 - i));
            float ss = 0.f;
#pragma unroll
            for (int eb = 0; eb < 4; ++eb) { o[eb] = o[eb] + tf[eb] * qfd + tb[eb] * qbd; ss += (o[eb].x * o[eb].x + o[eb].y * o[eb].y) + (o[eb].z * o[eb].z + o[eb].w * o[eb].w); }
            ss += __shfl_xor(ss, 16); ss += __shfl_xor(ss, 32);
            const float rs = rsqrtf(ss * (1.f / 64.f) + EPS);
#pragma unroll
            for (int eb = 0; eb < 4; ++eb) { const int e0 = 16 * eb + 4 * rq;
                const f32x4 gg = *(const f32x4*)(F.in[I_RNG] + e0); const u32x2 gt = *(const u32x2*)(GT + qrow * HW + h * 64 + e0);
                const f32x4 gv = { bf2f(gt.x & 0xffffu), bf2f(gt.x >> 16), bf2f(gt.y & 0xffffu), bf2f(gt.y >> 16) };
                const f32x4 v = o[eb] * rs * gg * gv;
                u32x2 w; w.x = pg8::cvt_pk_bf16(v.x, v.y); w.y = pg8::cvt_pk_bf16(v.z, v.w);
                *(u32x2*)(MIX + qrow * D + h * 64 + e0) = w; }
        }
#undef KVP
    }
    __syncthreads();
}

__device__ __forceinline__ void ph_sgumix(Frame& F) {
    bf16* U = (bf16*)(F.A + A_U); const bf16* V = (const bf16*)(F.A + A_V); const bf16* WS = (const bf16*)(F.ws + WS_WB + WB_WS);
    constexpr int VS2 = 272;
    LAS unsigned char* Vt = F.lds;
    LAS float* rsl = (LAS float*)(F.lds + 128 * VS2);
    const int lane = F.lane, wave = F.wave, q16 = lane & 15, rq = lane >> 4, tq = (lane & 15) >> 2, tp = lane & 3;
    const int ch4 = wave & 1, iq = wave >> 1;
    for (int it = blockIdx.x; it < NB * 32 * 8 * 3; it += gridDim.x) {
        const int third = it % 3, g = (it / 3) & 7, bc = it / 24; const size_t row0 = (size_t)bc * 128; const int cg0 = g * 384 + third * 128;
        __syncthreads();
        if (F.tid < 128) { const float* vp = F.VSS + (row0 + F.tid) * 48; float sacc = 0.f;
#pragma unroll
            for (int j = 0; j < 48; j += 4) { const f32x4 t = *(const f32x4*)(vp + j); sacc += (t.x + t.y) + (t.z + t.w); }
            rsl[F.tid] = rsqrtf(sacc * (1.f / SGW) + EPS); }
        __syncthreads();
#pragma unroll
        for (int pass = 0; pass < 4; ++pass) { const int j = pass * 32 + (F.tid >> 4), chn = F.tid & 15;
            const u32x4 v = *(const u32x4*)(V + (row0 + j) * SGW + cg0 + chn * 8); const float rs = rsl[j];
            const unsigned vv[4] = { v.x, v.y, v.z, v.w }; unsigned ro[4];
#pragma unroll
            for (int q = 0; q < 4; ++q) ro[q] = pg8::cvt_pk_bf16(bf2f(vv[q] & 0xffffu) * rs, bf2f(vv[q] >> 16) * rs);
            u32x4 o; o.x = ro[0]; o.y = ro[1]; o.z = ro[2]; o.w = ro[3];
            *(LAS u32x4*)(Vt + j * VS2 + chn * 16) = o; }
        __syncthreads();
        f32x4 acc[4][2];
#pragma unroll
        for (int cb = 0; cb < 4; ++cb)
#pragma unroll
            for (int ib = 0; ib < 2; ++ib) acc[cb][ib] = (f32x4){0.f, 0.f, 0.f, 0.f};
#pragma unroll
        for (int ks = 0; ks < 4; ++ks) {
            bf16x8 wf[2];
#pragma unroll
            for (int ib = 0; ib < 2; ++ib) wf[ib] = *(const bf16x8*)(WS + ((size_t)g * 128 + 32 * iq + 16 * ib + q16) * 128 + 32 * ks + 8 * rq);
            const int rb = 32 * ks + 8 * rq + tq;
#pragma unroll
            for (int cb = 0; cb < 4; ++cb) { const int coff = (64 * ch4 + 16 * cb + 4 * tp) * 2;
                const bf16x8 vf = cat8(tr_read(Vt + rb * VS2 + coff), tr_read(Vt + (rb + 4) * VS2 + coff));
#pragma unroll
                for (int ib = 0; ib < 2; ++ib) acc[cb][ib] = MFMA16(vf, wf[ib], acc[cb][ib]); }
        }
#pragma unroll
        for (int ib = 0; ib < 2; ++ib) { const int i = 32 * iq + 16 * ib + q16; const float bs = F.in[I_SBS][g * 128 + i];
#pragma unroll
            for (int cb = 0; cb < 4; ++cb) { const int cgl = cg0 + 64 * ch4 + 16 * cb + 4 * rq;
                const f32x4 ng = *(const f32x4*)(F.in[I_SNG] + cgl); bf16* up = U + (row0 + i) * SGW + cgl; const u32x2 uu = *(const u32x2*)up;
                const f32x4 uv = { bf2f(uu.x & 0xffffu), bf2f(uu.x >> 16), bf2f(uu.y & 0xffffu), bf2f(uu.y >> 16) };
                const f32x4 r = uv * (acc[cb][ib] * ng + bs);
                u32x2 w; w.x = pg8::cvt_pk_bf16(r.x, r.y); w.y = pg8::cvt_pk_bf16(r.z, r.w); *(u32x2*)up = w; } }
    }
    __syncthreads();
}

__device__ __forceinline__ void ph_mod2(Frame& F) {
    LAS float* sv = (LAS float*)F.lds; LAS float* red = sv + 5 * 1024;
    for (int i = F.tid; i < 5 * 1024; i += NTHREADS) { const int r = i >> 10, k = i & 1023; const float c = r < 4 ? F.in[I_C][r * 1024 + k] : F.in[I_CCTX][k]; sv[i] = siluf(c); }
    __syncthreads();
    for (int item = blockIdx.x; item < 192; item += gridDim.x) {
        const int l = item / 96, n0 = (item % 96) * 64, k0 = F.wave * 128;
        const float* W = F.in[I_ADAW] + (size_t)l * D * 6144 + n0 + F.lane + (size_t)k0 * 6144;
        float a0 = 0.f, a1 = 0.f, a2 = 0.f, a3 = 0.f, a4 = 0.f;
#pragma unroll 16
        for (int k = 0; k < 128; ++k) { const float w = W[(size_t)k * 6144];
            a0 += sv[k0 + k] * w; a1 += sv[1024 + k0 + k] * w; a2 += sv[2048 + k0 + k] * w; a3 += sv[3072 + k0 + k] * w; a4 += sv[4096 + k0 + k] * w; }
        red[(F.wave * 5 + 0) * 64 + F.lane] = a0; red[(F.wave * 5 + 1) * 64 + F.lane] = a1; red[(F.wave * 5 + 2) * 64 + F.lane] = a2; red[(F.wave * 5 + 3) * 64 + F.lane] = a3; red[(F.wave * 5 + 4) * 64 + F.lane] = a4;
        __syncthreads();
        if (F.wave < 5) { const int r = F.wave; float sacc = 0.f;
#pragma unroll
            for (int w = 0; w < 8; ++w) sacc += red[(w * 5 + r) * 64 + F.lane];
            sacc += F.in[I_ADAB][l * 6144 + n0 + F.lane];
            if (r < 4) F.MOD[(l * 4 + r) * 6144 + n0 + F.lane] = sacc; else if (l == 0 && n0 < 2048) F.MODC[n0 + F.lane] = sacc; }
        __syncthreads();
    }
    const int gt = F.gw * 64 + F.lane, ngt = F.ngw * 64;
    for (int it = gt; it < 64 * 16; it += ngt) {
        const int pos = it >> 4, j = it & 15;
        const float inv = powf(10000.0f, -(float)j / 16.0f);
        const float ang = (float)pos * inv;
        F.ROPE[it * 2] = cosf(ang); F.ROPE[it * 2 + 1] = sinf(ang);
    }
}
__device__ __forceinline__ void ph_inproj(Frame& F) {
    const DenseSched S{(const char*)F.H, (const char*)(F.ws + WS_WB + WB_WIN), D, 64, 14, (int)gridDim.x, (int)blockIdx.x, 64 * 14, 64, 8, 32};
    const EpiInproj E{F.A, F.ROPE, F.in[I_KG], F.in[I_QG]};
    pg8::gemm_phase<DenseSched, EpiInproj, true>(F.lds, D, S, E);
}
__device__ __forceinline__ void ph_outproj(Frame& F) {
    const DenseSched S{(const char*)(F.A + A_MIX), (const char*)(F.ws + WS_WB + WB_WOUT), D, 64, 4, (int)gridDim.x, (int)blockIdx.x, 64 * 4, 0, 1, 0};
    const EpiRes E{F.in[I_X], F.out, F.MOD + 2 * D};
    pg8::gemm_phase<DenseSched, EpiRes, false>(F.lds, D, S, E);
}
__device__ __forceinline__ void ph_sguin(Frame& F) {
    const DenseSched S{(const char*)F.H, (const char*)(F.ws + WS_WB + WB_SWIN), D, 64, 24, (int)gridDim.x, (int)blockIdx.x, 64 * 24, 0, 1, 0};
    const EpiSguIn E{(bf16*)(F.A + A_U), (bf16*)(F.A + A_V), F.in[I_SBIN], F.VSS};
    pg8::gemm_phase<DenseSched, EpiSguIn, true>(F.lds, D, S, E);
}
__device__ __forceinline__ void ph_sguout(Frame& F) {
    const DenseSched S{(const char*)(F.A + A_U), (const char*)(F.ws + WS_WB + WB_SWOUT), SGW, 64, 4, (int)gridDim.x, (int)blockIdx.x, 64 * 4, 0, 1, 0};
    const EpiRes E{F.out, F.out, F.MOD + 4 * 6144 + 2 * D};
    pg8::gemm_phase<DenseSched, EpiRes, false>(F.lds, SGW, S, E);
}
constexpr int TAB_OFF = LDSCTL_OFF + 1024;
__device__ __forceinline__ void ph_moe_gu(Frame& F, int l) {
    LAS int* tab = (LAS int*)(F.lds + TAB_OFF);
    const int tiles = moe_tab(F, l, tab);
    const MoeSched S{(const char*)F.H, (const char*)(F.ws + WS_WB + WB_GU) + (size_t)l * NE * 1024 * D * 2, D, (int)gridDim.x, (int)blockIdx.x, tiles * 4, tab, F.LIST, 1};
    const EpiMoeGU E{(bf16*)(F.A + A_ACT)};
    pg8::gemm_phase<MoeSched, EpiMoeGU, true>(F.lds, D, S, E);
}
__device__ __forceinline__ void ph_moe_dn(Frame& F, int l) {
    LAS int* tab = (LAS int*)(F.lds + TAB_OFF);
    const int tiles = moe_tab(F, l, tab);
    const MoeSched S{(const char*)(F.A + A_ACT), (const char*)(F.ws + WS_WB + WB_DN) + (size_t)l * NE * D * EW * 2, EW, (int)gridDim.x, (int)blockIdx.x, tiles * 4, tab, F.LIST, 0};
    const EpiMoeDn E{(bf16*)(F.A + A_Y), F.LIST, F.WT};
    pg8::gemm_phase<MoeSched, EpiMoeDn, true>(F.lds, EW, S, E);
}

constexpr int NPHASE = 18;
__global__ void __launch_bounds__(NTHREADS, 2) fwd_kernel(Args args) {
    extern __shared__ __attribute__((aligned(16))) unsigned char lds[];
    Frame F;
    F.lds = (LAS unsigned char*)lds;
    F.tid = threadIdx.x; F.lane = F.tid & 63; F.wave = __builtin_amdgcn_readfirstlane(F.tid >> 6);
    F.gw = blockIdx.x * NWAVES + F.wave; F.ngw = gridDim.x * NWAVES;
#pragma unroll
    for (int i = 0; i < 26; ++i) F.in[i] = args.in[i];
    F.out = args.out; F.ws = args.ws;
    F.ctl = (unsigned*)(args.ws + WS_CTL);
    F.MOD = (float*)(args.ws + WS_MOD); F.MODC = F.MOD + 2 * 4 * 6144; F.ROPE = F.MODC + 2048;
    F.LIST = (int*)(args.ws + WS_ROUTE); F.WT = (float*)(args.ws + WS_ROUTE + 1 * MiB);
    F.VSS = (float*)(args.ws + WS_VSS);
    F.H = (bf16*)(args.ws + WS_H); F.A = args.ws + WS_A;
    volatile LAS unsigned* MISC = (volatile LAS unsigned*)(F.lds + MISC_OFF);
    for (int u = F.tid; u < (LDS_BYTES - LDSCTL_OFF) / 4; u += NTHREADS) ((LAS unsigned*)(F.lds + LDSCTL_OFF))[u] = 0u;
    __syncthreads();
    XcdBarrier bar; bar.bar = F.ctl + CW_BAR; bar.x = 0; bar.st = nullptr;
    if (MK_ONE_LAUNCH) bar = xcd_barrier_post(F.ctl + CW_BAR, MISC + 8);
    const int lo = args.ph_lo, hi = args.ph_hi;
#define IN(k) (lo <= (k) && (k) < hi)
#ifdef ONLY_PHASE
#define PHON(k) ((k) == ONLY_PHASE)
#else
#define PHON(k) true
#endif
#define SEAM(k) do { if (IN(k) && IN((k) + 1)) xcd_barrier(bar); } while (0)
    if (PHON(0) && IN(0)) { ph_mod2(F); __syncthreads(); ph_convert(F); } SEAM(0);
    if (PHON(1) && IN(1)) { ph_norm0(F); } SEAM(1);
    if (PHON(2) && IN(2)) { if (NV_INPROJ) ph_inproj_naive(F); else ph_inproj(F); } SEAM(2);
    if (PHON(3) && IN(3)) { if (NV_RET) ph_scan_naive(F); else ph_kvstate(F); if (NV_NA) ph_na_naive(F); else ph_na(F); } SEAM(3);
    if (PHON(4) && IN(4)) { if (NV_RET) ph_retout_naive(F); else ph_retout(F); } SEAM(4);
    if (PHON(5) && IN(5)) { if (NV_OUTPROJ) ph_gemm_res_naive(F, (const bf16*)(F.A + A_MIX), D, D, F.in[I_WOUT], F.in[I_X], F.MOD + 2 * D); else ph_outproj(F); } SEAM(5);
    if (PHON(6) && IN(6)) { ph_route(F, 0); } SEAM(6);
    if (PHON(7) && IN(7)) { if (NV_MOEGU) ph_moe_gu_naive(F, 0); else ph_moe_gu(F, 0); } SEAM(7);
    if (PHON(8) && IN(8)) { if (NV_MOEDN) ph_moe_dn_naive(F, 0); else ph_moe_dn(F, 0); } SEAM(8);
    if (PHON(9) && IN(9)) { ph_combine(F, 0, true); } SEAM(9);
    if (PHON(10) && IN(10)) { if (NV_SGUIN) ph_sguin_naive(F); else ph_sguin(F); } SEAM(10);
    if (PHON(11) && IN(11)) { if (NV_SGUMIX) ph_sgumix_naive(F); else ph_sgumix(F); } SEAM(11);
    if (PHON(12) && IN(12)) { if (NV_SGUOUT) ph_gemm_res_naive(F, (const bf16*)(F.A + A_U), SGW, SGW, F.in[I_SWOUT], F.out, F.MOD + 4 * 6144 + 2 * D); else ph_sguout(F); } SEAM(12);
    if (PHON(13) && IN(13)) { ph_route(F, 1); } SEAM(13);
    if (PHON(14) && IN(14)) { if (NV_MOEGU) ph_moe_gu_naive(F, 1); else ph_moe_gu(F, 1); } SEAM(14);
    if (PHON(15) && IN(15)) { if (NV_MOEDN) ph_moe_dn_naive(F, 1); else ph_moe_dn(F, 1); } SEAM(15);
    if (PHON(16) && IN(16)) { ph_combine(F, 1, false); }
#undef IN
#undef SEAM
}

extern "C" void kernel_launch(void* const* d_in, const int* in_sizes, int n_in, void* d_out, int out_size, void* d_ws, size_t ws_size, hipStream_t stream) {
    static int grid = 0;
    if (grid == 0) {
        if (n_in != 26 || out_size != NTOK * D || ws_size < WS_END) { fprintf(stderr, "kernel_launch: unexpected shapes n_in %d out %d ws %zu (need %zu)\n", n_in, out_size, ws_size, (size_t)WS_END); grid = -1; return; }
        int dev = 0, cus = 0, per_cu = 0;
        hipGetDevice(&dev); hipDeviceGetAttribute(&cus, hipDeviceAttributeMultiprocessorCount, dev);
        hipFuncSetAttribute((const void*)fwd_kernel, hipFuncAttributeMaxDynamicSharedMemorySize, LDS_BYTES);
        hipOccupancyMaxActiveBlocksPerMultiprocessor(&per_cu, (const void*)fwd_kernel, NTHREADS, LDS_BYTES);
        (void)hipGetLastError();
        if (per_cu < 1) { fprintf(stderr, "kernel_launch: occupancy query says %d blocks/CU\n", per_cu); per_cu = 1; }
        grid = cus;
    }
    if (grid < 0) return;
    hipMemsetAsync((char*)d_ws + WS_CTL, 0, CTL_ZERO_BYTES, stream);
    Args a{};
    for (int i = 0; i < 26; ++i) a.in[i] = (const float*)d_in[i];
    a.out = (float*)d_out; a.ws = (unsigned char*)d_ws;
#if MK_ONE_LAUNCH
    a.ph_lo = 0; a.ph_hi = 17; a.li = 0;
    void* kargs[] = { &a };
    hipError_t e = hipLaunchCooperativeKernel((const void*)fwd_kernel, dim3(grid), dim3(NTHREADS), kargs, LDS_BYTES, stream);
    if (e != hipSuccess) fprintf(stderr, "cooperative launch failed: %s\n", hipGetErrorString(e));
#else
    for (int p = 0; p < 17; ++p) { a.ph_lo = p; a.ph_hi = p + 1; a.li = p; hipLaunchKernelGGL(fwd_kernel, dim3(grid), dim3(NTHREADS), LDS_BYTES, stream, a); }
#endif
}
```

```cpp
#include <hip/hip_runtime.h>
#include <cstdio>
#include <cstdint>

#ifndef NV_INPROJ
#define NV_INPROJ 0
#endif
#ifndef NV_OUTPROJ
#define NV_OUTPROJ 0
#endif
#ifndef NV_MOEGU
#define NV_MOEGU 0
#endif
#ifndef NV_MOEDN
#define NV_MOEDN 0
#endif
#ifndef NV_SGUIN
#define NV_SGUIN 0
#endif
#ifndef NV_SGUOUT
#define NV_SGUOUT 0
#endif
#ifndef NV_NA
#define NV_NA 0
#endif
#ifndef NV_RET
#define NV_RET 0
#endif
#ifndef NV_SGUMIX
#define NV_SGUMIX 0
#endif
#ifndef REP_PHASE
#define REP_PHASE -1
#endif
#ifndef REP_N
#define REP_N 2
#endif
#ifndef XBAR
#define XBAR 0
#endif
#ifndef GREP_PHASE
#define GREP_PHASE -1
#endif
#define GREP(k) ((k) == GREP_PHASE ? 2 : 1)
#ifndef MK_ONE_LAUNCH
#define MK_ONE_LAUNCH 1
#endif

constexpr int D = 1024, NB = 4, SEQ = 4096, NTOK = NB * SEQ, CTXL = 256, NCTX = NB * CTXL, NROW = NTOK + NCTX;
constexpr int HD = 64, NH = 8, HW = NH * HD;
constexpr int ABW = 3584;
constexpr int SGW = 3072;
constexpr int NE = 16, EW = 512;
constexpr float EPS = 1e-6f;
constexpr int NWAVES = 8, NTHREADS = 512;

constexpr size_t MiB = 1u << 20;
constexpr size_t WS_CTL = 0, CTL_ZERO_BYTES = 1 * MiB;
constexpr size_t WS_MOD = 1 * MiB;
constexpr size_t WS_ROUTE = 2 * MiB;
constexpr size_t WS_VSS = 4 * MiB;
constexpr size_t WS_WB = 8 * MiB;
constexpr size_t WS_H = 132 * MiB;
constexpr size_t WS_A = 166 * MiB;
constexpr size_t WS_END = 358 * MiB;
constexpr size_t A_RK = 0, A_RV = 17 * MiB, A_NK = 34 * MiB, A_NV = 51 * MiB, A_RQ = 68 * MiB, A_GT = 84 * MiB, A_NQ = 100 * MiB, A_MIX = 116 * MiB, A_SST = 148 * MiB;
constexpr size_t A_ACT = 0, A_Y = 36 * MiB;
constexpr size_t A_U = 0, A_V = 96 * MiB;

constexpr int CW_BAR = 4096;
constexpr int CW_CNT = 8192;

typedef unsigned short bf16;
typedef unsigned u32x4 __attribute__((ext_vector_type(4)));
typedef float f32x4 __attribute__((ext_vector_type(4)));
#define LAS __attribute__((address_space(3)))
#define RLX_AGENT __ATOMIC_RELAXED, __HIP_MEMORY_SCOPE_AGENT

__device__ __forceinline__ unsigned f2bf(float f) { unsigned u = __builtin_bit_cast(unsigned, f); return (u + 0x7fffu + ((u >> 16) & 1u)) >> 16; }
__device__ __forceinline__ float bf2f(unsigned h) { return __builtin_bit_cast(float, h << 16); }
__device__ __forceinline__ unsigned pk2(float lo, float hi) { return f2bf(lo) | (f2bf(hi) << 16); }
__device__ __forceinline__ float siluf(float v) { return v / (1.f + __expf(-v)); }
__device__ __forceinline__ float gelu_tanh(float v) { const float u = 0.7978845608028654f * (v + 0.044715f * v * v * v); return 0.5f * v * (1.f + tanhf(u)); }
__device__ __forceinline__ float wave_sum(float v) {
#pragma unroll
    for (int o = 1; o < 64; o <<= 1) v += __shfl_xor(v, o);
    return v;
}

#define XB_TMO      128
#define XB_XCNT(j)  (256  + 64 * (j))
#define XB_XSUB(j)  (1280 + 64 * (j))
#define XB_XGEN(j)  (2304 + 64 * (j))
#define XB_TOP      3328
#define XB_TOPGEN   3392
#define XCD_BAR_WORDS 3456
#define XB_SPIN_CAP (1u << 18)
__device__ __forceinline__ unsigned xb_ld(unsigned* p)              { return __hip_atomic_load(p, __ATOMIC_RELAXED, __HIP_MEMORY_SCOPE_AGENT); }
__device__ __forceinline__ unsigned xb_add(unsigned* p, unsigned v) { return __hip_atomic_fetch_add(p, v, __ATOMIC_RELAXED, __HIP_MEMORY_SCOPE_AGENT); }
__device__ __forceinline__ unsigned xb_xcc_id() { return (unsigned)__builtin_amdgcn_s_getreg((3 << 11) | 20) & 0xFu; }
#define XB_SPIN(cond, bar) do { unsigned _sp = 0; while (cond) { __builtin_amdgcn_s_sleep(1); \
    if ((++_sp & 255u) == 0u) { if (xb_ld(&(bar)[XB_TMO])) break; if (_sp > XB_SPIN_CAP) { atomicAdd(&(bar)[XB_TMO], 1u); break; } } } } while (0)
struct XcdBarrier { unsigned* bar; unsigned x; volatile LAS unsigned* st; };
__device__ __forceinline__ XcdBarrier xcd_barrier_post(unsigned* bar, volatile LAS unsigned* st) {
    XcdBarrier b; b.bar = bar; b.x = xb_xcc_id(); b.st = st;
    if (threadIdx.x == 0) (void)xb_add(&bar[XB_XCNT(b.x)], 1u);
    return b;
}
__device__ __forceinline__ void xcd_barrier_complete(unsigned* bar, unsigned x, unsigned& nloc, unsigned& nx) {
    const unsigned G = gridDim.x * gridDim.y * gridDim.z;
    unsigned sum, cnt, mine, sp = 0u;
    for (;;) {
        sum = 0u; cnt = 0u; mine = 0u;
#pragma unroll
        for (unsigned j = 0; j < 16; ++j) { const unsigned c = xb_ld(&bar[XB_XCNT(j)]); sum += c; cnt += (c > 0u) ? 1u : 0u; mine = (j == x) ? c : mine; }
        if (sum == G) break;
        __builtin_amdgcn_s_sleep(1);
        if ((++sp & 255u) == 0u) { if (xb_ld(&bar[XB_TMO])) break; if (sp > XB_SPIN_CAP) { atomicAdd(&bar[XB_TMO], 1u); break; } }
    }
    nloc = mine > 0u ? mine : 1u; nx = cnt > 0u ? cnt : 1u;
}
__device__ __forceinline__ void xcd_barrier(const XcdBarrier& b) {
    asm volatile("s_waitcnt vmcnt(0)" ::: "memory");
    __syncthreads();
    if (threadIdx.x == 0) {
        unsigned* bar = b.bar;
        __builtin_amdgcn_s_waitcnt(0);
        unsigned nloc = b.st[0], nx = b.st[1];
        if (nloc == 0u) { xcd_barrier_complete(bar, b.x, nloc, nx); b.st[0] = nloc; b.st[1] = nx; }
        const unsigned old = xb_add(&bar[XB_XSUB(b.x)], 1u);
        const unsigned gen = old / nloc;
        if (old + 1u == (gen + 1u) * nloc) {
            __builtin_amdgcn_fence(__ATOMIC_RELEASE, "agent");
            asm volatile("s_waitcnt vmcnt(0)" ::: "memory");
            const unsigned og = xb_add(&bar[XB_TOP], 1u);
            const unsigned tg = og / nx;
            if (og + 1u == (tg + 1u) * nx) xb_add(&bar[XB_TOPGEN], 1u);
            else XB_SPIN(xb_ld(&bar[XB_TOPGEN]) == tg, bar);
            __builtin_amdgcn_fence(__ATOMIC_ACQUIRE, "agent");
            xb_add(&bar[XB_XGEN(b.x)], 1u);
            asm volatile("s_waitcnt vmcnt(0)" ::: "memory");
        } else {
            XB_SPIN(xb_ld(&bar[XB_XGEN(b.x)]) == gen, bar);
            __builtin_amdgcn_fence(__ATOMIC_ACQUIRE, "agent");
            asm volatile("s_waitcnt vmcnt(0)" ::: "memory");
        }
    }
    __syncthreads();
}

constexpr int LDS_BYTES = 147456;
constexpr int LDSCTL_OFF = 131072, MISC_OFF = LDSCTL_OFF + 320, TAB_OFF = LDSCTL_OFF + 1024, ROPE_OFF = LDSCTL_OFF + 2048;

struct Args { const float* in[26]; float* out; unsigned char* ws; int ph_lo, ph_hi, li, pad; };

struct Frame {
    LAS unsigned char* lds;
    int tid, lane, wave, gw, ngw;
    const Args& a;
};
__device__ __forceinline__ unsigned* fctl(const Frame& F) { return (unsigned*)(F.a.ws + WS_CTL); }
__device__ __forceinline__ float* fmod(const Frame& F) { return (float*)(F.a.ws + WS_MOD); }
__device__ __forceinline__ float* fmodc(const Frame& F) { return (float*)(F.a.ws + WS_MOD) + 2 * 4 * 6144; }
__device__ __forceinline__ float* frope(const Frame& F) { return (float*)(F.a.ws + WS_MOD) + 2 * 4 * 6144 + 2048; }
__device__ __forceinline__ int* flist(const Frame& F) { return (int*)(F.a.ws + WS_ROUTE); }
__device__ __forceinline__ float* fwt(const Frame& F) { return (float*)(F.a.ws + WS_ROUTE + 1 * MiB); }
__device__ __forceinline__ float* fvss(const Frame& F) { return (float*)(F.a.ws + WS_VSS); }
__device__ __forceinline__ bf16* fH(const Frame& F) { return (bf16*)(F.a.ws + WS_H); }
__device__ __forceinline__ unsigned char* fA(const Frame& F) { return F.a.ws + WS_A; }
enum { I_X = 0, I_C, I_CTX, I_CCTX, I_ADAW, I_ADAB, I_NMG, I_NFG, I_RW, I_RB, I_WG, I_WU, I_WD, I_WIN, I_WOUT, I_RDEC, I_RNG, I_QG, I_KG, I_RPB, I_SWIN, I_SBIN, I_SNG, I_SWS, I_SBS, I_SWOUT };

template <int NC> __device__ __forceinline__ void naive_dot(const bf16* arow, const float* W, int ldw, int K, float (&acc)[NC]) {
#pragma unroll 1
    for (int k = 0; k < K; k += 2) {
        const unsigned a2 = *(const unsigned*)(arow + k);
        const float a0 = bf2f(a2 & 0xffffu), a1 = bf2f(a2 >> 16);
        const float* w = W + (size_t)k * ldw;
#pragma unroll
        for (int j = 0; j < NC; ++j) acc[j] = __builtin_fmaf(a0, w[j], acc[j]);
        asm volatile("" ::: "memory");
        w += ldw;
#pragma unroll
        for (int j = 0; j < NC; ++j) acc[j] = __builtin_fmaf(a1, w[j], acc[j]);
        asm volatile("" ::: "memory");
    }
}
template <int NC> __device__ __forceinline__ void store_row_bf16(bf16* dst, const float (&v)[NC]) {
#pragma unroll
    for (int j = 0; j < NC; j += 8) { u32x4 w; w.x = pk2(v[j], v[j + 1]); w.y = pk2(v[j + 2], v[j + 3]); w.z = pk2(v[j + 4], v[j + 5]); w.w = pk2(v[j + 6], v[j + 7]); *(u32x4*)(dst + j) = w; }
}

__device__ __forceinline__ void ph_mod(Frame& F) {
    const int gt = F.gw * 64 + F.lane, ngt = F.ngw * 64;
    for (int it = gt; it < 2 * 6144; it += ngt) {
        const int l = it / 6144, n = it % 6144;
        const float* W = F.a.in[I_ADAW] + (size_t)l * D * 6144 + n;
        float a0 = 0.f, a1 = 0.f, a2 = 0.f, a3 = 0.f, a4 = 0.f;
        const float* c = F.a.in[I_C]; const float* cc = F.a.in[I_CCTX];
        for (int k = 0; k < D; ++k) { const float w = W[(size_t)k * 6144];
            a0 += siluf(c[k]) * w; a1 += siluf(c[D + k]) * w; a2 += siluf(c[2 * D + k]) * w; a3 += siluf(c[3 * D + k]) * w; a4 += siluf(cc[k]) * w; }
        const float bb = F.a.in[I_ADAB][l * 6144 + n];
        fmod(F)[(l * 4 + 0) * 6144 + n] = a0 + bb; fmod(F)[(l * 4 + 1) * 6144 + n] = a1 + bb; fmod(F)[(l * 4 + 2) * 6144 + n] = a2 + bb; fmod(F)[(l * 4 + 3) * 6144 + n] = a3 + bb;
        if (l == 0 && n < 2048) fmodc(F)[n] = a4 + bb;
    }
    for (int it = gt; it < 64 * 16; it += ngt) {
        const int pos = it >> 4, j = it & 15;
        const float inv = powf(10000.0f, -(float)j / 16.0f);
        const float ang = (float)pos * inv;
        frope(F)[it * 2] = cosf(ang); frope(F)[it * 2 + 1] = sinf(ang);
    }
}

__device__ __forceinline__ void norm_row(Frame& F, const float* xrow, const float* g, const float* sh, const float* sc, bf16* hrow) {
    const f32x4* xr = (const f32x4*)xrow + F.lane;
    f32x4 v[4]; float s = 0.f;
#pragma unroll
    for (int j = 0; j < 4; ++j) { v[j] = xr[64 * j]; s += (v[j].x * v[j].x + v[j].y * v[j].y) + (v[j].z * v[j].z + v[j].w * v[j].w); }
    const float rstd = rsqrtf(wave_sum(s) * (1.f / D) + EPS);
    unsigned long long* o8 = (unsigned long long*)hrow + F.lane;
#pragma unroll
    for (int j = 0; j < 4; ++j) {
        const f32x4 gg = ((const f32x4*)g)[F.lane + 64 * j], s1 = ((const f32x4*)sh)[F.lane + 64 * j], s2 = ((const f32x4*)sc)[F.lane + 64 * j];
        const f32x4 y = (v[j] * rstd * gg) * (s2 + 1.f) + s1;
        o8[64 * j] = (unsigned long long)pk2(y.x, y.y) | ((unsigned long long)pk2(y.z, y.w) << 32);
    }
}
__device__ __forceinline__ void ph_norm0(Frame& F) {
    for (int r = F.gw; r < NROW; r += F.ngw) {
        if (r < NTOK) { const int b = r >> 12; norm_row(F, F.a.in[I_X] + (size_t)r * D, F.a.in[I_NMG], fmod(F) + (0 * 4 + b) * 6144, fmod(F) + (0 * 4 + b) * 6144 + D, fH(F) + (size_t)r * D); }
        else norm_row(F, F.a.in[I_CTX] + (size_t)(r - NTOK) * D, F.a.in[I_NMG], fmodc(F), fmodc(F) + D, fH(F) + (size_t)r * D);
    }
}

__device__ __forceinline__ void ph_inproj_naive(Frame& F) {
    const float* W = F.a.in[I_WIN];
    for (int it = F.gw; it < 272 * 56; it += F.ngw) {
        const int rg = it / 56, u = it % 56; if (rg >= 256 && u >= 32) continue;
        const int row = rg * 64 + F.lane;
        float acc[64];
#pragma unroll
        for (int j = 0; j < 64; ++j) acc[j] = 0.f;
        naive_dot<64>(fH(F) + (size_t)row * D, W + u * 64, ABW, D, acc);
        const int t = u >> 3, h = u & 7;
        if ((t == 0 || t == 4) && row < NTOK) {
            const int tt = row & 4095, pr = tt >> 6, pc = tt & 63;
#pragma unroll
            for (int j = 0; j < 16; ++j) {
                const float c1 = frope(F)[(pr * 16 + j) * 2], s1 = frope(F)[(pr * 16 + j) * 2 + 1], c2 = frope(F)[(pc * 16 + j) * 2], s2 = frope(F)[(pc * 16 + j) * 2 + 1];
                const float a = acc[j], b = acc[j + 16], c = acc[32 + j], d = acc[48 + j];
                acc[j] = a * c1 - b * s1; acc[j + 16] = a * s1 + b * c1; acc[32 + j] = c * c2 - d * s2; acc[48 + j] = c * s2 + d * c2;
            }
        }
        if (t == 0) {
#pragma unroll
            for (int j = 0; j < 64; ++j) acc[j] *= 0.125f;
        }
        if (t == 2 || t == 6) {
            float ss = 0.f;
#pragma unroll
            for (int j = 0; j < 64; ++j) ss += acc[j] * acc[j];
            const float r = rsqrtf(ss * (1.f / 64.f) + EPS) * (t == 6 ? 0.125f : 1.f);
            const float* g = t == 2 ? F.a.in[I_KG] : F.a.in[I_QG];
#pragma unroll
            for (int j = 0; j < 64; ++j) acc[j] = acc[j] * r * g[j];
        }
        if (t == 5) {
#pragma unroll
            for (int j = 0; j < 64; ++j) acc[j] = siluf(acc[j]);
        }
        const size_t off_t = t < 4 ? (size_t)t * 17 * MiB : (size_t)(68 + (t - 4) * 16) * MiB;
        bf16* dst = (bf16*)(fA(F) + off_t) + (size_t)row * HW + h * 64;
        store_row_bf16<64>(dst, acc);
    }
}

__device__ __forceinline__ float ret_gamma_log(Frame& F, int dir, int h) {
    const float th = F.a.in[I_RDEC][dir * 8 + h];
    return -(th > 0.f ? th + log1pf(__expf(-th)) : log1pf(__expf(th)));
}
__device__ __forceinline__ void ph_scan_naive(Frame& F) {
    const bf16* RK = (const bf16*)(fA(F) + A_RK); const bf16* RV = (const bf16*)(fA(F) + A_RV); bf16* SST = (bf16*)(fA(F) + A_SST);
    const int gt = F.gw * 64 + F.lane, ngt = F.ngw * 64;
    for (int it = gt; it < 64 * 4096; it += ngt) {
        const int bhd = it >> 12, ed = it & 4095, e = ed >> 6, d = ed & 63;
        const int dir = bhd & 1, h = (bhd >> 1) & 7, b = bhd >> 4;
        const float gam = __expf(ret_gamma_log(F, dir, h));
        float S = 0.f;
        bf16* sst = SST + ((size_t)((b * 8 + h) * 2 + dir) * 32) * 4096 + ed;
        for (int n = 0; n < CTXL; ++n) { const int nn = dir ? (CTXL - 1 - n) : n; const size_t row = NTOK + b * CTXL + nn;
            S = gam * S + bf2f(RK[row * HW + h * 64 + d]) * bf2f(RV[row * HW + h * 64 + e]); }
        for (int n = 0; n < SEQ; ++n) { const int t = dir ? (SEQ - 1 - n) : n; const size_t row = (size_t)b * SEQ + t;
            if ((n & 127) == 0) sst[(size_t)(t >> 7) * 4096] = (bf16)f2bf(S);
            S = gam * S + bf2f(RK[row * HW + h * 64 + d]) * bf2f(RV[row * HW + h * 64 + e]); }
    }
}
__device__ __forceinline__ void ph_na_naive(Frame& F) {
    const bf16* NK = (const bf16*)(fA(F) + A_NK); const bf16* NV = (const bf16*)(fA(F) + A_NV); const bf16* NQ = (const bf16*)(fA(F) + A_NQ); bf16* MIX = (bf16*)(fA(F) + A_MIX);
    const int gt = F.gw * 64 + F.lane, ngt = F.ngw * 64;
    for (int it = gt; it < NB * NH * SEQ; it += ngt) {
        const int t = it & 4095, h = (it >> 12) & 7, b = it >> 15;
        const int r = t >> 6, c = t & 63;
        int r0 = r - 4; r0 = r0 < 0 ? 0 : (r0 > 56 ? 56 : r0); int c0 = c - 8; c0 = c0 < 0 ? 0 : (c0 > 48 ? 48 : c0);
        const size_t qrow = (size_t)b * SEQ + t;
        unsigned q[32]; float o[64];
#pragma unroll
        for (int j = 0; j < 32; ++j) q[j] = *(const unsigned*)(NQ + qrow * HW + h * 64 + 2 * j);
#pragma unroll
        for (int j = 0; j < 64; ++j) o[j] = 0.f;
        float m = -1e30f, l = 0.f;
        const float* rpb = F.a.in[I_RPB] + h * 15 * 31;
#pragma unroll 1
        for (int kk = 0; kk < 384; ++kk) {
            size_t krow; float bias = 0.f;
            if (kk < 128) { const int kr = r0 + (kk >> 4), kc = c0 + (kk & 15); krow = (size_t)b * SEQ + kr * 64 + kc; bias = rpb[(kr - r + 7) * 31 + (kc - c + 15)]; }
            else krow = NTOK + b * CTXL + (kk - 128);
            float s = 0.f;
#pragma unroll
            for (int j = 0; j < 64; j += 2) { const unsigned w = *(const unsigned*)(NK + krow * HW + h * 64 + j); s += bf2f(q[j >> 1] & 0xffffu) * bf2f(w & 0xffffu) + bf2f(q[j >> 1] >> 16) * bf2f(w >> 16); }
            s += bias;
            asm volatile("" ::: "memory");
            const float mn = fmaxf(m, s), al = __expf(m - mn), p = __expf(s - mn);
            l = l * al + p; m = mn;
#pragma unroll
            for (int j = 0; j < 64; j += 2) { const unsigned w = *(const unsigned*)(NV + krow * HW + h * 64 + j); o[j] = o[j] * al + p * bf2f(w & 0xffffu); o[j + 1] = o[j + 1] * al + p * bf2f(w >> 16); }
        }
        const float il = 1.f / l;
#pragma unroll
        for (int j = 0; j < 64; ++j) o[j] *= il;
        store_row_bf16<64>(MIX + qrow * D + 512 + h * 64, o);
    }
}
__device__ __forceinline__ void ph_retout_naive(Frame& F) {
    const bf16* RK = (const bf16*)(fA(F) + A_RK); const bf16* RV = (const bf16*)(fA(F) + A_RV); const bf16* RQ = (const bf16*)(fA(F) + A_RQ); const bf16* GT = (const bf16*)(fA(F) + A_GT);
    const bf16* SST = (const bf16*)(fA(F) + A_SST); bf16* MIX = (bf16*)(fA(F) + A_MIX);
    const int gt = F.gw * 64 + F.lane, ngt = F.ngw * 64;
    for (int it = gt; it < NB * NH * SEQ * 2; it += ngt) {
        const int hf = it & 1, t = (it >> 1) & 4095, h = (it >> 13) & 7, b = it >> 16;
        const int i = t & 127, ch = t >> 7;
        const size_t qrow = (size_t)b * SEQ + t;
        const float lgf = ret_gamma_log(F, 0, h), lgb = ret_gamma_log(F, 1, h);
        unsigned q[32]; float o[32];
#pragma unroll
        for (int j = 0; j < 32; ++j) q[j] = *(const unsigned*)(RQ + qrow * HW + h * 64 + 2 * j);
#pragma unroll
        for (int j = 0; j < 32; ++j) o[j] = 0.f;
#pragma unroll 1
        for (int jj = 0; jj < 128; ++jj) {
            const size_t krow = (size_t)b * SEQ + ch * 128 + jj;
            float s = 0.f;
#pragma unroll
            for (int j = 0; j < 64; j += 2) { const unsigned w = *(const unsigned*)(RK + krow * HW + h * 64 + j); s += bf2f(q[j >> 1] & 0xffffu) * bf2f(w & 0xffffu) + bf2f(q[j >> 1] >> 16) * bf2f(w >> 16); }
            asm volatile("" ::: "memory");
            const float wgt = jj < i ? __expf(lgf * (float)(i - jj)) : (jj > i ? __expf(lgb * (float)(jj - i)) : 2.f);
            s *= wgt;
#pragma unroll
            for (int j = 0; j < 32; j += 2) { const unsigned w = *(const unsigned*)(RV + krow * HW + h * 64 + hf * 32 + j); o[j] += s * bf2f(w & 0xffffu); o[j + 1] += s * bf2f(w >> 16); }
            asm volatile("" ::: "memory");
        }
        const float qf = __expf(lgf * (float)(i + 1)), qb = __expf(lgb * (float)(128 - i));
        const bf16* Sf = SST + ((size_t)((b * 8 + h) * 2 + 0) * 32 + ch) * 4096 + hf * 32 * 64; const bf16* Sb = SST + ((size_t)((b * 8 + h) * 2 + 1) * 32 + ch) * 4096 + hf * 32 * 64;
#pragma unroll 1
        for (int d = 0; d < 64; ++d) {
            const float qd = bf2f(RQ[qrow * HW + h * 64 + d]); const float qfd = qf * qd, qbd = qb * qd;
#pragma unroll
            for (int e = 0; e < 32; ++e) o[e] += qfd * bf2f(Sf[e * 64 + d]) + qbd * bf2f(Sb[e * 64 + d]);
            asm volatile("" ::: "memory");
        }
        float ss = 0.f;
#pragma unroll
        for (int j = 0; j < 32; ++j) ss += o[j] * o[j];
        ss += __shfl_xor(ss, 1);
        const float rs = rsqrtf(ss * (1.f / 64.f) + EPS);
        const float* g = F.a.in[I_RNG] + hf * 32;
#pragma unroll
        for (int j = 0; j < 32; j += 2) { const unsigned w = *(const unsigned*)(GT + qrow * HW + h * 64 + hf * 32 + j); o[j] = o[j] * rs * g[j] * bf2f(w & 0xffffu); o[j + 1] = o[j + 1] * rs * g[j + 1] * bf2f(w >> 16); }
        store_row_bf16<32>(MIX + qrow * D + h * 64 + hf * 32, o);
    }
}
__device__ __forceinline__ void ph_gemm_res_naive(Frame& F, const bf16* A, int lda, int K, const float* W, const float* base, const float* gate  ) {
    for (int it = F.gw; it < 256 * 16; it += F.ngw) {
        const int rg = it >> 4, u = it & 15, row = rg * 64 + F.lane, b = row >> 12;
        float acc[64];
#pragma unroll
        for (int j = 0; j < 64; ++j) acc[j] = 0.f;
        naive_dot<64>(A + (size_t)row * lda, W + u * 64, D, K, acc);
        const float* gp = gate + b * 6144 + u * 64; const float* bp = base + (size_t)row * D + u * 64; float* op = F.a.out + (size_t)row * D + u * 64;
#pragma unroll
        for (int j = 0; j < 64; j += 4) { const f32x4 bv = *(const f32x4*)(bp + j), gv = *(const f32x4*)(gp + j);
            *(f32x4*)(op + j) = bv + gv * (f32x4){acc[j], acc[j + 1], acc[j + 2], acc[j + 3]}; }
    }
}
__device__ __forceinline__ void ph_route(Frame& F, int l, bool dry = false) {
    typedef short bf16x8_ __attribute__((ext_vector_type(8)));
    LAS bf16* wh = (LAS bf16*)F.lds;
    LAS bf16* wl = wh + 16 * 1024;
    LAS float* gsb = (LAS float*)(F.lds + 65536);
    LAS float* shb = gsb + 4 * 1024;
    for (int i = F.tid; i < D * NE; i += NTHREADS) { const int e = i >> 10, k = i & 1023; const float w = F.a.in[I_RW][k * 16 + e]; const unsigned h = f2bf(w); const float rem = w - bf2f(h);
        wh[i] = (bf16)h; wl[i] = (bf16)f2bf(rem); }
    for (int i = F.tid; i < 4 * D; i += NTHREADS) { const int b = i >> 10, k = i & 1023; const float* md = fmod(F) + (l * 4 + b) * 6144;
        gsb[i] = F.a.in[I_NFG][l * D + k] * (md[4 * D + k] + 1.f); shb[i] = md[3 * D + k]; }
    __syncthreads();
    unsigned* cnt = fctl(F) + CW_CNT + l * 1024;
    const int row16 = F.lane & 15, kq = F.lane >> 4;
    for (int item = F.gw; item < NTOK / 16; item += F.ngw) {
        const int r = item * 16 + row16, b = (item * 16) >> 12;
        const float* xrow = F.a.out + (size_t)r * D + 8 * kq;
        float ss = 0.f;
#pragma unroll 8
        for (int s2 = 0; s2 < 32; ++s2) { const f32x4 a = *(const f32x4*)(xrow + 32 * s2), c = *(const f32x4*)(xrow + 32 * s2 + 4);
            ss += (a.x * a.x + a.y * a.y) + (a.z * a.z + a.w * a.w) + (c.x * c.x + c.y * c.y) + (c.z * c.z + c.w * c.w); }
        ss += __shfl_xor(ss, 16); ss += __shfl_xor(ss, 32);
        const float rstd = rsqrtf(ss * (1.f / D) + EPS);
        f32x4 acc = {0.f, 0.f, 0.f, 0.f};
        bf16* hrow = fH(F) + (size_t)r * D + 8 * kq;
        const LAS float* gp = gsb + b * 1024 + 8 * kq; const LAS float* sp = shb + b * 1024 + 8 * kq;
        const LAS bf16* whp = wh + row16 * 1024 + 8 * kq; const LAS bf16* wlp = wl + row16 * 1024 + 8 * kq;
#pragma unroll 4
        for (int s2 = 0; s2 < 32; ++s2) {
            const f32x4 a = *(const f32x4*)(xrow + 32 * s2), c = *(const f32x4*)(xrow + 32 * s2 + 4);
            const f32x4 g0 = *(const LAS f32x4*)(gp + 32 * s2), g1 = *(const LAS f32x4*)(gp + 32 * s2 + 4), h0 = *(const LAS f32x4*)(sp + 32 * s2), h1 = *(const LAS f32x4*)(sp + 32 * s2 + 4);
            const f32x4 y0 = (a * rstd) * g0 + h0, y1 = (c * rstd) * g1 + h1;
            u32x4 yh; yh.x = pk2(y0.x, y0.y); yh.y = pk2(y0.z, y0.w); yh.z = pk2(y1.x, y1.y); yh.w = pk2(y1.z, y1.w);
            *(u32x4*)(hrow + 32 * s2) = yh;
            const f32x4 r0 = { y0.x - bf2f(yh.x & 0xffffu), y0.y - bf2f(yh.x >> 16), y0.z - bf2f(yh.y & 0xffffu), y0.w - bf2f(yh.y >> 16) };
            const f32x4 r1 = { y1.x - bf2f(yh.z & 0xffffu), y1.y - bf2f(yh.z >> 16), y1.z - bf2f(yh.w & 0xffffu), y1.w - bf2f(yh.w >> 16) };
            u32x4 yl; yl.x = pk2(r0.x, r0.y); yl.y = pk2(r0.z, r0.w); yl.z = pk2(r1.x, r1.y); yl.w = pk2(r1.z, r1.w);
            const bf16x8_ wfh = *(const LAS bf16x8_*)(whp + 32 * s2), wfl = *(const LAS bf16x8_*)(wlp + 32 * s2);
            const bf16x8_ yfh = __builtin_bit_cast(bf16x8_, yh), yfl = __builtin_bit_cast(bf16x8_, yl);
            acc = __builtin_amdgcn_mfma_f32_16x16x32_bf16(wfh, yfh, acc, 0, 0, 0);
            acc = __builtin_amdgcn_mfma_f32_16x16x32_bf16(wfl, yfh, acc, 0, 0, 0);
            acc = __builtin_amdgcn_mfma_f32_16x16x32_bf16(wfh, yfl, acc, 0, 0, 0);
        }
        float m1 = -1e30f, m2 = -1e30f, w1 = 0.f, w2 = 0.f; int i1 = 0, i2 = 0;
#pragma unroll
        for (int g = 0; g < 4; ++g) { const float af = 1.f / (1.f + __expf(-acc[g])); const float x = af + F.a.in[I_RB][4 * kq + g]; const int id = 4 * kq + g;
            if (x > m1) { m2 = m1; i2 = i1; w2 = w1; m1 = x; i1 = id; w1 = af; } else if (x > m2) { m2 = x; i2 = id; w2 = af; } }
        const float gsc = m1 + m2;
        const float s0 = __shfl(gsc, row16), s1 = __shfl(gsc, row16 + 16), s2_ = __shfl(gsc, row16 + 32), s3 = __shfl(gsc, row16 + 48);
        int best = 0; float bs = s0; if (s1 > bs) { bs = s1; best = 1; } if (s2_ > bs) { bs = s2_; best = 2; } if (s3 > bs) { bs = s3; best = 3; }
        const bool writer = (kq == best) && !dry;
        int mycount = 0; unsigned long long below1 = 0ull, below2 = 0ull;
        const unsigned long long ltmask = (1ull << F.lane) - 1ull;
#pragma unroll
        for (int e = 0; e < 16; ++e) { const unsigned long long m = __ballot(writer && (i1 == e || i2 == e));
            if (F.lane == e) mycount = __popcll(m);
            if (i1 == e) below1 = m & ltmask; if (i2 == e) below2 = m & ltmask; }
        int base = 0;
        if (F.lane < 16 && mycount > 0) base = (int)__hip_atomic_fetch_add(cnt + F.lane * 64, (unsigned)mycount, RLX_AGENT);
        const int b1 = __shfl(base, i1), b2 = __shfl(base, i2);
        if (writer) { const float inv = 1.f / (w1 + w2);
            flist(F)[i1 * 16384 + b1 + __popcll(below1)] = 2 * r; flist(F)[i2 * 16384 + b2 + __popcll(below2)] = 2 * r + 1;
            fwt(F)[2 * r] = w1 * inv; fwt(F)[2 * r + 1] = w2 * inv; }
    }
    __syncthreads();
}
struct Seg { int cnt[16]; int base[16]; };
__device__ __forceinline__ void load_seg(Frame& F, int l, int (&cnt)[16], int (&base)[16]) {
    int acc = 0;
#pragma unroll
    for (int e = 0; e < 16; ++e) { cnt[e] = (int)__hip_atomic_load(fctl(F) + CW_CNT + l * 1024 + e * 64, RLX_AGENT); base[e] = acc; acc += (cnt[e] + 255) & ~255; }
}
__device__ __forceinline__ void ph_moe_gu_naive(Frame& F, int l) {
    int cnt[16], base[16]; load_seg(F, l, cnt, base);
    bf16* ACT = (bf16*)(fA(F) + A_ACT);
    int tot = 0;
#pragma unroll
    for (int i = 0; i < 16; ++i) tot += (cnt[i] + 63) >> 6;
    for (int it = F.gw; it < tot * 16; it += F.ngw) {
        const int gi_all = it >> 4, u = it & 15;
        int ee = 0, gs = 0;
#pragma unroll
        for (int i = 0, cum = 0; i < 16; ++i) { cum += (cnt[i] + 63) >> 6; if (gi_all >= cum) { gs = cum; ee = i + 1; } }
        int ce = 0, be = 0;
#pragma unroll
        for (int i = 0; i < 16; ++i) if (i == ee) { ce = cnt[i]; be = base[i]; }
        const int pos = (gi_all - gs) * 64 + F.lane; const bool valid = pos < ce;
        const int ent = flist(F)[ee * 16384 + (valid ? pos : 0)]; const int tok = ent >> 1;
        float ag[32], au[32];
#pragma unroll
        for (int j = 0; j < 32; ++j) { ag[j] = 0.f; au[j] = 0.f; }
        const float* Wg = F.a.in[I_WG] + ((size_t)(l * NE + ee) * D) * EW + u * 32; const float* Wu = F.a.in[I_WU] + ((size_t)(l * NE + ee) * D) * EW + u * 32;
        naive_dot<32>(fH(F) + (size_t)tok * D, Wg, EW, D, ag);
        naive_dot<32>(fH(F) + (size_t)tok * D, Wu, EW, D, au);
#pragma unroll
        for (int j = 0; j < 32; ++j) ag[j] = siluf(ag[j]) * au[j];
        if (valid) store_row_bf16<32>(ACT + (size_t)(be + pos) * EW + u * 32, ag);
    }
}
__device__ __forceinline__ void ph_moe_dn_naive(Frame& F, int l) {
    int cnt[16], base[16]; load_seg(F, l, cnt, base);
    const bf16* ACT = (const bf16*)(fA(F) + A_ACT); bf16* Y = (bf16*)(fA(F) + A_Y);
    int tot = 0;
#pragma unroll
    for (int i = 0; i < 16; ++i) tot += (cnt[i] + 63) >> 6;
    for (int it = F.gw; it < tot * 16; it += F.ngw) {
        const int gi_all = it >> 4, u = it & 15;
        int ee = 0, gs = 0;
#pragma unroll
        for (int i = 0, cum = 0; i < 16; ++i) { cum += (cnt[i] + 63) >> 6; if (gi_all >= cum) { gs = cum; ee = i + 1; } }
        int ce = 0, be = 0;
#pragma unroll
        for (int i = 0; i < 16; ++i) if (i == ee) { ce = cnt[i]; be = base[i]; }
        const int pos = (gi_all - gs) * 64 + F.lane; const bool valid = pos < ce;
        const int ent = flist(F)[ee * 16384 + (valid ? pos : 0)];
        float acc[64];
#pragma unroll
        for (int j = 0; j < 64; ++j) acc[j] = 0.f;
        const float* Wd = F.a.in[I_WD] + ((size_t)(l * NE + ee) * EW) * D + u * 64;
        naive_dot<64>(ACT + (size_t)(be + (valid ? pos : 0)) * EW, Wd, D, EW, acc);
        const float w = fwt(F)[ent];
#pragma unroll
        for (int j = 0; j < 64; ++j) acc[j] *= w;
        if (valid) store_row_bf16<64>(Y + (size_t)ent * D + u * 64, acc);
    }
}
__device__ __forceinline__ void ph_combine(Frame& F, int l, bool do_norm, bool dry = false) {
    const float dsc = dry ? 0.f : 1.f;
    const bf16* Y = (const bf16*)(fA(F) + A_Y);
    for (int r = F.gw; r < NTOK; r += F.ngw) {
        const int b = r >> 12;
        const float* gf = fmod(F) + (l * 4 + b) * 6144 + 5 * D;
        f32x4* xr = (f32x4*)(F.a.out + (size_t)r * D) + F.lane;
        const unsigned long long* ya = (const unsigned long long*)(Y + (size_t)(2 * r) * D) + F.lane; const unsigned long long* yb = (const unsigned long long*)(Y + (size_t)(2 * r + 1) * D) + F.lane;
        f32x4 v[4]; float s = 0.f;
#pragma unroll
        for (int j = 0; j < 4; ++j) {
            const unsigned long long a = ya[64 * j], bq = yb[64 * j];
            const f32x4 yy = { bf2f((unsigned)a & 0xffffu) + bf2f((unsigned)bq & 0xffffu), bf2f(((unsigned)a) >> 16) + bf2f(((unsigned)bq) >> 16),
                               bf2f((unsigned)(a >> 32) & 0xffffu) + bf2f((unsigned)(bq >> 32) & 0xffffu), bf2f((unsigned)(a >> 48)) + bf2f((unsigned)(bq >> 48)) };
            v[j] = xr[64 * j] + ((const f32x4*)gf)[F.lane + 64 * j] * yy * dsc;
            xr[64 * j] = v[j];
            s += (v[j].x * v[j].x + v[j].y * v[j].y) + (v[j].z * v[j].z + v[j].w * v[j].w);
        }
        if (do_norm) {
            const float rstd = rsqrtf(wave_sum(s) * (1.f / D) + EPS);
            const float* g = F.a.in[I_NMG] + (l + 1) * D; const float* sh = fmod(F) + ((l + 1) * 4 + b) * 6144; const float* sc = sh + D;
            unsigned long long* o8 = (unsigned long long*)(fH(F) + (size_t)r * D) + F.lane;
#pragma unroll
            for (int j = 0; j < 4; ++j) {
                const f32x4 gg = ((const f32x4*)g)[F.lane + 64 * j], s1 = ((const f32x4*)sh)[F.lane + 64 * j], s2 = ((const f32x4*)sc)[F.lane + 64 * j];
                const f32x4 y = (v[j] * rstd * gg) * (s2 + 1.f) + s1;
                o8[64 * j] = (unsigned long long)pk2(y.x, y.y) | ((unsigned long long)pk2(y.z, y.w) << 32);
            }
        }
    }
}
__device__ __forceinline__ void ph_sguin_naive(Frame& F) {
    bf16* U = (bf16*)(fA(F) + A_U); bf16* V = (bf16*)(fA(F) + A_V);
    for (int it = F.gw; it < 256 * 96; it += F.ngw) {
        const int rg = it / 96, u = it % 96, row = rg * 64 + F.lane;
        float acc[64];
#pragma unroll
        for (int j = 0; j < 64; ++j) acc[j] = 0.f;
        naive_dot<64>(fH(F) + (size_t)row * D, F.a.in[I_SWIN] + u * 64, 2 * SGW, D, acc);
        const float* bi = F.a.in[I_SBIN] + u * 64; float ss = 0.f;
#pragma unroll
        for (int j = 0; j < 64; ++j) { acc[j] = gelu_tanh(acc[j] + bi[j]); ss += acc[j] * acc[j]; }
        if (u < 48) store_row_bf16<64>(U + (size_t)row * SGW + u * 64, acc);
        else { store_row_bf16<64>(V + (size_t)row * SGW + (u - 48) * 64, acc); fvss(F)[(size_t)row * 48 + (u - 48)] = ss; }
    }
}
__device__ __forceinline__ void ph_sgumix_naive(Frame& F) {
    bf16* U = (bf16*)(fA(F) + A_U); const bf16* V = (const bf16*)(fA(F) + A_V);
    LAS float* rs = (LAS float*)F.lds;
    for (int bc = blockIdx.x; bc < NB * 32; bc += gridDim.x) {
        const size_t row0 = (size_t)bc * 128;
        __syncthreads();
        if (F.tid < 128) { float s = 0.f; for (int j = 0; j < 48; ++j) s += fvss(F)[(row0 + F.tid) * 48 + j]; rs[F.tid] = rsqrtf(s * (1.f / SGW) + EPS); }
        __syncthreads();
        for (int o = F.tid; o < 128 * SGW; o += NTHREADS) {
            const int i = o / SGW, c = o % SGW, g = c / 384;
            const float* ws = F.a.in[I_SWS] + ((size_t)g * 128 + i) * 128;
            float acc = 0.f;
            for (int j = 0; j < 128; ++j) acc += ws[j] * (bf2f(V[(row0 + j) * SGW + c]) * rs[j]);
            const float mixed = acc * F.a.in[I_SNG][c] + F.a.in[I_SBS][g * 128 + i];
            const size_t idx = (row0 + i) * SGW + c;
            U[idx] = (bf16)f2bf(bf2f(U[idx]) * mixed);
        }
    }
    __syncthreads();
}


namespace pg8 {
typedef short bf16x8 __attribute__((ext_vector_type(8)));
constexpr int BM = 256, BK = 64, HALF = 128, HTB = HALF * BK * 2, STAGE_BYTES = 8 * HTB;
__host__ __device__ __forceinline__ int lds_byte(int r, int c) { const int st = (r >> 4) * 2 + (c >> 5), rr = r & 15, cc = c & 31, ob = rr * 64 + cc * 2; return st * 1024 + (ob ^ (((ob >> 9) & 1) << 5)); }
__host__ __device__ __forceinline__ void stage_rc(int b, int& R, int& C) { const int st = b / 1024, sb = b % 1024, swz = sb ^ (((sb >> 9) & 1) << 5); R = (st >> 1) * 16 + swz / 64; C = (st & 1) * 32 + (swz % 64) / 2; }
struct Unit { int pm, pn; const char* Ab; const char* Bb; int x0, x1, x2; };
__device__ __forceinline__ unsigned cvt_pk_bf16(float lo, float hi) { unsigned r; asm volatile("v_cvt_pk_bf16_f32 %0, %1, %2" : "=v"(r) : "v"(lo), "v"(hi)); return r; }

template <class Sched, class Epi, bool ALIGN_EPI>
__device__ __forceinline__ void gemm_phase(LAS unsigned char* lds, const int K, const Sched& S, const Epi& E) {
    const int tid = threadIdx.x, wid = __builtin_amdgcn_readfirstlane(tid >> 6), lane = tid & 63, wr = wid >> 2, wc = wid & 3, fr = lane & 15, fq = lane >> 4;
    const int nt = K / BK;
    unsigned voffB[2];
#pragma unroll
    for (int i = 0; i < 2; ++i) { int R_, C_; stage_rc(tid * 16 + i * 8192, R_, C_); voffB[i] = (unsigned)(R_ * K + C_) * 2u; }
    const size_t kstep = (size_t)(BK * 2);
    const size_t hstep = (size_t)HALF * K * 2;
    const unsigned ldsw = (unsigned)wid * 1024u;
    const int aoff = lds_byte(wr * 64 + fr, fq * 8), boff = lds_byte(wc * 32 + fr, fq * 8);
#define PG8_SA(b, h) (((b) * 2 + (h)) * HTB)
#define PG8_SB(b, h) ((4 + (b) * 2 + (h)) * HTB)
#define PG8_STAGE(bufoff, gbase, voff) do { _Pragma("unroll") for (int _i = 0; _i < 2; ++_i) \
        __builtin_amdgcn_global_load_lds((const unsigned*)((const char*)(gbase) + (voff)[_i]), (LAS unsigned*)(lds + (bufoff) + ldsw + _i * 8192), 16, 0, 0); } while (0)
#define PG8_LDA(dst, b, h) do { _Pragma("unroll") for (int m = 0; m < 4; ++m) _Pragma("unroll") for (int k = 0; k < 2; ++k) dst[m][k] = *(const LAS bf16x8*)(lds + PG8_SA(b, h) + aoff + m * 2048 + k * 1024); } while (0)
#define PG8_LDB(dst, b, h) do { _Pragma("unroll") for (int n = 0; n < 2; ++n) _Pragma("unroll") for (int k = 0; k < 2; ++k) dst[n][k] = *(const LAS bf16x8*)(lds + PG8_SB(b, h) + boff + n * 2048 + k * 1024); } while (0)
#define PG8_MMA(ai, bj, At, Bt) do { __builtin_amdgcn_s_setprio(1); _Pragma("unroll") for (int m = 0; m < 4; ++m) _Pragma("unroll") for (int n = 0; n < 2; ++n) _Pragma("unroll") for (int k = 0; k < 2; ++k) \
        acc[ai][bj][m][n] = __builtin_amdgcn_mfma_f32_16x16x32_bf16(Bt[n][k], At[m][k], acc[ai][bj][m][n], 0, 0, 0); __builtin_amdgcn_s_setprio(0); } while (0)
#define PG8_WAIT_V(n) asm volatile("s_waitcnt vmcnt(" #n ")" ::: "memory")
#define PG8_WAIT_L(n) asm volatile("s_waitcnt lgkmcnt(" #n ")" ::: "memory")
#define PG8_BAR __builtin_amdgcn_s_barrier()
#define PG8_SCHED __builtin_amdgcn_sched_barrier(0)
    Unit cur, nxt; int ui = 0;
    if (!S.next(0, cur)) return;
    unsigned vA[2][2];
    S.arows(cur, vA);
    asm volatile("" : "+v"(vA[0][0]), "+v"(vA[0][1]), "+v"(vA[1][0]), "+v"(vA[1][1]));
    f32x4 acc[2][2][4][2];
#pragma unroll
    for (int a = 0; a < 2; ++a)
#pragma unroll
        for (int b = 0; b < 2; ++b)
#pragma unroll
            for (int m = 0; m < 4; ++m)
#pragma unroll
                for (int n = 0; n < 2; ++n) acc[a][b][m][n] = (f32x4){0.f, 0.f, 0.f, 0.f};
    bf16x8 At[4][2], B0[2][2], B1[2][2];
    const char* cA = cur.Ab; const char* cB = cur.Bb;
    PG8_STAGE(PG8_SB(0, 0), cB, voffB); PG8_STAGE(PG8_SB(0, 1), cB + hstep, voffB); PG8_STAGE(PG8_SA(0, 0), cA, vA[0]); PG8_STAGE(PG8_SA(0, 1), cA, vA[1]);
    if (wr == 1) PG8_BAR;
    PG8_WAIT_V(2); PG8_BAR;
    PG8_STAGE(PG8_SB(1, 0), cB + kstep, voffB); PG8_STAGE(PG8_SA(1, 0), cA + kstep, vA[0]); PG8_STAGE(PG8_SB(1, 1), cB + hstep + kstep, voffB);
    PG8_WAIT_V(6); PG8_BAR;
    for (;;) {
        const bool has_next = S.next(ui + 1, nxt);
        const char* nA = has_next ? nxt.Ab : cA; const char* nB = has_next ? nxt.Bb : cB;
        for (int t = 0; t < nt; t += 2) {
            const bool last = (t == nt - 2);
            const char* a1 = cA + (size_t)(t + 1) * kstep;
            const char* a2 = last ? nA : cA + (size_t)(t + 2) * kstep; const char* b2 = last ? nB : cB + (size_t)(t + 2) * kstep;
            const char* a3 = a2 + kstep; const char* b3 = b2 + kstep;
            unsigned w0[2], w1[2];
            w0[0] = vA[0][0]; w0[1] = vA[0][1]; w1[0] = vA[1][0]; w1[1] = vA[1][1];
            if (last && has_next) { unsigned nv[2][2]; pg8::Unit tu = nxt; asm volatile("" : "+v"(tu.pm)); S.arows(tu, nv);
                asm volatile("" : "+v"(nv[0][0]), "+v"(nv[0][1]), "+v"(nv[1][0]), "+v"(nv[1][1]));
                w0[0] = nv[0][0]; w0[1] = nv[0][1]; w1[0] = nv[1][0]; w1[1] = nv[1][1]; }
            PG8_LDB(B0, 0, 0); PG8_LDB(B1, 0, 1); PG8_SCHED; PG8_LDA(At, 0, 0); PG8_STAGE(PG8_SA(1, 1), a1, vA[1]);
            PG8_WAIT_V(8); PG8_WAIT_L(0); PG8_BAR; PG8_MMA(0, 0, At, B0); PG8_MMA(0, 1, At, B1); PG8_BAR; PG8_SCHED;
            PG8_LDA(At, 0, 1); PG8_STAGE(PG8_SB(0, 0), b2, voffB); PG8_STAGE(PG8_SB(0, 1), b2 + hstep, voffB); PG8_STAGE(PG8_SA(0, 0), a2, w0);
            PG8_WAIT_V(8); PG8_WAIT_L(0); PG8_BAR; PG8_MMA(1, 0, At, B0); PG8_MMA(1, 1, At, B1); PG8_BAR; PG8_SCHED;
            PG8_LDB(B0, 1, 0); PG8_LDB(B1, 1, 1); PG8_SCHED; PG8_LDA(At, 1, 0); PG8_STAGE(PG8_SA(0, 1), a2, w1);
            PG8_WAIT_V(8); PG8_WAIT_L(0); PG8_BAR; PG8_MMA(0, 0, At, B0); PG8_MMA(0, 1, At, B1); PG8_BAR; PG8_SCHED;
            PG8_LDA(At, 1, 1); PG8_STAGE(PG8_SB(1, 0), b3, voffB); PG8_STAGE(PG8_SB(1, 1), b3 + hstep, voffB); PG8_STAGE(PG8_SA(1, 0), a3, w0);
            PG8_WAIT_V(8); PG8_WAIT_L(0); PG8_BAR; PG8_MMA(1, 0, At, B0); PG8_MMA(1, 1, At, B1); PG8_BAR; PG8_SCHED;
        }
        if constexpr (ALIGN_EPI) { if (wr == 0) PG8_BAR; }
        E(acc, cur, wr, wc, fr, fq);
        if (!has_next) break;
#pragma unroll
        for (int a = 0; a < 2; ++a)
#pragma unroll
            for (int b = 0; b < 2; ++b)
#pragma unroll
                for (int m = 0; m < 4; ++m)
#pragma unroll
                    for (int n = 0; n < 2; ++n) acc[a][b][m][n] = (f32x4){0.f, 0.f, 0.f, 0.f};
        cur = nxt; cA = nA; cB = nB; ++ui;
        S.arows(cur, vA);
        asm volatile("" : "+v"(vA[0][0]), "+v"(vA[0][1]), "+v"(vA[1][0]), "+v"(vA[1][1]));
        if constexpr (ALIGN_EPI) { if (wr == 1) PG8_BAR; }
    }
    PG8_WAIT_V(0);
    if constexpr (!ALIGN_EPI) { if (wr == 0) PG8_BAR; }
    PG8_BAR;
#undef PG8_SA
#undef PG8_SB
#undef PG8_STAGE
#undef PG8_LDA
#undef PG8_LDB
#undef PG8_MMA
#undef PG8_WAIT_V
#undef PG8_WAIT_L
#undef PG8_BAR
#undef PG8_SCHED
}
}

constexpr size_t WB_WIN = 0;
constexpr size_t WB_WOUT = WB_WIN + (size_t)ABW * D * 2;
constexpr size_t WB_SWIN = WB_WOUT + (size_t)D * D * 2;
constexpr size_t WB_SWOUT = WB_SWIN + (size_t)2 * SGW * D * 2;
constexpr size_t WB_GU = WB_SWOUT + (size_t)D * SGW * 2;
constexpr size_t WB_DN = WB_GU + (size_t)2 * NE * 1024 * D * 2;
constexpr size_t WB_WS = WB_DN + (size_t)2 * NE * D * EW * 2;
constexpr size_t WB_END = WB_WS + (size_t)8 * 128 * 128 * 2;
static_assert(WB_END <= 124 * MiB, "bf16 weights fit");

__device__ __forceinline__ int slot_of(int mode, int c) {
    if (mode == 0) { const int bj = (c >> 7) & 1, wc = (c >> 5) & 3, fq = (c >> 3) & 3, nn = (c >> 2) & 1, rg = c & 3; return 128 * bj + 32 * wc + 16 * nn + 4 * fq + rg; }
    if (mode == 1) { const int wc = (c >> 6) & 3, bj = (c >> 5) & 1, nn = (c >> 4) & 1, fq = (c >> 2) & 3, rg = c & 3; return 128 * bj + 32 * wc + 16 * nn + 4 * fq + rg; }
    const int wc = (c >> 6) & 3, bj = (c >> 5) & 1, fq = (c >> 3) & 3, nn = (c >> 2) & 1, rg = c & 3; return 128 * bj + 32 * wc + 16 * nn + 4 * fq + rg;
}
template <class RowFn> __device__ __forceinline__ void conv_item(const float* W, int ldw, int k0, int n0, bf16* WT, int Kp, LAS float* scr, int lane, const RowFn& rowfn) {
    f32x4 v[8];
#pragma unroll
    for (int i = 0; i < 8; ++i) { const int kk = 8 * i + (lane >> 3); v[i] = *(const f32x4*)(W + (size_t)(k0 + kk) * ldw + n0 + 4 * (lane & 7)); }
#pragma unroll
    for (int i = 0; i < 8; ++i) { const int kk = 8 * i + (lane >> 3); LAS float* p = scr + kk * 33 + 4 * (lane & 7); p[0] = v[i].x; p[1] = v[i].y; p[2] = v[i].z; p[3] = v[i].w; }
    asm volatile("s_waitcnt lgkmcnt(0)" ::: "memory");
    const int c = lane & 7;
#pragma unroll
    for (int j = 0; j < 4; ++j) { const int n = (lane >> 3) + 8 * j; const LAS float* sp = scr + (8 * c) * 33 + n;
        u32x4 o; o.x = pk2(sp[0 * 33], sp[1 * 33]); o.y = pk2(sp[2 * 33], sp[3 * 33]); o.z = pk2(sp[4 * 33], sp[5 * 33]); o.w = pk2(sp[6 * 33], sp[7 * 33]);
        *(u32x4*)(WT + (size_t)rowfn(n0 + n) * Kp + k0 + 8 * c) = o; }
    asm volatile("s_waitcnt lgkmcnt(0)" ::: "memory");
}
__device__ __forceinline__ void ph_convert(Frame& F) {
    LAS float* scr = (LAS float*)(F.lds + F.wave * 16384);
    bf16* WB = (bf16*)(F.a.ws + WS_WB);
    constexpr int I_1 = 16 * 112, I_2 = 16 * 32, I_3 = 16 * 192, I_4 = 48 * 32, I_5 = 32 * 512, I_6 = 32 * 256, I_7 = 8 * 128 * 128 / 512;
    constexpr int NIT = I_1 + I_2 + I_3 + I_4 + I_5 + I_6 + I_7;
    for (int it = F.gw; it < NIT; it += F.ngw) {
        int r = it;
        if (r < I_1) { const int kb = r / 112, nb = r % 112, n0 = nb * 32; const int tile = n0 >> 8, ty = tile >> 1; const int mode = (ty == 0 || ty == 4) ? 1 : 2;
            conv_item(F.a.in[I_WIN], ABW, kb * 64, n0, (bf16*)((char*)WB + WB_WIN), D, scr, F.lane, [=](int n) { return (n & ~255) + slot_of(mode, n & 255); }); continue; } r -= I_1;
        if (r < I_2) { const int kb = r / 32, nb = r % 32;
            conv_item(F.a.in[I_WOUT], D, kb * 64, nb * 32, (bf16*)((char*)WB + WB_WOUT), D, scr, F.lane, [=](int n) { return (n & ~255) + slot_of(0, n & 255); }); continue; } r -= I_2;
        if (r < I_3) { const int kb = r / 192, nb = r % 192;
            conv_item(F.a.in[I_SWIN], 2 * SGW, kb * 64, nb * 32, (bf16*)((char*)WB + WB_SWIN), D, scr, F.lane, [=](int n) { return (n & ~255) + slot_of(0, n & 255); }); continue; } r -= I_3;
        if (r < I_4) { const int kb = r / 32, nb = r % 32;
            conv_item(F.a.in[I_SWOUT], D, kb * 64, nb * 32, (bf16*)((char*)WB + WB_SWOUT), SGW, scr, F.lane, [=](int n) { return (n & ~255) + slot_of(0, n & 255); }); continue; } r -= I_4;
        if (r < I_5) { const int le = r / 512, q = r % 512, which = q >> 8, kb = (q & 255) / 16, nb = q % 16;
            const float* W = (which ? F.a.in[I_WU] : F.a.in[I_WG]) + (size_t)le * D * EW;
            conv_item(W, EW, kb * 64, nb * 32, (bf16*)((char*)WB + WB_GU) + (size_t)le * 1024 * D, D, scr, F.lane,
                      [=](int j) { const int w = j & 127; return (j >> 7) * 256 + 128 * which + 32 * ((w >> 5) & 3) + 16 * ((w >> 2) & 1) + 4 * ((w >> 3) & 3) + (w & 3); }); continue; } r -= I_5;
        if (r < I_6) { const int le = r / 256, q = r % 256, kb = q / 32, nb = q % 32;
            conv_item(F.a.in[I_WD] + (size_t)le * EW * D, D, kb * 64, nb * 32, (bf16*)((char*)WB + WB_DN) + (size_t)le * D * EW, EW, scr, F.lane, [=](int n) { return (n & ~255) + slot_of(0, n & 255); }); continue; } r -= I_6;
        {
            const float* src = F.a.in[I_SWS] + (size_t)r * 512 + F.lane * 8; const f32x4 a = *(const f32x4*)src, b = *(const f32x4*)(src + 4);
            u32x4 o; o.x = pk2(a.x, a.y); o.y = pk2(a.z, a.w); o.z = pk2(b.x, b.y); o.w = pk2(b.z, b.w);
            *(u32x4*)((bf16*)((char*)WB + WB_WS) + (size_t)r * 512 + F.lane * 8) = o; }
    }
}

struct DenseSched {
    const char* A; const char* Bt; int K, nM, nN, G, c, nwg, xM0, xN, nx, rep;
    __device__ __forceinline__ bool next(int i, pg8::Unit& u) const {
        int L = i * G + c; if (L >= (nwg + nx) * rep) return false; L %= (nwg + nx);
        if (L < nwg) { int wgid = L; { const int q = nwg / 8, r = nwg % 8, xcd = wgid % 8, off = wgid / 8; wgid = (xcd < r ? xcd * (q + 1) : r * (q + 1) + (xcd - r) * q) + off; }
            const int nig = 8 * nN, gid = wgid / nig, fm = gid * 8, gsz = (nM - fm) < 8 ? (nM - fm) : 8;
            u.pm = fm + ((wgid % nig) % gsz); u.pn = (wgid % nig) / gsz; }
        else { const int j = L - nwg; u.pm = xM0 + j / xN; u.pn = j % xN; }
        u.Ab = A; u.Bb = Bt + (size_t)u.pn * 256 * K * 2; u.x0 = 0; u.x1 = 0; u.x2 = 0; return true;
    }
    __device__ __forceinline__ void arows(const pg8::Unit& u, unsigned (&v)[2][2]) const {
#pragma unroll
        for (int i = 0; i < 2; ++i) { int R, C; pg8::stage_rc((int)threadIdx.x * 16 + i * 8192, R, C);
#pragma unroll
            for (int h = 0; h < 2; ++h) v[h][i] = (unsigned)((u.pm * 256 + h * 128 + R) * K + C) * 2u; }
    }
};
struct MoeSched {
    const char* A; const char* Bt; int K, G, c, total; const LAS int* tab; const int* LIST; int gather, rep;
    __device__ __forceinline__ bool next(int i, pg8::Unit& u) const {
        int L = i * G + c; if (L >= total * rep) return false; L %= total;
        const int rt = L >> 2; u.pn = L & 3; int ee = 0;
#pragma unroll
        for (int e = 0; e < 16; ++e) { if (tab[e * 4] <= rt && tab[e * 4 + 1] > 0) ee = e; }
        u.pm = rt - tab[ee * 4]; u.x0 = ee; u.x1 = tab[ee * 4 + 1]; u.x2 = tab[ee * 4 + 2];
        u.Ab = A; u.Bb = Bt + ((size_t)ee * 1024 + u.pn * 256) * K * 2; return true;
    }
    __device__ __forceinline__ void arows(const pg8::Unit& u, unsigned (&v)[2][2]) const {
#pragma unroll
        for (int i = 0; i < 2; ++i) { int R, C; pg8::stage_rc((int)threadIdx.x * 16 + i * 8192, R, C);
#pragma unroll
            for (int h = 0; h < 2; ++h) { const int pos = u.pm * 256 + h * 128 + R; int row;
                if (gather) { const int ent = LIST[u.x0 * 16384 + (pos < u.x1 ? pos : u.pm * 256)]; row = ent >> 1; } else row = u.x2 + pos;
                v[h][i] = (unsigned)(row * K + C) * 2u; } }
    }
};

typedef unsigned u32x2 __attribute__((ext_vector_type(2)));
struct EpiInproj {
    unsigned char* Areg; const LAS float* ROPE; const float* kg; const float* qg;
    __device__ __forceinline__ void operator()(f32x4 (&acc)[2][2][4][2], const pg8::Unit& u, int wr, int wc, int fr, int fq) const {
        const int ty = u.pn >> 1, head = (u.pn & 1) * 4 + wc;
        const size_t off_t = ty < 4 ? (size_t)ty * 17 * MiB : (size_t)(68 + (ty - 4) * 16) * MiB;
        bf16* dst = (bf16*)(Areg + off_t);
        const int row0 = u.pm * 256 + wr * 64 + fr;
        if (ty == 0 || ty == 4) {
            const float sc = ty == 0 ? 0.125f : 1.f;
#pragma unroll
            for (int ai = 0; ai < 2; ++ai)
#pragma unroll
                for (int m = 0; m < 4; ++m) { const int row = row0 + ai * 128 + m * 16; const int tt = row & 4095; const bool lat = row < NTOK;
#pragma unroll
                    for (int bj = 0; bj < 2; ++bj) { const int pos = bj ? (tt & 63) : (tt >> 6);
                        f32x4 u1 = acc[ai][bj][m][0], u2 = acc[ai][bj][m][1];
                        if (lat) { const f32x4 cs0 = *(const LAS f32x4*)(ROPE + (pos * 16 + 4 * fq) * 2), cs1 = *(const LAS f32x4*)(ROPE + (pos * 16 + 4 * fq) * 2 + 4);
                            const f32x4 co = { cs0.x, cs0.z, cs1.x, cs1.z }, si = { cs0.y, cs0.w, cs1.y, cs1.w };
                            const f32x4 a = u1 * co - u2 * si, b = u1 * si + u2 * co; u1 = a; u2 = b; }
                        u1 = u1 * sc; u2 = u2 * sc;
                        bf16* p = dst + (size_t)row * HW + head * 64 + 32 * bj + 4 * fq;
                        u32x2 w; w.x = pg8::cvt_pk_bf16(u1.x, u1.y); w.y = pg8::cvt_pk_bf16(u1.z, u1.w); *(u32x2*)p = w;
                        w.x = pg8::cvt_pk_bf16(u2.x, u2.y); w.y = pg8::cvt_pk_bf16(u2.z, u2.w); *(u32x2*)(p + 16) = w; } }
        } else {
            const bool nrm = (ty == 2 || ty == 6);
            f32x4 g[2][2];
            if (nrm) { const float* gp = ty == 2 ? kg : qg;
#pragma unroll
                for (int bj = 0; bj < 2; ++bj)
#pragma unroll
                    for (int n = 0; n < 2; ++n) g[bj][n] = *(const f32x4*)(gp + 32 * bj + 8 * fq + 4 * n) * (ty == 6 ? 0.125f : 1.f); }
#pragma unroll
            for (int ai = 0; ai < 2; ++ai)
#pragma unroll
                for (int m = 0; m < 4; ++m) { const int row = row0 + ai * 128 + m * 16;
                    f32x4 v[2][2];
#pragma unroll
                    for (int bj = 0; bj < 2; ++bj)
#pragma unroll
                        for (int n = 0; n < 2; ++n) v[bj][n] = acc[ai][bj][m][n];
                    if (nrm) { float ss = 0.f;
#pragma unroll
                        for (int bj = 0; bj < 2; ++bj)
#pragma unroll
                            for (int n = 0; n < 2; ++n) ss += (v[bj][n].x * v[bj][n].x + v[bj][n].y * v[bj][n].y) + (v[bj][n].z * v[bj][n].z + v[bj][n].w * v[bj][n].w);
                        ss += __shfl_xor(ss, 16); ss += __shfl_xor(ss, 32);
                        const float rs = rsqrtf(ss * (1.f / 64.f) + EPS);
#pragma unroll
                        for (int bj = 0; bj < 2; ++bj)
#pragma unroll
                            for (int n = 0; n < 2; ++n) v[bj][n] = v[bj][n] * rs * g[bj][n]; }
                    if (ty == 5) {
#pragma unroll
                        for (int bj = 0; bj < 2; ++bj)
#pragma unroll
                            for (int n = 0; n < 2; ++n)
#pragma unroll
                                for (int q = 0; q < 4; ++q) v[bj][n][q] = siluf(v[bj][n][q]); }
#pragma unroll
                    for (int bj = 0; bj < 2; ++bj) { u32x4 w; w.x = pg8::cvt_pk_bf16(v[bj][0].x, v[bj][0].y); w.y = pg8::cvt_pk_bf16(v[bj][0].z, v[bj][0].w); w.z = pg8::cvt_pk_bf16(v[bj][1].x, v[bj][1].y); w.w = pg8::cvt_pk_bf16(v[bj][1].z, v[bj][1].w);
                        *(u32x4*)(dst + (size_t)row * HW + head * 64 + 32 * bj + 8 * fq) = w; } }
        }
    }
};
struct EpiRes {
    const float* base; float* out; const float* gate;
    __device__ __forceinline__ void operator()(f32x4 (&acc)[2][2][4][2], const pg8::Unit& u, int wr, int wc, int fr, int fq) const {
        const int b = u.pm >> 4, col0 = u.pn * 256 + wc * 32 + 8 * fq, row0 = u.pm * 256 + wr * 64 + fr;
        f32x4 gv[2][2];
#pragma unroll
        for (int bj = 0; bj < 2; ++bj)
#pragma unroll
            for (int n = 0; n < 2; ++n) gv[bj][n] = *(const f32x4*)(gate + b * 6144 + col0 + bj * 128 + 4 * n);
#pragma unroll
        for (int ai = 0; ai < 2; ++ai)
#pragma unroll
            for (int m = 0; m < 4; ++m) { const size_t off = (size_t)(row0 + ai * 128 + m * 16) * D + col0;
#pragma unroll
                for (int bj = 0; bj < 2; ++bj)
#pragma unroll
                    for (int n = 0; n < 2; ++n) { const f32x4 bs = *(const f32x4*)(base + off + bj * 128 + 4 * n); *(f32x4*)(out + off + bj * 128 + 4 * n) = bs + gv[bj][n] * acc[ai][bj][m][n]; } }
    }
};
__device__ __forceinline__ float gelu_fast(float v) { const float u2 = -2.302208198f * (v + 0.044715f * v * v * v); return v * __builtin_amdgcn_rcpf(1.f + __builtin_amdgcn_exp2f(u2)); }
struct EpiSguIn {
    bf16* U; bf16* V; const float* bias; float* VSS;
    __device__ __forceinline__ void operator()(f32x4 (&acc)[2][2][4][2], const pg8::Unit& u, int wr, int wc, int fr, int fq) const {
        const int col0 = u.pn * 256 + wc * 32 + 8 * fq, row0 = u.pm * 256 + wr * 64 + fr; const bool isv = u.pn >= 12;
        bf16* dstb = isv ? V + (col0 - SGW) : U + col0;
        f32x4 bv[2][2];
#pragma unroll
        for (int bj = 0; bj < 2; ++bj)
#pragma unroll
            for (int n = 0; n < 2; ++n) bv[bj][n] = *(const f32x4*)(bias + col0 + bj * 128 + 4 * n);
#pragma unroll
        for (int ai = 0; ai < 2; ++ai)
#pragma unroll
            for (int m = 0; m < 4; ++m) { const int row = row0 + ai * 128 + m * 16; float ss = 0.f;
#pragma unroll
                for (int bj = 0; bj < 2; ++bj) { f32x4 z0 = acc[ai][bj][m][0] + bv[bj][0], z1 = acc[ai][bj][m][1] + bv[bj][1];
#pragma unroll
                    for (int q = 0; q < 4; ++q) { z0[q] = gelu_fast(z0[q]); z1[q] = gelu_fast(z1[q]); }
                    ss += (z0.x * z0.x + z0.y * z0.y) + (z0.z * z0.z + z0.w * z0.w) + (z1.x * z1.x + z1.y * z1.y) + (z1.z * z1.z + z1.w * z1.w);
                    u32x4 w; w.x = pg8::cvt_pk_bf16(z0.x, z0.y); w.y = pg8::cvt_pk_bf16(z0.z, z0.w); w.z = pg8::cvt_pk_bf16(z1.x, z1.y); w.w = pg8::cvt_pk_bf16(z1.z, z1.w);
                    *(u32x4*)(dstb + (size_t)row * SGW + bj * 128) = w; }
                if (isv) { ss += __shfl_xor(ss, 16); ss += __shfl_xor(ss, 32); if (fq == 0) VSS[(size_t)row * 48 + (u.pn - 12) * 4 + wc] = ss; } }
    }
};
struct EpiMoeGU {
    bf16* ACT;
    __device__ __forceinline__ void operator()(f32x4 (&acc)[2][2][4][2], const pg8::Unit& u, int wr, int wc, int fr, int fq) const {
        const int col0 = u.pn * 128 + wc * 32 + 8 * fq, row0 = u.x2 + u.pm * 256 + wr * 64 + fr;
#pragma unroll
        for (int ai = 0; ai < 2; ++ai)
#pragma unroll
            for (int m = 0; m < 4; ++m) { f32x4 a0 = acc[ai][0][m][0], a1 = acc[ai][0][m][1]; const f32x4 b0 = acc[ai][1][m][0], b1 = acc[ai][1][m][1];
#pragma unroll
                for (int q = 0; q < 4; ++q) { a0[q] = a0[q] * __builtin_amdgcn_rcpf(1.f + __builtin_amdgcn_exp2f(-1.44269504f * a0[q])) * b0[q]; a1[q] = a1[q] * __builtin_amdgcn_rcpf(1.f + __builtin_amdgcn_exp2f(-1.44269504f * a1[q])) * b1[q]; }
                u32x4 w; w.x = pg8::cvt_pk_bf16(a0.x, a0.y); w.y = pg8::cvt_pk_bf16(a0.z, a0.w); w.z = pg8::cvt_pk_bf16(a1.x, a1.y); w.w = pg8::cvt_pk_bf16(a1.z, a1.w);
                *(u32x4*)(ACT + (size_t)(row0 + ai * 128 + m * 16) * EW + col0) = w; }
    }
};
struct EpiMoeDn {
    bf16* Y; const int* LIST; const float* WT;
    __device__ __forceinline__ void operator()(f32x4 (&acc)[2][2][4][2], const pg8::Unit& u, int wr, int wc, int fr, int fq) const {
        const int col0 = u.pn * 256 + wc * 32 + 8 * fq;
#pragma unroll
        for (int ai = 0; ai < 2; ++ai) {
            int ent[4]; float w8[4];
#pragma unroll
            for (int m = 0; m < 4; ++m) { const int pos = u.pm * 256 + ai * 128 + wr * 64 + m * 16 + fr; ent[m] = pos < u.x1 ? LIST[u.x0 * 16384 + pos] : -1; }
#pragma unroll
            for (int m = 0; m < 4; ++m) w8[m] = ent[m] >= 0 ? WT[ent[m]] : 0.f;
#pragma unroll
            for (int m = 0; m < 4; ++m) {
                if (ent[m] >= 0) {
#pragma unroll
                    for (int bj = 0; bj < 2; ++bj) { const f32x4 a0 = acc[ai][bj][m][0] * w8[m], a1 = acc[ai][bj][m][1] * w8[m];
                        u32x4 w; w.x = pg8::cvt_pk_bf16(a0.x, a0.y); w.y = pg8::cvt_pk_bf16(a0.z, a0.w); w.z = pg8::cvt_pk_bf16(a1.x, a1.y); w.w = pg8::cvt_pk_bf16(a1.z, a1.w);
                        *(u32x4*)(Y + (size_t)ent[m] * D + col0 + bj * 128) = w; } } }
            asm volatile("" ::: "memory");
        }
    }
};
__device__ __forceinline__ int moe_tab(Frame& F, int l, LAS int* tab) {
    __syncthreads();
    if (F.tid == 0) { int tiles = 0, base = 0;
        for (int e = 0; e < 16; ++e) { const int c = (int)__hip_atomic_load(fctl(F) + CW_CNT + l * 1024 + e * 64, RLX_AGENT); tab[e * 4] = tiles; tab[e * 4 + 1] = c; tab[e * 4 + 2] = base; tab[e * 4 + 3] = 0; tiles += (c + 255) >> 8; base += (c + 255) & ~255; }
        tab[64] = tiles; }
    __syncthreads();
    return tab[64];
}


typedef short bf16x8 __attribute__((ext_vector_type(8)));
typedef short s16x4 __attribute__((ext_vector_type(4)));
typedef short v4i16_t __attribute__((ext_vector_type(4)));
__device__ __forceinline__ s16x4 tr_read(const LAS unsigned char* p) { return __builtin_bit_cast(s16x4, __builtin_amdgcn_ds_read_tr16_b64_v4i16((LAS v4i16_t*)p)); }
__device__ __forceinline__ bf16x8 cat8(s16x4 a, s16x4 b) { return (bf16x8){a[0], a[1], a[2], a[3], b[0], b[1], b[2], b[3]}; }
__device__ __forceinline__ bf16x8 pk8(f32x4 a, f32x4 b) { u32x4 w; w.x = pg8::cvt_pk_bf16(a.x, a.y); w.y = pg8::cvt_pk_bf16(a.z, a.w); w.z = pg8::cvt_pk_bf16(b.x, b.y); w.w = pg8::cvt_pk_bf16(b.z, b.w); return __builtin_bit_cast(bf16x8, w); }
#define MFMA16(a, b, c) __builtin_amdgcn_mfma_f32_16x16x32_bf16((a), (b), (c), 0, 0, 0)
constexpr int VST = 144;
constexpr size_t A_KV = 148 * MiB;

__device__ __forceinline__ void ph_na(Frame& F) {
    const bf16* NK = (const bf16*)(fA(F) + A_NK); const bf16* NV = (const bf16*)(fA(F) + A_NV); const bf16* NQ = (const bf16*)(fA(F) + A_NQ); bf16* MIX = (bf16*)(fA(F) + A_MIX);
    LAS unsigned char* Vl = F.lds;
    LAS float* mrg = (LAS float*)(F.lds + 768 * VST);
    LAS float* rpbl = (LAS float*)(F.lds + 768 * VST + 4 * 1056 * 4);
    const int lane = F.lane, wave = F.wave, sb = wave & 3, half = wave >> 2, q16 = lane & 15, rq = lane >> 4;
    const int tq = (lane & 15) >> 2, tp = lane & 3;
    const float L2E = 1.44269504f;
    for (int tg = blockIdx.x; tg < 256; tg += gridDim.x) {
        const int bh = tg >> 3, b = bh >> 3, h = bh & 7, rbase = (tg & 7) * 8;
        __syncthreads();
#pragma unroll
        for (int pass = 0; pass < 4; ++pass) { const int n = pass * 64 + (F.tid >> 3), ch = F.tid & 7;
            *(LAS u32x4*)(Vl + (512 + n) * VST + ch * 16) = *(const u32x4*)(NV + ((size_t)(NTOK + b * CTXL + n)) * HW + h * 64 + ch * 8); }
        for (int i = F.tid; i < 465; i += NTHREADS) rpbl[i] = F.a.in[I_RPB][h * 465 + i];
        int lo = 0, hi = -1;
        for (int ti = 0; ti < 8; ++ti) {
            const int r = rbase + ti; int r0 = r - 4; r0 = r0 < 0 ? 0 : (r0 > 56 ? 56 : r0);
            __syncthreads();
            for (int kr = r0; kr <= r0 + 7; ++kr) if (kr < lo || kr > hi) { const int col = F.tid >> 3, ch = F.tid & 7;
                *(LAS u32x4*)(Vl + ((kr & 7) * 64 + col) * VST + ch * 16) = *(const u32x4*)(NV + ((size_t)(b * SEQ + kr * 64 + col)) * HW + h * 64 + ch * 8); }
            lo = r0; hi = r0 + 7;
            __syncthreads();
            const int c = 16 * sb + q16; const size_t qrow = (size_t)b * SEQ + r * 64 + c;
            const int w0 = sb == 0 ? 0 : (sb == 1 ? 8 : (sb == 2 ? 24 : 32));
            int c0 = c - 8; c0 = c0 < 0 ? 0 : (c0 > 48 ? 48 : c0);
            bf16x8 qf[2];
#pragma unroll
            for (int ks = 0; ks < 2; ++ks) qf[ks] = *(const bf16x8*)(NQ + qrow * HW + h * 64 + 8 * rq + 32 * ks);
            f32x4 sc[16];
#pragma unroll
            for (int lb = 0; lb < 8; ++lb) { const int kr = r0 + 4 * half + (lb >> 1), cb = w0 + 16 * (lb & 1);
                const bf16* kp = NK + ((size_t)(b * SEQ + kr * 64 + cb + q16)) * HW + h * 64 + 8 * rq;
                const bf16x8 k0 = *(const bf16x8*)kp, k1 = *(const bf16x8*)(kp + 32);
                f32x4 a = MFMA16(k0, qf[0], ((f32x4){0.f, 0.f, 0.f, 0.f})); a = MFMA16(k1, qf[1], a);
#pragma unroll
                for (int g = 0; g < 4; ++g) { const int kc = cb + 4 * rq + g; const bool valid = (kc >= c0) && (kc <= c0 + 15);
                    const int bi = valid ? ((kr - r + 7) * 31 + (kc - c + 15)) : 0;
                    a[g] = valid ? a[g] + rpbl[bi] : -1e30f; }
                sc[lb] = a; }
#pragma unroll
            for (int cb = 0; cb < 8; ++cb) { const int n = 128 * half + 16 * cb + q16;
                const bf16* kp = NK + ((size_t)(NTOK + b * CTXL + n)) * HW + h * 64 + 8 * rq;
                const bf16x8 k0 = *(const bf16x8*)kp, k1 = *(const bf16x8*)(kp + 32);
                f32x4 a = MFMA16(k0, qf[0], ((f32x4){0.f, 0.f, 0.f, 0.f})); a = MFMA16(k1, qf[1], a); sc[8 + cb] = a; }
            float m = -1e30f;
#pragma unroll
            for (int i = 0; i < 16; ++i) m = fmaxf(fmaxf(m, fmaxf(sc[i].x, sc[i].y)), fmaxf(sc[i].z, sc[i].w));
            m = fmaxf(m, __shfl_xor(m, 16)); m = fmaxf(m, __shfl_xor(m, 32));
            float l = 0.f;
#pragma unroll
            for (int i = 0; i < 16; ++i) {
#pragma unroll
                for (int g = 0; g < 4; ++g) { const float p = __builtin_amdgcn_exp2f((sc[i][g] - m) * L2E); sc[i][g] = p; l += p; } }
            l += __shfl_xor(l, 16); l += __shfl_xor(l, 32);
            f32x4 o[4];
#pragma unroll
            for (int eb = 0; eb < 4; ++eb) o[eb] = (f32x4){0.f, 0.f, 0.f, 0.f};
#pragma unroll
            for (int ks = 0; ks < 8; ++ks) {
                const bf16x8 pf = pk8(sc[2 * ks], sc[2 * ks + 1]);
                int rowA, rowB;
                if (ks < 4) { const int kr = r0 + 4 * half + ks; rowA = (kr & 7) * 64 + w0; rowB = rowA + 16; }
                else { rowA = 512 + 128 * half + 32 * (ks - 4); rowB = rowA + 16; }
                const LAS unsigned char* pa = Vl + (rowA + 4 * rq + tq) * VST + 8 * tp; const LAS unsigned char* pb = Vl + (rowB + 4 * rq + tq) * VST + 8 * tp;
#pragma unroll
                for (int eb = 0; eb < 4; ++eb) { const bf16x8 vf = cat8(tr_read(pa + 32 * eb), tr_read(pb + 32 * eb)); o[eb] = MFMA16(vf, pf, o[eb]); }
            }
            LAS float* mw = mrg + sb * 1056;
            if (half == 1) {
                if (rq == 0) { mw[q16] = m; mw[16 + q16] = l; }
#pragma unroll
                for (int eb = 0; eb < 4; ++eb)
#pragma unroll
                    for (int g = 0; g < 4; ++g) mw[32 + (16 * eb + 4 * rq + g) * 16 + q16] = o[eb][g];
            }
            __syncthreads();
            if (half == 0) {
                const float m2 = mw[q16], l2 = mw[16 + q16];
                const float mn = fmaxf(m, m2), a1 = __builtin_amdgcn_exp2f((m - mn) * L2E), a2 = __builtin_amdgcn_exp2f((m2 - mn) * L2E);
                const float inv = 1.f / (l * a1 + l2 * a2);
#pragma unroll
                for (int eb = 0; eb < 4; ++eb) { f32x4 v;
#pragma unroll
                    for (int g = 0; g < 4; ++g) v[g] = (o[eb][g] * a1 + mw[32 + (16 * eb + 4 * rq + g) * 16 + q16] * a2) * inv;
                    u32x2 w; w.x = pg8::cvt_pk_bf16(v.x, v.y); w.y = pg8::cvt_pk_bf16(v.z, v.w);
                    *(u32x2*)(MIX + qrow * D + 512 + h * 64 + 16 * eb + 4 * rq) = w; }
            }
        }
    }
    __syncthreads();
}

__device__ __forceinline__ void ph_kvstate(Frame& F) {
    const bf16* RK = (const bf16*)(fA(F) + A_RK); const bf16* RV = (const bf16*)(fA(F) + A_RV); float* KV = (float*)(fA(F) + A_KV);
    LAS unsigned char* Kt = F.lds; LAS unsigned char* Vf = F.lds + 128 * VST; LAS unsigned char* Vb = F.lds + 256 * VST;
    const int lane = F.lane, wave = F.wave, rq = lane >> 4, tq = (lane & 15) >> 2, tp = lane & 3, db = wave & 3, ep = wave >> 2;
    for (int it = blockIdx.x; it < NB * NH * 34; it += gridDim.x) {
        const int cc = it % 34, bh = it / 34, b = bh >> 3, h = bh & 7;
        const float lgf = ret_gamma_log(F, 0, h) * 1.44269504f, lgb = ret_gamma_log(F, 1, h) * 1.44269504f;
        const size_t row0 = cc < 32 ? (size_t)b * SEQ + cc * 128 : (size_t)NTOK + b * CTXL + (cc - 32) * 128;
        __syncthreads();
#pragma unroll
        for (int pass = 0; pass < 2; ++pass) { const int j = pass * 64 + (F.tid >> 3), ch = F.tid & 7;
            *(LAS u32x4*)(Kt + j * VST + ch * 16) = *(const u32x4*)(RK + (row0 + j) * HW + h * 64 + ch * 8);
            const u32x4 v = *(const u32x4*)(RV + (row0 + j) * HW + h * 64 + ch * 8);
            const float wf = __builtin_amdgcn_exp2f(lgf * (float)(127 - j)), wb = __builtin_amdgcn_exp2f(lgb * (float)j);
            const unsigned vv[4] = { v.x, v.y, v.z, v.w }; u32x4 of, ob; unsigned rf[4], rb[4];
#pragma unroll
            for (int q = 0; q < 4; ++q) { const float lo = bf2f(vv[q] & 0xffffu), hi = bf2f(vv[q] >> 16); rf[q] = pg8::cvt_pk_bf16(lo * wf, hi * wf); rb[q] = pg8::cvt_pk_bf16(lo * wb, hi * wb); }
            of.x = rf[0]; of.y = rf[1]; of.z = rf[2]; of.w = rf[3]; ob.x = rb[0]; ob.y = rb[1]; ob.z = rb[2]; ob.w = rb[3];
            *(LAS u32x4*)(Vf + j * VST + ch * 16) = of; *(LAS u32x4*)(Vb + j * VST + ch * 16) = ob; }
        __syncthreads();
        f32x4 acc[2][2];
#pragma unroll
        for (int d = 0; d < 2; ++d)
#pragma unroll
            for (int e = 0; e < 2; ++e) acc[d][e] = (f32x4){0.f, 0.f, 0.f, 0.f};
#pragma unroll
        for (int ks = 0; ks < 4; ++ks) {
            const int rbase = 32 * ks + 8 * rq + tq;
            const bf16x8 kf = cat8(tr_read(Kt + rbase * VST + (16 * db + 4 * tp) * 2), tr_read(Kt + (rbase + 4) * VST + (16 * db + 4 * tp) * 2));
#pragma unroll
            for (int e2 = 0; e2 < 2; ++e2) { const int eoff = (16 * (2 * ep + e2) + 4 * tp) * 2;
                const bf16x8 vf = cat8(tr_read(Vf + rbase * VST + eoff), tr_read(Vf + (rbase + 4) * VST + eoff));
                const bf16x8 vb = cat8(tr_read(Vb + rbase * VST + eoff), tr_read(Vb + (rbase + 4) * VST + eoff));
                acc[0][e2] = MFMA16(kf, vf, acc[0][e2]); acc[1][e2] = MFMA16(kf, vb, acc[1][e2]); }
        }
        float* kvp = KV + (size_t)it * 2 * 4096;
#pragma unroll
        for (int d = 0; d < 2; ++d)
#pragma unroll
            for (int e2 = 0; e2 < 2; ++e2) *(f32x4*)(kvp + d * 4096 + (16 * (2 * ep + e2) + (lane & 15)) * 64 + 16 * db + 4 * rq) = acc[d][e2];
    }
    __syncthreads();
}

__device__ __forceinline__ void ph_retout(Frame& F) {
    const bf16* RK = (const bf16*)(fA(F) + A_RK); const bf16* RV = (const bf16*)(fA(F) + A_RV); const bf16* RQ = (const bf16*)(fA(F) + A_RQ); const bf16* GT = (const bf16*)(fA(F) + A_GT);
    const float* KV = (const float*)(fA(F) + A_KV); bf16* MIX = (bf16*)(fA(F) + A_MIX);
    LAS unsigned char* Vl = F.lds;
    LAS unsigned char* SF = F.lds + 128 * VST;
    LAS unsigned char* SB = SF + 64 * VST;
    const int lane = F.lane, wave = F.wave, q16 = lane & 15, rq = lane >> 4, tq = (lane & 15) >> 2, tp = lane & 3;
    for (int g = blockIdx.x; g < 256; g += gridDim.x) {
        const int bh = g >> 3, b = bh >> 3, h = bh & 7, c0 = (g & 7) * 4;
        const float lnf = ret_gamma_log(F, 0, h), lnb = ret_gamma_log(F, 1, h);
        const float lgf = lnf * 1.44269504f, lgb = lnb * 1.44269504f;
        const float gf128 = __builtin_amdgcn_exp2f(lgf * 128.f), gb128 = __builtin_amdgcn_exp2f(lgb * 128.f);
        const float* kvb = KV + (size_t)bh * 34 * 2 * 4096 + F.tid * 8;
#define KVP(cc, dir) (kvb + ((size_t)(cc) * 2 + (dir)) * 4096)
        f32x4 sf0, sf1, sb0, sb1;
        { const f32x4 a0 = *(const f32x4*)KVP(32, 0), a1 = *(const f32x4*)(KVP(32, 0) + 4), b0 = *(const f32x4*)KVP(33, 0), b1 = *(const f32x4*)(KVP(33, 0) + 4);
          sf0 = a0 * gf128 + b0; sf1 = a1 * gf128 + b1; }
        for (int cp = 0; cp < c0; ++cp) { const f32x4 a0 = *(const f32x4*)KVP(cp, 0), a1 = *(const f32x4*)(KVP(cp, 0) + 4); sf0 = sf0 * gf128 + a0; sf1 = sf1 * gf128 + a1; }
        { const f32x4 a0 = *(const f32x4*)KVP(33, 1), a1 = *(const f32x4*)(KVP(33, 1) + 4), b0 = *(const f32x4*)KVP(32, 1), b1 = *(const f32x4*)(KVP(32, 1) + 4);
          sb0 = a0 * gb128 + b0; sb1 = a1 * gb128 + b1; }
        for (int cp = 31; cp >= c0 + 4; --cp) { const f32x4 a0 = *(const f32x4*)KVP(cp, 1), a1 = *(const f32x4*)(KVP(cp, 1) + 4); sb0 = sb0 * gb128 + a0; sb1 = sb1 * gb128 + a1; }
        __syncthreads();
        const int se = F.tid >> 3, sd = (F.tid & 7) * 8;
#pragma unroll
        for (int k = 3; k >= 0; --k) {
            *(LAS u32x4*)(SB + k * 64 * VST + se * VST + sd * 2) = __builtin_bit_cast(u32x4, pk8(sb0, sb1));
            if (k > 0) { const f32x4 a0 = *(const f32x4*)KVP(c0 + k, 1), a1 = *(const f32x4*)(KVP(c0 + k, 1) + 4); sb0 = sb0 * gb128 + a0; sb1 = sb1 * gb128 + a1; }
        }
        for (int k = 0; k < 4; ++k) {
            const int c = c0 + k; const size_t row0 = (size_t)b * SEQ + c * 128;
            __syncthreads();
            *(LAS u32x4*)(SF + se * VST + sd * 2) = __builtin_bit_cast(u32x4, pk8(sf0, sf1));
            { const f32x4 a0 = *(const f32x4*)KVP(c, 0), a1 = *(const f32x4*)(KVP(c, 0) + 4); sf0 = sf0 * gf128 + a0; sf1 = sf1 * gf128 + a1; }
#pragma unroll
            for (int pass = 0; pass < 2; ++pass) { const int j = pass * 64 + (F.tid >> 3), ch = F.tid & 7;
                *(LAS u32x4*)(Vl + j * VST + ch * 16) = *(const u32x4*)(RV + (row0 + j) * HW + h * 64 + ch * 8); }
            __syncthreads();
            const int i = 16 * wave + q16; const size_t qrow = row0 + i;
            bf16x8 qf[2];
#pragma unroll
            for (int ks = 0; ks < 2; ++ks) qf[ks] = *(const bf16x8*)(RQ + qrow * HW + h * 64 + 8 * rq + 32 * ks);
            f32x4 sc[8];
#pragma unroll
            for (int jb = 0; jb < 8; ++jb) { const bf16* kp = RK + (row0 + 16 * jb + q16) * HW + h * 64 + 8 * rq;
                const bf16x8 k0 = *(const bf16x8*)kp, k1 = *(const bf16x8*)(kp + 32);
                f32x4 a = MFMA16(k0, qf[0], ((f32x4){0.f, 0.f, 0.f, 0.f})); a = MFMA16(k1, qf[1], a);
#pragma unroll
                for (int gq = 0; gq < 4; ++gq) { const int j = 16 * jb + 4 * rq + gq;
                    const float wgt = j < i ? __builtin_amdgcn_exp2f(lgf * (float)(i - j)) : (j > i ? __builtin_amdgcn_exp2f(lgb * (float)(j - i)) : 2.f);
                    a[gq] *= wgt; }
                sc[jb] = a; }
            f32x4 o[4], tf[4], tb[4];
#pragma unroll
            for (int eb = 0; eb < 4; ++eb) { o[eb] = (f32x4){0.f, 0.f, 0.f, 0.f}; tf[eb] = o[eb]; tb[eb] = o[eb]; }
#pragma unroll
            for (int ks = 0; ks < 4; ++ks) {
                const bf16x8 pf = pk8(sc[2 * ks], sc[2 * ks + 1]);
                const LAS unsigned char* pa = Vl + (32 * ks + 4 * rq + tq) * VST + 8 * tp; const LAS unsigned char* pb = pa + 16 * VST;
#pragma unroll
                for (int eb = 0; eb < 4; ++eb) { const bf16x8 vf = cat8(tr_read(pa + 32 * eb), tr_read(pb + 32 * eb)); o[eb] = MFMA16(vf, pf, o[eb]); }
            }
#pragma unroll
            for (int eb = 0; eb < 4; ++eb)
#pragma unroll
                for (int ks = 0; ks < 2; ++ks) {
                    const bf16x8 s1 = *(const LAS bf16x8*)(SF + (16 * eb + q16) * VST + (8 * rq + 32 * ks) * 2);
                    const bf16x8 s2 = *(const LAS bf16x8*)(SB + k * 64 * VST + (16 * eb + q16) * VST + (8 * rq + 32 * ks) * 2);
                    tf[eb] = MFMA16(s1, qf[ks], tf[eb]); tb[eb] = MFMA16(s2, qf[ks], tb[eb]); }
            const float qfd = __builtin_amdgcn_exp2f(lgf * (float)(i + 1)), qbd = __builtin_amdgcn_exp2f(lgb * (float)(128 - i));
            float ss = 0.f;
#pragma unroll
            for (int eb = 0; eb < 4; ++eb) { o[eb] = o[eb] + tf[eb] * qfd + tb[eb] * qbd; ss += (o[eb].x * o[eb].x + o[eb].y * o[eb].y) + (o[eb].z * o[eb].z + o[eb].w * o[eb].w); }
            ss += __shfl_xor(ss, 16); ss += __shfl_xor(ss, 32);
            const float rs = rsqrtf(ss * (1.f / 64.f) + EPS);
#pragma unroll
            for (int eb = 0; eb < 4; ++eb) { const int e0 = 16 * eb + 4 * rq;
                const f32x4 gg = *(const f32x4*)(F.a.in[I_RNG] + e0); const u32x2 gt = *(const u32x2*)(GT + qrow * HW + h * 64 + e0);
                const f32x4 gv = { bf2f(gt.x & 0xffffu), bf2f(gt.x >> 16), bf2f(gt.y & 0xffffu), bf2f(gt.y >> 16) };
                const f32x4 v = o[eb] * rs * gg * gv;
                u32x2 w; w.x = pg8::cvt_pk_bf16(v.x, v.y); w.y = pg8::cvt_pk_bf16(v.z, v.w);
                *(u32x2*)(MIX + qrow * D + h * 64 + e0) = w; }
        }
#undef KVP
    }
    __syncthreads();
}

__device__ __forceinline__ void ph_sgumix(Frame& F, bool dry = false) {
    bf16* U = (bf16*)(fA(F) + A_U); const bf16* V = (const bf16*)(fA(F) + A_V); const bf16* WS = (const bf16*)(F.a.ws + WS_WB + WB_WS);
    constexpr int VS2 = 272;
    LAS unsigned char* Vt = F.lds;
    LAS float* rsl = (LAS float*)(F.lds + 128 * VS2);
    const int lane = F.lane, wave = F.wave, q16 = lane & 15, rq = lane >> 4, tq = (lane & 15) >> 2, tp = lane & 3;
    const int ch4 = wave & 1, iq = wave >> 1;
    constexpr int NIT = NB * 32 * 8 * 3;
    const int ipb = (NIT + (int)gridDim.x - 1) / (int)gridDim.x, it0 = (int)blockIdx.x * ipb, it1 = (it0 + ipb) < NIT ? (it0 + ipb) : NIT;
    const int sj = F.tid >> 4, schn = F.tid & 15;
    u32x4 vn[4];
    if (it0 < it1) { const int third = it0 % 3, g = (it0 / 3) & 7, bc = it0 / 24; const size_t row0 = (size_t)bc * 128; const int cg0 = g * 384 + third * 128;
#pragma unroll
        for (int pass = 0; pass < 4; ++pass) vn[pass] = *(const u32x4*)(V + (row0 + pass * 32 + sj) * SGW + cg0 + schn * 8); }
    int prev_bc = -1;
    for (int it = it0; it < it1; ++it) {
        const int third = it % 3, g = (it / 3) & 7, bc = it / 24; const size_t row0 = (size_t)bc * 128; const int cg0 = g * 384 + third * 128;
        __syncthreads();
        if (bc != prev_bc) { prev_bc = bc;
            if (F.tid < 128) { const float* vp = fvss(F) + (row0 + F.tid) * 48; float sacc = 0.f;
#pragma unroll
                for (int j = 0; j < 48; j += 4) { const f32x4 t = *(const f32x4*)(vp + j); sacc += (t.x + t.y) + (t.z + t.w); }
                rsl[F.tid] = rsqrtf(sacc * (1.f / SGW) + EPS); }
            __syncthreads(); }
#pragma unroll
        for (int pass = 0; pass < 4; ++pass) { const int j = pass * 32 + sj; const float rs = rsl[j];
            const unsigned vv[4] = { vn[pass].x, vn[pass].y, vn[pass].z, vn[pass].w }; unsigned ro[4];
#pragma unroll
            for (int q = 0; q < 4; ++q) ro[q] = pg8::cvt_pk_bf16(bf2f(vv[q] & 0xffffu) * rs, bf2f(vv[q] >> 16) * rs);
            u32x4 o; o.x = ro[0]; o.y = ro[1]; o.z = ro[2]; o.w = ro[3];
            *(LAS u32x4*)(Vt + j * VS2 + schn * 16) = o; }
        __syncthreads();
        if (it + 1 < it1) { const int n = it + 1, t2 = n % 3, g2 = (n / 3) & 7, bc2 = n / 24; const size_t r2 = (size_t)bc2 * 128; const int c2 = g2 * 384 + t2 * 128;
#pragma unroll
            for (int pass = 0; pass < 4; ++pass) vn[pass] = *(const u32x4*)(V + (r2 + pass * 32 + sj) * SGW + c2 + schn * 8); }
        u32x4 uu[2][2];
#pragma unroll
        for (int ib = 0; ib < 2; ++ib)
#pragma unroll
            for (int cb2 = 0; cb2 < 2; ++cb2) uu[ib][cb2] = *(const u32x4*)(U + (row0 + 32 * iq + 16 * ib + q16) * SGW + cg0 + 64 * ch4 + 32 * cb2 + 8 * rq);
        f32x4 acc[4][2];
#pragma unroll
        for (int cb = 0; cb < 4; ++cb)
#pragma unroll
            for (int ib = 0; ib < 2; ++ib) acc[cb][ib] = (f32x4){0.f, 0.f, 0.f, 0.f};
#pragma unroll
        for (int ks = 0; ks < 4; ++ks) {
            bf16x8 wf[2];
#pragma unroll
            for (int ib = 0; ib < 2; ++ib) wf[ib] = *(const bf16x8*)(WS + ((size_t)g * 128 + 32 * iq + 16 * ib + q16) * 128 + 32 * ks + 8 * rq);
            const int rb = 32 * ks + 8 * rq + tq;
#pragma unroll
            for (int cb = 0; cb < 4; ++cb) { const int coff = (64 * ch4 + 32 * (cb >> 1) + 8 * tp + 4 * (cb & 1)) * 2;
                const bf16x8 vf = cat8(tr_read(Vt + rb * VS2 + coff), tr_read(Vt + (rb + 4) * VS2 + coff));
#pragma unroll
                for (int ib = 0; ib < 2; ++ib) acc[cb][ib] = MFMA16(vf, wf[ib], acc[cb][ib]); }
        }
#pragma unroll
        for (int ib = 0; ib < 2; ++ib) { const int i = 32 * iq + 16 * ib + q16; const float bs = F.a.in[I_SBS][g * 128 + i];
#pragma unroll
            for (int cb2 = 0; cb2 < 2; ++cb2) { const int cgl = cg0 + 64 * ch4 + 32 * cb2 + 8 * rq;
                const f32x4 ng0 = *(const f32x4*)(F.a.in[I_SNG] + cgl), ng1 = *(const f32x4*)(F.a.in[I_SNG] + cgl + 4); bf16* up = U + (row0 + i) * SGW + cgl; const u32x4 u4 = uu[ib][cb2];
                const f32x4 uv0 = { bf2f(u4.x & 0xffffu), bf2f(u4.x >> 16), bf2f(u4.y & 0xffffu), bf2f(u4.y >> 16) }, uv1 = { bf2f(u4.z & 0xffffu), bf2f(u4.z >> 16), bf2f(u4.w & 0xffffu), bf2f(u4.w >> 16) };
                const f32x4 r0 = dry ? uv0 + acc[2 * cb2][ib] * 0.f : uv0 * (acc[2 * cb2][ib] * ng0 + bs), r1 = dry ? uv1 + acc[2 * cb2 + 1][ib] * 0.f : uv1 * (acc[2 * cb2 + 1][ib] * ng1 + bs);
                u32x4 w; w.x = pg8::cvt_pk_bf16(r0.x, r0.y); w.y = pg8::cvt_pk_bf16(r0.z, r0.w); w.z = pg8::cvt_pk_bf16(r1.x, r1.y); w.w = pg8::cvt_pk_bf16(r1.z, r1.w); *(u32x4*)up = w; } }
    }
    __syncthreads();
}

__device__ __forceinline__ void ph_mod2(Frame& F) {
    LAS float* sv = (LAS float*)F.lds; LAS float* red = sv + 5 * 1024;
    for (int i = F.tid; i < 5 * 1024; i += NTHREADS) { const int r = i >> 10, k = i & 1023; const float c = r < 4 ? F.a.in[I_C][r * 1024 + k] : F.a.in[I_CCTX][k]; sv[i] = siluf(c); }
    __syncthreads();
    for (int item = blockIdx.x; item < 192; item += gridDim.x) {
        const int l = item / 96, n0 = (item % 96) * 64, k0 = F.wave * 128;
        const float* W = F.a.in[I_ADAW] + (size_t)l * D * 6144 + n0 + F.lane + (size_t)k0 * 6144;
        float a0 = 0.f, a1 = 0.f, a2 = 0.f, a3 = 0.f, a4 = 0.f;
#pragma unroll 16
        for (int k = 0; k < 128; ++k) { const float w = W[(size_t)k * 6144];
            a0 += sv[k0 + k] * w; a1 += sv[1024 + k0 + k] * w; a2 += sv[2048 + k0 + k] * w; a3 += sv[3072 + k0 + k] * w; a4 += sv[4096 + k0 + k] * w; }
        red[(F.wave * 5 + 0) * 64 + F.lane] = a0; red[(F.wave * 5 + 1) * 64 + F.lane] = a1; red[(F.wave * 5 + 2) * 64 + F.lane] = a2; red[(F.wave * 5 + 3) * 64 + F.lane] = a3; red[(F.wave * 5 + 4) * 64 + F.lane] = a4;
        __syncthreads();
        if (F.wave < 5) { const int r = F.wave; float sacc = 0.f;
#pragma unroll
            for (int w = 0; w < 8; ++w) sacc += red[(w * 5 + r) * 64 + F.lane];
            sacc += F.a.in[I_ADAB][l * 6144 + n0 + F.lane];
            if (r < 4) fmod(F)[(l * 4 + r) * 6144 + n0 + F.lane] = sacc; else if (l == 0 && n0 < 2048) fmodc(F)[n0 + F.lane] = sacc; }
        __syncthreads();
    }
    const int gt = F.gw * 64 + F.lane, ngt = F.ngw * 64;
    for (int it = gt; it < 64 * 16; it += ngt) {
        const int pos = it >> 4, j = it & 15;
        const float inv = powf(10000.0f, -(float)j / 16.0f);
        const float ang = (float)pos * inv;
        frope(F)[it * 2] = cosf(ang); frope(F)[it * 2 + 1] = sinf(ang);
    }
}
__device__ __forceinline__ void ph_inproj(Frame& F) {
    const DenseSched S{(const char*)fH(F), (const char*)(F.a.ws + WS_WB + WB_WIN), D, 64, 14, (int)gridDim.x, (int)blockIdx.x, 64 * 14, 64, 8, 32, GREP(2)};
    LAS float* ropel = (LAS float*)(F.lds + ROPE_OFF);
    for (int i = F.tid; i < 2048; i += NTHREADS) ropel[i] = frope(F)[i];
    __syncthreads();
    const EpiInproj E{fA(F), ropel, F.a.in[I_KG], F.a.in[I_QG]};
    pg8::gemm_phase<DenseSched, EpiInproj, true>(F.lds, D, S, E);
}
__device__ __forceinline__ void ph_outproj(Frame& F) {
    const DenseSched S{(const char*)(fA(F) + A_MIX), (const char*)(F.a.ws + WS_WB + WB_WOUT), D, 64, 4, (int)gridDim.x, (int)blockIdx.x, 64 * 4, 0, 1, 0, GREP(5)};
    const EpiRes E{F.a.in[I_X], F.a.out, fmod(F) + 2 * D};
    pg8::gemm_phase<DenseSched, EpiRes, false>(F.lds, D, S, E);
}
__device__ __forceinline__ void ph_sguin(Frame& F) {
    const DenseSched S{(const char*)fH(F), (const char*)(F.a.ws + WS_WB + WB_SWIN), D, 64, 24, (int)gridDim.x, (int)blockIdx.x, 64 * 24, 0, 1, 0, GREP(10)};
    const EpiSguIn E{(bf16*)(fA(F) + A_U), (bf16*)(fA(F) + A_V), F.a.in[I_SBIN], fvss(F)};
    pg8::gemm_phase<DenseSched, EpiSguIn, true>(F.lds, D, S, E);
}
__device__ __forceinline__ void ph_sguout(Frame& F) {
    const DenseSched S{(const char*)(fA(F) + A_U), (const char*)(F.a.ws + WS_WB + WB_SWOUT), SGW, 64, 4, (int)gridDim.x, (int)blockIdx.x, 64 * 4, 0, 1, 0, GREP(12)};
    const EpiRes E{F.a.out, F.a.out, fmod(F) + 4 * 6144 + 2 * D};
    pg8::gemm_phase<DenseSched, EpiRes, false>(F.lds, SGW, S, E);
}

__device__ __forceinline__ void ph_moe_gu(Frame& F, int l) {
    LAS int* tab = (LAS int*)(F.lds + TAB_OFF);
    const int tiles = moe_tab(F, l, tab);
    const MoeSched S{(const char*)fH(F), (const char*)(F.a.ws + WS_WB + WB_GU) + (size_t)l * NE * 1024 * D * 2, D, (int)gridDim.x, (int)blockIdx.x, tiles * 4, tab, flist(F), 1, GREP(7)};
    const EpiMoeGU E{(bf16*)(fA(F) + A_ACT)};
    pg8::gemm_phase<MoeSched, EpiMoeGU, true>(F.lds, D, S, E);
}
__device__ __forceinline__ void ph_moe_dn(Frame& F, int l) {
    LAS int* tab = (LAS int*)(F.lds + TAB_OFF);
    const int tiles = moe_tab(F, l, tab);
    const MoeSched S{(const char*)(fA(F) + A_ACT), (const char*)(F.a.ws + WS_WB + WB_DN) + (size_t)l * NE * D * EW * 2, EW, (int)gridDim.x, (int)blockIdx.x, tiles * 4, tab, flist(F), 0, GREP(8)};
    const EpiMoeDn E{(bf16*)(fA(F) + A_Y), flist(F), fwt(F)};
    pg8::gemm_phase<MoeSched, EpiMoeDn, true>(F.lds, EW, S, E);
}

constexpr int NPHASE = 18;
__global__ void __launch_bounds__(NTHREADS, 2) fwd_kernel(Args args) {
    extern __shared__ __attribute__((aligned(16))) unsigned char lds[];
    const int tid_ = threadIdx.x, wave_ = __builtin_amdgcn_readfirstlane(tid_ >> 6);
    Frame F{(LAS unsigned char*)lds, tid_, tid_ & 63, wave_, (int)blockIdx.x * NWAVES + wave_, (int)gridDim.x * NWAVES, args};
    volatile LAS unsigned* MISC = (volatile LAS unsigned*)(F.lds + MISC_OFF);
    for (int u = F.tid; u < (LDS_BYTES - LDSCTL_OFF) / 4; u += NTHREADS) ((LAS unsigned*)(F.lds + LDSCTL_OFF))[u] = 0u;
    __syncthreads();
    XcdBarrier bar; bar.bar = fctl(F) + CW_BAR; bar.x = 0; bar.st = nullptr;
    if (MK_ONE_LAUNCH) bar = xcd_barrier_post(fctl(F) + CW_BAR, MISC + 8);
    const int lo = args.ph_lo, hi = args.ph_hi;
#define IN(k) (lo <= (k) && (k) < hi)
#define REP(k) for (int _r = 0; _r < ((k) == REP_PHASE ? REP_N : 1); ++_r)
#ifdef ONLY_PHASE
#define PHON(k) ((k) == ONLY_PHASE)
#else
#define PHON(k) true
#endif
#define SEAM(k) do { if (IN(k) && IN((k) + 1)) xcd_barrier(bar); } while (0)
    if (PHON(0) && IN(0)) REP(0) { ph_mod2(F); __syncthreads(); ph_convert(F); __syncthreads(); } SEAM(0);
    if (PHON(1) && IN(1)) REP(1) { ph_norm0(F); } SEAM(1);
    if (PHON(2) && IN(2)) REP(2) { if (NV_INPROJ) ph_inproj_naive(F); else ph_inproj(F); } SEAM(2);
    if (PHON(3) && IN(3)) REP(3) { if (NV_RET) ph_scan_naive(F); else ph_kvstate(F); if (NV_NA) ph_na_naive(F); else ph_na(F); } SEAM(3);
    if (PHON(4) && IN(4)) REP(4) { if (NV_RET) ph_retout_naive(F); else ph_retout(F); } SEAM(4);
    if (PHON(5) && IN(5)) REP(5) { if (NV_OUTPROJ) ph_gemm_res_naive(F, (const bf16*)(fA(F) + A_MIX), D, D, F.a.in[I_WOUT], F.a.in[I_X], fmod(F) + 2 * D); else ph_outproj(F); } SEAM(5);
    if (PHON(6) && IN(6)) REP(6) { ph_route(F, 0, _r > 0); } SEAM(6);
    if (PHON(7) && IN(7)) REP(7) { if (NV_MOEGU) ph_moe_gu_naive(F, 0); else ph_moe_gu(F, 0); } SEAM(7);
    if (PHON(8) && IN(8)) REP(8) { if (NV_MOEDN) ph_moe_dn_naive(F, 0); else ph_moe_dn(F, 0); } SEAM(8);
    if (PHON(9) && IN(9)) REP(9) { ph_combine(F, 0, true, _r > 0); } SEAM(9);
    if (PHON(10) && IN(10)) REP(10) { if (NV_SGUIN) ph_sguin_naive(F); else ph_sguin(F); } SEAM(10);
    if (PHON(11) && IN(11)) REP(11) { if (NV_SGUMIX) ph_sgumix_naive(F); else ph_sgumix(F, _r > 0); } SEAM(11);
    if (PHON(12) && IN(12)) REP(12) { if (NV_SGUOUT) ph_gemm_res_naive(F, (const bf16*)(fA(F) + A_U), SGW, SGW, F.a.in[I_SWOUT], F.a.out, fmod(F) + 4 * 6144 + 2 * D); else ph_sguout(F); } SEAM(12);
    if (PHON(13) && IN(13)) REP(13) { ph_route(F, 1, _r > 0); } SEAM(13);
    if (PHON(14) && IN(14)) REP(14) { if (NV_MOEGU) ph_moe_gu_naive(F, 1); else ph_moe_gu(F, 1); } SEAM(14);
    if (PHON(15) && IN(15)) REP(15) { if (NV_MOEDN) ph_moe_dn_naive(F, 1); else ph_moe_dn(F, 1); } SEAM(15);
    if (PHON(16) && IN(16)) REP(16) { ph_combine(F, 1, false, _r > 0); }
    for (int xb = 0; xb < XBAR; ++xb) xcd_barrier(bar);
#undef IN
#undef SEAM
}

extern "C" void kernel_launch(void* const* d_in, const int* in_sizes, int n_in, void* d_out, int out_size, void* d_ws, size_t ws_size, hipStream_t stream) {
    static int grid = 0;
    if (grid == 0) {
        if (n_in != 26 || out_size != NTOK * D || ws_size < WS_END) { fprintf(stderr, "kernel_launch: unexpected shapes n_in %d out %d ws %zu (need %zu)\n", n_in, out_size, ws_size, (size_t)WS_END); grid = -1; return; }
        int dev = 0, cus = 0, per_cu = 0;
        hipGetDevice(&dev); hipDeviceGetAttribute(&cus, hipDeviceAttributeMultiprocessorCount, dev);
        hipFuncSetAttribute((const void*)fwd_kernel, hipFuncAttributeMaxDynamicSharedMemorySize, LDS_BYTES);
        hipOccupancyMaxActiveBlocksPerMultiprocessor(&per_cu, (const void*)fwd_kernel, NTHREADS, LDS_BYTES);
        (void)hipGetLastError();
        if (per_cu < 1) { fprintf(stderr, "kernel_launch: occupancy query says %d blocks/CU\n", per_cu); per_cu = 1; }
        grid = cus;
    }
    if (grid < 0) return;
    hipMemsetAsync((char*)d_ws + WS_CTL, 0, CTL_ZERO_BYTES, stream);
    Args a{};
    for (int i = 0; i < 26; ++i) a.in[i] = (const float*)d_in[i];
    a.out = (float*)d_out; a.ws = (unsigned char*)d_ws;
#if MK_ONE_LAUNCH
    a.ph_lo = 0; a.ph_hi = 17; a.li = 0;
    void* kargs[] = { &a };
    hipError_t e = hipLaunchCooperativeKernel((const void*)fwd_kernel, dim3(grid), dim3(NTHREADS), kargs, LDS_BYTES, stream);
    if (e != hipSuccess) fprintf(stderr, "cooperative launch failed: %s\n", hipGetErrorString(e));
#else
    for (int p = 0; p < 17; ++p) { a.ph_lo = p; a.ph_hi = p + 1; a.li = p; hipLaunchKernelGGL(fwd_kernel, dim3(grid), dim3(NTHREADS), LDS_BYTES, stream, a); }
#endif
}
```

```cpp
#include <hip/hip_runtime.h>
#include <cstdio>
#include <cstdint>

#ifndef NV_INPROJ
#define NV_INPROJ 0
#endif
#ifndef NV_OUTPROJ
#define NV_OUTPROJ 0
#endif
#ifndef NV_MOEGU
#define NV_MOEGU 0
#endif
#ifndef NV_MOEDN
#define NV_MOEDN 0
#endif
#ifndef NV_SGUIN
#define NV_SGUIN 0
#endif
#ifndef NV_SGUOUT
#define NV_SGUOUT 0
#endif
#ifndef NV_NA
#define NV_NA 0
#endif
#ifndef NV_RET
#define NV_RET 0
#endif
#ifndef NV_SGUMIX
#define NV_SGUMIX 0
#endif
#ifndef REP_PHASE
#define REP_PHASE -1
#endif
#ifndef REP_N
#define REP_N 2
#endif
#ifndef XBAR
#define XBAR 0
#endif
#ifndef GREP_PHASE
#define GREP_PHASE -1
#endif
#define GREP(k) ((k) == GREP_PHASE ? 2 : 1)
#ifndef RET_MODE
#define RET_MODE 0
#endif
#ifndef MK_ONE_LAUNCH
#define MK_ONE_LAUNCH 1
#endif

constexpr int D = 1024, NB = 4, SEQ = 4096, NTOK = NB * SEQ, CTXL = 256, NCTX = NB * CTXL, NROW = NTOK + NCTX;
constexpr int HD = 64, NH = 8, HW = NH * HD;
constexpr int ABW = 3584;
constexpr int SGW = 3072;
constexpr int NE = 16, EW = 512;
constexpr float EPS = 1e-6f;
constexpr int NWAVES = 8, NTHREADS = 512;

constexpr size_t MiB = 1u << 20;
constexpr size_t WS_CTL = 0, CTL_ZERO_BYTES = 1 * MiB;
constexpr size_t WS_MOD = 1 * MiB;
constexpr size_t WS_ROUTE = 2 * MiB;
constexpr size_t WS_VSS = 4 * MiB;
constexpr size_t WS_WB = 8 * MiB;
constexpr size_t WS_H = 132 * MiB;
constexpr size_t WS_A = 166 * MiB;
constexpr size_t WS_END = 358 * MiB;
constexpr size_t A_RK = 0, A_RV = 17 * MiB, A_NK = 34 * MiB, A_NV = 51 * MiB, A_RQ = 68 * MiB, A_GT = 84 * MiB, A_NQ = 100 * MiB, A_MIX = 116 * MiB, A_SST = 148 * MiB;
constexpr size_t A_ACT = 0, A_Y = 36 * MiB;
constexpr size_t A_U = 0, A_V = 96 * MiB;

constexpr int CW_BAR = 4096;
constexpr int CW_CNT = 8192;

typedef unsigned short bf16;
typedef unsigned u32x4 __attribute__((ext_vector_type(4)));
typedef float f32x4 __attribute__((ext_vector_type(4)));
#define LAS __attribute__((address_space(3)))
#define RLX_AGENT __ATOMIC_RELAXED, __HIP_MEMORY_SCOPE_AGENT

__device__ __forceinline__ unsigned f2bf(float f) { unsigned u = __builtin_bit_cast(unsigned, f); return (u + 0x7fffu + ((u >> 16) & 1u)) >> 16; }
__device__ __forceinline__ float bf2f(unsigned h) { return __builtin_bit_cast(float, h << 16); }
__device__ __forceinline__ unsigned pk2(float lo, float hi) { return f2bf(lo) | (f2bf(hi) << 16); }
__device__ __forceinline__ float siluf(float v) { return v / (1.f + __expf(-v)); }
__device__ __forceinline__ float gelu_tanh(float v) { const float u = 0.7978845608028654f * (v + 0.044715f * v * v * v); return 0.5f * v * (1.f + tanhf(u)); }
__device__ __forceinline__ float wave_sum(float v) {
#pragma unroll
    for (int o = 1; o < 64; o <<= 1) v += __shfl_xor(v, o);
    return v;
}

#define XB_TMO      128
#define XB_XCNT(j)  (256  + 64 * (j))
#define XB_XSUB(j)  (1280 + 64 * (j))
#define XB_XGEN(j)  (2304 + 64 * (j))
#define XB_TOP      3328
#define XB_TOPGEN   3392
#define XCD_BAR_WORDS 3456
#define XB_SPIN_CAP (1u << 18)
__device__ __forceinline__ unsigned xb_ld(unsigned* p)              { return __hip_atomic_load(p, __ATOMIC_RELAXED, __HIP_MEMORY_SCOPE_AGENT); }
__device__ __forceinline__ unsigned xb_add(unsigned* p, unsigned v) { return __hip_atomic_fetch_add(p, v, __ATOMIC_RELAXED, __HIP_MEMORY_SCOPE_AGENT); }
__device__ __forceinline__ unsigned xb_xcc_id() { return (unsigned)__builtin_amdgcn_s_getreg((3 << 11) | 20) & 0xFu; }
#define XB_SPIN(cond, bar) do { unsigned _sp = 0; while (cond) { __builtin_amdgcn_s_sleep(1); \
    if ((++_sp & 255u) == 0u) { if (xb_ld(&(bar)[XB_TMO])) break; if (_sp > XB_SPIN_CAP) { atomicAdd(&(bar)[XB_TMO], 1u); break; } } } } while (0)
struct XcdBarrier { unsigned* bar; unsigned x; volatile LAS unsigned* st; };
__device__ __forceinline__ XcdBarrier xcd_barrier_post(unsigned* bar, volatile LAS unsigned* st) {
    XcdBarrier b; b.bar = bar; b.x = xb_xcc_id(); b.st = st;
    if (threadIdx.x == 0) (void)xb_add(&bar[XB_XCNT(b.x)], 1u);
    return b;
}
__device__ __forceinline__ void xcd_barrier_complete(unsigned* bar, unsigned x, unsigned& nloc, unsigned& nx) {
    const unsigned G = gridDim.x * gridDim.y * gridDim.z;
    unsigned sum, cnt, mine, sp = 0u;
    for (;;) {
        sum = 0u; cnt = 0u; mine = 0u;
#pragma unroll
        for (unsigned j = 0; j < 16; ++j) { const unsigned c = xb_ld(&bar[XB_XCNT(j)]); sum += c; cnt += (c > 0u) ? 1u : 0u; mine = (j == x) ? c : mine; }
        if (sum == G) break;
        __builtin_amdgcn_s_sleep(1);
        if ((++sp & 255u) == 0u) { if (xb_ld(&bar[XB_TMO])) break; if (sp > XB_SPIN_CAP) { atomicAdd(&bar[XB_TMO], 1u); break; } }
    }
    nloc = mine > 0u ? mine : 1u; nx = cnt > 0u ? cnt : 1u;
}
__device__ __forceinline__ void xcd_barrier(const XcdBarrier& b) {
    asm volatile("s_waitcnt vmcnt(0)" ::: "memory");
    __syncthreads();
    if (threadIdx.x == 0) {
        unsigned* bar = b.bar;
        __builtin_amdgcn_s_waitcnt(0);
        unsigned nloc = b.st[0], nx = b.st[1];
        if (nloc == 0u) { xcd_barrier_complete(bar, b.x, nloc, nx); b.st[0] = nloc; b.st[1] = nx; }
        const unsigned old = xb_add(&bar[XB_XSUB(b.x)], 1u);
        const unsigned gen = old / nloc;
        if (old + 1u == (gen + 1u) * nloc) {
            __builtin_amdgcn_fence(__ATOMIC_RELEASE, "agent");
            asm volatile("s_waitcnt vmcnt(0)" ::: "memory");
            const unsigned og = xb_add(&bar[XB_TOP], 1u);
            const unsigned tg = og / nx;
            if (og + 1u == (tg + 1u) * nx) xb_add(&bar[XB_TOPGEN], 1u);
            else XB_SPIN(xb_ld(&bar[XB_TOPGEN]) == tg, bar);
            __builtin_amdgcn_fence(__ATOMIC_ACQUIRE, "agent");
            xb_add(&bar[XB_XGEN(b.x)], 1u);
            asm volatile("s_waitcnt vmcnt(0)" ::: "memory");
        } else {
            XB_SPIN(xb_ld(&bar[XB_XGEN(b.x)]) == gen, bar);
            __builtin_amdgcn_fence(__ATOMIC_ACQUIRE, "agent");
            asm volatile("s_waitcnt vmcnt(0)" ::: "memory");
        }
    }
    __syncthreads();
}

constexpr int LDS_BYTES = 163840;
constexpr int LDSCTL_OFF = 147456, MISC_OFF = LDSCTL_OFF + 320, TAB_OFF = LDSCTL_OFF + 1024, ROPE_OFF = LDSCTL_OFF + 2048;

struct Args { const float* in[26]; float* out; unsigned char* ws; int ph_lo, ph_hi, li, pad; };

struct Frame {
    LAS unsigned char* lds;
    int tid, lane, wave, gw, ngw;
    const Args& a;
};
__device__ __forceinline__ unsigned* fctl(const Frame& F) { return (unsigned*)(F.a.ws + WS_CTL); }
__device__ __forceinline__ float* fmod(const Frame& F) { return (float*)(F.a.ws + WS_MOD); }
__device__ __forceinline__ float* fmodc(const Frame& F) { return (float*)(F.a.ws + WS_MOD) + 2 * 4 * 6144; }
__device__ __forceinline__ float* frope(const Frame& F) { return (float*)(F.a.ws + WS_MOD) + 2 * 4 * 6144 + 2048; }
__device__ __forceinline__ int* flist(const Frame& F) { return (int*)(F.a.ws + WS_ROUTE); }
__device__ __forceinline__ float* fwt(const Frame& F) { return (float*)(F.a.ws + WS_ROUTE + 1 * MiB); }
__device__ __forceinline__ float* fvss(const Frame& F) { return (float*)(F.a.ws + WS_VSS); }
__device__ __forceinline__ bf16* fH(const Frame& F) { return (bf16*)(F.a.ws + WS_H); }
__device__ __forceinline__ unsigned char* fA(const Frame& F) { return F.a.ws + WS_A; }
enum { I_X = 0, I_C, I_CTX, I_CCTX, I_ADAW, I_ADAB, I_NMG, I_NFG, I_RW, I_RB, I_WG, I_WU, I_WD, I_WIN, I_WOUT, I_RDEC, I_RNG, I_QG, I_KG, I_RPB, I_SWIN, I_SBIN, I_SNG, I_SWS, I_SBS, I_SWOUT };

template <int NC> __device__ __forceinline__ void naive_dot(const bf16* arow, const float* W, int ldw, int K, float (&acc)[NC]) {
#pragma unroll 1
    for (int k = 0; k < K; k += 2) {
        const unsigned a2 = *(const unsigned*)(arow + k);
        const float a0 = bf2f(a2 & 0xffffu), a1 = bf2f(a2 >> 16);
        const float* w = W + (size_t)k * ldw;
#pragma unroll
        for (int j = 0; j < NC; ++j) acc[j] = __builtin_fmaf(a0, w[j], acc[j]);
        asm volatile("" ::: "memory");
        w += ldw;
#pragma unroll
        for (int j = 0; j < NC; ++j) acc[j] = __builtin_fmaf(a1, w[j], acc[j]);
        asm volatile("" ::: "memory");
    }
}
template <int NC> __device__ __forceinline__ void store_row_bf16(bf16* dst, const float (&v)[NC]) {
#pragma unroll
    for (int j = 0; j < NC; j += 8) { u32x4 w; w.x = pk2(v[j], v[j + 1]); w.y = pk2(v[j + 2], v[j + 3]); w.z = pk2(v[j + 4], v[j + 5]); w.w = pk2(v[j + 6], v[j + 7]); *(u32x4*)(dst + j) = w; }
}

__device__ __forceinline__ void ph_mod(Frame& F) {
    const int gt = F.gw * 64 + F.lane, ngt = F.ngw * 64;
    for (int it = gt; it < 2 * 6144; it += ngt) {
        const int l = it / 6144, n = it % 6144;
        const float* W = F.a.in[I_ADAW] + (size_t)l * D * 6144 + n;
        float a0 = 0.f, a1 = 0.f, a2 = 0.f, a3 = 0.f, a4 = 0.f;
        const float* c = F.a.in[I_C]; const float* cc = F.a.in[I_CCTX];
        for (int k = 0; k < D; ++k) { const float w = W[(size_t)k * 6144];
            a0 += siluf(c[k]) * w; a1 += siluf(c[D + k]) * w; a2 += siluf(c[2 * D + k]) * w; a3 += siluf(c[3 * D + k]) * w; a4 += siluf(cc[k]) * w; }
        const float bb = F.a.in[I_ADAB][l * 6144 + n];
        fmod(F)[(l * 4 + 0) * 6144 + n] = a0 + bb; fmod(F)[(l * 4 + 1) * 6144 + n] = a1 + bb; fmod(F)[(l * 4 + 2) * 6144 + n] = a2 + bb; fmod(F)[(l * 4 + 3) * 6144 + n] = a3 + bb;
        if (l == 0 && n < 2048) fmodc(F)[n] = a4 + bb;
    }
    for (int it = gt; it < 64 * 16; it += ngt) {
        const int pos = it >> 4, j = it & 15;
        const float inv = powf(10000.0f, -(float)j / 16.0f);
        const float ang = (float)pos * inv;
        frope(F)[it * 2] = cosf(ang); frope(F)[it * 2 + 1] = sinf(ang);
    }
}

__device__ __forceinline__ void norm_row(Frame& F, const float* xrow, const float* g, const float* sh, const float* sc, bf16* hrow) {
    const f32x4* xr = (const f32x4*)xrow + F.lane;
    f32x4 v[4]; float s = 0.f;
#pragma unroll
    for (int j = 0; j < 4; ++j) { v[j] = xr[64 * j]; s += (v[j].x * v[j].x + v[j].y * v[j].y) + (v[j].z * v[j].z + v[j].w * v[j].w); }
    const float rstd = rsqrtf(wave_sum(s) * (1.f / D) + EPS);
    unsigned long long* o8 = (unsigned long long*)hrow + F.lane;
#pragma unroll
    for (int j = 0; j < 4; ++j) {
        const f32x4 gg = ((const f32x4*)g)[F.lane + 64 * j], s1 = ((const f32x4*)sh)[F.lane + 64 * j], s2 = ((const f32x4*)sc)[F.lane + 64 * j];
        const f32x4 y = (v[j] * rstd * gg) * (s2 + 1.f) + s1;
        o8[64 * j] = (unsigned long long)pk2(y.x, y.y) | ((unsigned long long)pk2(y.z, y.w) << 32);
    }
}
__device__ __forceinline__ void ph_norm0(Frame& F) {
    for (int r = F.gw; r < NROW; r += F.ngw) {
        if (r < NTOK) { const int b = r >> 12; norm_row(F, F.a.in[I_X] + (size_t)r * D, F.a.in[I_NMG], fmod(F) + (0 * 4 + b) * 6144, fmod(F) + (0 * 4 + b) * 6144 + D, fH(F) + (size_t)r * D); }
        else norm_row(F, F.a.in[I_CTX] + (size_t)(r - NTOK) * D, F.a.in[I_NMG], fmodc(F), fmodc(F) + D, fH(F) + (size_t)r * D);
    }
}

__device__ __forceinline__ void ph_inproj_naive(Frame& F) {
    const float* W = F.a.in[I_WIN];
    for (int it = F.gw; it < 272 * 56; it += F.ngw) {
        const int rg = it / 56, u = it % 56; if (rg >= 256 && u >= 32) continue;
        const int row = rg * 64 + F.lane;
        float acc[64];
#pragma unroll
        for (int j = 0; j < 64; ++j) acc[j] = 0.f;
        naive_dot<64>(fH(F) + (size_t)row * D, W + u * 64, ABW, D, acc);
        const int t = u >> 3, h = u & 7;
        if ((t == 0 || t == 4) && row < NTOK) {
            const int tt = row & 4095, pr = tt >> 6, pc = tt & 63;
#pragma unroll
            for (int j = 0; j < 16; ++j) {
                const float c1 = frope(F)[(pr * 16 + j) * 2], s1 = frope(F)[(pr * 16 + j) * 2 + 1], c2 = frope(F)[(pc * 16 + j) * 2], s2 = frope(F)[(pc * 16 + j) * 2 + 1];
                const float a = acc[j], b = acc[j + 16], c = acc[32 + j], d = acc[48 + j];
                acc[j] = a * c1 - b * s1; acc[j + 16] = a * s1 + b * c1; acc[32 + j] = c * c2 - d * s2; acc[48 + j] = c * s2 + d * c2;
            }
        }
        if (t == 0) {
#pragma unroll
            for (int j = 0; j < 64; ++j) acc[j] *= 0.125f;
        }
        if (t == 2 || t == 6) {
            float ss = 0.f;
#pragma unroll
            for (int j = 0; j < 64; ++j) ss += acc[j] * acc[j];
            const float r = rsqrtf(ss * (1.f / 64.f) + EPS) * (t == 6 ? 0.125f : 1.f);
            const float* g = t == 2 ? F.a.in[I_KG] : F.a.in[I_QG];
#pragma unroll
            for (int j = 0; j < 64; ++j) acc[j] = acc[j] * r * g[j];
        }
        if (t == 5) {
#pragma unroll
            for (int j = 0; j < 64; ++j) acc[j] = siluf(acc[j]);
        }
        const size_t off_t = t < 4 ? (size_t)t * 17 * MiB : (size_t)(68 + (t - 4) * 16) * MiB;
        bf16* dst = (bf16*)(fA(F) + off_t) + (size_t)row * HW + h * 64;
        store_row_bf16<64>(dst, acc);
    }
}

__device__ __forceinline__ float ret_gamma_log(Frame& F, int dir, int h) {
    const float th = F.a.in[I_RDEC][dir * 8 + h];
    return -(th > 0.f ? th + log1pf(__expf(-th)) : log1pf(__expf(th)));
}
__device__ __forceinline__ void ph_scan_naive(Frame& F) {
    const bf16* RK = (const bf16*)(fA(F) + A_RK); const bf16* RV = (const bf16*)(fA(F) + A_RV); bf16* SST = (bf16*)(fA(F) + A_SST);
    const int gt = F.gw * 64 + F.lane, ngt = F.ngw * 64;
    for (int it = gt; it < 64 * 4096; it += ngt) {
        const int bhd = it >> 12, ed = it & 4095, e = ed >> 6, d = ed & 63;
        const int dir = bhd & 1, h = (bhd >> 1) & 7, b = bhd >> 4;
        const float gam = __expf(ret_gamma_log(F, dir, h));
        float S = 0.f;
        bf16* sst = SST + ((size_t)((b * 8 + h) * 2 + dir) * 32) * 4096 + ed;
        for (int n = 0; n < CTXL; ++n) { const int nn = dir ? (CTXL - 1 - n) : n; const size_t row = NTOK + b * CTXL + nn;
            S = gam * S + bf2f(RK[row * HW + h * 64 + d]) * bf2f(RV[row * HW + h * 64 + e]); }
        for (int n = 0; n < SEQ; ++n) { const int t = dir ? (SEQ - 1 - n) : n; const size_t row = (size_t)b * SEQ + t;
            if ((n & 127) == 0) sst[(size_t)(t >> 7) * 4096] = (bf16)f2bf(S);
            S = gam * S + bf2f(RK[row * HW + h * 64 + d]) * bf2f(RV[row * HW + h * 64 + e]); }
    }
}
__device__ __forceinline__ void ph_na_naive(Frame& F) {
    const bf16* NK = (const bf16*)(fA(F) + A_NK); const bf16* NV = (const bf16*)(fA(F) + A_NV); const bf16* NQ = (const bf16*)(fA(F) + A_NQ); bf16* MIX = (bf16*)(fA(F) + A_MIX);
    const int gt = F.gw * 64 + F.lane, ngt = F.ngw * 64;
    for (int it = gt; it < NB * NH * SEQ; it += ngt) {
        const int t = it & 4095, h = (it >> 12) & 7, b = it >> 15;
        const int r = t >> 6, c = t & 63;
        int r0 = r - 4; r0 = r0 < 0 ? 0 : (r0 > 56 ? 56 : r0); int c0 = c - 8; c0 = c0 < 0 ? 0 : (c0 > 48 ? 48 : c0);
        const size_t qrow = (size_t)b * SEQ + t;
        unsigned q[32]; float o[64];
#pragma unroll
        for (int j = 0; j < 32; ++j) q[j] = *(const unsigned*)(NQ + qrow * HW + h * 64 + 2 * j);
#pragma unroll
        for (int j = 0; j < 64; ++j) o[j] = 0.f;
        float m = -1e30f, l = 0.f;
        const float* rpb = F.a.in[I_RPB] + h * 15 * 31;
#pragma unroll 1
        for (int kk = 0; kk < 384; ++kk) {
            size_t krow; float bias = 0.f;
            if (kk < 128) { const int kr = r0 + (kk >> 4), kc = c0 + (kk & 15); krow = (size_t)b * SEQ + kr * 64 + kc; bias = rpb[(kr - r + 7) * 31 + (kc - c + 15)]; }
            else krow = NTOK + b * CTXL + (kk - 128);
            float s = 0.f;
#pragma unroll
            for (int j = 0; j < 64; j += 2) { const unsigned w = *(const unsigned*)(NK + krow * HW + h * 64 + j); s += bf2f(q[j >> 1] & 0xffffu) * bf2f(w & 0xffffu) + bf2f(q[j >> 1] >> 16) * bf2f(w >> 16); }
            s += bias;
            asm volatile("" ::: "memory");
            const float mn = fmaxf(m, s), al = __expf(m - mn), p = __expf(s - mn);
            l = l * al + p; m = mn;
#pragma unroll
            for (int j = 0; j < 64; j += 2) { const unsigned w = *(const unsigned*)(NV + krow * HW + h * 64 + j); o[j] = o[j] * al + p * bf2f(w & 0xffffu); o[j + 1] = o[j + 1] * al + p * bf2f(w >> 16); }
        }
        const float il = 1.f / l;
#pragma unroll
        for (int j = 0; j < 64; ++j) o[j] *= il;
        store_row_bf16<64>(MIX + qrow * D + 512 + h * 64, o);
    }
}
__device__ __forceinline__ void ph_retout_naive(Frame& F) {
    const bf16* RK = (const bf16*)(fA(F) + A_RK); const bf16* RV = (const bf16*)(fA(F) + A_RV); const bf16* RQ = (const bf16*)(fA(F) + A_RQ); const bf16* GT = (const bf16*)(fA(F) + A_GT);
    const bf16* SST = (const bf16*)(fA(F) + A_SST); bf16* MIX = (bf16*)(fA(F) + A_MIX);
    const int gt = F.gw * 64 + F.lane, ngt = F.ngw * 64;
    for (int it = gt; it < NB * NH * SEQ * 2; it += ngt) {
        const int hf = it & 1, t = (it >> 1) & 4095, h = (it >> 13) & 7, b = it >> 16;
        const int i = t & 127, ch = t >> 7;
        const size_t qrow = (size_t)b * SEQ + t;
        const float lgf = ret_gamma_log(F, 0, h), lgb = ret_gamma_log(F, 1, h);
        unsigned q[32]; float o[32];
#pragma unroll
        for (int j = 0; j < 32; ++j) q[j] = *(const unsigned*)(RQ + qrow * HW + h * 64 + 2 * j);
#pragma unroll
        for (int j = 0; j < 32; ++j) o[j] = 0.f;
#pragma unroll 1
        for (int jj = 0; jj < 128; ++jj) {
            const size_t krow = (size_t)b * SEQ + ch * 128 + jj;
            float s = 0.f;
#pragma unroll
            for (int j = 0; j < 64; j += 2) { const unsigned w = *(const unsigned*)(RK + krow * HW + h * 64 + j); s += bf2f(q[j >> 1] & 0xffffu) * bf2f(w & 0xffffu) + bf2f(q[j >> 1] >> 16) * bf2f(w >> 16); }
            asm volatile("" ::: "memory");
            const float wgt = jj < i ? __expf(lgf * (float)(i - jj)) : (jj > i ? __expf(lgb * (float)(jj - i)) : 2.f);
            s *= wgt;
#pragma unroll
            for (int j = 0; j < 32; j += 2) { const unsigned w = *(const unsigned*)(RV + krow * HW + h * 64 + hf * 32 + j); o[j] += s * bf2f(w & 0xffffu); o[j + 1] += s * bf2f(w >> 16); }
            asm volatile("" ::: "memory");
        }
        const float qf = __expf(lgf * (float)(i + 1)), qb = __expf(lgb * (float)(128 - i));
        const bf16* Sf = SST + ((size_t)((b * 8 + h) * 2 + 0) * 32 + ch) * 4096 + hf * 32 * 64; const bf16* Sb = SST + ((size_t)((b * 8 + h) * 2 + 1) * 32 + ch) * 4096 + hf * 32 * 64;
#pragma unroll 1
        for (int d = 0; d < 64; ++d) {
            const float qd = bf2f(RQ[qrow * HW + h * 64 + d]); const float qfd = qf * qd, qbd = qb * qd;
#pragma unroll
            for (int e = 0; e < 32; ++e) o[e] += qfd * bf2f(Sf[e * 64 + d]) + qbd * bf2f(Sb[e * 64 + d]);
            asm volatile("" ::: "memory");
        }
        float ss = 0.f;
#pragma unroll
        for (int j = 0; j < 32; ++j) ss += o[j] * o[j];
        ss += __shfl_xor(ss, 1);
        const float rs = rsqrtf(ss * (1.f / 64.f) + EPS);
        const float* g = F.a.in[I_RNG] + hf * 32;
#pragma unroll
        for (int j = 0; j < 32; j += 2) { const unsigned w = *(const unsigned*)(GT + qrow * HW + h * 64 + hf * 32 + j); o[j] = o[j] * rs * g[j] * bf2f(w & 0xffffu); o[j + 1] = o[j + 1] * rs * g[j + 1] * bf2f(w >> 16); }
        store_row_bf16<32>(MIX + qrow * D + h * 64 + hf * 32, o);
    }
}
__device__ __forceinline__ void ph_gemm_res_naive(Frame& F, const bf16* A, int lda, int K, const float* W, const float* base, const float* gate  ) {
    for (int it = F.gw; it < 256 * 16; it += F.ngw) {
        const int rg = it >> 4, u = it & 15, row = rg * 64 + F.lane, b = row >> 12;
        float acc[64];
#pragma unroll
        for (int j = 0; j < 64; ++j) acc[j] = 0.f;
        naive_dot<64>(A + (size_t)row * lda, W + u * 64, D, K, acc);
        const float* gp = gate + b * 6144 + u * 64; const float* bp = base + (size_t)row * D + u * 64; float* op = F.a.out + (size_t)row * D + u * 64;
#pragma unroll
        for (int j = 0; j < 64; j += 4) { const f32x4 bv = *(const f32x4*)(bp + j), gv = *(const f32x4*)(gp + j);
            *(f32x4*)(op + j) = bv + gv * (f32x4){acc[j], acc[j + 1], acc[j + 2], acc[j + 3]}; }
    }
}
__device__ __forceinline__ void ph_route(Frame& F, int l, bool dry = false) {
    typedef short bf16x8_ __attribute__((ext_vector_type(8)));
    LAS bf16* wh = (LAS bf16*)F.lds;
    LAS bf16* wl = wh + 16 * 1024;
    LAS float* gsb = (LAS float*)(F.lds + 65536);
    LAS float* shb = gsb + 4 * 1024;
    for (int i = F.tid; i < D * NE; i += NTHREADS) { const int e = i >> 10, k = i & 1023; const float w = F.a.in[I_RW][k * 16 + e]; const unsigned h = f2bf(w); const float rem = w - bf2f(h);
        wh[i] = (bf16)h; wl[i] = (bf16)f2bf(rem); }
    for (int i = F.tid; i < 4 * D; i += NTHREADS) { const int b = i >> 10, k = i & 1023; const float* md = fmod(F) + (l * 4 + b) * 6144;
        gsb[i] = F.a.in[I_NFG][l * D + k] * (md[4 * D + k] + 1.f); shb[i] = md[3 * D + k]; }
    __syncthreads();
    unsigned* cnt = fctl(F) + CW_CNT + l * 1024;
    const int row16 = F.lane & 15, kq = F.lane >> 4;
    LAS float* xss = (LAS float*)(F.lds + 65536 + 32768);
    LAS float* xlg = xss + 128;
    const int kh = F.wave >> 2, wi = F.wave & 3;
    for (int item0 = (int)blockIdx.x * 4; item0 < NTOK / 16; item0 += (int)gridDim.x * 4) {
        const int item = item0 + wi;
        const int r = item * 16 + row16, b = (item * 16) >> 12;
        const float* xrow = F.a.out + (size_t)r * D + 512 * kh + 8 * kq;
        float ss = 0.f;
#pragma unroll 8
        for (int s2 = 0; s2 < 16; ++s2) { const f32x4 a = *(const f32x4*)(xrow + 32 * s2), c = *(const f32x4*)(xrow + 32 * s2 + 4);
            ss += (a.x * a.x + a.y * a.y) + (a.z * a.z + a.w * a.w) + (c.x * c.x + c.y * c.y) + (c.z * c.z + c.w * c.w); }
        ss += __shfl_xor(ss, 16); ss += __shfl_xor(ss, 32);
        __syncthreads();
        if (kq == 0) xss[F.wave * 16 + row16] = ss;
        __syncthreads();
        ss = xss[wi * 16 + row16] + xss[(wi + 4) * 16 + row16];
        const float rstd = rsqrtf(ss * (1.f / D) + EPS);
        f32x4 acc = {0.f, 0.f, 0.f, 0.f};
        bf16* hrow = fH(F) + (size_t)r * D + 512 * kh + 8 * kq;
        const LAS float* gp = gsb + b * 1024 + 512 * kh + 8 * kq; const LAS float* sp = shb + b * 1024 + 512 * kh + 8 * kq;
        const LAS bf16* whp = wh + row16 * 1024 + 512 * kh + 8 * kq; const LAS bf16* wlp = wl + row16 * 1024 + 512 * kh + 8 * kq;
#pragma unroll 4
        for (int s2 = 0; s2 < 16; ++s2) {
            const f32x4 a = *(const f32x4*)(xrow + 32 * s2), c = *(const f32x4*)(xrow + 32 * s2 + 4);
            const f32x4 g0 = *(const LAS f32x4*)(gp + 32 * s2), g1 = *(const LAS f32x4*)(gp + 32 * s2 + 4), h0 = *(const LAS f32x4*)(sp + 32 * s2), h1 = *(const LAS f32x4*)(sp + 32 * s2 + 4);
            const f32x4 y0 = (a * rstd) * g0 + h0, y1 = (c * rstd) * g1 + h1;
            u32x4 yh; yh.x = pk2(y0.x, y0.y); yh.y = pk2(y0.z, y0.w); yh.z = pk2(y1.x, y1.y); yh.w = pk2(y1.z, y1.w);
            *(u32x4*)(hrow + 32 * s2) = yh;
            const f32x4 r0 = { y0.x - bf2f(yh.x & 0xffffu), y0.y - bf2f(yh.x >> 16), y0.z - bf2f(yh.y & 0xffffu), y0.w - bf2f(yh.y >> 16) };
            const f32x4 r1 = { y1.x - bf2f(yh.z & 0xffffu), y1.y - bf2f(yh.z >> 16), y1.z - bf2f(yh.w & 0xffffu), y1.w - bf2f(yh.w >> 16) };
            u32x4 yl; yl.x = pk2(r0.x, r0.y); yl.y = pk2(r0.z, r0.w); yl.z = pk2(r1.x, r1.y); yl.w = pk2(r1.z, r1.w);
            const bf16x8_ wfh = *(const LAS bf16x8_*)(whp + 32 * s2), wfl = *(const LAS bf16x8_*)(wlp + 32 * s2);
            const bf16x8_ yfh = __builtin_bit_cast(bf16x8_, yh), yfl = __builtin_bit_cast(bf16x8_, yl);
            acc = __builtin_amdgcn_mfma_f32_16x16x32_bf16(wfh, yfh, acc, 0, 0, 0);
            acc = __builtin_amdgcn_mfma_f32_16x16x32_bf16(wfl, yfh, acc, 0, 0, 0);
            acc = __builtin_amdgcn_mfma_f32_16x16x32_bf16(wfh, yfl, acc, 0, 0, 0);
        }
        if (kh == 1) *(LAS f32x4*)(xlg + (wi * 64 + F.lane) * 4) = acc;
        __syncthreads();
        if (kh == 1) continue;
        acc = acc + *(const LAS f32x4*)(xlg + (wi * 64 + F.lane) * 4);
        float m1 = -1e30f, m2 = -1e30f, w1 = 0.f, w2 = 0.f; int i1 = 0, i2 = 0;
#pragma unroll
        for (int g = 0; g < 4; ++g) { const float af = 1.f / (1.f + __expf(-acc[g])); const float x = af + F.a.in[I_RB][4 * kq + g]; const int id = 4 * kq + g;
            if (x > m1) { m2 = m1; i2 = i1; w2 = w1; m1 = x; i1 = id; w1 = af; } else if (x > m2) { m2 = x; i2 = id; w2 = af; } }
        const float gsc = m1 + m2;
        const float s0 = __shfl(gsc, row16), s1 = __shfl(gsc, row16 + 16), s2_ = __shfl(gsc, row16 + 32), s3 = __shfl(gsc, row16 + 48);
        int best = 0; float bs = s0; if (s1 > bs) { bs = s1; best = 1; } if (s2_ > bs) { bs = s2_; best = 2; } if (s3 > bs) { bs = s3; best = 3; }
        const bool writer = (kq == best) && !dry;
        int mycount = 0; unsigned long long below1 = 0ull, below2 = 0ull;
        const unsigned long long ltmask = (1ull << F.lane) - 1ull;
#pragma unroll
        for (int e = 0; e < 16; ++e) { const unsigned long long m = __ballot(writer && (i1 == e || i2 == e));
            if (F.lane == e) mycount = __popcll(m);
            if (i1 == e) below1 = m & ltmask; if (i2 == e) below2 = m & ltmask; }
        int base = 0;
        if (F.lane < 16 && mycount > 0) base = (int)__hip_atomic_fetch_add(cnt + F.lane * 64, (unsigned)mycount, RLX_AGENT);
        const int b1 = __shfl(base, i1), b2 = __shfl(base, i2);
        if (writer) { const float inv = 1.f / (w1 + w2);
            flist(F)[i1 * 16384 + b1 + __popcll(below1)] = 2 * r; flist(F)[i2 * 16384 + b2 + __popcll(below2)] = 2 * r + 1;
            fwt(F)[2 * r] = w1 * inv; fwt(F)[2 * r + 1] = w2 * inv; }
    }
    __syncthreads();
}
struct Seg { int cnt[16]; int base[16]; };
__device__ __forceinline__ void load_seg(Frame& F, int l, int (&cnt)[16], int (&base)[16]) {
    int acc = 0;
#pragma unroll
    for (int e = 0; e < 16; ++e) { cnt[e] = (int)__hip_atomic_load(fctl(F) + CW_CNT + l * 1024 + e * 64, RLX_AGENT); base[e] = acc; acc += (cnt[e] + 255) & ~255; }
}
__device__ __forceinline__ void ph_moe_gu_naive(Frame& F, int l) {
    int cnt[16], base[16]; load_seg(F, l, cnt, base);
    bf16* ACT = (bf16*)(fA(F) + A_ACT);
    int tot = 0;
#pragma unroll
    for (int i = 0; i < 16; ++i) tot += (cnt[i] + 63) >> 6;
    for (int it = F.gw; it < tot * 16; it += F.ngw) {
        const int gi_all = it >> 4, u = it & 15;
        int ee = 0, gs = 0;
#pragma unroll
        for (int i = 0, cum = 0; i < 16; ++i) { cum += (cnt[i] + 63) >> 6; if (gi_all >= cum) { gs = cum; ee = i + 1; } }
        int ce = 0, be = 0;
#pragma unroll
        for (int i = 0; i < 16; ++i) if (i == ee) { ce = cnt[i]; be = base[i]; }
        const int pos = (gi_all - gs) * 64 + F.lane; const bool valid = pos < ce;
        const int ent = flist(F)[ee * 16384 + (valid ? pos : 0)]; const int tok = ent >> 1;
        float ag[32], au[32];
#pragma unroll
        for (int j = 0; j < 32; ++j) { ag[j] = 0.f; au[j] = 0.f; }
        const float* Wg = F.a.in[I_WG] + ((size_t)(l * NE + ee) * D) * EW + u * 32; const float* Wu = F.a.in[I_WU] + ((size_t)(l * NE + ee) * D) * EW + u * 32;
        naive_dot<32>(fH(F) + (size_t)tok * D, Wg, EW, D, ag);
        naive_dot<32>(fH(F) + (size_t)tok * D, Wu, EW, D, au);
#pragma unroll
        for (int j = 0; j < 32; ++j) ag[j] = siluf(ag[j]) * au[j];
        if (valid) store_row_bf16<32>(ACT + (size_t)(be + pos) * EW + u * 32, ag);
    }
}
__device__ __forceinline__ void ph_moe_dn_naive(Frame& F, int l) {
    int cnt[16], base[16]; load_seg(F, l, cnt, base);
    const bf16* ACT = (const bf16*)(fA(F) + A_ACT); bf16* Y = (bf16*)(fA(F) + A_Y);
    int tot = 0;
#pragma unroll
    for (int i = 0; i < 16; ++i) tot += (cnt[i] + 63) >> 6;
    for (int it = F.gw; it < tot * 16; it += F.ngw) {
        const int gi_all = it >> 4, u = it & 15;
        int ee = 0, gs = 0;
#pragma unroll
        for (int i = 0, cum = 0; i < 16; ++i) { cum += (cnt[i] + 63) >> 6; if (gi_all >= cum) { gs = cum; ee = i + 1; } }
        int ce = 0, be = 0;
#pragma unroll
        for (int i = 0; i < 16; ++i) if (i == ee) { ce = cnt[i]; be = base[i]; }
        const int pos = (gi_all - gs) * 64 + F.lane; const bool valid = pos < ce;
        const int ent = flist(F)[ee * 16384 + (valid ? pos : 0)];
        float acc[64];
#pragma unroll
        for (int j = 0; j < 64; ++j) acc[j] = 0.f;
        const float* Wd = F.a.in[I_WD] + ((size_t)(l * NE + ee) * EW) * D + u * 64;
        naive_dot<64>(ACT + (size_t)(be + (valid ? pos : 0)) * EW, Wd, D, EW, acc);
        const float w = fwt(F)[ent];
#pragma unroll
        for (int j = 0; j < 64; ++j) acc[j] *= w;
        if (valid) store_row_bf16<64>(Y + (size_t)ent * D + u * 64, acc);
    }
}
__device__ __forceinline__ void ph_combine(Frame& F, int l, bool do_norm, bool dry = false) {
    const float dsc = dry ? 0.f : 1.f;
    const bf16* Y = (const bf16*)(fA(F) + A_Y);
    for (int r = F.gw; r < NTOK; r += F.ngw) {
        const int b = r >> 12;
        const float* gf = fmod(F) + (l * 4 + b) * 6144 + 5 * D;
        f32x4* xr = (f32x4*)(F.a.out + (size_t)r * D) + F.lane;
        const unsigned long long* ya = (const unsigned long long*)(Y + (size_t)(2 * r) * D) + F.lane; const unsigned long long* yb = (const unsigned long long*)(Y + (size_t)(2 * r + 1) * D) + F.lane;
        f32x4 v[4]; float s = 0.f;
#pragma unroll
        for (int j = 0; j < 4; ++j) {
            const unsigned long long a = ya[64 * j], bq = yb[64 * j];
            const f32x4 yy = { bf2f((unsigned)a & 0xffffu) + bf2f((unsigned)bq & 0xffffu), bf2f(((unsigned)a) >> 16) + bf2f(((unsigned)bq) >> 16),
                               bf2f((unsigned)(a >> 32) & 0xffffu) + bf2f((unsigned)(bq >> 32) & 0xffffu), bf2f((unsigned)(a >> 48)) + bf2f((unsigned)(bq >> 48)) };
            v[j] = xr[64 * j] + ((const f32x4*)gf)[F.lane + 64 * j] * yy * dsc;
            xr[64 * j] = v[j];
            s += (v[j].x * v[j].x + v[j].y * v[j].y) + (v[j].z * v[j].z + v[j].w * v[j].w);
        }
        if (do_norm) {
            const float rstd = rsqrtf(wave_sum(s) * (1.f / D) + EPS);
            const float* g = F.a.in[I_NMG] + (l + 1) * D; const float* sh = fmod(F) + ((l + 1) * 4 + b) * 6144; const float* sc = sh + D;
            unsigned long long* o8 = (unsigned long long*)(fH(F) + (size_t)r * D) + F.lane;
#pragma unroll
            for (int j = 0; j < 4; ++j) {
                const f32x4 gg = ((const f32x4*)g)[F.lane + 64 * j], s1 = ((const f32x4*)sh)[F.lane + 64 * j], s2 = ((const f32x4*)sc)[F.lane + 64 * j];
                const f32x4 y = (v[j] * rstd * gg) * (s2 + 1.f) + s1;
                o8[64 * j] = (unsigned long long)pk2(y.x, y.y) | ((unsigned long long)pk2(y.z, y.w) << 32);
            }
        }
    }
}
__device__ __forceinline__ void ph_sguin_naive(Frame& F) {
    bf16* U = (bf16*)(fA(F) + A_U); bf16* V = (bf16*)(fA(F) + A_V);
    for (int it = F.gw; it < 256 * 96; it += F.ngw) {
        const int rg = it / 96, u = it % 96, row = rg * 64 + F.lane;
        float acc[64];
#pragma unroll
        for (int j = 0; j < 64; ++j) acc[j] = 0.f;
        naive_dot<64>(fH(F) + (size_t)row * D, F.a.in[I_SWIN] + u * 64, 2 * SGW, D, acc);
        const float* bi = F.a.in[I_SBIN] + u * 64; float ss = 0.f;
#pragma unroll
        for (int j = 0; j < 64; ++j) { acc[j] = gelu_tanh(acc[j] + bi[j]); ss += acc[j] * acc[j]; }
        if (u < 48) store_row_bf16<64>(U + (size_t)row * SGW + u * 64, acc);
        else { store_row_bf16<64>(V + (size_t)row * SGW + (u - 48) * 64, acc); fvss(F)[(size_t)row * 48 + (u - 48)] = ss; }
    }
}
__device__ __forceinline__ void ph_sgumix_naive(Frame& F) {
    bf16* U = (bf16*)(fA(F) + A_U); const bf16* V = (const bf16*)(fA(F) + A_V);
    LAS float* rs = (LAS float*)F.lds;
    for (int bc = blockIdx.x; bc < NB * 32; bc += gridDim.x) {
        const size_t row0 = (size_t)bc * 128;
        __syncthreads();
        if (F.tid < 128) { float s = 0.f; for (int j = 0; j < 48; ++j) s += fvss(F)[(row0 + F.tid) * 48 + j]; rs[F.tid] = rsqrtf(s * (1.f / SGW) + EPS); }
        __syncthreads();
        for (int o = F.tid; o < 128 * SGW; o += NTHREADS) {
            const int i = o / SGW, c = o % SGW, g = c / 384;
            const float* ws = F.a.in[I_SWS] + ((size_t)g * 128 + i) * 128;
            float acc = 0.f;
            for (int j = 0; j < 128; ++j) acc += ws[j] * (bf2f(V[(row0 + j) * SGW + c]) * rs[j]);
            const float mixed = acc * F.a.in[I_SNG][c] + F.a.in[I_SBS][g * 128 + i];
            const size_t idx = (row0 + i) * SGW + c;
            U[idx] = (bf16)f2bf(bf2f(U[idx]) * mixed);
        }
    }
    __syncthreads();
}


namespace pg8 {
typedef short bf16x8 __attribute__((ext_vector_type(8)));
constexpr int BM = 256, BK = 64, HALF = 128, HTB = HALF * BK * 2, STAGE_BYTES = 8 * HTB;
__host__ __device__ __forceinline__ int lds_byte(int r, int c) { const int st = (r >> 4) * 2 + (c >> 5), rr = r & 15, cc = c & 31, ob = rr * 64 + cc * 2; return st * 1024 + (ob ^ (((ob >> 9) & 1) << 5)); }
__host__ __device__ __forceinline__ void stage_rc(int b, int& R, int& C) { const int st = b / 1024, sb = b % 1024, swz = sb ^ (((sb >> 9) & 1) << 5); R = (st >> 1) * 16 + swz / 64; C = (st & 1) * 32 + (swz % 64) / 2; }
struct Unit { int pm, pn; const char* Ab; const char* Bb; int x0, x1, x2; };
__device__ __forceinline__ unsigned cvt_pk_bf16(float lo, float hi) { unsigned r; asm volatile("v_cvt_pk_bf16_f32 %0, %1, %2" : "=v"(r) : "v"(lo), "v"(hi)); return r; }

template <class Sched, class Epi, bool ALIGN_EPI>
__device__ __forceinline__ void gemm_phase(LAS unsigned char* lds, const int K, const Sched& S, const Epi& E) {
    const int tid = threadIdx.x, wid = __builtin_amdgcn_readfirstlane(tid >> 6), lane = tid & 63, wr = wid >> 2, wc = wid & 3, fr = lane & 15, fq = lane >> 4;
    const int nt = K / BK;
    unsigned voffB[2];
#pragma unroll
    for (int i = 0; i < 2; ++i) { int R_, C_; stage_rc(tid * 16 + i * 8192, R_, C_); voffB[i] = (unsigned)(R_ * K + C_) * 2u; }
    const size_t kstep = (size_t)(BK * 2);
    const size_t hstep = (size_t)HALF * K * 2;
    const unsigned ldsw = (unsigned)wid * 1024u;
    const int aoff = lds_byte(wr * 64 + fr, fq * 8), boff = lds_byte(wc * 32 + fr, fq * 8);
#define PG8_SA(b, h) (((b) * 2 + (h)) * HTB)
#define PG8_SB(b, h) ((4 + (b) * 2 + (h)) * HTB)
#define PG8_STAGE(bufoff, gbase, voff) do { _Pragma("unroll") for (int _i = 0; _i < 2; ++_i) \
        __builtin_amdgcn_global_load_lds((const unsigned*)((const char*)(gbase) + (voff)[_i]), (LAS unsigned*)(lds + (bufoff) + ldsw + _i * 8192), 16, 0, 0); } while (0)
#define PG8_LDA(dst, b, h) do { _Pragma("unroll") for (int m = 0; m < 4; ++m) _Pragma("unroll") for (int k = 0; k < 2; ++k) dst[m][k] = *(const LAS bf16x8*)(lds + PG8_SA(b, h) + aoff + m * 2048 + k * 1024); } while (0)
#define PG8_LDB(dst, b, h) do { _Pragma("unroll") for (int n = 0; n < 2; ++n) _Pragma("unroll") for (int k = 0; k < 2; ++k) dst[n][k] = *(const LAS bf16x8*)(lds + PG8_SB(b, h) + boff + n * 2048 + k * 1024); } while (0)
#define PG8_MMA(ai, bj, At, Bt) do { __builtin_amdgcn_s_setprio(1); _Pragma("unroll") for (int m = 0; m < 4; ++m) _Pragma("unroll") for (int n = 0; n < 2; ++n) _Pragma("unroll") for (int k = 0; k < 2; ++k) \
        acc[ai][bj][m][n] = __builtin_amdgcn_mfma_f32_16x16x32_bf16(Bt[n][k], At[m][k], acc[ai][bj][m][n], 0, 0, 0); __builtin_amdgcn_s_setprio(0); } while (0)
#define PG8_WAIT_V(n) asm volatile("s_waitcnt vmcnt(" #n ")" ::: "memory")
#define PG8_WAIT_L(n) asm volatile("s_waitcnt lgkmcnt(" #n ")" ::: "memory")
#define PG8_BAR __builtin_amdgcn_s_barrier()
#define PG8_SCHED __builtin_amdgcn_sched_barrier(0)
    Unit cur, nxt; int ui = 0;
    if (!S.next(0, cur)) return;
    unsigned vA[2][2];
    S.arows(cur, vA);
    asm volatile("" : "+v"(vA[0][0]), "+v"(vA[0][1]), "+v"(vA[1][0]), "+v"(vA[1][1]));
    f32x4 acc[2][2][4][2];
#pragma unroll
    for (int a = 0; a < 2; ++a)
#pragma unroll
        for (int b = 0; b < 2; ++b)
#pragma unroll
            for (int m = 0; m < 4; ++m)
#pragma unroll
                for (int n = 0; n < 2; ++n) acc[a][b][m][n] = (f32x4){0.f, 0.f, 0.f, 0.f};
    bf16x8 At[4][2], B0[2][2], B1[2][2];
    const char* cA = cur.Ab; const char* cB = cur.Bb;
    PG8_STAGE(PG8_SB(0, 0), cB, voffB); PG8_STAGE(PG8_SB(0, 1), cB + hstep, voffB); PG8_STAGE(PG8_SA(0, 0), cA, vA[0]); PG8_STAGE(PG8_SA(0, 1), cA, vA[1]);
    if (wr == 1) PG8_BAR;
    PG8_WAIT_V(2); PG8_BAR;
    PG8_STAGE(PG8_SB(1, 0), cB + kstep, voffB); PG8_STAGE(PG8_SA(1, 0), cA + kstep, vA[0]); PG8_STAGE(PG8_SB(1, 1), cB + hstep + kstep, voffB);
    PG8_WAIT_V(6); PG8_BAR;
    for (;;) {
        const bool has_next = S.next(ui + 1, nxt);
        const char* nA = has_next ? nxt.Ab : cA; const char* nB = has_next ? nxt.Bb : cB;
        for (int t = 0; t < nt; t += 2) {
            const bool last = (t == nt - 2);
            const char* a1 = cA + (size_t)(t + 1) * kstep;
            const char* a2 = last ? nA : cA + (size_t)(t + 2) * kstep; const char* b2 = last ? nB : cB + (size_t)(t + 2) * kstep;
            const char* a3 = a2 + kstep; const char* b3 = b2 + kstep;
            unsigned w0[2], w1[2];
            w0[0] = vA[0][0]; w0[1] = vA[0][1]; w1[0] = vA[1][0]; w1[1] = vA[1][1];
            if (last && has_next) { unsigned nv[2][2]; pg8::Unit tu = nxt; asm volatile("" : "+v"(tu.pm)); S.arows(tu, nv);
                asm volatile("" : "+v"(nv[0][0]), "+v"(nv[0][1]), "+v"(nv[1][0]), "+v"(nv[1][1]));
                w0[0] = nv[0][0]; w0[1] = nv[0][1]; w1[0] = nv[1][0]; w1[1] = nv[1][1]; }
            PG8_LDB(B0, 0, 0); PG8_LDB(B1, 0, 1); PG8_SCHED; PG8_LDA(At, 0, 0); PG8_STAGE(PG8_SA(1, 1), a1, vA[1]);
            PG8_WAIT_V(8); PG8_WAIT_L(0); PG8_BAR; PG8_MMA(0, 0, At, B0); PG8_MMA(0, 1, At, B1); PG8_BAR; PG8_SCHED;
            PG8_LDA(At, 0, 1); PG8_STAGE(PG8_SB(0, 0), b2, voffB); PG8_STAGE(PG8_SB(0, 1), b2 + hstep, voffB); PG8_STAGE(PG8_SA(0, 0), a2, w0);
            PG8_WAIT_V(8); PG8_WAIT_L(0); PG8_BAR; PG8_MMA(1, 0, At, B0); PG8_MMA(1, 1, At, B1); PG8_BAR; PG8_SCHED;
            PG8_LDB(B0, 1, 0); PG8_LDB(B1, 1, 1); PG8_SCHED; PG8_LDA(At, 1, 0); PG8_STAGE(PG8_SA(0, 1), a2, w1);
            PG8_WAIT_V(8); PG8_WAIT_L(0); PG8_BAR; PG8_MMA(0, 0, At, B0); PG8_MMA(0, 1, At, B1); PG8_BAR; PG8_SCHED;
            PG8_LDA(At, 1, 1); PG8_STAGE(PG8_SB(1, 0), b3, voffB); PG8_STAGE(PG8_SB(1, 1), b3 + hstep, voffB); PG8_STAGE(PG8_SA(1, 0), a3, w0);
            PG8_WAIT_V(8); PG8_WAIT_L(0); PG8_BAR; PG8_MMA(1, 0, At, B0); PG8_MMA(1, 1, At, B1); PG8_BAR; PG8_SCHED;
        }
        if constexpr (ALIGN_EPI) { if (wr == 0) PG8_BAR; }
        E(acc, cur, wr, wc, fr, fq);
        if (!has_next) break;
#pragma unroll
        for (int a = 0; a < 2; ++a)
#pragma unroll
            for (int b = 0; b < 2; ++b)
#pragma unroll
                for (int m = 0; m < 4; ++m)
#pragma unroll
                    for (int n = 0; n < 2; ++n) acc[a][b][m][n] = (f32x4){0.f, 0.f, 0.f, 0.f};
        cur = nxt; cA = nA; cB = nB; ++ui;
        S.arows(cur, vA);
        asm volatile("" : "+v"(vA[0][0]), "+v"(vA[0][1]), "+v"(vA[1][0]), "+v"(vA[1][1]));
        if constexpr (ALIGN_EPI) { if (wr == 1) PG8_BAR; }
    }
    PG8_WAIT_V(0);
    if constexpr (!ALIGN_EPI) { if (wr == 0) PG8_BAR; }
    PG8_BAR;
#undef PG8_SA
#undef PG8_SB
#undef PG8_STAGE
#undef PG8_LDA
#undef PG8_LDB
#undef PG8_MMA
#undef PG8_WAIT_V
#undef PG8_WAIT_L
#undef PG8_BAR
#undef PG8_SCHED
}
}

constexpr size_t WB_WIN = 0;
constexpr size_t WB_WOUT = WB_WIN + (size_t)ABW * D * 2;
constexpr size_t WB_SWIN = WB_WOUT + (size_t)D * D * 2;
constexpr size_t WB_SWOUT = WB_SWIN + (size_t)2 * SGW * D * 2;
constexpr size_t WB_GU = WB_SWOUT + (size_t)D * SGW * 2;
constexpr size_t WB_DN = WB_GU + (size_t)2 * NE * 1024 * D * 2;
constexpr size_t WB_WS = WB_DN + (size_t)2 * NE * D * EW * 2;
constexpr size_t WB_END = WB_WS + (size_t)8 * 128 * 128 * 2;
static_assert(WB_END <= 124 * MiB, "bf16 weights fit");

__device__ __forceinline__ int slot_of(int mode, int c) {
    if (mode == 0) { const int bj = (c >> 7) & 1, wc = (c >> 5) & 3, fq = (c >> 3) & 3, nn = (c >> 2) & 1, rg = c & 3; return 128 * bj + 32 * wc + 16 * nn + 4 * fq + rg; }
    if (mode == 1) { const int wc = (c >> 6) & 3, bj = (c >> 5) & 1, nn = (c >> 4) & 1, fq = (c >> 2) & 3, rg = c & 3; return 128 * bj + 32 * wc + 16 * nn + 4 * fq + rg; }
    const int wc = (c >> 6) & 3, bj = (c >> 5) & 1, fq = (c >> 3) & 3, nn = (c >> 2) & 1, rg = c & 3; return 128 * bj + 32 * wc + 16 * nn + 4 * fq + rg;
}
template <class RowFn> __device__ __forceinline__ void conv_item(const float* W, int ldw, int k0, int n0, bf16* WT, int Kp, LAS float* scr, int lane, const RowFn& rowfn) {
    f32x4 v[8];
#pragma unroll
    for (int i = 0; i < 8; ++i) { const int kk = 8 * i + (lane >> 3); v[i] = *(const f32x4*)(W + (size_t)(k0 + kk) * ldw + n0 + 4 * (lane & 7)); }
#pragma unroll
    for (int i = 0; i < 8; ++i) { const int kk = 8 * i + (lane >> 3); LAS float* p = scr + kk * 33 + 4 * (lane & 7); p[0] = v[i].x; p[1] = v[i].y; p[2] = v[i].z; p[3] = v[i].w; }
    asm volatile("s_waitcnt lgkmcnt(0)" ::: "memory");
    const int c = lane & 7;
#pragma unroll
    for (int j = 0; j < 4; ++j) { const int n = (lane >> 3) + 8 * j; const LAS float* sp = scr + (8 * c) * 33 + n;
        u32x4 o; o.x = pk2(sp[0 * 33], sp[1 * 33]); o.y = pk2(sp[2 * 33], sp[3 * 33]); o.z = pk2(sp[4 * 33], sp[5 * 33]); o.w = pk2(sp[6 * 33], sp[7 * 33]);
        *(u32x4*)(WT + (size_t)rowfn(n0 + n) * Kp + k0 + 8 * c) = o; }
    asm volatile("s_waitcnt lgkmcnt(0)" ::: "memory");
}
__device__ __forceinline__ void ph_convert(Frame& F, int set, int wj, int nw, int pct_lo = 0, int pct_hi = 100) {
    LAS float* scr = (LAS float*)(F.lds + F.wave * 16384);
    bf16* WB = (bf16*)(F.a.ws + WS_WB);
    constexpr int I_1 = 16 * 112, I_2 = 16 * 32, I_3 = 16 * 192, I_4 = 48 * 32, I_5 = 32 * 512, I_6 = 32 * 256, I_7 = 8 * 128 * 128 / 512;
    constexpr int B5 = I_1 + I_2 + I_3 + I_4, B6 = B5 + I_5, B7 = B6 + I_6;
    constexpr int N_EARLY = I_1 + I_2 + I_5 / 2 + I_6 / 2, N_LATE = I_3 + I_4 + I_5 / 2 + I_6 / 2 + I_7;
    const int nset = set == 0 ? N_EARLY : N_LATE; const int jlo = nset * pct_lo / 100, jhi = nset * pct_hi / 100;
    for (int j = jlo + wj; j < jhi; j += nw) {
        int r;
        if (set == 0) { if (j < I_1 + I_2) r = j; else if (j < I_1 + I_2 + I_5 / 2) r = B5 + (j - (I_1 + I_2)); else r = B6 + (j - (I_1 + I_2 + I_5 / 2)); }
        else { if (j < I_3 + I_4) r = I_1 + I_2 + j; else if (j < I_3 + I_4 + I_5 / 2) r = B5 + I_5 / 2 + (j - (I_3 + I_4)); else if (j < I_3 + I_4 + I_5 / 2 + I_6 / 2) r = B6 + I_6 / 2 + (j - (I_3 + I_4 + I_5 / 2)); else r = B7 + (j - (I_3 + I_4 + I_5 / 2 + I_6 / 2)); }
        if (r < I_1) { const int kb = r / 112, nb = r % 112, n0 = nb * 32; const int tile = n0 >> 8, ty = tile >> 1; const int mode = (ty == 0 || ty == 4) ? 1 : 2;
            conv_item(F.a.in[I_WIN], ABW, kb * 64, n0, (bf16*)((char*)WB + WB_WIN), D, scr, F.lane, [=](int n) { return (n & ~255) + slot_of(mode, n & 255); }); continue; } r -= I_1;
        if (r < I_2) { const int kb = r / 32, nb = r % 32;
            conv_item(F.a.in[I_WOUT], D, kb * 64, nb * 32, (bf16*)((char*)WB + WB_WOUT), D, scr, F.lane, [=](int n) { return (n & ~255) + slot_of(0, n & 255); }); continue; } r -= I_2;
        if (r < I_3) { const int kb = r / 192, nb = r % 192;
            conv_item(F.a.in[I_SWIN], 2 * SGW, kb * 64, nb * 32, (bf16*)((char*)WB + WB_SWIN), D, scr, F.lane, [=](int n) { return (n & ~255) + slot_of(0, n & 255); }); continue; } r -= I_3;
        if (r < I_4) { const int kb = r / 32, nb = r % 32;
            conv_item(F.a.in[I_SWOUT], D, kb * 64, nb * 32, (bf16*)((char*)WB + WB_SWOUT), SGW, scr, F.lane, [=](int n) { return (n & ~255) + slot_of(0, n & 255); }); continue; } r -= I_4;
        if (r < I_5) { const int le = r / 512, q = r % 512, which = q >> 8, kb = (q & 255) / 16, nb = q % 16;
            const float* W = (which ? F.a.in[I_WU] : F.a.in[I_WG]) + (size_t)le * D * EW;
            conv_item(W, EW, kb * 64, nb * 32, (bf16*)((char*)WB + WB_GU) + (size_t)le * 1024 * D, D, scr, F.lane,
                      [=](int jc) { const int w = jc & 127; return (jc >> 7) * 256 + 128 * which + 32 * ((w >> 5) & 3) + 16 * ((w >> 2) & 1) + 4 * ((w >> 3) & 3) + (w & 3); }); continue; } r -= I_5;
        if (r < I_6) { const int le = r / 256, q = r % 256, kb = q / 32, nb = q % 32;
            conv_item(F.a.in[I_WD] + (size_t)le * EW * D, D, kb * 64, nb * 32, (bf16*)((char*)WB + WB_DN) + (size_t)le * D * EW, EW, scr, F.lane, [=](int n) { return (n & ~255) + slot_of(0, n & 255); }); continue; } r -= I_6;
        {
            const float* src = F.a.in[I_SWS] + (size_t)r * 512 + F.lane * 8; const f32x4 a = *(const f32x4*)src, b2 = *(const f32x4*)(src + 4);
            u32x4 o; o.x = pk2(a.x, a.y); o.y = pk2(a.z, a.w); o.z = pk2(b2.x, b2.y); o.w = pk2(b2.z, b2.w);
            *(u32x4*)((bf16*)((char*)WB + WB_WS) + (size_t)r * 512 + F.lane * 8) = o; }
    }
}

struct DenseSched {
    const char* A; const char* Bt; int K, nM, nN, G, c, nwg, xM0, xN, nx, rep;
    __device__ __forceinline__ bool next(int i, pg8::Unit& u) const {
        int L = i * G + c; if (L >= (nwg + nx) * rep) return false; L %= (nwg + nx);
        if (L < nwg) { int wgid = L; { const int q = nwg / 8, r = nwg % 8, xcd = wgid % 8, off = wgid / 8; wgid = (xcd < r ? xcd * (q + 1) : r * (q + 1) + (xcd - r) * q) + off; }
            const int nig = 8 * nN, gid = wgid / nig, fm = gid * 8, gsz = (nM - fm) < 8 ? (nM - fm) : 8;
            u.pm = fm + ((wgid % nig) % gsz); u.pn = (wgid % nig) / gsz; }
        else { const int j = L - nwg; u.pm = xM0 + j / xN; u.pn = j % xN; }
        u.Ab = A; u.Bb = Bt + (size_t)u.pn * 256 * K * 2; u.x0 = 0; u.x1 = 0; u.x2 = 0; return true;
    }
    __device__ __forceinline__ void arows(const pg8::Unit& u, unsigned (&v)[2][2]) const {
#pragma unroll
        for (int i = 0; i < 2; ++i) { int R, C; pg8::stage_rc((int)threadIdx.x * 16 + i * 8192, R, C);
#pragma unroll
            for (int h = 0; h < 2; ++h) v[h][i] = (unsigned)((u.pm * 256 + h * 128 + R) * K + C) * 2u; }
    }
};
struct MoeSched {
    const char* A; const char* Bt; int K, G, c, total; const LAS int* tab; const int* LIST; int gather, rep;
    __device__ __forceinline__ bool next(int i, pg8::Unit& u) const {
        int L = i * G + c; if (L >= total * rep) return false; L %= total;
        if ((G & 7) == 0) { const int q = total / 8, r8 = total % 8, xcd = L % 8, off = L / 8; L = (xcd < r8 ? xcd * (q + 1) : r8 * (q + 1) + (xcd - r8) * q) + off; }
        const int rt = L >> 2; u.pn = L & 3; int ee = 0;
#pragma unroll
        for (int e = 0; e < 16; ++e) { if (tab[e * 4] <= rt && tab[e * 4 + 1] > 0) ee = e; }
        u.pm = rt - tab[ee * 4]; u.x0 = ee; u.x1 = tab[ee * 4 + 1]; u.x2 = tab[ee * 4 + 2];
        u.Ab = A; u.Bb = Bt + ((size_t)ee * 1024 + u.pn * 256) * K * 2; return true;
    }
    __device__ __forceinline__ void arows(const pg8::Unit& u, unsigned (&v)[2][2]) const {
#pragma unroll
        for (int i = 0; i < 2; ++i) { int R, C; pg8::stage_rc((int)threadIdx.x * 16 + i * 8192, R, C);
#pragma unroll
            for (int h = 0; h < 2; ++h) { const int pos = u.pm * 256 + h * 128 + R; int row;
                if (gather) { const int ent = LIST[u.x0 * 16384 + (pos < u.x1 ? pos : u.pm * 256)]; row = ent >> 1; } else row = u.x2 + pos;
                v[h][i] = (unsigned)(row * K + C) * 2u; } }
    }
};

typedef unsigned u32x2 __attribute__((ext_vector_type(2)));
struct EpiInproj {
    unsigned char* Areg; const LAS float* ROPE; const float* kg; const float* qg;
    __device__ __forceinline__ void operator()(f32x4 (&acc)[2][2][4][2], const pg8::Unit& u, int wr, int wc, int fr, int fq) const {
        const int ty = u.pn >> 1, head = (u.pn & 1) * 4 + wc;
        const size_t off_t = ty < 4 ? (size_t)ty * 17 * MiB : (size_t)(68 + (ty - 4) * 16) * MiB;
        bf16* dst = (bf16*)(Areg + off_t);
        const int row0 = u.pm * 256 + wr * 64 + fr;
        if (ty == 0 || ty == 4) {
            const float sc = ty == 0 ? 0.125f : 1.f;
#pragma unroll
            for (int ai = 0; ai < 2; ++ai)
#pragma unroll
                for (int m = 0; m < 4; ++m) { const int row = row0 + ai * 128 + m * 16; const int tt = row & 4095; const bool lat = row < NTOK;
#pragma unroll
                    for (int bj = 0; bj < 2; ++bj) { const int pos = bj ? (tt & 63) : (tt >> 6);
                        f32x4 u1 = acc[ai][bj][m][0], u2 = acc[ai][bj][m][1];
                        if (lat) { const f32x4 cs0 = *(const LAS f32x4*)(ROPE + (pos * 16 + 4 * fq) * 2), cs1 = *(const LAS f32x4*)(ROPE + (pos * 16 + 4 * fq) * 2 + 4);
                            const f32x4 co = { cs0.x, cs0.z, cs1.x, cs1.z }, si = { cs0.y, cs0.w, cs1.y, cs1.w };
                            const f32x4 a = u1 * co - u2 * si, b = u1 * si + u2 * co; u1 = a; u2 = b; }
                        u1 = u1 * sc; u2 = u2 * sc;
                        bf16* p = dst + (size_t)row * HW + head * 64 + 32 * bj + 4 * fq;
                        u32x2 w; w.x = pg8::cvt_pk_bf16(u1.x, u1.y); w.y = pg8::cvt_pk_bf16(u1.z, u1.w); *(u32x2*)p = w;
                        w.x = pg8::cvt_pk_bf16(u2.x, u2.y); w.y = pg8::cvt_pk_bf16(u2.z, u2.w); *(u32x2*)(p + 16) = w; } }
        } else {
            const bool nrm = (ty == 2 || ty == 6);
            f32x4 g[2][2];
            if (nrm) { const float* gp = ty == 2 ? kg : qg;
#pragma unroll
                for (int bj = 0; bj < 2; ++bj)
#pragma unroll
                    for (int n = 0; n < 2; ++n) g[bj][n] = *(const f32x4*)(gp + 32 * bj + 8 * fq + 4 * n) * (ty == 6 ? 0.125f : 1.f); }
#pragma unroll
            for (int ai = 0; ai < 2; ++ai)
#pragma unroll
                for (int m = 0; m < 4; ++m) { const int row = row0 + ai * 128 + m * 16;
                    f32x4 v[2][2];
#pragma unroll
                    for (int bj = 0; bj < 2; ++bj)
#pragma unroll
                        for (int n = 0; n < 2; ++n) v[bj][n] = acc[ai][bj][m][n];
                    if (nrm) { float ss = 0.f;
#pragma unroll
                        for (int bj = 0; bj < 2; ++bj)
#pragma unroll
                            for (int n = 0; n < 2; ++n) ss += (v[bj][n].x * v[bj][n].x + v[bj][n].y * v[bj][n].y) + (v[bj][n].z * v[bj][n].z + v[bj][n].w * v[bj][n].w);
                        ss += __shfl_xor(ss, 16); ss += __shfl_xor(ss, 32);
                        const float rs = rsqrtf(ss * (1.f / 64.f) + EPS);
#pragma unroll
                        for (int bj = 0; bj < 2; ++bj)
#pragma unroll
                            for (int n = 0; n < 2; ++n) v[bj][n] = v[bj][n] * rs * g[bj][n]; }
                    if (ty == 5) {
#pragma unroll
                        for (int bj = 0; bj < 2; ++bj)
#pragma unroll
                            for (int n = 0; n < 2; ++n)
#pragma unroll
                                for (int q = 0; q < 4; ++q) v[bj][n][q] = siluf(v[bj][n][q]); }
#pragma unroll
                    for (int bj = 0; bj < 2; ++bj) { u32x4 w; w.x = pg8::cvt_pk_bf16(v[bj][0].x, v[bj][0].y); w.y = pg8::cvt_pk_bf16(v[bj][0].z, v[bj][0].w); w.z = pg8::cvt_pk_bf16(v[bj][1].x, v[bj][1].y); w.w = pg8::cvt_pk_bf16(v[bj][1].z, v[bj][1].w);
                        *(u32x4*)(dst + (size_t)row * HW + head * 64 + 32 * bj + 8 * fq) = w; } }
        }
    }
};
struct EpiRes {
    const float* base; float* out; const float* gate;
    __device__ __forceinline__ void operator()(f32x4 (&acc)[2][2][4][2], const pg8::Unit& u, int wr, int wc, int fr, int fq) const {
        const int b = u.pm >> 4, col0 = u.pn * 256 + wc * 32 + 8 * fq, row0 = u.pm * 256 + wr * 64 + fr;
        f32x4 gv[2][2];
#pragma unroll
        for (int bj = 0; bj < 2; ++bj)
#pragma unroll
            for (int n = 0; n < 2; ++n) gv[bj][n] = *(const f32x4*)(gate + b * 6144 + col0 + bj * 128 + 4 * n);
#pragma unroll
        for (int ai = 0; ai < 2; ++ai)
#pragma unroll
            for (int m = 0; m < 4; ++m) { const size_t off = (size_t)(row0 + ai * 128 + m * 16) * D + col0;
#pragma unroll
                for (int bj = 0; bj < 2; ++bj)
#pragma unroll
                    for (int n = 0; n < 2; ++n) { const f32x4 bs = *(const f32x4*)(base + off + bj * 128 + 4 * n); *(f32x4*)(out + off + bj * 128 + 4 * n) = bs + gv[bj][n] * acc[ai][bj][m][n]; } }
    }
};
__device__ __forceinline__ float gelu_fast(float v) { const float u2 = -2.302208198f * (v + 0.044715f * v * v * v); return v * __builtin_amdgcn_rcpf(1.f + __builtin_amdgcn_exp2f(u2)); }
struct EpiSguIn {
    bf16* U; bf16* V; const float* bias; float* VSS;
    __device__ __forceinline__ void operator()(f32x4 (&acc)[2][2][4][2], const pg8::Unit& u, int wr, int wc, int fr, int fq) const {
        const int col0 = u.pn * 256 + wc * 32 + 8 * fq, row0 = u.pm * 256 + wr * 64 + fr; const bool isv = u.pn >= 12;
        bf16* dstb = isv ? V + (col0 - SGW) : U + col0;
        f32x4 bv[2][2];
#pragma unroll
        for (int bj = 0; bj < 2; ++bj)
#pragma unroll
            for (int n = 0; n < 2; ++n) bv[bj][n] = *(const f32x4*)(bias + col0 + bj * 128 + 4 * n);
#pragma unroll
        for (int ai = 0; ai < 2; ++ai)
#pragma unroll
            for (int m = 0; m < 4; ++m) { const int row = row0 + ai * 128 + m * 16; float ss = 0.f;
#pragma unroll
                for (int bj = 0; bj < 2; ++bj) { f32x4 z0 = acc[ai][bj][m][0] + bv[bj][0], z1 = acc[ai][bj][m][1] + bv[bj][1];
#pragma unroll
                    for (int q = 0; q < 4; ++q) { z0[q] = gelu_fast(z0[q]); z1[q] = gelu_fast(z1[q]); }
                    ss += (z0.x * z0.x + z0.y * z0.y) + (z0.z * z0.z + z0.w * z0.w) + (z1.x * z1.x + z1.y * z1.y) + (z1.z * z1.z + z1.w * z1.w);
                    u32x4 w; w.x = pg8::cvt_pk_bf16(z0.x, z0.y); w.y = pg8::cvt_pk_bf16(z0.z, z0.w); w.z = pg8::cvt_pk_bf16(z1.x, z1.y); w.w = pg8::cvt_pk_bf16(z1.z, z1.w);
                    *(u32x4*)(dstb + (size_t)row * SGW + bj * 128) = w; }
                if (isv) { ss += __shfl_xor(ss, 16); ss += __shfl_xor(ss, 32); if (fq == 0) VSS[(size_t)row * 48 + (u.pn - 12) * 4 + wc] = ss; } }
    }
};
struct EpiMoeGU {
    bf16* ACT;
    __device__ __forceinline__ void operator()(f32x4 (&acc)[2][2][4][2], const pg8::Unit& u, int wr, int wc, int fr, int fq) const {
        const int col0 = u.pn * 128 + wc * 32 + 8 * fq, row0 = u.x2 + u.pm * 256 + wr * 64 + fr;
#pragma unroll
        for (int ai = 0; ai < 2; ++ai)
#pragma unroll
            for (int m = 0; m < 4; ++m) { f32x4 a0 = acc[ai][0][m][0], a1 = acc[ai][0][m][1]; const f32x4 b0 = acc[ai][1][m][0], b1 = acc[ai][1][m][1];
#pragma unroll
                for (int q = 0; q < 4; ++q) { a0[q] = a0[q] * __builtin_amdgcn_rcpf(1.f + __builtin_amdgcn_exp2f(-1.44269504f * a0[q])) * b0[q]; a1[q] = a1[q] * __builtin_amdgcn_rcpf(1.f + __builtin_amdgcn_exp2f(-1.44269504f * a1[q])) * b1[q]; }
                u32x4 w; w.x = pg8::cvt_pk_bf16(a0.x, a0.y); w.y = pg8::cvt_pk_bf16(a0.z, a0.w); w.z = pg8::cvt_pk_bf16(a1.x, a1.y); w.w = pg8::cvt_pk_bf16(a1.z, a1.w);
                *(u32x4*)(ACT + (size_t)(row0 + ai * 128 + m * 16) * EW + col0) = w; }
    }
};
struct EpiMoeDn {
    bf16* Y; const int* LIST; const float* WT;
    __device__ __forceinline__ void operator()(f32x4 (&acc)[2][2][4][2], const pg8::Unit& u, int wr, int wc, int fr, int fq) const {
        const int col0 = u.pn * 256 + wc * 32 + 8 * fq;
#pragma unroll
        for (int ai = 0; ai < 2; ++ai) {
            int ent[4]; float w8[4];
#pragma unroll
            for (int m = 0; m < 4; ++m) { const int pos = u.pm * 256 + ai * 128 + wr * 64 + m * 16 + fr; ent[m] = pos < u.x1 ? LIST[u.x0 * 16384 + pos] : -1; }
#pragma unroll
            for (int m = 0; m < 4; ++m) w8[m] = ent[m] >= 0 ? WT[ent[m]] : 0.f;
#pragma unroll
            for (int m = 0; m < 4; ++m) {
                if (ent[m] >= 0) {
#pragma unroll
                    for (int bj = 0; bj < 2; ++bj) { const f32x4 a0 = acc[ai][bj][m][0] * w8[m], a1 = acc[ai][bj][m][1] * w8[m];
                        u32x4 w; w.x = pg8::cvt_pk_bf16(a0.x, a0.y); w.y = pg8::cvt_pk_bf16(a0.z, a0.w); w.z = pg8::cvt_pk_bf16(a1.x, a1.y); w.w = pg8::cvt_pk_bf16(a1.z, a1.w);
                        *(u32x4*)(Y + (size_t)ent[m] * D + col0 + bj * 128) = w; } } }
            asm volatile("" ::: "memory");
        }
    }
};
__device__ __forceinline__ int moe_tab(Frame& F, int l, LAS int* tab) {
    __syncthreads();
    if (F.tid == 0) { int tiles = 0, base = 0;
        for (int e = 0; e < 16; ++e) { const int c = (int)__hip_atomic_load(fctl(F) + CW_CNT + l * 1024 + e * 64, RLX_AGENT); tab[e * 4] = tiles; tab[e * 4 + 1] = c; tab[e * 4 + 2] = base; tab[e * 4 + 3] = 0; tiles += (c + 255) >> 8; base += (c + 255) & ~255; }
        tab[64] = tiles; }
    __syncthreads();
    return tab[64];
}


typedef short bf16x8 __attribute__((ext_vector_type(8)));
typedef short s16x4 __attribute__((ext_vector_type(4)));
typedef short v4i16_t __attribute__((ext_vector_type(4)));
__device__ __forceinline__ s16x4 tr_read(const LAS unsigned char* p) { return __builtin_bit_cast(s16x4, __builtin_amdgcn_ds_read_tr16_b64_v4i16((LAS v4i16_t*)p)); }
__device__ __forceinline__ bf16x8 cat8(s16x4 a, s16x4 b) { return (bf16x8){a[0], a[1], a[2], a[3], b[0], b[1], b[2], b[3]}; }
__device__ __forceinline__ bf16x8 pk8(f32x4 a, f32x4 b) { u32x4 w; w.x = pg8::cvt_pk_bf16(a.x, a.y); w.y = pg8::cvt_pk_bf16(a.z, a.w); w.z = pg8::cvt_pk_bf16(b.x, b.y); w.w = pg8::cvt_pk_bf16(b.z, b.w); return __builtin_bit_cast(bf16x8, w); }
#define MFMA16(a, b, c) __builtin_amdgcn_mfma_f32_16x16x32_bf16((a), (b), (c), 0, 0, 0)
constexpr int VST = 144;
constexpr size_t A_KV = 148 * MiB;

__device__ __forceinline__ void ph_na(Frame& F) {
    const bf16* NK = (const bf16*)(fA(F) + A_NK); const bf16* NV = (const bf16*)(fA(F) + A_NV); const bf16* NQ = (const bf16*)(fA(F) + A_NQ); bf16* MIX = (bf16*)(fA(F) + A_MIX);
    LAS unsigned char* Vl = F.lds;
    LAS float* mrg = (LAS float*)(F.lds + 832 * VST);
    LAS float* rpbl = (LAS float*)(F.lds + 832 * VST + 4 * 1056 * 4);
    const int lane = F.lane, wave = F.wave, sb = wave & 3, half = wave >> 2, q16 = lane & 15, rq = lane >> 4;
    const int tq = (lane & 15) >> 2, tp = lane & 3;
    const int vcol = F.tid >> 3, vch = F.tid & 7;
    const float L2E = 1.44269504f;
    const int w0 = sb == 0 ? 0 : (sb == 1 ? 8 : (sb == 2 ? 24 : 32));
    for (int tg0 = blockIdx.x; tg0 < 256; tg0 += gridDim.x) {
        const int tg = (gridDim.x == 256) ? ((tg0 & 7) * 32 + (tg0 >> 3)) : tg0;
        const int bh = tg >> 3, b = bh >> 3, h = bh & 7, rbase = (tg & 7) * 8;
        __syncthreads();
#pragma unroll
        for (int pass = 0; pass < 4; ++pass) { const int n = pass * 64 + vcol;
            *(LAS u32x4*)(Vl + (576 + n) * VST + vch * 16) = *(const u32x4*)(NV + ((size_t)(NTOK + b * CTXL + n)) * HW + h * 64 + vch * 8); }
        for (int i = F.tid; i < 465; i += NTHREADS) rpbl[i] = F.a.in[I_RPB][h * 465 + i];
        { int r0 = rbase - 4; r0 = r0 < 0 ? 0 : (r0 > 56 ? 56 : r0);
#pragma unroll
          for (int k8 = 0; k8 < 8; ++k8) { const int kr = r0 + k8;
              *(LAS u32x4*)(Vl + ((kr % 9) * 64 + vcol) * VST + vch * 16) = *(const u32x4*)(NV + ((size_t)(b * SEQ + kr * 64 + vcol)) * HW + h * 64 + vch * 8); } }
        bf16x8 kfc[8][2];
#pragma unroll
        for (int cb = 0; cb < 8; ++cb) { const bf16* kp = NK + ((size_t)(NTOK + b * CTXL + 128 * half + 16 * cb + q16)) * HW + h * 64 + 8 * rq; kfc[cb][0] = *(const bf16x8*)kp; kfc[cb][1] = *(const bf16x8*)(kp + 32); }
        __syncthreads();
#pragma unroll 1
        for (int ti = 0; ti < 8; ++ti) {
            const int r = rbase + ti; int r0 = r - 4; r0 = r0 < 0 ? 0 : (r0 > 56 ? 56 : r0);
            int r0n = r - 3; r0n = r0n < 0 ? 0 : (r0n > 56 ? 56 : r0n);
            const bool newrow = (ti < 7) && (r0n != r0); const int krn = r0n + 7;
            const int c = 16 * sb + q16; const size_t qrow = (size_t)b * SEQ + r * 64 + c;
            int c0 = c - 8; c0 = c0 < 0 ? 0 : (c0 > 48 ? 48 : c0);
            bf16x8 qf[2], kfl[8][2];
#pragma unroll
            for (int ks = 0; ks < 2; ++ks) qf[ks] = *(const bf16x8*)(NQ + qrow * HW + h * 64 + 8 * rq + 32 * ks);
#pragma unroll
            for (int lb = 0; lb < 8; ++lb) { const int kr = r0 + 4 * half + (lb >> 1), cb = w0 + 16 * (lb & 1);
                const bf16* kp = NK + ((size_t)(b * SEQ + kr * 64 + cb + q16)) * HW + h * 64 + 8 * rq; kfl[lb][0] = *(const bf16x8*)kp; kfl[lb][1] = *(const bf16x8*)(kp + 32); }
            u32x4 vnext = {0u, 0u, 0u, 0u};
            if (newrow) vnext = *(const u32x4*)(NV + ((size_t)(b * SEQ + krn * 64 + vcol)) * HW + h * 64 + vch * 8);
            f32x4 sc[16];
#pragma unroll
            for (int cb = 0; cb < 8; ++cb) { f32x4 a = MFMA16(kfc[cb][0], qf[0], ((f32x4){0.f, 0.f, 0.f, 0.f})); a = MFMA16(kfc[cb][1], qf[1], a); sc[8 + cb] = a; }
#pragma unroll
            for (int lb = 0; lb < 8; ++lb) { const int kr = r0 + 4 * half + (lb >> 1), cb = w0 + 16 * (lb & 1);
                f32x4 a = MFMA16(kfl[lb][0], qf[0], ((f32x4){0.f, 0.f, 0.f, 0.f})); a = MFMA16(kfl[lb][1], qf[1], a);
#pragma unroll
                for (int g = 0; g < 4; ++g) { const int kc = cb + 4 * rq + g; const bool valid = (kc >= c0) && (kc <= c0 + 15);
                    const int bi = valid ? ((kr - r + 7) * 31 + (kc - c + 15)) : 0;
                    a[g] = valid ? a[g] + rpbl[bi] : -1e30f; }
                sc[lb] = a; }
            float m = -1e30f;
#pragma unroll
            for (int i = 0; i < 16; ++i) m = fmaxf(fmaxf(m, fmaxf(sc[i].x, sc[i].y)), fmaxf(sc[i].z, sc[i].w));
            m = fmaxf(m, __shfl_xor(m, 16)); m = fmaxf(m, __shfl_xor(m, 32));
            float l = 0.f;
#pragma unroll
            for (int i = 0; i < 16; ++i) {
#pragma unroll
                for (int g = 0; g < 4; ++g) { const float p = __builtin_amdgcn_exp2f((sc[i][g] - m) * L2E); sc[i][g] = p; l += p; } }
            l += __shfl_xor(l, 16); l += __shfl_xor(l, 32);
            f32x4 o[4];
#pragma unroll
            for (int eb = 0; eb < 4; ++eb) o[eb] = (f32x4){0.f, 0.f, 0.f, 0.f};
#pragma unroll
            for (int ks = 0; ks < 8; ++ks) {
                const bf16x8 pf = pk8(sc[2 * ks], sc[2 * ks + 1]);
                int rowA;
                if (ks < 4) { const int kr = r0 + 4 * half + ks; rowA = (kr % 9) * 64 + w0; }
                else rowA = 576 + 128 * half + 32 * (ks - 4);
                const LAS unsigned char* pa = Vl + (rowA + 4 * rq + tq) * VST + 8 * tp; const LAS unsigned char* pb = pa + 16 * VST;
#pragma unroll
                for (int eb = 0; eb < 4; ++eb) { const bf16x8 vf = cat8(tr_read(pa + 32 * eb), tr_read(pb + 32 * eb)); o[eb] = MFMA16(vf, pf, o[eb]); }
            }
            LAS float* mw = mrg + sb * 1056;
            const bool merger = (half == (ti & 1));
            if (!merger) {
                if (rq == 0) { mw[q16] = m; mw[16 + q16] = l; }
#pragma unroll
                for (int eb = 0; eb < 4; ++eb)
#pragma unroll
                    for (int g = 0; g < 4; ++g) mw[32 + (16 * eb + 4 * rq + g) * 16 + q16] = o[eb][g];
            }
            if (newrow) *(LAS u32x4*)(Vl + ((krn % 9) * 64 + vcol) * VST + vch * 16) = vnext;
            __syncthreads();
            if (merger) {
                const float m2 = mw[q16], l2 = mw[16 + q16];
                const float mn = fmaxf(m, m2), a1 = __builtin_amdgcn_exp2f((m - mn) * L2E), a2 = __builtin_amdgcn_exp2f((m2 - mn) * L2E);
                const float inv = 1.f / (l * a1 + l2 * a2);
#pragma unroll
                for (int eb = 0; eb < 4; ++eb) { f32x4 v;
#pragma unroll
                    for (int g = 0; g < 4; ++g) v[g] = (o[eb][g] * a1 + mw[32 + (16 * eb + 4 * rq + g) * 16 + q16] * a2) * inv;
                    u32x2 w; w.x = pg8::cvt_pk_bf16(v.x, v.y); w.y = pg8::cvt_pk_bf16(v.z, v.w);
                    *(u32x2*)(MIX + qrow * D + 512 + h * 64 + 16 * eb + 4 * rq) = w; }
            }
        }
    }
    __syncthreads();
}

__device__ __forceinline__ void ph_kvstate(Frame& F) {
    const bf16* RK = (const bf16*)(fA(F) + A_RK); const bf16* RV = (const bf16*)(fA(F) + A_RV); float* KV = (float*)(fA(F) + A_KV);
    LAS unsigned char* Kt = F.lds; LAS unsigned char* Vf = F.lds + 128 * VST; LAS unsigned char* Vb = F.lds + 256 * VST;
    const int lane = F.lane, wave = F.wave, rq = lane >> 4, tq = (lane & 15) >> 2, tp = lane & 3, db = wave & 3, ep = wave >> 2;
    for (int it = blockIdx.x; it < NB * NH * 34; it += gridDim.x) {
        const int cc = it % 34, bh = it / 34, b = bh >> 3, h = bh & 7;
        const float lgf = ret_gamma_log(F, 0, h) * 1.44269504f, lgb = ret_gamma_log(F, 1, h) * 1.44269504f;
        const size_t row0 = cc < 32 ? (size_t)b * SEQ + cc * 128 : (size_t)NTOK + b * CTXL + (cc - 32) * 128;
        __syncthreads();
#pragma unroll
        for (int pass = 0; pass < 2; ++pass) { const int j = pass * 64 + (F.tid >> 3), ch = F.tid & 7;
            *(LAS u32x4*)(Kt + j * VST + ch * 16) = *(const u32x4*)(RK + (row0 + j) * HW + h * 64 + ch * 8);
            const u32x4 v = *(const u32x4*)(RV + (row0 + j) * HW + h * 64 + ch * 8);
            const float wf = __builtin_amdgcn_exp2f(lgf * (float)(127 - j)), wb = __builtin_amdgcn_exp2f(lgb * (float)j);
            const unsigned vv[4] = { v.x, v.y, v.z, v.w }; u32x4 of, ob; unsigned rf[4], rb[4];
#pragma unroll
            for (int q = 0; q < 4; ++q) { const float lo = bf2f(vv[q] & 0xffffu), hi = bf2f(vv[q] >> 16); rf[q] = pg8::cvt_pk_bf16(lo * wf, hi * wf); rb[q] = pg8::cvt_pk_bf16(lo * wb, hi * wb); }
            of.x = rf[0]; of.y = rf[1]; of.z = rf[2]; of.w = rf[3]; ob.x = rb[0]; ob.y = rb[1]; ob.z = rb[2]; ob.w = rb[3];
            *(LAS u32x4*)(Vf + j * VST + ch * 16) = of; *(LAS u32x4*)(Vb + j * VST + ch * 16) = ob; }
        __syncthreads();
        f32x4 acc[2][2];
#pragma unroll
        for (int d = 0; d < 2; ++d)
#pragma unroll
            for (int e = 0; e < 2; ++e) acc[d][e] = (f32x4){0.f, 0.f, 0.f, 0.f};
#pragma unroll
        for (int ks = 0; ks < 4; ++ks) {
            const int rbase = 32 * ks + 8 * rq + tq;
            const bf16x8 kf = cat8(tr_read(Kt + rbase * VST + (16 * db + 4 * tp) * 2), tr_read(Kt + (rbase + 4) * VST + (16 * db + 4 * tp) * 2));
#pragma unroll
            for (int e2 = 0; e2 < 2; ++e2) { const int eoff = (16 * (2 * ep + e2) + 4 * tp) * 2;
                const bf16x8 vf = cat8(tr_read(Vf + rbase * VST + eoff), tr_read(Vf + (rbase + 4) * VST + eoff));
                const bf16x8 vb = cat8(tr_read(Vb + rbase * VST + eoff), tr_read(Vb + (rbase + 4) * VST + eoff));
                acc[0][e2] = MFMA16(kf, vf, acc[0][e2]); acc[1][e2] = MFMA16(kf, vb, acc[1][e2]); }
        }
        float* kvp = KV + (size_t)it * 2 * 4096;
#pragma unroll
        for (int d = 0; d < 2; ++d)
#pragma unroll
            for (int e2 = 0; e2 < 2; ++e2) *(f32x4*)(kvp + d * 4096 + (16 * (2 * ep + e2) + (lane & 15)) * 64 + 16 * db + 4 * rq) = acc[d][e2];
    }
    __syncthreads();
}

__device__ __forceinline__ void ph_retout(Frame& F, int mode = 0) {
    const bf16* RK = (const bf16*)(fA(F) + A_RK); const bf16* RV = (const bf16*)(fA(F) + A_RV); const bf16* RQ = (const bf16*)(fA(F) + A_RQ); const bf16* GT = (const bf16*)(fA(F) + A_GT);
    const float* KV = (const float*)(fA(F) + A_KV); bf16* MIX = (bf16*)(fA(F) + A_MIX);
    LAS unsigned char* Vl = F.lds;
    LAS unsigned char* SF = F.lds + 4 * 128 * VST;
    LAS unsigned char* SB = SF + 4 * 64 * VST;
    const int lane = F.lane, wave = F.wave, q16 = lane & 15, rq = lane >> 4, tq = (lane & 15) >> 2, tp = lane & 3;
    for (int g0 = blockIdx.x; g0 < 256; g0 += gridDim.x) {
        const int g = (gridDim.x == 256) ? ((g0 & 7) * 32 + (g0 >> 3)) : g0;
        const int bh = g >> 3, b = bh >> 3, h = bh & 7, c0 = (g & 7) * 4;
        const float lnf = ret_gamma_log(F, 0, h), lnb = ret_gamma_log(F, 1, h);
        const float lgf = lnf * 1.44269504f, lgb = lnb * 1.44269504f;
        const float gf128 = __builtin_amdgcn_exp2f(lgf * 128.f), gb128 = __builtin_amdgcn_exp2f(lgb * 128.f);
        const float* kvb = KV + (size_t)bh * 34 * 2 * 4096 + F.tid * 8;
#define KVP(cc, dir) (kvb + ((size_t)(cc) * 2 + (dir)) * 4096)
        f32x4 sf0 = {0.f, 0.f, 0.f, 0.f}, sf1 = sf0, sb0 = sf0, sb1 = sf0;
#pragma unroll 8
        for (int cp = 0; cp < (mode == 2 ? 0 : 32); ++cp) {
            const bool isf = cp < c0, isb = cp >= c0 + 4;
            const float wf_ = isf ? __builtin_amdgcn_exp2f(lgf * 128.f * (float)(c0 - 1 - cp)) : 0.f, wb_ = isb ? __builtin_amdgcn_exp2f(lgb * 128.f * (float)(cp - c0 - 4)) : 0.f;
            const float* p = KVP(cp, isf ? 0 : 1);
            const f32x4 a0 = *(const f32x4*)p, a1 = *(const f32x4*)(p + 4);
            sf0 = sf0 + a0 * wf_; sf1 = sf1 + a1 * wf_; sb0 = sb0 + a0 * wb_; sb1 = sb1 + a1 * wb_;
        }
        { const f32x4 a0 = *(const f32x4*)KVP(32, 0), a1 = *(const f32x4*)(KVP(32, 0) + 4), b0 = *(const f32x4*)KVP(33, 0), b1 = *(const f32x4*)(KVP(33, 0) + 4);
          const float wc = __builtin_amdgcn_exp2f(lgf * 128.f * (float)c0);
          sf0 = sf0 + (a0 * gf128 + b0) * wc; sf1 = sf1 + (a1 * gf128 + b1) * wc; }
        { const f32x4 a0 = *(const f32x4*)KVP(33, 1), a1 = *(const f32x4*)(KVP(33, 1) + 4), b0 = *(const f32x4*)KVP(32, 1), b1 = *(const f32x4*)(KVP(32, 1) + 4);
          const float wc = __builtin_amdgcn_exp2f(lgb * 128.f * (float)(28 - c0));
          sb0 = sb0 + (a0 * gb128 + b0) * wc; sb1 = sb1 + (a1 * gb128 + b1) * wc; }
        __syncthreads();
        const int se = F.tid >> 3, sd = (F.tid & 7) * 8;
#pragma unroll
        for (int k = 3; k >= 0; --k) {
            *(LAS u32x4*)(SB + k * 64 * VST + se * VST + sd * 2) = __builtin_bit_cast(u32x4, pk8(sb0, sb1));
            if (k > 0) { const f32x4 a0 = *(const f32x4*)KVP(c0 + k, 1), a1 = *(const f32x4*)(KVP(c0 + k, 1) + 4); sb0 = sb0 * gb128 + a0; sb1 = sb1 * gb128 + a1; }
        }
#pragma unroll
        for (int k = 0; k < 4; ++k) {
            *(LAS u32x4*)(SF + k * 64 * VST + se * VST + sd * 2) = __builtin_bit_cast(u32x4, pk8(sf0, sf1));
            if (k < 3) { const f32x4 a0 = *(const f32x4*)KVP(c0 + k, 0), a1 = *(const f32x4*)(KVP(c0 + k, 0) + 4); sf0 = sf0 * gf128 + a0; sf1 = sf1 * gf128 + a1; }
        }
        if (mode != 2)
#pragma unroll
        for (int pass = 0; pass < 8; ++pass) { const int j = pass * 64 + (F.tid >> 3), ch = F.tid & 7;
            *(LAS u32x4*)(Vl + j * VST + ch * 16) = *(const u32x4*)(RV + ((size_t)b * SEQ + c0 * 128 + j) * HW + h * 64 + ch * 8); }
        __syncthreads();
        if (mode == 1) continue;
        const int k = wave >> 1; const size_t row0 = (size_t)b * SEQ + (c0 + k) * 128;
        bf16x8 kf[8][2];
#pragma unroll
        for (int jb = 0; jb < 8; ++jb) { const bf16* kp = RK + (row0 + 16 * jb + q16) * HW + h * 64 + 8 * rq; kf[jb][0] = *(const bf16x8*)kp; kf[jb][1] = *(const bf16x8*)(kp + 32); }
        const LAS unsigned char* Vc = Vl + k * 128 * VST; const LAS unsigned char* SFc = SF + k * 64 * VST; const LAS unsigned char* SBc = SB + k * 64 * VST;
#pragma unroll 1
        for (int qb = 0; qb < 4; ++qb) {
            const int i = 64 * (wave & 1) + 16 * qb + q16; const size_t qrow = row0 + i;
            bf16x8 qf[2];
#pragma unroll
            for (int ks = 0; ks < 2; ++ks) qf[ks] = *(const bf16x8*)(RQ + qrow * HW + h * 64 + 8 * rq + 32 * ks);
            const float qfd = __builtin_amdgcn_exp2f(lgf * (float)(i + 1)), qbd = __builtin_amdgcn_exp2f(lgb * (float)(128 - i));
            f32x4 o[4];
#pragma unroll
            for (int eb = 0; eb < 4; ++eb) {
                f32x4 t1 = {0.f, 0.f, 0.f, 0.f}, t2 = {0.f, 0.f, 0.f, 0.f};
#pragma unroll
                for (int ks = 0; ks < 2; ++ks) {
                    const bf16x8 s1 = *(const LAS bf16x8*)(SFc + (16 * eb + q16) * VST + (8 * rq + 32 * ks) * 2);
                    const bf16x8 s2 = *(const LAS bf16x8*)(SBc + (16 * eb + q16) * VST + (8 * rq + 32 * ks) * 2);
                    t1 = MFMA16(s1, qf[ks], t1); t2 = MFMA16(s2, qf[ks], t2); }
                o[eb] = t1 * qfd + t2 * qbd; }
            __builtin_amdgcn_sched_barrier(0);
            f32x4 sc[8];
#pragma unroll
            for (int jb = 0; jb < 8; ++jb) {
                f32x4 a = MFMA16(kf[jb][0], qf[0], ((f32x4){0.f, 0.f, 0.f, 0.f})); a = MFMA16(kf[jb][1], qf[1], a);
#pragma unroll
                for (int gq = 0; gq < 4; ++gq) { const int j = 16 * jb + 4 * rq + gq;
                    const float wgt = j < i ? __builtin_amdgcn_exp2f(lgf * (float)(i - j)) : (j > i ? __builtin_amdgcn_exp2f(lgb * (float)(j - i)) : 2.f);
                    a[gq] *= wgt; }
                sc[jb] = a; }
            __builtin_amdgcn_sched_barrier(0);
#pragma unroll
            for (int ks = 0; ks < 4; ++ks) {
                const bf16x8 pf = pk8(sc[2 * ks], sc[2 * ks + 1]);
                const LAS unsigned char* pa = Vc + (32 * ks + 4 * rq + tq) * VST + 8 * tp; const LAS unsigned char* pb = pa + 16 * VST;
#pragma unroll
                for (int eb = 0; eb < 4; ++eb) { const bf16x8 vf = cat8(tr_read(pa + 32 * eb), tr_read(pb + 32 * eb)); o[eb] = MFMA16(vf, pf, o[eb]); }
            }
            __builtin_amdgcn_sched_barrier(0);
            u32x2 gt[4];
#pragma unroll
            for (int eb = 0; eb < 4; ++eb) gt[eb] = *(const u32x2*)(GT + qrow * HW + h * 64 + 16 * eb + 4 * rq);
            float ss = 0.f;
#pragma unroll
            for (int eb = 0; eb < 4; ++eb) { ss += (o[eb].x * o[eb].x + o[eb].y * o[eb].y) + (o[eb].z * o[eb].z + o[eb].w * o[eb].w); }
            ss += __shfl_xor(ss, 16); ss += __shfl_xor(ss, 32);
            const float rs = rsqrtf(ss * (1.f / 64.f) + EPS);
#pragma unroll
            for (int eb = 0; eb < 4; ++eb) { const int e0 = 16 * eb + 4 * rq;
                const f32x4 gg = *(const f32x4*)(F.a.in[I_RNG] + e0);
                const f32x4 gv = { bf2f(gt[eb].x & 0xffffu), bf2f(gt[eb].x >> 16), bf2f(gt[eb].y & 0xffffu), bf2f(gt[eb].y >> 16) };
                const f32x4 v = o[eb] * rs * gg * gv;
                u32x2 w; w.x = pg8::cvt_pk_bf16(v.x, v.y); w.y = pg8::cvt_pk_bf16(v.z, v.w);
                if (mode == 0) *(u32x2*)(MIX + qrow * D + h * 64 + e0) = w; else asm volatile("" :: "v"(w.x), "v"(w.y)); }
        }
#undef KVP
    }
    __syncthreads();
}

__device__ __forceinline__ void ph_sgumix(Frame& F, bool dry = false) {
    bf16* U = (bf16*)(fA(F) + A_U); const bf16* V = (const bf16*)(fA(F) + A_V); const bf16* WS = (const bf16*)(F.a.ws + WS_WB + WB_WS);
    constexpr int VS2 = 272;
    LAS unsigned char* Vt = F.lds;
    LAS float* rsl = (LAS float*)(F.lds + 128 * VS2);
    const int lane = F.lane, wave = F.wave, q16 = lane & 15, rq = lane >> 4, tq = (lane & 15) >> 2, tp = lane & 3;
    const int ch4 = wave & 1, iq = wave >> 1;
    constexpr int NIT = NB * 32 * 8 * 3;
    const int ipb = (NIT + (int)gridDim.x - 1) / (int)gridDim.x, it0 = (int)blockIdx.x * ipb, it1 = (it0 + ipb) < NIT ? (it0 + ipb) : NIT;
    const int sj = F.tid >> 4, schn = F.tid & 15;
    u32x4 vn[4];
    if (it0 < it1) { const int third = it0 % 3, g = (it0 / 3) & 7, bc = it0 / 24; const size_t row0 = (size_t)bc * 128; const int cg0 = g * 384 + third * 128;
#pragma unroll
        for (int pass = 0; pass < 4; ++pass) vn[pass] = *(const u32x4*)(V + (row0 + pass * 32 + sj) * SGW + cg0 + schn * 8); }
    int prev_bc = -1;
    for (int it = it0; it < it1; ++it) {
        const int third = it % 3, g = (it / 3) & 7, bc = it / 24; const size_t row0 = (size_t)bc * 128; const int cg0 = g * 384 + third * 128;
        __syncthreads();
        if (bc != prev_bc) { prev_bc = bc;
            if (F.tid < 128) { const float* vp = fvss(F) + (row0 + F.tid) * 48; float sacc = 0.f;
#pragma unroll
                for (int j = 0; j < 48; j += 4) { const f32x4 t = *(const f32x4*)(vp + j); sacc += (t.x + t.y) + (t.z + t.w); }
                rsl[F.tid] = rsqrtf(sacc * (1.f / SGW) + EPS); }
            __syncthreads(); }
#pragma unroll
        for (int pass = 0; pass < 4; ++pass) { const int j = pass * 32 + sj; const float rs = rsl[j];
            const unsigned vv[4] = { vn[pass].x, vn[pass].y, vn[pass].z, vn[pass].w }; unsigned ro[4];
#pragma unroll
            for (int q = 0; q < 4; ++q) ro[q] = pg8::cvt_pk_bf16(bf2f(vv[q] & 0xffffu) * rs, bf2f(vv[q] >> 16) * rs);
            u32x4 o; o.x = ro[0]; o.y = ro[1]; o.z = ro[2]; o.w = ro[3];
            *(LAS u32x4*)(Vt + j * VS2 + schn * 16) = o; }
        __syncthreads();
        if (it + 1 < it1) { const int n = it + 1, t2 = n % 3, g2 = (n / 3) & 7, bc2 = n / 24; const size_t r2 = (size_t)bc2 * 128; const int c2 = g2 * 384 + t2 * 128;
#pragma unroll
            for (int pass = 0; pass < 4; ++pass) vn[pass] = *(const u32x4*)(V + (r2 + pass * 32 + sj) * SGW + c2 + schn * 8); }
        u32x4 uu[2][2];
#pragma unroll
        for (int ib = 0; ib < 2; ++ib)
#pragma unroll
            for (int cb2 = 0; cb2 < 2; ++cb2) uu[ib][cb2] = *(const u32x4*)(U + (row0 + 32 * iq + 16 * ib + q16) * SGW + cg0 + 64 * ch4 + 32 * cb2 + 8 * rq);
        f32x4 acc[4][2];
#pragma unroll
        for (int cb = 0; cb < 4; ++cb)
#pragma unroll
            for (int ib = 0; ib < 2; ++ib) acc[cb][ib] = (f32x4){0.f, 0.f, 0.f, 0.f};
#pragma unroll
        for (int ks = 0; ks < 4; ++ks) {
            bf16x8 wf[2];
#pragma unroll
            for (int ib = 0; ib < 2; ++ib) wf[ib] = *(const bf16x8*)(WS + ((size_t)g * 128 + 32 * iq + 16 * ib + q16) * 128 + 32 * ks + 8 * rq);
            const int rb = 32 * ks + 8 * rq + tq;
#pragma unroll
            for (int cb = 0; cb < 4; ++cb) { const int coff = (64 * ch4 + 32 * (cb >> 1) + 8 * tp + 4 * (cb & 1)) * 2;
                const bf16x8 vf = cat8(tr_read(Vt + rb * VS2 + coff), tr_read(Vt + (rb + 4) * VS2 + coff));
#pragma unroll
                for (int ib = 0; ib < 2; ++ib) acc[cb][ib] = MFMA16(vf, wf[ib], acc[cb][ib]); }
        }
#pragma unroll
        for (int ib = 0; ib < 2; ++ib) { const int i = 32 * iq + 16 * ib + q16; const float bs = F.a.in[I_SBS][g * 128 + i];
#pragma unroll
            for (int cb2 = 0; cb2 < 2; ++cb2) { const int cgl = cg0 + 64 * ch4 + 32 * cb2 + 8 * rq;
                const f32x4 ng0 = *(const f32x4*)(F.a.in[I_SNG] + cgl), ng1 = *(const f32x4*)(F.a.in[I_SNG] + cgl + 4); bf16* up = U + (row0 + i) * SGW + cgl; const u32x4 u4 = uu[ib][cb2];
                const f32x4 uv0 = { bf2f(u4.x & 0xffffu), bf2f(u4.x >> 16), bf2f(u4.y & 0xffffu), bf2f(u4.y >> 16) }, uv1 = { bf2f(u4.z & 0xffffu), bf2f(u4.z >> 16), bf2f(u4.w & 0xffffu), bf2f(u4.w >> 16) };
                const f32x4 r0 = dry ? uv0 + acc[2 * cb2][ib] * 0.f : uv0 * (acc[2 * cb2][ib] * ng0 + bs), r1 = dry ? uv1 + acc[2 * cb2 + 1][ib] * 0.f : uv1 * (acc[2 * cb2 + 1][ib] * ng1 + bs);
                u32x4 w; w.x = pg8::cvt_pk_bf16(r0.x, r0.y); w.y = pg8::cvt_pk_bf16(r0.z, r0.w); w.z = pg8::cvt_pk_bf16(r1.x, r1.y); w.w = pg8::cvt_pk_bf16(r1.z, r1.w); *(u32x4*)up = w; } }
    }
    __syncthreads();
}

__device__ __forceinline__ void ph_mod2(Frame& F) {
    LAS float* sv = (LAS float*)F.lds; LAS float* red = sv + 5 * 1024;
    for (int i = F.tid; i < 5 * 1024; i += NTHREADS) { const int r = i >> 10, k = i & 1023; const float c = r < 4 ? F.a.in[I_C][r * 1024 + k] : F.a.in[I_CCTX][k]; sv[i] = siluf(c); }
    __syncthreads();
    for (int item = blockIdx.x; item < 192; item += gridDim.x) {
        const int l = item / 96, n0 = (item % 96) * 64, k0 = F.wave * 128;
        const float* W = F.a.in[I_ADAW] + (size_t)l * D * 6144 + n0 + F.lane + (size_t)k0 * 6144;
        float a0 = 0.f, a1 = 0.f, a2 = 0.f, a3 = 0.f, a4 = 0.f;
#pragma unroll 16
        for (int k = 0; k < 128; ++k) { const float w = W[(size_t)k * 6144];
            a0 += sv[k0 + k] * w; a1 += sv[1024 + k0 + k] * w; a2 += sv[2048 + k0 + k] * w; a3 += sv[3072 + k0 + k] * w; a4 += sv[4096 + k0 + k] * w; }
        red[(F.wave * 5 + 0) * 64 + F.lane] = a0; red[(F.wave * 5 + 1) * 64 + F.lane] = a1; red[(F.wave * 5 + 2) * 64 + F.lane] = a2; red[(F.wave * 5 + 3) * 64 + F.lane] = a3; red[(F.wave * 5 + 4) * 64 + F.lane] = a4;
        __syncthreads();
        if (F.wave < 5) { const int r = F.wave; float sacc = 0.f;
#pragma unroll
            for (int w = 0; w < 8; ++w) sacc += red[(w * 5 + r) * 64 + F.lane];
            sacc += F.a.in[I_ADAB][l * 6144 + n0 + F.lane];
            if (r < 4) fmod(F)[(l * 4 + r) * 6144 + n0 + F.lane] = sacc; else if (l == 0 && n0 < 2048) fmodc(F)[n0 + F.lane] = sacc; }
        __syncthreads();
    }
    const int gt = F.gw * 64 + F.lane, ngt = F.ngw * 64;
    for (int it = gt; it < 64 * 16; it += ngt) {
        const int pos = it >> 4, j = it & 15;
        const float inv = powf(10000.0f, -(float)j / 16.0f);
        const float ang = (float)pos * inv;
        frope(F)[it * 2] = cosf(ang); frope(F)[it * 2 + 1] = sinf(ang);
    }
}
__device__ __forceinline__ void ph_inproj(Frame& F) {
    const DenseSched S{(const char*)fH(F), (const char*)(F.a.ws + WS_WB + WB_WIN), D, 64, 14, (int)gridDim.x, (int)blockIdx.x, 64 * 14, 64, 8, 32, GREP(2)};
    LAS float* ropel = (LAS float*)(F.lds + ROPE_OFF);
    for (int i = F.tid; i < 2048; i += NTHREADS) ropel[i] = frope(F)[i];
    __syncthreads();
    const EpiInproj E{fA(F), ropel, F.a.in[I_KG], F.a.in[I_QG]};
    pg8::gemm_phase<DenseSched, EpiInproj, true>(F.lds, D, S, E);
}
__device__ __forceinline__ void ph_outproj(Frame& F) {
    const DenseSched S{(const char*)(fA(F) + A_MIX), (const char*)(F.a.ws + WS_WB + WB_WOUT), D, 64, 4, (int)gridDim.x, (int)blockIdx.x, 64 * 4, 0, 1, 0, GREP(5)};
    const EpiRes E{F.a.in[I_X], F.a.out, fmod(F) + 2 * D};
    pg8::gemm_phase<DenseSched, EpiRes, false>(F.lds, D, S, E);
}
__device__ __forceinline__ void ph_sguin(Frame& F) {
    const DenseSched S{(const char*)fH(F), (const char*)(F.a.ws + WS_WB + WB_SWIN), D, 64, 24, (int)gridDim.x, (int)blockIdx.x, 64 * 24, 0, 1, 0, GREP(10)};
    const EpiSguIn E{(bf16*)(fA(F) + A_U), (bf16*)(fA(F) + A_V), F.a.in[I_SBIN], fvss(F)};
    pg8::gemm_phase<DenseSched, EpiSguIn, true>(F.lds, D, S, E);
}
__device__ __forceinline__ void ph_sguout(Frame& F) {
    const DenseSched S{(const char*)(fA(F) + A_U), (const char*)(F.a.ws + WS_WB + WB_SWOUT), SGW, 64, 4, (int)gridDim.x, (int)blockIdx.x, 64 * 4, 0, 1, 0, GREP(12)};
    const EpiRes E{F.a.out, F.a.out, fmod(F) + 4 * 6144 + 2 * D};
    pg8::gemm_phase<DenseSched, EpiRes, false>(F.lds, SGW, S, E);
}

__device__ __forceinline__ void late_convert(Frame& F, int units, int pct_lo, int pct_hi) {
    const int G = (int)gridDim.x, rounds = (units + G - 1) / G, rem = units - (rounds - 1) * G;
    const int first = rem >= G ? 0 : rem, nidle = G - first;
    __syncthreads();
    if ((int)blockIdx.x >= first) ph_convert(F, 1, ((int)blockIdx.x - first) * NWAVES + F.wave, nidle * NWAVES, pct_lo, pct_hi);
    __syncthreads();
}
__device__ __forceinline__ void ph_moe_gu(Frame& F, int l) {
    LAS int* tab = (LAS int*)(F.lds + TAB_OFF);
    const int tiles = moe_tab(F, l, tab);
    const MoeSched S{(const char*)fH(F), (const char*)(F.a.ws + WS_WB + WB_GU) + (size_t)l * NE * 1024 * D * 2, D, (int)gridDim.x, (int)blockIdx.x, tiles * 4, tab, flist(F), 1, GREP(7)};
    const EpiMoeGU E{(bf16*)(fA(F) + A_ACT)};
    pg8::gemm_phase<MoeSched, EpiMoeGU, true>(F.lds, D, S, E);
    if (l == 0) late_convert(F, tiles * 4, 0, 58);
}
__device__ __forceinline__ void ph_moe_dn(Frame& F, int l) {
    LAS int* tab = (LAS int*)(F.lds + TAB_OFF);
    const int tiles = moe_tab(F, l, tab);
    const MoeSched S{(const char*)(fA(F) + A_ACT), (const char*)(F.a.ws + WS_WB + WB_DN) + (size_t)l * NE * D * EW * 2, EW, (int)gridDim.x, (int)blockIdx.x, tiles * 4, tab, flist(F), 0, GREP(8)};
    const EpiMoeDn E{(bf16*)(fA(F) + A_Y), flist(F), fwt(F)};
    pg8::gemm_phase<MoeSched, EpiMoeDn, true>(F.lds, EW, S, E);
    if (l == 0) late_convert(F, tiles * 4, 58, 100);
}

constexpr int NPHASE = 18;
__global__ void __launch_bounds__(NTHREADS, 2) fwd_kernel(Args args) {
    extern __shared__ __attribute__((aligned(16))) unsigned char lds[];
    const int tid_ = threadIdx.x, wave_ = __builtin_amdgcn_readfirstlane(tid_ >> 6);
    Frame F{(LAS unsigned char*)lds, tid_, tid_ & 63, wave_, (int)blockIdx.x * NWAVES + wave_, (int)gridDim.x * NWAVES, args};
    volatile LAS unsigned* MISC = (volatile LAS unsigned*)(F.lds + MISC_OFF);
    for (int u = F.tid; u < (LDS_BYTES - LDSCTL_OFF) / 4; u += NTHREADS) ((LAS unsigned*)(F.lds + LDSCTL_OFF))[u] = 0u;
    __syncthreads();
    XcdBarrier bar; bar.bar = fctl(F) + CW_BAR; bar.x = 0; bar.st = nullptr;
    if (MK_ONE_LAUNCH) bar = xcd_barrier_post(fctl(F) + CW_BAR, MISC + 8);
    const int lo = args.ph_lo, hi = args.ph_hi;
#define IN(k) (lo <= (k) && (k) < hi)
#define REP(k) for (int _r##k = 0, _r = 0; _r##k < ((k) == REP_PHASE ? REP_N : 1); ++_r##k, _r = _r##k)
#ifdef ONLY_PHASE
#define PHON(k) ((k) == ONLY_PHASE)
#else
#define PHON(k) true
#endif
#define SEAM(k) do { if (IN(k) && IN((k) + 1)) xcd_barrier(bar); } while (0)
    if (PHON(0) && IN(0)) REP(0) { ph_mod2(F); __syncthreads(); ph_convert(F, 0, F.gw, F.ngw); __syncthreads(); } SEAM(0);
    if (PHON(1) && IN(1)) REP(1) { ph_norm0(F); } SEAM(1);
    if (PHON(2) && IN(2)) REP(2) { if (NV_INPROJ) ph_inproj_naive(F); else ph_inproj(F); } SEAM(2);
    if (PHON(3) && IN(3)) REP(3) { REP(30) { if (NV_RET) ph_scan_naive(F); else ph_kvstate(F); } REP(31) { if (NV_NA) ph_na_naive(F); else ph_na(F); } } SEAM(3);
    if (PHON(4) && IN(4)) REP(4) { if (NV_RET) ph_retout_naive(F); else ph_retout(F, _r > 0 ? RET_MODE : 0); } SEAM(4);
    if (PHON(5) && IN(5)) REP(5) { if (NV_OUTPROJ) ph_gemm_res_naive(F, (const bf16*)(fA(F) + A_MIX), D, D, F.a.in[I_WOUT], F.a.in[I_X], fmod(F) + 2 * D); else ph_outproj(F); } SEAM(5);
    if (PHON(6) && IN(6)) REP(6) { ph_route(F, 0, _r > 0); } SEAM(6);
    if (PHON(7) && IN(7)) REP(7) { if (NV_MOEGU) ph_moe_gu_naive(F, 0); else ph_moe_gu(F, 0); } SEAM(7);
    if (PHON(8) && IN(8)) REP(8) { if (NV_MOEDN) ph_moe_dn_naive(F, 0); else ph_moe_dn(F, 0); } SEAM(8);
    if (PHON(9) && IN(9)) REP(9) { ph_combine(F, 0, true, _r > 0); } SEAM(9);
    if (PHON(10) && IN(10)) REP(10) { if (NV_SGUIN) ph_sguin_naive(F); else ph_sguin(F); } SEAM(10);
    if (PHON(11) && IN(11)) REP(11) { if (NV_SGUMIX) ph_sgumix_naive(F); else ph_sgumix(F, _r > 0); } SEAM(11);
    if (PHON(12) && IN(12)) REP(12) { if (NV_SGUOUT) ph_gemm_res_naive(F, (const bf16*)(fA(F) + A_U), SGW, SGW, F.a.in[I_SWOUT], F.a.out, fmod(F) + 4 * 6144 + 2 * D); else ph_sguout(F); } SEAM(12);
    if (PHON(13) && IN(13)) REP(13) { ph_route(F, 1, _r > 0); } SEAM(13);
    if (PHON(14) && IN(14)) REP(14) { if (NV_MOEGU) ph_moe_gu_naive(F, 1); else ph_moe_gu(F, 1); } SEAM(14);
    if (PHON(15) && IN(15)) REP(15) { if (NV_MOEDN) ph_moe_dn_naive(F, 1); else ph_moe_dn(F, 1); } SEAM(15);
    if (PHON(16) && IN(16)) REP(16) { ph_combine(F, 1, false, _r > 0); }
    for (int xb = 0; xb < XBAR; ++xb) xcd_barrier(bar);
#undef IN
#undef SEAM
}

extern "C" void kernel_launch(void* const* d_in, const int* in_sizes, int n_in, void* d_out, int out_size, void* d_ws, size_t ws_size, hipStream_t stream) {
    static int grid = 0;
    if (grid == 0) {
        if (n_in != 26 || out_size != NTOK * D || ws_size < WS_END) { fprintf(stderr, "kernel_launch: unexpected shapes n_in %d out %d ws %zu (need %zu)\n", n_in, out_size, ws_size, (size_t)WS_END); grid = -1; return; }
        int dev = 0, cus = 0, per_cu = 0;
        hipGetDevice(&dev); hipDeviceGetAttribute(&cus, hipDeviceAttributeMultiprocessorCount, dev);
        hipFuncSetAttribute((const void*)fwd_kernel, hipFuncAttributeMaxDynamicSharedMemorySize, LDS_BYTES);
        hipOccupancyMaxActiveBlocksPerMultiprocessor(&per_cu, (const void*)fwd_kernel, NTHREADS, LDS_BYTES);
        (void)hipGetLastError();
        if (per_cu < 1) { fprintf(stderr, "kernel_launch: occupancy query says %d blocks/CU\n", per_cu); per_cu = 1; }
        grid = cus;
    }
    if (grid < 0) return;
    hipMemsetAsync((char*)d_ws + WS_CTL, 0, CTL_ZERO_BYTES, stream);
    Args a{};
    for (int i = 0; i < 26; ++i) a.in[i] = (const float*)d_in[i];
    a.out = (float*)d_out; a.ws = (unsigned char*)d_ws;
#if MK_ONE_LAUNCH
    a.ph_lo = 0; a.ph_hi = 17; a.li = 0;
    void* kargs[] = { &a };
    hipError_t e = hipLaunchCooperativeKernel((const void*)fwd_kernel, dim3(grid), dim3(NTHREADS), kargs, LDS_BYTES, stream);
    if (e != hipSuccess) fprintf(stderr, "cooperative launch failed: %s\n", hipGetErrorString(e));
#else
    for (int p = 0; p < 17; ++p) { a.ph_lo = p; a.ph_hi = p + 1; a.li = p; hipLaunchKernelGGL(fwd_kernel, dim3(grid), dim3(NTHREADS), LDS_BYTES, stream, a); }
#endif
}
```

```cpp
#include <hip/hip_runtime.h>
#include <cstdio>
#include <cstdint>

#ifndef NV_INPROJ
#define NV_INPROJ 0
#endif
#ifndef NV_OUTPROJ
#define NV_OUTPROJ 0
#endif
#ifndef NV_MOEGU
#define NV_MOEGU 0
#endif
#ifndef NV_MOEDN
#define NV_MOEDN 0
#endif
#ifndef NV_SGUIN
#define NV_SGUIN 0
#endif
#ifndef NV_SGUOUT
#define NV_SGUOUT 0
#endif
#ifndef NV_NA
#define NV_NA 0
#endif
#ifndef NV_RET
#define NV_RET 0
#endif
#ifndef NV_SGUMIX
#define NV_SGUMIX 0
#endif
#ifndef REP_PHASE
#define REP_PHASE -1
#endif
#ifndef REP_N
#define REP_N 2
#endif
#ifndef XBAR
#define XBAR 0
#endif
#ifndef GREP_PHASE
#define GREP_PHASE -1
#endif
#define GREP(k) ((k) == GREP_PHASE ? 2 : 1)
#ifndef RET_MODE
#define RET_MODE 0
#endif
#ifndef EARLY_PCT
#define EARLY_PCT 54
#endif
#ifndef MK_ONE_LAUNCH
#define MK_ONE_LAUNCH 1
#endif

constexpr int D = 1024, NB = 4, SEQ = 4096, NTOK = NB * SEQ, CTXL = 256, NCTX = NB * CTXL, NROW = NTOK + NCTX;
constexpr int HD = 64, NH = 8, HW = NH * HD;
constexpr int ABW = 3584;
constexpr int SGW = 3072;
constexpr int NE = 16, EW = 512;
constexpr float EPS = 1e-6f;
constexpr int NWAVES = 8, NTHREADS = 512;

constexpr size_t MiB = 1u << 20;
constexpr size_t WS_CTL = 0, CTL_ZERO_BYTES = 1 * MiB;
constexpr size_t WS_MOD = 1 * MiB;
constexpr size_t WS_ROUTE = 2 * MiB;
constexpr size_t WS_VSS = 4 * MiB;
constexpr size_t WS_WB = 8 * MiB;
constexpr size_t WS_H = 132 * MiB;
constexpr size_t WS_A = 166 * MiB;
constexpr size_t WS_END = 358 * MiB;
constexpr size_t A_RK = 0, A_RV = 17 * MiB, A_NK = 34 * MiB, A_NV = 51 * MiB, A_RQ = 68 * MiB, A_GT = 84 * MiB, A_NQ = 100 * MiB, A_MIX = 116 * MiB, A_SST = 148 * MiB;
constexpr size_t A_ACT = 32 * MiB, A_Y = 68 * MiB;
constexpr size_t A_X1 = 0, A_X3 = 132 * MiB;
constexpr size_t A_U = 0, A_V = 96 * MiB;

constexpr int CW_BAR = 4096;
constexpr int CW_CNT = 8192;

typedef unsigned short bf16;
typedef unsigned u32x4 __attribute__((ext_vector_type(4)));
typedef float f32x4 __attribute__((ext_vector_type(4)));
typedef unsigned u32x2 __attribute__((ext_vector_type(2)));
#define LAS __attribute__((address_space(3)))
#define RLX_AGENT __ATOMIC_RELAXED, __HIP_MEMORY_SCOPE_AGENT

__device__ __forceinline__ unsigned f2bf(float f) { unsigned u = __builtin_bit_cast(unsigned, f); return (u + 0x7fffu + ((u >> 16) & 1u)) >> 16; }
__device__ __forceinline__ float bf2f(unsigned h) { return __builtin_bit_cast(float, h << 16); }
__device__ __forceinline__ unsigned pk2(float lo, float hi) { return f2bf(lo) | (f2bf(hi) << 16); }
__device__ __forceinline__ float siluf(float v) { return v / (1.f + __expf(-v)); }
__device__ __forceinline__ float gelu_tanh(float v) { const float u = 0.7978845608028654f * (v + 0.044715f * v * v * v); return 0.5f * v * (1.f + tanhf(u)); }
__device__ __forceinline__ float wave_sum(float v) {
#pragma unroll
    for (int o = 1; o < 64; o <<= 1) v += __shfl_xor(v, o);
    return v;
}

#define XB_TMO      128
#define XB_XCNT(j)  (256  + 64 * (j))
#define XB_XSUB(j)  (1280 + 64 * (j))
#define XB_XGEN(j)  (2304 + 64 * (j))
#define XB_TOP      3328
#define XB_TOPGEN   3392
#define XCD_BAR_WORDS 3456
#define XB_SPIN_CAP (1u << 18)
__device__ __forceinline__ unsigned xb_ld(unsigned* p)              { return __hip_atomic_load(p, __ATOMIC_RELAXED, __HIP_MEMORY_SCOPE_AGENT); }
__device__ __forceinline__ unsigned xb_add(unsigned* p, unsigned v) { return __hip_atomic_fetch_add(p, v, __ATOMIC_RELAXED, __HIP_MEMORY_SCOPE_AGENT); }
__device__ __forceinline__ unsigned xb_xcc_id() { return (unsigned)__builtin_amdgcn_s_getreg((3 << 11) | 20) & 0xFu; }
#define XB_SPIN(cond, bar) do { unsigned _sp = 0; while (cond) { __builtin_amdgcn_s_sleep(1); \
    if ((++_sp & 255u) == 0u) { if (xb_ld(&(bar)[XB_TMO])) break; if (_sp > XB_SPIN_CAP) { atomicAdd(&(bar)[XB_TMO], 1u); break; } } } } while (0)
struct XcdBarrier { unsigned* bar; unsigned x; volatile LAS unsigned* st; };
__device__ __forceinline__ XcdBarrier xcd_barrier_post(unsigned* bar, volatile LAS unsigned* st) {
    XcdBarrier b; b.bar = bar; b.x = xb_xcc_id(); b.st = st;
    if (threadIdx.x == 0) (void)xb_add(&bar[XB_XCNT(b.x)], 1u);
    return b;
}
__device__ __forceinline__ void xcd_barrier_complete(unsigned* bar, unsigned x, unsigned& nloc, unsigned& nx) {
    const unsigned G = gridDim.x * gridDim.y * gridDim.z;
    unsigned sum, cnt, mine, sp = 0u;
    for (;;) {
        sum = 0u; cnt = 0u; mine = 0u;
#pragma unroll
        for (unsigned j = 0; j < 16; ++j) { const unsigned c = xb_ld(&bar[XB_XCNT(j)]); sum += c; cnt += (c > 0u) ? 1u : 0u; mine = (j == x) ? c : mine; }
        if (sum == G) break;
        __builtin_amdgcn_s_sleep(1);
        if ((++sp & 255u) == 0u) { if (xb_ld(&bar[XB_TMO])) break; if (sp > XB_SPIN_CAP) { atomicAdd(&bar[XB_TMO], 1u); break; } }
    }
    nloc = mine > 0u ? mine : 1u; nx = cnt > 0u ? cnt : 1u;
}
__device__ __forceinline__ void xcd_barrier(const XcdBarrier& b) {
    asm volatile("s_waitcnt vmcnt(0)" ::: "memory");
    __syncthreads();
    if (threadIdx.x == 0) {
        unsigned* bar = b.bar;
        __builtin_amdgcn_s_waitcnt(0);
        unsigned nloc = b.st[0], nx = b.st[1];
        if (nloc == 0u) { xcd_barrier_complete(bar, b.x, nloc, nx); b.st[0] = nloc; b.st[1] = nx; }
        const unsigned old = xb_add(&bar[XB_XSUB(b.x)], 1u);
        const unsigned gen = old / nloc;
        if (old + 1u == (gen + 1u) * nloc) {
            __builtin_amdgcn_fence(__ATOMIC_RELEASE, "agent");
            asm volatile("s_waitcnt vmcnt(0)" ::: "memory");
            const unsigned og = xb_add(&bar[XB_TOP], 1u);
            const unsigned tg = og / nx;
            if (og + 1u == (tg + 1u) * nx) xb_add(&bar[XB_TOPGEN], 1u);
            else XB_SPIN(xb_ld(&bar[XB_TOPGEN]) == tg, bar);
            __builtin_amdgcn_fence(__ATOMIC_ACQUIRE, "agent");
            xb_add(&bar[XB_XGEN(b.x)], 1u);
            asm volatile("s_waitcnt vmcnt(0)" ::: "memory");
        } else {
            XB_SPIN(xb_ld(&bar[XB_XGEN(b.x)]) == gen, bar);
            __builtin_amdgcn_fence(__ATOMIC_ACQUIRE, "agent");
            asm volatile("s_waitcnt vmcnt(0)" ::: "memory");
        }
    }
    __syncthreads();
}

constexpr int LDS_BYTES = 163840;
constexpr int LDSCTL_OFF = 147456, MISC_OFF = LDSCTL_OFF + 320, TAB_OFF = LDSCTL_OFF + 1024, ROPE_OFF = LDSCTL_OFF + 2048;

struct Args { const float* in[26]; float* out; unsigned char* ws; int ph_lo, ph_hi, li, pad; };

struct Frame {
    LAS unsigned char* lds;
    int tid, lane, wave, gw, ngw;
    const Args& a;
};
__device__ __forceinline__ unsigned* fctl(const Frame& F) { return (unsigned*)(F.a.ws + WS_CTL); }
__device__ __forceinline__ float* fmod(const Frame& F) { return (float*)(F.a.ws + WS_MOD); }
__device__ __forceinline__ float* fmodc(const Frame& F) { return (float*)(F.a.ws + WS_MOD) + 2 * 4 * 6144; }
__device__ __forceinline__ float* frope(const Frame& F) { return (float*)(F.a.ws + WS_MOD) + 2 * 4 * 6144 + 2048; }
__device__ __forceinline__ int* flist(const Frame& F) { return (int*)(F.a.ws + WS_ROUTE); }
__device__ __forceinline__ float* fwt(const Frame& F) { return (float*)(F.a.ws + WS_ROUTE + 1 * MiB); }
__device__ __forceinline__ float* fvss(const Frame& F) { return (float*)(F.a.ws + WS_VSS); }
__device__ __forceinline__ bf16* fH(const Frame& F) { return (bf16*)(F.a.ws + WS_H); }
__device__ __forceinline__ unsigned char* fA(const Frame& F) { return F.a.ws + WS_A; }
enum { I_X = 0, I_C, I_CTX, I_CCTX, I_ADAW, I_ADAB, I_NMG, I_NFG, I_RW, I_RB, I_WG, I_WU, I_WD, I_WIN, I_WOUT, I_RDEC, I_RNG, I_QG, I_KG, I_RPB, I_SWIN, I_SBIN, I_SNG, I_SWS, I_SBS, I_SWOUT };

template <int NC> __device__ __forceinline__ void naive_dot(const bf16* arow, const float* W, int ldw, int K, float (&acc)[NC]) {
#pragma unroll 1
    for (int k = 0; k < K; k += 2) {
        const unsigned a2 = *(const unsigned*)(arow + k);
        const float a0 = bf2f(a2 & 0xffffu), a1 = bf2f(a2 >> 16);
        const float* w = W + (size_t)k * ldw;
#pragma unroll
        for (int j = 0; j < NC; ++j) acc[j] = __builtin_fmaf(a0, w[j], acc[j]);
        asm volatile("" ::: "memory");
        w += ldw;
#pragma unroll
        for (int j = 0; j < NC; ++j) acc[j] = __builtin_fmaf(a1, w[j], acc[j]);
        asm volatile("" ::: "memory");
    }
}
template <int NC> __device__ __forceinline__ void store_row_bf16(bf16* dst, const float (&v)[NC]) {
#pragma unroll
    for (int j = 0; j < NC; j += 8) { u32x4 w; w.x = pk2(v[j], v[j + 1]); w.y = pk2(v[j + 2], v[j + 3]); w.z = pk2(v[j + 4], v[j + 5]); w.w = pk2(v[j + 6], v[j + 7]); *(u32x4*)(dst + j) = w; }
}

__device__ __forceinline__ void ph_mod(Frame& F) {
    const int gt = F.gw * 64 + F.lane, ngt = F.ngw * 64;
    for (int it = gt; it < 2 * 6144; it += ngt) {
        const int l = it / 6144, n = it % 6144;
        const float* W = F.a.in[I_ADAW] + (size_t)l * D * 6144 + n;
        float a0 = 0.f, a1 = 0.f, a2 = 0.f, a3 = 0.f, a4 = 0.f;
        const float* c = F.a.in[I_C]; const float* cc = F.a.in[I_CCTX];
        for (int k = 0; k < D; ++k) { const float w = W[(size_t)k * 6144];
            a0 += siluf(c[k]) * w; a1 += siluf(c[D + k]) * w; a2 += siluf(c[2 * D + k]) * w; a3 += siluf(c[3 * D + k]) * w; a4 += siluf(cc[k]) * w; }
        const float bb = F.a.in[I_ADAB][l * 6144 + n];
        fmod(F)[(l * 4 + 0) * 6144 + n] = a0 + bb; fmod(F)[(l * 4 + 1) * 6144 + n] = a1 + bb; fmod(F)[(l * 4 + 2) * 6144 + n] = a2 + bb; fmod(F)[(l * 4 + 3) * 6144 + n] = a3 + bb;
        if (l == 0 && n < 2048) fmodc(F)[n] = a4 + bb;
    }
    for (int it = gt; it < 64 * 16; it += ngt) {
        const int pos = it >> 4, j = it & 15;
        const float inv = powf(10000.0f, -(float)j / 16.0f);
        const float ang = (float)pos * inv;
        frope(F)[it * 2] = cosf(ang); frope(F)[it * 2 + 1] = sinf(ang);
    }
}

__device__ __forceinline__ void norm_row(Frame& F, const float* xrow, const float* g, const float* sh, const float* sc, bf16* hrow) {
    const f32x4* xr = (const f32x4*)xrow + F.lane;
    f32x4 v[4]; float s = 0.f;
#pragma unroll
    for (int j = 0; j < 4; ++j) { v[j] = xr[64 * j]; s += (v[j].x * v[j].x + v[j].y * v[j].y) + (v[j].z * v[j].z + v[j].w * v[j].w); }
    const float rstd = rsqrtf(wave_sum(s) * (1.f / D) + EPS);
    unsigned long long* o8 = (unsigned long long*)hrow + F.lane;
#pragma unroll
    for (int j = 0; j < 4; ++j) {
        const f32x4 gg = ((const f32x4*)g)[F.lane + 64 * j], s1 = ((const f32x4*)sh)[F.lane + 64 * j], s2 = ((const f32x4*)sc)[F.lane + 64 * j];
        const f32x4 y = (v[j] * rstd * gg) * (s2 + 1.f) + s1;
        o8[64 * j] = (unsigned long long)pk2(y.x, y.y) | ((unsigned long long)pk2(y.z, y.w) << 32);
    }
}
__device__ __forceinline__ void ph_norm0(Frame& F) {
    for (int r = F.gw; r < NROW; r += F.ngw) {
        if (r < NTOK) { const int b = r >> 12; norm_row(F, F.a.in[I_X] + (size_t)r * D, F.a.in[I_NMG], fmod(F) + (0 * 4 + b) * 6144, fmod(F) + (0 * 4 + b) * 6144 + D, fH(F) + (size_t)r * D); }
        else norm_row(F, F.a.in[I_CTX] + (size_t)(r - NTOK) * D, F.a.in[I_NMG], fmodc(F), fmodc(F) + D, fH(F) + (size_t)r * D);
    }
}

__device__ __forceinline__ void ph_inproj_naive(Frame& F) {
    const float* W = F.a.in[I_WIN];
    for (int it = F.gw; it < 272 * 56; it += F.ngw) {
        const int rg = it / 56, u = it % 56; if (rg >= 256 && u >= 32) continue;
        const int row = rg * 64 + F.lane;
        float acc[64];
#pragma unroll
        for (int j = 0; j < 64; ++j) acc[j] = 0.f;
        naive_dot<64>(fH(F) + (size_t)row * D, W + u * 64, ABW, D, acc);
        const int t = u >> 3, h = u & 7;
        if ((t == 0 || t == 4) && row < NTOK) {
            const int tt = row & 4095, pr = tt >> 6, pc = tt & 63;
#pragma unroll
            for (int j = 0; j < 16; ++j) {
                const float c1 = frope(F)[(pr * 16 + j) * 2], s1 = frope(F)[(pr * 16 + j) * 2 + 1], c2 = frope(F)[(pc * 16 + j) * 2], s2 = frope(F)[(pc * 16 + j) * 2 + 1];
                const float a = acc[j], b = acc[j + 16], c = acc[32 + j], d = acc[48 + j];
                acc[j] = a * c1 - b * s1; acc[j + 16] = a * s1 + b * c1; acc[32 + j] = c * c2 - d * s2; acc[48 + j] = c * s2 + d * c2;
            }
        }
        if (t == 0) {
#pragma unroll
            for (int j = 0; j < 64; ++j) acc[j] *= 0.125f;
        }
        if (t == 2 || t == 6) {
            float ss = 0.f;
#pragma unroll
            for (int j = 0; j < 64; ++j) ss += acc[j] * acc[j];
            const float r = rsqrtf(ss * (1.f / 64.f) + EPS) * (t == 6 ? 0.125f : 1.f);
            const float* g = t == 2 ? F.a.in[I_KG] : F.a.in[I_QG];
#pragma unroll
            for (int j = 0; j < 64; ++j) acc[j] = acc[j] * r * g[j];
        }
        if (t == 5) {
#pragma unroll
            for (int j = 0; j < 64; ++j) acc[j] = siluf(acc[j]);
        }
        const size_t off_t = t < 4 ? (size_t)t * 17 * MiB : (size_t)(68 + (t - 4) * 16) * MiB;
        bf16* dst = (bf16*)(fA(F) + off_t) + (size_t)row * HW + h * 64;
        store_row_bf16<64>(dst, acc);
    }
}

__device__ __forceinline__ float ret_gamma_log(Frame& F, int dir, int h) {
    const float th = F.a.in[I_RDEC][dir * 8 + h];
    return -(th > 0.f ? th + log1pf(__expf(-th)) : log1pf(__expf(th)));
}
__device__ __forceinline__ void ph_scan_naive(Frame& F) {
    const bf16* RK = (const bf16*)(fA(F) + A_RK); const bf16* RV = (const bf16*)(fA(F) + A_RV); bf16* SST = (bf16*)(fA(F) + A_SST);
    const int gt = F.gw * 64 + F.lane, ngt = F.ngw * 64;
    for (int it = gt; it < 64 * 4096; it += ngt) {
        const int bhd = it >> 12, ed = it & 4095, e = ed >> 6, d = ed & 63;
        const int dir = bhd & 1, h = (bhd >> 1) & 7, b = bhd >> 4;
        const float gam = __expf(ret_gamma_log(F, dir, h));
        float S = 0.f;
        bf16* sst = SST + ((size_t)((b * 8 + h) * 2 + dir) * 32) * 4096 + ed;
        for (int n = 0; n < CTXL; ++n) { const int nn = dir ? (CTXL - 1 - n) : n; const size_t row = NTOK + b * CTXL + nn;
            S = gam * S + bf2f(RK[row * HW + h * 64 + d]) * bf2f(RV[row * HW + h * 64 + e]); }
        for (int n = 0; n < SEQ; ++n) { const int t = dir ? (SEQ - 1 - n) : n; const size_t row = (size_t)b * SEQ + t;
            if ((n & 127) == 0) sst[(size_t)(t >> 7) * 4096] = (bf16)f2bf(S);
            S = gam * S + bf2f(RK[row * HW + h * 64 + d]) * bf2f(RV[row * HW + h * 64 + e]); }
    }
}
__device__ __forceinline__ void ph_na_naive(Frame& F) {
    const bf16* NK = (const bf16*)(fA(F) + A_NK); const bf16* NV = (const bf16*)(fA(F) + A_NV); const bf16* NQ = (const bf16*)(fA(F) + A_NQ); bf16* MIX = (bf16*)(fA(F) + A_MIX);
    const int gt = F.gw * 64 + F.lane, ngt = F.ngw * 64;
    for (int it = gt; it < NB * NH * SEQ; it += ngt) {
        const int t = it & 4095, h = (it >> 12) & 7, b = it >> 15;
        const int r = t >> 6, c = t & 63;
        int r0 = r - 4; r0 = r0 < 0 ? 0 : (r0 > 56 ? 56 : r0); int c0 = c - 8; c0 = c0 < 0 ? 0 : (c0 > 48 ? 48 : c0);
        const size_t qrow = (size_t)b * SEQ + t;
        unsigned q[32]; float o[64];
#pragma unroll
        for (int j = 0; j < 32; ++j) q[j] = *(const unsigned*)(NQ + qrow * HW + h * 64 + 2 * j);
#pragma unroll
        for (int j = 0; j < 64; ++j) o[j] = 0.f;
        float m = -1e30f, l = 0.f;
        const float* rpb = F.a.in[I_RPB] + h * 15 * 31;
#pragma unroll 1
        for (int kk = 0; kk < 384; ++kk) {
            size_t krow; float bias = 0.f;
            if (kk < 128) { const int kr = r0 + (kk >> 4), kc = c0 + (kk & 15); krow = (size_t)b * SEQ + kr * 64 + kc; bias = rpb[(kr - r + 7) * 31 + (kc - c + 15)]; }
            else krow = NTOK + b * CTXL + (kk - 128);
            float s = 0.f;
#pragma unroll
            for (int j = 0; j < 64; j += 2) { const unsigned w = *(const unsigned*)(NK + krow * HW + h * 64 + j); s += bf2f(q[j >> 1] & 0xffffu) * bf2f(w & 0xffffu) + bf2f(q[j >> 1] >> 16) * bf2f(w >> 16); }
            s += bias;
            asm volatile("" ::: "memory");
            const float mn = fmaxf(m, s), al = __expf(m - mn), p = __expf(s - mn);
            l = l * al + p; m = mn;
#pragma unroll
            for (int j = 0; j < 64; j += 2) { const unsigned w = *(const unsigned*)(NV + krow * HW + h * 64 + j); o[j] = o[j] * al + p * bf2f(w & 0xffffu); o[j + 1] = o[j + 1] * al + p * bf2f(w >> 16); }
        }
        const float il = 1.f / l;
#pragma unroll
        for (int j = 0; j < 64; ++j) o[j] *= il;
        store_row_bf16<64>(MIX + qrow * D + 512 + h * 64, o);
    }
}
__device__ __forceinline__ void ph_retout_naive(Frame& F) {
    const bf16* RK = (const bf16*)(fA(F) + A_RK); const bf16* RV = (const bf16*)(fA(F) + A_RV); const bf16* RQ = (const bf16*)(fA(F) + A_RQ); const bf16* GT = (const bf16*)(fA(F) + A_GT);
    const bf16* SST = (const bf16*)(fA(F) + A_SST); bf16* MIX = (bf16*)(fA(F) + A_MIX);
    const int gt = F.gw * 64 + F.lane, ngt = F.ngw * 64;
    for (int it = gt; it < NB * NH * SEQ * 2; it += ngt) {
        const int hf = it & 1, t = (it >> 1) & 4095, h = (it >> 13) & 7, b = it >> 16;
        const int i = t & 127, ch = t >> 7;
        const size_t qrow = (size_t)b * SEQ + t;
        const float lgf = ret_gamma_log(F, 0, h), lgb = ret_gamma_log(F, 1, h);
        unsigned q[32]; float o[32];
#pragma unroll
        for (int j = 0; j < 32; ++j) q[j] = *(const unsigned*)(RQ + qrow * HW + h * 64 + 2 * j);
#pragma unroll
        for (int j = 0; j < 32; ++j) o[j] = 0.f;
#pragma unroll 1
        for (int jj = 0; jj < 128; ++jj) {
            const size_t krow = (size_t)b * SEQ + ch * 128 + jj;
            float s = 0.f;
#pragma unroll
            for (int j = 0; j < 64; j += 2) { const unsigned w = *(const unsigned*)(RK + krow * HW + h * 64 + j); s += bf2f(q[j >> 1] & 0xffffu) * bf2f(w & 0xffffu) + bf2f(q[j >> 1] >> 16) * bf2f(w >> 16); }
            asm volatile("" ::: "memory");
            const float wgt = jj < i ? __expf(lgf * (float)(i - jj)) : (jj > i ? __expf(lgb * (float)(jj - i)) : 2.f);
            s *= wgt;
#pragma unroll
            for (int j = 0; j < 32; j += 2) { const unsigned w = *(const unsigned*)(RV + krow * HW + h * 64 + hf * 32 + j); o[j] += s * bf2f(w & 0xffffu); o[j + 1] += s * bf2f(w >> 16); }
            asm volatile("" ::: "memory");
        }
        const float qf = __expf(lgf * (float)(i + 1)), qb = __expf(lgb * (float)(128 - i));
        const bf16* Sf = SST + ((size_t)((b * 8 + h) * 2 + 0) * 32 + ch) * 4096 + hf * 32 * 64; const bf16* Sb = SST + ((size_t)((b * 8 + h) * 2 + 1) * 32 + ch) * 4096 + hf * 32 * 64;
#pragma unroll 1
        for (int d = 0; d < 64; ++d) {
            const float qd = bf2f(RQ[qrow * HW + h * 64 + d]); const float qfd = qf * qd, qbd = qb * qd;
#pragma unroll
            for (int e = 0; e < 32; ++e) o[e] += qfd * bf2f(Sf[e * 64 + d]) + qbd * bf2f(Sb[e * 64 + d]);
            asm volatile("" ::: "memory");
        }
        float ss = 0.f;
#pragma unroll
        for (int j = 0; j < 32; ++j) ss += o[j] * o[j];
        ss += __shfl_xor(ss, 1);
        const float rs = rsqrtf(ss * (1.f / 64.f) + EPS);
        const float* g = F.a.in[I_RNG] + hf * 32;
#pragma unroll
        for (int j = 0; j < 32; j += 2) { const unsigned w = *(const unsigned*)(GT + qrow * HW + h * 64 + hf * 32 + j); o[j] = o[j] * rs * g[j] * bf2f(w & 0xffffu); o[j + 1] = o[j + 1] * rs * g[j + 1] * bf2f(w >> 16); }
        store_row_bf16<32>(MIX + qrow * D + h * 64 + hf * 32, o);
    }
}
__device__ __forceinline__ void ph_gemm_res_naive(Frame& F, const bf16* A, int lda, int K, const float* W, const float* base, const float* gate  ) {
    for (int it = F.gw; it < 256 * 16; it += F.ngw) {
        const int rg = it >> 4, u = it & 15, row = rg * 64 + F.lane, b = row >> 12;
        float acc[64];
#pragma unroll
        for (int j = 0; j < 64; ++j) acc[j] = 0.f;
        naive_dot<64>(A + (size_t)row * lda, W + u * 64, D, K, acc);
        const float* gp = gate + b * 6144 + u * 64; const float* bp = base + (size_t)row * D + u * 64; float* op = F.a.out + (size_t)row * D + u * 64;
#pragma unroll
        for (int j = 0; j < 64; j += 4) { const f32x4 bv = *(const f32x4*)(bp + j), gv = *(const f32x4*)(gp + j);
            *(f32x4*)(op + j) = bv + gv * (f32x4){acc[j], acc[j + 1], acc[j + 2], acc[j + 3]}; }
    }
}
__device__ __forceinline__ void ph_route(Frame& F, int l, bool dry = false) {
    typedef short bf16x8_ __attribute__((ext_vector_type(8)));
    LAS bf16* wh = (LAS bf16*)F.lds;
    LAS bf16* wl = wh + 16 * 1024;
    LAS float* gsb = (LAS float*)(F.lds + 65536);
    LAS float* shb = gsb + 4 * 1024;
    for (int i = F.tid; i < D * NE; i += NTHREADS) { const int e = i >> 10, k = i & 1023; const float w = F.a.in[I_RW][k * 16 + e]; const unsigned h = f2bf(w); const float rem = w - bf2f(h);
        wh[i] = (bf16)h; wl[i] = (bf16)f2bf(rem); }
    for (int i = F.tid; i < 4 * D; i += NTHREADS) { const int b = i >> 10, k = i & 1023; const float* md = fmod(F) + (l * 4 + b) * 6144;
        gsb[i] = F.a.in[I_NFG][l * D + k] * (md[4 * D + k] + 1.f); shb[i] = md[3 * D + k]; }
    __syncthreads();
    unsigned* cnt = fctl(F) + CW_CNT + l * 1024;
    const int row16 = F.lane & 15, kq = F.lane >> 4;
    LAS float* xss = (LAS float*)(F.lds + 65536 + 32768);
    LAS float* xlg = xss + 128;
    const int kh = F.wave >> 2, wi = F.wave & 3;
    for (int item0 = (int)blockIdx.x * 4; item0 < NTOK / 16; item0 += (int)gridDim.x * 4) {
        const int item = item0 + wi;
        const int r = item * 16 + row16, b = (item * 16) >> 12;
        const bf16* xrow = (const bf16*)(l == 0 ? fA(F) + A_X1 : fA(F) + A_X3) + (size_t)r * D + 512 * kh + 8 * kq;
        float ss = 0.f;
#pragma unroll 8
        for (int s2 = 0; s2 < 16; ++s2) { const u32x4 t = *(const u32x4*)(xrow + 32 * s2);
            const f32x4 a = { bf2f(t.x & 0xffffu), bf2f(t.x >> 16), bf2f(t.y & 0xffffu), bf2f(t.y >> 16) }, c = { bf2f(t.z & 0xffffu), bf2f(t.z >> 16), bf2f(t.w & 0xffffu), bf2f(t.w >> 16) };
            ss += (a.x * a.x + a.y * a.y) + (a.z * a.z + a.w * a.w) + (c.x * c.x + c.y * c.y) + (c.z * c.z + c.w * c.w); }
        ss += __shfl_xor(ss, 16); ss += __shfl_xor(ss, 32);
        __syncthreads();
        if (kq == 0) xss[F.wave * 16 + row16] = ss;
        __syncthreads();
        ss = xss[wi * 16 + row16] + xss[(wi + 4) * 16 + row16];
        const float rstd = rsqrtf(ss * (1.f / D) + EPS);
        f32x4 acc = {0.f, 0.f, 0.f, 0.f};
        bf16* hrow = fH(F) + (size_t)r * D + 512 * kh + 8 * kq;
        const LAS float* gp = gsb + b * 1024 + 512 * kh + 8 * kq; const LAS float* sp = shb + b * 1024 + 512 * kh + 8 * kq;
        const LAS bf16* whp = wh + row16 * 1024 + 512 * kh + 8 * kq; const LAS bf16* wlp = wl + row16 * 1024 + 512 * kh + 8 * kq;
#pragma unroll 4
        for (int s2 = 0; s2 < 16; ++s2) {
            const u32x4 t = *(const u32x4*)(xrow + 32 * s2);
            const f32x4 a = { bf2f(t.x & 0xffffu), bf2f(t.x >> 16), bf2f(t.y & 0xffffu), bf2f(t.y >> 16) }, c = { bf2f(t.z & 0xffffu), bf2f(t.z >> 16), bf2f(t.w & 0xffffu), bf2f(t.w >> 16) };
            const f32x4 g0 = *(const LAS f32x4*)(gp + 32 * s2), g1 = *(const LAS f32x4*)(gp + 32 * s2 + 4), h0 = *(const LAS f32x4*)(sp + 32 * s2), h1 = *(const LAS f32x4*)(sp + 32 * s2 + 4);
            const f32x4 y0 = (a * rstd) * g0 + h0, y1 = (c * rstd) * g1 + h1;
            u32x4 yh; yh.x = pk2(y0.x, y0.y); yh.y = pk2(y0.z, y0.w); yh.z = pk2(y1.x, y1.y); yh.w = pk2(y1.z, y1.w);
            *(u32x4*)(hrow + 32 * s2) = yh;
            const f32x4 r0 = { y0.x - bf2f(yh.x & 0xffffu), y0.y - bf2f(yh.x >> 16), y0.z - bf2f(yh.y & 0xffffu), y0.w - bf2f(yh.y >> 16) };
            const f32x4 r1 = { y1.x - bf2f(yh.z & 0xffffu), y1.y - bf2f(yh.z >> 16), y1.z - bf2f(yh.w & 0xffffu), y1.w - bf2f(yh.w >> 16) };
            u32x4 yl; yl.x = pk2(r0.x, r0.y); yl.y = pk2(r0.z, r0.w); yl.z = pk2(r1.x, r1.y); yl.w = pk2(r1.z, r1.w);
            const bf16x8_ wfh = *(const LAS bf16x8_*)(whp + 32 * s2), wfl = *(const LAS bf16x8_*)(wlp + 32 * s2);
            const bf16x8_ yfh = __builtin_bit_cast(bf16x8_, yh), yfl = __builtin_bit_cast(bf16x8_, yl);
            acc = __builtin_amdgcn_mfma_f32_16x16x32_bf16(wfh, yfh, acc, 0, 0, 0);
            acc = __builtin_amdgcn_mfma_f32_16x16x32_bf16(wfl, yfh, acc, 0, 0, 0);
            acc = __builtin_amdgcn_mfma_f32_16x16x32_bf16(wfh, yfl, acc, 0, 0, 0);
        }
        if (kh == 1) *(LAS f32x4*)(xlg + (wi * 64 + F.lane) * 4) = acc;
        __syncthreads();
        if (kh == 1) continue;
        acc = acc + *(const LAS f32x4*)(xlg + (wi * 64 + F.lane) * 4);
        float m1 = -1e30f, m2 = -1e30f, w1 = 0.f, w2 = 0.f; int i1 = 0, i2 = 0;
#pragma unroll
        for (int g = 0; g < 4; ++g) { const float af = 1.f / (1.f + __expf(-acc[g])); const float x = af + F.a.in[I_RB][4 * kq + g]; const int id = 4 * kq + g;
            if (x > m1) { m2 = m1; i2 = i1; w2 = w1; m1 = x; i1 = id; w1 = af; } else if (x > m2) { m2 = x; i2 = id; w2 = af; } }
        const float gsc = m1 + m2;
        const float s0 = __shfl(gsc, row16), s1 = __shfl(gsc, row16 + 16), s2_ = __shfl(gsc, row16 + 32), s3 = __shfl(gsc, row16 + 48);
        int best = 0; float bs = s0; if (s1 > bs) { bs = s1; best = 1; } if (s2_ > bs) { bs = s2_; best = 2; } if (s3 > bs) { bs = s3; best = 3; }
        const bool writer = (kq == best) && !dry;
        int mycount = 0; unsigned long long below1 = 0ull, below2 = 0ull;
        const unsigned long long ltmask = (1ull << F.lane) - 1ull;
#pragma unroll
        for (int e = 0; e < 16; ++e) { const unsigned long long m = __ballot(writer && (i1 == e || i2 == e));
            if (F.lane == e) mycount = __popcll(m);
            if (i1 == e) below1 = m & ltmask; if (i2 == e) below2 = m & ltmask; }
        int base = 0;
        if (F.lane < 16 && mycount > 0) base = (int)__hip_atomic_fetch_add(cnt + F.lane * 64, (unsigned)mycount, RLX_AGENT);
        const int b1 = __shfl(base, i1), b2 = __shfl(base, i2);
        if (writer) { const float inv = 1.f / (w1 + w2);
            u32x2 r1_, r2_; r1_.x = (unsigned)(2 * r); r1_.y = __builtin_bit_cast(unsigned, w1 * inv); r2_.x = (unsigned)(2 * r + 1); r2_.y = __builtin_bit_cast(unsigned, w2 * inv);
            ((u32x2*)flist(F))[i1 * 16384 + b1 + __popcll(below1)] = r1_; ((u32x2*)flist(F))[i2 * 16384 + b2 + __popcll(below2)] = r2_; }
    }
    __syncthreads();
}
struct Seg { int cnt[16]; int base[16]; };
__device__ __forceinline__ void load_seg(Frame& F, int l, int (&cnt)[16], int (&base)[16]) {
    int acc = 0;
#pragma unroll
    for (int e = 0; e < 16; ++e) { cnt[e] = (int)__hip_atomic_load(fctl(F) + CW_CNT + l * 1024 + e * 64, RLX_AGENT); base[e] = acc; acc += (cnt[e] + 255) & ~255; }
}
__device__ __forceinline__ void ph_moe_gu_naive(Frame& F, int l) {
    int cnt[16], base[16]; load_seg(F, l, cnt, base);
    bf16* ACT = (bf16*)(fA(F) + A_ACT);
    int tot = 0;
#pragma unroll
    for (int i = 0; i < 16; ++i) tot += (cnt[i] + 63) >> 6;
    for (int it = F.gw; it < tot * 16; it += F.ngw) {
        const int gi_all = it >> 4, u = it & 15;
        int ee = 0, gs = 0;
#pragma unroll
        for (int i = 0, cum = 0; i < 16; ++i) { cum += (cnt[i] + 63) >> 6; if (gi_all >= cum) { gs = cum; ee = i + 1; } }
        int ce = 0, be = 0;
#pragma unroll
        for (int i = 0; i < 16; ++i) if (i == ee) { ce = cnt[i]; be = base[i]; }
        const int pos = (gi_all - gs) * 64 + F.lane; const bool valid = pos < ce;
        const int ent = flist(F)[(ee * 16384 + (valid ? pos : 0)) * 2]; const int tok = ent >> 1;
        float ag[32], au[32];
#pragma unroll
        for (int j = 0; j < 32; ++j) { ag[j] = 0.f; au[j] = 0.f; }
        const float* Wg = F.a.in[I_WG] + ((size_t)(l * NE + ee) * D) * EW + u * 32; const float* Wu = F.a.in[I_WU] + ((size_t)(l * NE + ee) * D) * EW + u * 32;
        naive_dot<32>(fH(F) + (size_t)tok * D, Wg, EW, D, ag);
        naive_dot<32>(fH(F) + (size_t)tok * D, Wu, EW, D, au);
#pragma unroll
        for (int j = 0; j < 32; ++j) ag[j] = siluf(ag[j]) * au[j];
        if (valid) store_row_bf16<32>(ACT + (size_t)(be + pos) * EW + u * 32, ag);
    }
}
__device__ __forceinline__ void ph_moe_dn_naive(Frame& F, int l) {
    int cnt[16], base[16]; load_seg(F, l, cnt, base);
    const bf16* ACT = (const bf16*)(fA(F) + A_ACT); bf16* Y = (bf16*)(fA(F) + A_Y);
    int tot = 0;
#pragma unroll
    for (int i = 0; i < 16; ++i) tot += (cnt[i] + 63) >> 6;
    for (int it = F.gw; it < tot * 16; it += F.ngw) {
        const int gi_all = it >> 4, u = it & 15;
        int ee = 0, gs = 0;
#pragma unroll
        for (int i = 0, cum = 0; i < 16; ++i) { cum += (cnt[i] + 63) >> 6; if (gi_all >= cum) { gs = cum; ee = i + 1; } }
        int ce = 0, be = 0;
#pragma unroll
        for (int i = 0; i < 16; ++i) if (i == ee) { ce = cnt[i]; be = base[i]; }
        const int pos = (gi_all - gs) * 64 + F.lane; const bool valid = pos < ce;
        const int ent = flist(F)[(ee * 16384 + (valid ? pos : 0)) * 2];
        float acc[64];
#pragma unroll
        for (int j = 0; j < 64; ++j) acc[j] = 0.f;
        const float* Wd = F.a.in[I_WD] + ((size_t)(l * NE + ee) * EW) * D + u * 64;
        naive_dot<64>(ACT + (size_t)(be + (valid ? pos : 0)) * EW, Wd, D, EW, acc);
        const float w = __builtin_bit_cast(float, flist(F)[(ee * 16384 + (valid ? pos : 0)) * 2 + 1]);
#pragma unroll
        for (int j = 0; j < 64; ++j) acc[j] *= w;
        if (valid) store_row_bf16<64>(Y + (size_t)ent * D + u * 64, acc);
    }
}
__device__ __forceinline__ void ph_combine(Frame& F, int l, bool do_norm, bool dry = false) {
    const float dsc = dry ? 0.f : 1.f;
    const bf16* Y = (const bf16*)(fA(F) + A_Y);
    const bf16* X = (const bf16*)(l == 0 ? fA(F) + A_X1 : fA(F) + A_X3);
    for (int r = F.gw; r < NTOK; r += F.ngw) {
        const int b = r >> 12;
        const float* gf = fmod(F) + (l * 4 + b) * 6144 + 5 * D;
        const unsigned long long* xr = (const unsigned long long*)(X + (size_t)r * D) + F.lane;
        const unsigned long long* ya = (const unsigned long long*)(Y + (size_t)(2 * r) * D) + F.lane; const unsigned long long* yb = (const unsigned long long*)(Y + (size_t)(2 * r + 1) * D) + F.lane;
        f32x4 v[4]; float s = 0.f;
#pragma unroll
        for (int j = 0; j < 4; ++j) {
            const unsigned long long a = ya[64 * j], bq = yb[64 * j], xq = xr[64 * j];
            const f32x4 yy = { bf2f((unsigned)a & 0xffffu) + bf2f((unsigned)bq & 0xffffu), bf2f(((unsigned)a) >> 16) + bf2f(((unsigned)bq) >> 16),
                               bf2f((unsigned)(a >> 32) & 0xffffu) + bf2f((unsigned)(bq >> 32) & 0xffffu), bf2f((unsigned)(a >> 48)) + bf2f((unsigned)(bq >> 48)) };
            const f32x4 xv = { bf2f((unsigned)xq & 0xffffu), bf2f(((unsigned)xq) >> 16), bf2f((unsigned)(xq >> 32) & 0xffffu), bf2f((unsigned)(xq >> 48)) };
            v[j] = xv + ((const f32x4*)gf)[F.lane + 64 * j] * yy * dsc;
            if (do_norm) ((unsigned long long*)((bf16*)F.a.out + (size_t)r * D))[F.lane + 64 * j] = (unsigned long long)pk2(v[j].x, v[j].y) | ((unsigned long long)pk2(v[j].z, v[j].w) << 32);
            else ((f32x4*)(F.a.out + (size_t)r * D))[F.lane + 64 * j] = v[j];
            s += (v[j].x * v[j].x + v[j].y * v[j].y) + (v[j].z * v[j].z + v[j].w * v[j].w);
        }
        if (do_norm) {
            const float rstd = rsqrtf(wave_sum(s) * (1.f / D) + EPS);
            const float* g = F.a.in[I_NMG] + (l + 1) * D; const float* sh = fmod(F) + ((l + 1) * 4 + b) * 6144; const float* sc = sh + D;
            unsigned long long* o8 = (unsigned long long*)(fH(F) + (size_t)r * D) + F.lane;
#pragma unroll
            for (int j = 0; j < 4; ++j) {
                const f32x4 gg = ((const f32x4*)g)[F.lane + 64 * j], s1 = ((const f32x4*)sh)[F.lane + 64 * j], s2 = ((const f32x4*)sc)[F.lane + 64 * j];
                const f32x4 y = (v[j] * rstd * gg) * (s2 + 1.f) + s1;
                o8[64 * j] = (unsigned long long)pk2(y.x, y.y) | ((unsigned long long)pk2(y.z, y.w) << 32);
            }
        }
    }
}
__device__ __forceinline__ void ph_sguin_naive(Frame& F) {
    bf16* U = (bf16*)(fA(F) + A_U); bf16* V = (bf16*)(fA(F) + A_V);
    for (int it = F.gw; it < 256 * 96; it += F.ngw) {
        const int rg = it / 96, u = it % 96, row = rg * 64 + F.lane;
        float acc[64];
#pragma unroll
        for (int j = 0; j < 64; ++j) acc[j] = 0.f;
        naive_dot<64>(fH(F) + (size_t)row * D, F.a.in[I_SWIN] + u * 64, 2 * SGW, D, acc);
        const float* bi = F.a.in[I_SBIN] + u * 64; float ss = 0.f;
#pragma unroll
        for (int j = 0; j < 64; ++j) { acc[j] = gelu_tanh(acc[j] + bi[j]); ss += acc[j] * acc[j]; }
        if (u < 48) store_row_bf16<64>(U + (size_t)row * SGW + u * 64, acc);
        else { store_row_bf16<64>(V + (size_t)row * SGW + (u - 48) * 64, acc); fvss(F)[(size_t)row * 48 + (u - 48)] = ss; }
    }
}
__device__ __forceinline__ void ph_sgumix_naive(Frame& F) {
    bf16* U = (bf16*)(fA(F) + A_U); const bf16* V = (const bf16*)(fA(F) + A_V);
    LAS float* rs = (LAS float*)F.lds;
    for (int bc = blockIdx.x; bc < NB * 32; bc += gridDim.x) {
        const size_t row0 = (size_t)bc * 128;
        __syncthreads();
        if (F.tid < 128) { float s = 0.f; for (int j = 0; j < 48; ++j) s += fvss(F)[(row0 + F.tid) * 48 + j]; rs[F.tid] = rsqrtf(s * (1.f / SGW) + EPS); }
        __syncthreads();
        for (int o = F.tid; o < 128 * SGW; o += NTHREADS) {
            const int i = o / SGW, c = o % SGW, g = c / 384;
            const float* ws = F.a.in[I_SWS] + ((size_t)g * 128 + i) * 128;
            float acc = 0.f;
            for (int j = 0; j < 128; ++j) acc += ws[j] * (bf2f(V[(row0 + j) * SGW + c]) * rs[j]);
            const float mixed = acc * F.a.in[I_SNG][c] + F.a.in[I_SBS][g * 128 + i];
            const size_t idx = (row0 + i) * SGW + c;
            U[idx] = (bf16)f2bf(bf2f(U[idx]) * mixed);
        }
    }
    __syncthreads();
}


namespace pg8 {
typedef short bf16x8 __attribute__((ext_vector_type(8)));
constexpr int BM = 256, BK = 64, HALF = 128, HTB = HALF * BK * 2, STAGE_BYTES = 8 * HTB;
__host__ __device__ __forceinline__ int lds_byte(int r, int c) { const int st = (r >> 4) * 2 + (c >> 5), rr = r & 15, cc = c & 31, ob = rr * 64 + cc * 2; return st * 1024 + (ob ^ (((ob >> 9) & 1) << 5)); }
__host__ __device__ __forceinline__ void stage_rc(int b, int& R, int& C) { const int st = b / 1024, sb = b % 1024, swz = sb ^ (((sb >> 9) & 1) << 5); R = (st >> 1) * 16 + swz / 64; C = (st & 1) * 32 + (swz % 64) / 2; }
struct Unit { int pm, pn; const char* Ab; const char* Bb; int x0, x1, x2; };
__device__ __forceinline__ unsigned cvt_pk_bf16(float lo, float hi) { unsigned r; asm volatile("v_cvt_pk_bf16_f32 %0, %1, %2" : "=v"(r) : "v"(lo), "v"(hi)); return r; }

template <class Sched, class Epi, bool ALIGN_EPI>
__device__ __forceinline__ void gemm_phase(LAS unsigned char* lds, const int K, const Sched& S, const Epi& E) {
    const int tid = threadIdx.x, wid = __builtin_amdgcn_readfirstlane(tid >> 6), lane = tid & 63, wr = wid >> 2, wc = wid & 3, fr = lane & 15, fq = lane >> 4;
    const int nt = K / BK;
    unsigned voffB[2];
#pragma unroll
    for (int i = 0; i < 2; ++i) { int R_, C_; stage_rc(tid * 16 + i * 8192, R_, C_); voffB[i] = (unsigned)(R_ * K + C_) * 2u; }
    const size_t kstep = (size_t)(BK * 2);
    const size_t hstep = (size_t)HALF * K * 2;
    const unsigned ldsw = (unsigned)wid * 1024u;
    const int aoff = lds_byte(wr * 64 + fr, fq * 8), boff = lds_byte(wc * 32 + fr, fq * 8);
#define PG8_SA(b, h) (((b) * 2 + (h)) * HTB)
#define PG8_SB(b, h) ((4 + (b) * 2 + (h)) * HTB)
#define PG8_STAGE(bufoff, gbase, voff) do { _Pragma("unroll") for (int _i = 0; _i < 2; ++_i) \
        __builtin_amdgcn_global_load_lds((const unsigned*)((const char*)(gbase) + (voff)[_i]), (LAS unsigned*)(lds + (bufoff) + ldsw + _i * 8192), 16, 0, 0); } while (0)
#define PG8_LDA(dst, b, h) do { _Pragma("unroll") for (int m = 0; m < 4; ++m) _Pragma("unroll") for (int k = 0; k < 2; ++k) dst[m][k] = *(const LAS bf16x8*)(lds + PG8_SA(b, h) + aoff + m * 2048 + k * 1024); } while (0)
#define PG8_LDB(dst, b, h) do { _Pragma("unroll") for (int n = 0; n < 2; ++n) _Pragma("unroll") for (int k = 0; k < 2; ++k) dst[n][k] = *(const LAS bf16x8*)(lds + PG8_SB(b, h) + boff + n * 2048 + k * 1024); } while (0)
#define PG8_MMA(ai, bj, At, Bt) do { __builtin_amdgcn_s_setprio(1); _Pragma("unroll") for (int m = 0; m < 4; ++m) _Pragma("unroll") for (int n = 0; n < 2; ++n) _Pragma("unroll") for (int k = 0; k < 2; ++k) \
        acc[ai][bj][m][n] = __builtin_amdgcn_mfma_f32_16x16x32_bf16(Bt[n][k], At[m][k], acc[ai][bj][m][n], 0, 0, 0); __builtin_amdgcn_s_setprio(0); } while (0)
#define PG8_WAIT_V(n) asm volatile("s_waitcnt vmcnt(" #n ")" ::: "memory")
#define PG8_WAIT_L(n) asm volatile("s_waitcnt lgkmcnt(" #n ")" ::: "memory")
#define PG8_BAR __builtin_amdgcn_s_barrier()
#define PG8_SCHED __builtin_amdgcn_sched_barrier(0)
    Unit cur, nxt; int ui = 0;
    if (!S.next(0, cur)) return;
    unsigned vA[2][2];
    S.arows(cur, vA);
    asm volatile("" : "+v"(vA[0][0]), "+v"(vA[0][1]), "+v"(vA[1][0]), "+v"(vA[1][1]));
    f32x4 acc[2][2][4][2];
#pragma unroll
    for (int a = 0; a < 2; ++a)
#pragma unroll
        for (int b = 0; b < 2; ++b)
#pragma unroll
            for (int m = 0; m < 4; ++m)
#pragma unroll
                for (int n = 0; n < 2; ++n) acc[a][b][m][n] = (f32x4){0.f, 0.f, 0.f, 0.f};
    bf16x8 At[4][2], B0[2][2], B1[2][2];
    const char* cA = cur.Ab; const char* cB = cur.Bb;
    PG8_STAGE(PG8_SB(0, 0), cB, voffB); PG8_STAGE(PG8_SB(0, 1), cB + hstep, voffB); PG8_STAGE(PG8_SA(0, 0), cA, vA[0]); PG8_STAGE(PG8_SA(0, 1), cA, vA[1]);
    if (wr == 1) PG8_BAR;
    PG8_WAIT_V(2); PG8_BAR;
    PG8_STAGE(PG8_SB(1, 0), cB + kstep, voffB); PG8_STAGE(PG8_SA(1, 0), cA + kstep, vA[0]); PG8_STAGE(PG8_SB(1, 1), cB + hstep + kstep, voffB);
    PG8_WAIT_V(6); PG8_BAR;
    for (;;) {
        const bool has_next = S.next(ui + 1, nxt);
        const char* nA = has_next ? nxt.Ab : cA; const char* nB = has_next ? nxt.Bb : cB;
        for (int t = 0; t < nt; t += 2) {
            const bool last = (t == nt - 2);
            const char* a1 = cA + (size_t)(t + 1) * kstep;
            const char* a2 = last ? nA : cA + (size_t)(t + 2) * kstep; const char* b2 = last ? nB : cB + (size_t)(t + 2) * kstep;
            const char* a3 = a2 + kstep; const char* b3 = b2 + kstep;
            unsigned w0[2], w1[2];
            w0[0] = vA[0][0]; w0[1] = vA[0][1]; w1[0] = vA[1][0]; w1[1] = vA[1][1];
            if (last && has_next) { unsigned nv[2][2]; pg8::Unit tu = nxt; asm volatile("" : "+v"(tu.pm)); S.arows(tu, nv);
                asm volatile("" : "+v"(nv[0][0]), "+v"(nv[0][1]), "+v"(nv[1][0]), "+v"(nv[1][1]));
                w0[0] = nv[0][0]; w0[1] = nv[0][1]; w1[0] = nv[1][0]; w1[1] = nv[1][1]; }
            PG8_LDB(B0, 0, 0); PG8_LDB(B1, 0, 1); PG8_SCHED; PG8_LDA(At, 0, 0); PG8_STAGE(PG8_SA(1, 1), a1, vA[1]);
            PG8_WAIT_V(8); PG8_WAIT_L(0); PG8_BAR; PG8_MMA(0, 0, At, B0); PG8_MMA(0, 1, At, B1); PG8_BAR; PG8_SCHED;
            PG8_LDA(At, 0, 1); PG8_STAGE(PG8_SB(0, 0), b2, voffB); PG8_STAGE(PG8_SB(0, 1), b2 + hstep, voffB); PG8_STAGE(PG8_SA(0, 0), a2, w0);
            PG8_WAIT_V(8); PG8_WAIT_L(0); PG8_BAR; PG8_MMA(1, 0, At, B0); PG8_MMA(1, 1, At, B1); PG8_BAR; PG8_SCHED;
            PG8_LDB(B0, 1, 0); PG8_LDB(B1, 1, 1); PG8_SCHED; PG8_LDA(At, 1, 0); PG8_STAGE(PG8_SA(0, 1), a2, w1);
            PG8_WAIT_V(8); PG8_WAIT_L(0); PG8_BAR; PG8_MMA(0, 0, At, B0); PG8_MMA(0, 1, At, B1); PG8_BAR; PG8_SCHED;
            PG8_LDA(At, 1, 1); PG8_STAGE(PG8_SB(1, 0), b3, voffB); PG8_STAGE(PG8_SB(1, 1), b3 + hstep, voffB); PG8_STAGE(PG8_SA(1, 0), a3, w0);
            PG8_WAIT_V(8); PG8_WAIT_L(0); PG8_BAR; PG8_MMA(1, 0, At, B0); PG8_MMA(1, 1, At, B1); PG8_BAR; PG8_SCHED;
        }
        if constexpr (ALIGN_EPI) { if (wr == 0) PG8_BAR; }
        E(acc, cur, wr, wc, fr, fq);
        if (!has_next) break;
#pragma unroll
        for (int a = 0; a < 2; ++a)
#pragma unroll
            for (int b = 0; b < 2; ++b)
#pragma unroll
                for (int m = 0; m < 4; ++m)
#pragma unroll
                    for (int n = 0; n < 2; ++n) acc[a][b][m][n] = (f32x4){0.f, 0.f, 0.f, 0.f};
        cur = nxt; cA = nA; cB = nB; ++ui;
        S.arows(cur, vA);
        asm volatile("" : "+v"(vA[0][0]), "+v"(vA[0][1]), "+v"(vA[1][0]), "+v"(vA[1][1]));
        if constexpr (ALIGN_EPI) { if (wr == 1) PG8_BAR; }
    }
    PG8_WAIT_V(0);
    if constexpr (!ALIGN_EPI) { if (wr == 0) PG8_BAR; }
    PG8_BAR;
#undef PG8_SA
#undef PG8_SB
#undef PG8_STAGE
#undef PG8_LDA
#undef PG8_LDB
#undef PG8_MMA
#undef PG8_WAIT_V
#undef PG8_WAIT_L
#undef PG8_BAR
#undef PG8_SCHED
}
}

constexpr size_t WB_WIN = 0;
constexpr size_t WB_WOUT = WB_WIN + (size_t)ABW * D * 2;
constexpr size_t WB_SWIN = WB_WOUT + (size_t)D * D * 2;
constexpr size_t WB_SWOUT = WB_SWIN + (size_t)2 * SGW * D * 2;
constexpr size_t WB_GU = WB_SWOUT + (size_t)D * SGW * 2;
constexpr size_t WB_DN = WB_GU + (size_t)2 * NE * 1024 * D * 2;
constexpr size_t WB_WS = WB_DN + (size_t)2 * NE * D * EW * 2;
constexpr size_t WB_END = WB_WS + (size_t)8 * 128 * 128 * 2;
static_assert(WB_END <= 124 * MiB, "bf16 weights fit");

__device__ __forceinline__ int slot_of(int mode, int c) {
    if (mode == 0) { const int bj = (c >> 7) & 1, wc = (c >> 5) & 3, fq = (c >> 3) & 3, nn = (c >> 2) & 1, rg = c & 3; return 128 * bj + 32 * wc + 16 * nn + 4 * fq + rg; }
    if (mode == 1) { const int wc = (c >> 6) & 3, bj = (c >> 5) & 1, nn = (c >> 4) & 1, fq = (c >> 2) & 3, rg = c & 3; return 128 * bj + 32 * wc + 16 * nn + 4 * fq + rg; }
    const int wc = (c >> 6) & 3, bj = (c >> 5) & 1, fq = (c >> 3) & 3, nn = (c >> 2) & 1, rg = c & 3; return 128 * bj + 32 * wc + 16 * nn + 4 * fq + rg;
}
template <class RowFn> __device__ __forceinline__ void conv_item(const float* W, int ldw, int k0, int n0, bf16* WT, int Kp, LAS float* scr, int lane, const RowFn& rowfn) {
    f32x4 v[8];
#pragma unroll
    for (int i = 0; i < 8; ++i) { const int kk = 8 * i + (lane >> 3); v[i] = *(const f32x4*)(W + (size_t)(k0 + kk) * ldw + n0 + 4 * (lane & 7)); }
#pragma unroll
    for (int i = 0; i < 8; ++i) { const int kk = 8 * i + (lane >> 3); LAS float* p = scr + kk * 33 + 4 * (lane & 7); p[0] = v[i].x; p[1] = v[i].y; p[2] = v[i].z; p[3] = v[i].w; }
    asm volatile("s_waitcnt lgkmcnt(0)" ::: "memory");
    const int c = lane & 7;
#pragma unroll
    for (int j = 0; j < 4; ++j) { const int n = (lane >> 3) + 8 * j; const LAS float* sp = scr + (8 * c) * 33 + n;
        u32x4 o; o.x = pk2(sp[0 * 33], sp[1 * 33]); o.y = pk2(sp[2 * 33], sp[3 * 33]); o.z = pk2(sp[4 * 33], sp[5 * 33]); o.w = pk2(sp[6 * 33], sp[7 * 33]);
        *(u32x4*)(WT + (size_t)rowfn(n0 + n) * Kp + k0 + 8 * c) = o; }
    asm volatile("s_waitcnt lgkmcnt(0)" ::: "memory");
}
__device__ __forceinline__ void ph_convert(Frame& F, int set, int wj, int nw, int pct_lo = 0, int pct_hi = 100) {
    LAS float* scr = (LAS float*)(F.lds + F.wave * 16384);
    bf16* WB = (bf16*)(F.a.ws + WS_WB);
    constexpr int I_1 = 16 * 112, I_2 = 16 * 32, I_3 = 16 * 192, I_4 = 48 * 32, I_5 = 32 * 512, I_6 = 32 * 256, I_7 = 8 * 128 * 128 / 512;
    constexpr int B5 = I_1 + I_2 + I_3 + I_4, B6 = B5 + I_5, B7 = B6 + I_6;
    constexpr int N_EARLY = I_1 + I_2 + I_5 / 2 + I_6 / 2, N_LATE = I_3 + I_4 + I_5 / 2 + I_6 / 2 + I_7;
    const int nset = set == 0 ? N_EARLY : N_LATE; const int jlo = nset * pct_lo / 100, jhi = nset * pct_hi / 100;
    for (int j = jlo + wj; j < jhi; j += nw) {
        int r;
        if (set == 0) { if (j < I_1 + I_2) r = j; else if (j < I_1 + I_2 + I_5 / 2) r = B5 + (j - (I_1 + I_2)); else r = B6 + (j - (I_1 + I_2 + I_5 / 2)); }
        else { if (j < I_3 + I_4) r = I_1 + I_2 + j; else if (j < I_3 + I_4 + I_5 / 2) r = B5 + I_5 / 2 + (j - (I_3 + I_4)); else if (j < I_3 + I_4 + I_5 / 2 + I_6 / 2) r = B6 + I_6 / 2 + (j - (I_3 + I_4 + I_5 / 2)); else r = B7 + (j - (I_3 + I_4 + I_5 / 2 + I_6 / 2)); }
        if (r < I_1) { const int kb = r / 112, nb = r % 112, n0 = nb * 32; const int tile = n0 >> 8, ty = tile >> 1; const int mode = (ty == 0 || ty == 4) ? 1 : 2;
            conv_item(F.a.in[I_WIN], ABW, kb * 64, n0, (bf16*)((char*)WB + WB_WIN), D, scr, F.lane, [=](int n) { return (n & ~255) + slot_of(mode, n & 255); }); continue; } r -= I_1;
        if (r < I_2) { const int kb = r / 32, nb = r % 32;
            conv_item(F.a.in[I_WOUT], D, kb * 64, nb * 32, (bf16*)((char*)WB + WB_WOUT), D, scr, F.lane, [=](int n) { return (n & ~255) + slot_of(0, n & 255); }); continue; } r -= I_2;
        if (r < I_3) { const int kb = r / 192, nb = r % 192;
            conv_item(F.a.in[I_SWIN], 2 * SGW, kb * 64, nb * 32, (bf16*)((char*)WB + WB_SWIN), D, scr, F.lane, [=](int n) { return (n & ~255) + slot_of(0, n & 255); }); continue; } r -= I_3;
        if (r < I_4) { const int kb = r / 32, nb = r % 32;
            conv_item(F.a.in[I_SWOUT], D, kb * 64, nb * 32, (bf16*)((char*)WB + WB_SWOUT), SGW, scr, F.lane, [=](int n) { return (n & ~255) + slot_of(0, n & 255); }); continue; } r -= I_4;
        if (r < I_5) { const int le = r / 512, q = r % 512, which = q >> 8, kb = (q & 255) / 16, nb = q % 16;
            const float* W = (which ? F.a.in[I_WU] : F.a.in[I_WG]) + (size_t)le * D * EW;
            conv_item(W, EW, kb * 64, nb * 32, (bf16*)((char*)WB + WB_GU) + (size_t)le * 1024 * D, D, scr, F.lane,
                      [=](int jc) { const int w = jc & 127; return (jc >> 7) * 256 + 128 * which + 32 * ((w >> 5) & 3) + 16 * ((w >> 2) & 1) + 4 * ((w >> 3) & 3) + (w & 3); }); continue; } r -= I_5;
        if (r < I_6) { const int le = r / 256, q = r % 256, kb = q / 32, nb = q % 32;
            conv_item(F.a.in[I_WD] + (size_t)le * EW * D, D, kb * 64, nb * 32, (bf16*)((char*)WB + WB_DN) + (size_t)le * D * EW, EW, scr, F.lane, [=](int n) { return (n & ~255) + slot_of(0, n & 255); }); continue; } r -= I_6;
        {
            const float* src = F.a.in[I_SWS] + (size_t)r * 512 + F.lane * 8; const f32x4 a = *(const f32x4*)src, b2 = *(const f32x4*)(src + 4);
            u32x4 o; o.x = pk2(a.x, a.y); o.y = pk2(a.z, a.w); o.z = pk2(b2.x, b2.y); o.w = pk2(b2.z, b2.w);
            *(u32x4*)((bf16*)((char*)WB + WB_WS) + (size_t)r * 512 + F.lane * 8) = o; }
    }
}

struct DenseSched {
    const char* A; const char* Bt; int K, nM, nN, G, c, nwg, xM0, xN, nx, rep;
    __device__ __forceinline__ bool next(int i, pg8::Unit& u) const {
        int L = i * G + c; if (L >= (nwg + nx) * rep) return false; L %= (nwg + nx);
        if (L < nwg) { int wgid = L; { const int q = nwg / 8, r = nwg % 8, xcd = wgid % 8, off = wgid / 8; wgid = (xcd < r ? xcd * (q + 1) : r * (q + 1) + (xcd - r) * q) + off; }
            const int nig = 8 * nN, gid = wgid / nig, fm = gid * 8, gsz = (nM - fm) < 8 ? (nM - fm) : 8;
            u.pm = fm + ((wgid % nig) % gsz); u.pn = (wgid % nig) / gsz; }
        else { const int j = L - nwg; u.pm = xM0 + j / xN; u.pn = j % xN; }
        u.Ab = A; u.Bb = Bt + (size_t)u.pn * 256 * K * 2; u.x0 = 0; u.x1 = 0; u.x2 = 0; return true;
    }
    __device__ __forceinline__ void arows(const pg8::Unit& u, unsigned (&v)[2][2]) const {
#pragma unroll
        for (int i = 0; i < 2; ++i) { int R, C; pg8::stage_rc((int)threadIdx.x * 16 + i * 8192, R, C);
#pragma unroll
            for (int h = 0; h < 2; ++h) v[h][i] = (unsigned)((u.pm * 256 + h * 128 + R) * K + C) * 2u; }
    }
};
struct MoeSched {
    const char* A; const char* Bt; int K, G, c, total; const LAS int* tab; const int* LIST; int gather, rep;
    __device__ __forceinline__ bool next(int i, pg8::Unit& u) const {
        int L = i * G + c; if (L >= total * rep) return false; L %= total;
        if ((G & 7) == 0) { const int q = total / 8, r8 = total % 8, xcd = L % 8, off = L / 8; L = (xcd < r8 ? xcd * (q + 1) : r8 * (q + 1) + (xcd - r8) * q) + off; }
        const int rt = L >> 2; u.pn = L & 3; int ee = 0;
#pragma unroll
        for (int e = 0; e < 16; ++e) { if (tab[e * 4] <= rt && tab[e * 4 + 1] > 0) ee = e; }
        u.pm = rt - tab[ee * 4]; u.x0 = ee; u.x1 = tab[ee * 4 + 1]; u.x2 = tab[ee * 4 + 2];
        u.Ab = A; u.Bb = Bt + ((size_t)ee * 1024 + u.pn * 256) * K * 2; return true;
    }
    __device__ __forceinline__ void arows(const pg8::Unit& u, unsigned (&v)[2][2]) const {
#pragma unroll
        for (int i = 0; i < 2; ++i) { int R, C; pg8::stage_rc((int)threadIdx.x * 16 + i * 8192, R, C);
#pragma unroll
            for (int h = 0; h < 2; ++h) { const int pos = u.pm * 256 + h * 128 + R; int row;
                if (gather) { const int ent = LIST[(u.x0 * 16384 + (pos < u.x1 ? pos : u.pm * 256)) * 2]; row = ent >> 1; } else row = u.x2 + pos;
                v[h][i] = (unsigned)(row * K + C) * 2u; } }
    }
};

struct EpiInproj {
    unsigned char* Areg; const LAS float* ROPE; const float* kg; const float* qg;
    __device__ __forceinline__ void operator()(f32x4 (&acc)[2][2][4][2], const pg8::Unit& u, int wr, int wc, int fr, int fq) const {
        const int ty = u.pn >> 1, head = (u.pn & 1) * 4 + wc;
        const size_t off_t = ty < 4 ? (size_t)ty * 17 * MiB : (size_t)(68 + (ty - 4) * 16) * MiB;
        bf16* dst = (bf16*)(Areg + off_t);
        const int row0 = u.pm * 256 + wr * 64 + fr;
        if (ty == 0 || ty == 4) {
            const float sc = ty == 0 ? 0.125f : 1.f;
#pragma unroll
            for (int ai = 0; ai < 2; ++ai)
#pragma unroll
                for (int m = 0; m < 4; ++m) { const int row = row0 + ai * 128 + m * 16; const int tt = row & 4095; const bool lat = row < NTOK;
#pragma unroll
                    for (int bj = 0; bj < 2; ++bj) { const int pos = bj ? (tt & 63) : (tt >> 6);
                        f32x4 u1 = acc[ai][bj][m][0], u2 = acc[ai][bj][m][1];
                        if (lat) { const f32x4 cs0 = *(const LAS f32x4*)(ROPE + (pos * 16 + 4 * fq) * 2), cs1 = *(const LAS f32x4*)(ROPE + (pos * 16 + 4 * fq) * 2 + 4);
                            const f32x4 co = { cs0.x, cs0.z, cs1.x, cs1.z }, si = { cs0.y, cs0.w, cs1.y, cs1.w };
                            const f32x4 a = u1 * co - u2 * si, b = u1 * si + u2 * co; u1 = a; u2 = b; }
                        u1 = u1 * sc; u2 = u2 * sc;
                        bf16* p = dst + (size_t)row * HW + head * 64 + 32 * bj + 4 * fq;
                        u32x2 w; w.x = pg8::cvt_pk_bf16(u1.x, u1.y); w.y = pg8::cvt_pk_bf16(u1.z, u1.w); *(u32x2*)p = w;
                        w.x = pg8::cvt_pk_bf16(u2.x, u2.y); w.y = pg8::cvt_pk_bf16(u2.z, u2.w); *(u32x2*)(p + 16) = w; } }
        } else {
            const bool nrm = (ty == 2 || ty == 6);
            f32x4 g[2][2];
            if (nrm) { const float* gp = ty == 2 ? kg : qg;
#pragma unroll
                for (int bj = 0; bj < 2; ++bj)
#pragma unroll
                    for (int n = 0; n < 2; ++n) g[bj][n] = *(const f32x4*)(gp + 32 * bj + 8 * fq + 4 * n) * (ty == 6 ? 0.125f : 1.f); }
#pragma unroll
            for (int ai = 0; ai < 2; ++ai)
#pragma unroll
                for (int m = 0; m < 4; ++m) { const int row = row0 + ai * 128 + m * 16;
                    f32x4 v[2][2];
#pragma unroll
                    for (int bj = 0; bj < 2; ++bj)
#pragma unroll
                        for (int n = 0; n < 2; ++n) v[bj][n] = acc[ai][bj][m][n];
                    if (nrm) { float ss = 0.f;
#pragma unroll
                        for (int bj = 0; bj < 2; ++bj)
#pragma unroll
                            for (int n = 0; n < 2; ++n) ss += (v[bj][n].x * v[bj][n].x + v[bj][n].y * v[bj][n].y) + (v[bj][n].z * v[bj][n].z + v[bj][n].w * v[bj][n].w);
                        ss += __shfl_xor(ss, 16); ss += __shfl_xor(ss, 32);
                        const float rs = rsqrtf(ss * (1.f / 64.f) + EPS);
#pragma unroll
                        for (int bj = 0; bj < 2; ++bj)
#pragma unroll
                            for (int n = 0; n < 2; ++n) v[bj][n] = v[bj][n] * rs * g[bj][n]; }
                    if (ty == 5) {
#pragma unroll
                        for (int bj = 0; bj < 2; ++bj)
#pragma unroll
                            for (int n = 0; n < 2; ++n)
#pragma unroll
                                for (int q = 0; q < 4; ++q) v[bj][n][q] = siluf(v[bj][n][q]); }
#pragma unroll
                    for (int bj = 0; bj < 2; ++bj) { u32x4 w; w.x = pg8::cvt_pk_bf16(v[bj][0].x, v[bj][0].y); w.y = pg8::cvt_pk_bf16(v[bj][0].z, v[bj][0].w); w.z = pg8::cvt_pk_bf16(v[bj][1].x, v[bj][1].y); w.w = pg8::cvt_pk_bf16(v[bj][1].z, v[bj][1].w);
                        *(u32x4*)(dst + (size_t)row * HW + head * 64 + 32 * bj + 8 * fq) = w; } }
        }
    }
};
template <bool BF> struct EpiRes {
    const void* base; bf16* out; const float* gate;
    __device__ __forceinline__ void operator()(f32x4 (&acc)[2][2][4][2], const pg8::Unit& u, int wr, int wc, int fr, int fq) const {
        const int b = u.pm >> 4, col0 = u.pn * 256 + wc * 32 + 8 * fq, row0 = u.pm * 256 + wr * 64 + fr;
        f32x4 gv[2][2];
#pragma unroll
        for (int bj = 0; bj < 2; ++bj)
#pragma unroll
            for (int n = 0; n < 2; ++n) gv[bj][n] = *(const f32x4*)(gate + b * 6144 + col0 + bj * 128 + 4 * n);
#pragma unroll
        for (int ai = 0; ai < 2; ++ai)
#pragma unroll
            for (int m = 0; m < 4; ++m) { const size_t off = (size_t)(row0 + ai * 128 + m * 16) * D + col0;
#pragma unroll
                for (int bj = 0; bj < 2; ++bj) { f32x4 b0, b1;
                    if (BF) { const u32x4 t = *(const u32x4*)((const bf16*)base + off + bj * 128);
                        b0 = (f32x4){ bf2f(t.x & 0xffffu), bf2f(t.x >> 16), bf2f(t.y & 0xffffu), bf2f(t.y >> 16) }; b1 = (f32x4){ bf2f(t.z & 0xffffu), bf2f(t.z >> 16), bf2f(t.w & 0xffffu), bf2f(t.w >> 16) }; }
                    else { b0 = *(const f32x4*)((const float*)base + off + bj * 128); b1 = *(const f32x4*)((const float*)base + off + bj * 128 + 4); }
                    const f32x4 r0 = b0 + gv[bj][0] * acc[ai][bj][m][0], r1 = b1 + gv[bj][1] * acc[ai][bj][m][1];
                    u32x4 w; w.x = pg8::cvt_pk_bf16(r0.x, r0.y); w.y = pg8::cvt_pk_bf16(r0.z, r0.w); w.z = pg8::cvt_pk_bf16(r1.x, r1.y); w.w = pg8::cvt_pk_bf16(r1.z, r1.w);
                    *(u32x4*)(out + off + bj * 128) = w; } }
    }
};
__device__ __forceinline__ float gelu_fast(float v) { const float u2 = -2.302208198f * (v + 0.044715f * v * v * v); return v * __builtin_amdgcn_rcpf(1.f + __builtin_amdgcn_exp2f(u2)); }
__device__ __forceinline__ f32x4 gelu4(f32x4 v) {
    const f32x4 t = (v * v) * 0.044715f + 1.f; const f32x4 u2 = (t * v) * -2.302208198f;
    f32x4 e; e.x = __builtin_amdgcn_exp2f(u2.x); e.y = __builtin_amdgcn_exp2f(u2.y); e.z = __builtin_amdgcn_exp2f(u2.z); e.w = __builtin_amdgcn_exp2f(u2.w);
    const f32x4 d = e + 1.f; f32x4 r; r.x = __builtin_amdgcn_rcpf(d.x); r.y = __builtin_amdgcn_rcpf(d.y); r.z = __builtin_amdgcn_rcpf(d.z); r.w = __builtin_amdgcn_rcpf(d.w);
    return v * r; }
__device__ __forceinline__ f32x4 silu_mul4(f32x4 a, f32x4 b) {
    const f32x4 u2 = a * -1.44269504f;
    f32x4 e; e.x = __builtin_amdgcn_exp2f(u2.x); e.y = __builtin_amdgcn_exp2f(u2.y); e.z = __builtin_amdgcn_exp2f(u2.z); e.w = __builtin_amdgcn_exp2f(u2.w);
    const f32x4 d = e + 1.f; f32x4 r; r.x = __builtin_amdgcn_rcpf(d.x); r.y = __builtin_amdgcn_rcpf(d.y); r.z = __builtin_amdgcn_rcpf(d.z); r.w = __builtin_amdgcn_rcpf(d.w);
    return (a * r) * b; }
struct EpiSguIn {
    bf16* U; bf16* V; const float* bias; float* VSS;
    __device__ __forceinline__ void operator()(f32x4 (&acc)[2][2][4][2], const pg8::Unit& u, int wr, int wc, int fr, int fq) const {
        const int col0 = u.pn * 256 + wc * 32 + 8 * fq, row0 = u.pm * 256 + wr * 64 + fr; const bool isv = u.pn >= 12;
        bf16* dstb = isv ? V + (col0 - SGW) : U + col0;
        f32x4 bv[2][2];
#pragma unroll
        for (int bj = 0; bj < 2; ++bj)
#pragma unroll
            for (int n = 0; n < 2; ++n) bv[bj][n] = *(const f32x4*)(bias + col0 + bj * 128 + 4 * n);
#pragma unroll
        for (int ai = 0; ai < 2; ++ai)
#pragma unroll
            for (int m = 0; m < 4; ++m) { const int row = row0 + ai * 128 + m * 16; float ss = 0.f;
#pragma unroll
                for (int bj = 0; bj < 2; ++bj) { const f32x4 z0 = gelu4(acc[ai][bj][m][0] + bv[bj][0]), z1 = gelu4(acc[ai][bj][m][1] + bv[bj][1]);
                    { const f32x4 q2 = z0 * z0 + z1 * z1; ss += (q2.x + q2.y) + (q2.z + q2.w); }
                    u32x4 w; w.x = pg8::cvt_pk_bf16(z0.x, z0.y); w.y = pg8::cvt_pk_bf16(z0.z, z0.w); w.z = pg8::cvt_pk_bf16(z1.x, z1.y); w.w = pg8::cvt_pk_bf16(z1.z, z1.w);
                    *(u32x4*)(dstb + (size_t)row * SGW + bj * 128) = w; }
                if (isv) { ss += __shfl_xor(ss, 16); ss += __shfl_xor(ss, 32); if (fq == 0) VSS[(size_t)row * 48 + (u.pn - 12) * 4 + wc] = ss; } }
    }
};
struct EpiMoeGU {
    bf16* ACT;
    __device__ __forceinline__ void operator()(f32x4 (&acc)[2][2][4][2], const pg8::Unit& u, int wr, int wc, int fr, int fq) const {
        const int col0 = u.pn * 128 + wc * 32 + 8 * fq, row0 = u.x2 + u.pm * 256 + wr * 64 + fr;
#pragma unroll
        for (int ai = 0; ai < 2; ++ai)
#pragma unroll
            for (int m = 0; m < 4; ++m) { const f32x4 a0 = silu_mul4(acc[ai][0][m][0], acc[ai][1][m][0]), a1 = silu_mul4(acc[ai][0][m][1], acc[ai][1][m][1]);
                u32x4 w; w.x = pg8::cvt_pk_bf16(a0.x, a0.y); w.y = pg8::cvt_pk_bf16(a0.z, a0.w); w.z = pg8::cvt_pk_bf16(a1.x, a1.y); w.w = pg8::cvt_pk_bf16(a1.z, a1.w);
                *(u32x4*)(ACT + (size_t)(row0 + ai * 128 + m * 16) * EW + col0) = w; }
    }
};
struct EpiMoeDn {
    bf16* Y; const int* LIST; const float* WT;
    __device__ __forceinline__ void operator()(f32x4 (&acc)[2][2][4][2], const pg8::Unit& u, int wr, int wc, int fr, int fq) const {
        const int col0 = u.pn * 256 + wc * 32 + 8 * fq;
        const unsigned long long* rec = (const unsigned long long*)LIST + (size_t)u.x0 * 16384;
#pragma unroll
        for (int ai = 0; ai < 2; ++ai) {
            unsigned long long rc[4];
#pragma unroll
            for (int m = 0; m < 4; ++m) { const int pos = u.pm * 256 + ai * 128 + wr * 64 + m * 16 + fr; rc[m] = rec[pos < u.x1 ? pos : u.pm * 256]; if (pos >= u.x1) rc[m] = 0xffffffffull; }
#pragma unroll
            for (int m = 0; m < 4; ++m) { const int ent = (int)(unsigned)rc[m];
                if (ent >= 0) { const float w8 = __builtin_bit_cast(float, (unsigned)(rc[m] >> 32));
#pragma unroll
                    for (int bj = 0; bj < 2; ++bj) { const f32x4 a0 = acc[ai][bj][m][0] * w8, a1 = acc[ai][bj][m][1] * w8;
                        u32x4 w; w.x = pg8::cvt_pk_bf16(a0.x, a0.y); w.y = pg8::cvt_pk_bf16(a0.z, a0.w); w.z = pg8::cvt_pk_bf16(a1.x, a1.y); w.w = pg8::cvt_pk_bf16(a1.z, a1.w);
                        *(u32x4*)(Y + (size_t)ent * D + col0 + bj * 128) = w; } } }
            asm volatile("" ::: "memory");
        }
    }
};
__device__ __forceinline__ int moe_tab(Frame& F, int l, LAS int* tab) {
    __syncthreads();
    if (F.tid == 0) { int tiles = 0, base = 0;
        for (int e = 0; e < 16; ++e) { const int c = (int)__hip_atomic_load(fctl(F) + CW_CNT + l * 1024 + e * 64, RLX_AGENT); tab[e * 4] = tiles; tab[e * 4 + 1] = c; tab[e * 4 + 2] = base; tab[e * 4 + 3] = 0; tiles += (c + 255) >> 8; base += (c + 255) & ~255; }
        tab[64] = tiles; }
    __syncthreads();
    return tab[64];
}


typedef short bf16x8 __attribute__((ext_vector_type(8)));
typedef short s16x4 __attribute__((ext_vector_type(4)));
typedef short v4i16_t __attribute__((ext_vector_type(4)));
__device__ __forceinline__ s16x4 tr_read(const LAS unsigned char* p) { return __builtin_bit_cast(s16x4, __builtin_amdgcn_ds_read_tr16_b64_v4i16((LAS v4i16_t*)p)); }
__device__ __forceinline__ bf16x8 cat8(s16x4 a, s16x4 b) { return (bf16x8){a[0], a[1], a[2], a[3], b[0], b[1], b[2], b[3]}; }
__device__ __forceinline__ bf16x8 pk8(f32x4 a, f32x4 b) { u32x4 w; w.x = pg8::cvt_pk_bf16(a.x, a.y); w.y = pg8::cvt_pk_bf16(a.z, a.w); w.z = pg8::cvt_pk_bf16(b.x, b.y); w.w = pg8::cvt_pk_bf16(b.z, b.w); return __builtin_bit_cast(bf16x8, w); }
#define MFMA16(a, b, c) __builtin_amdgcn_mfma_f32_16x16x32_bf16((a), (b), (c), 0, 0, 0)
constexpr int VST = 144;
constexpr size_t A_KV = 148 * MiB;

__device__ __forceinline__ void ph_na(Frame& F) {
    const bf16* NK = (const bf16*)(fA(F) + A_NK); const bf16* NV = (const bf16*)(fA(F) + A_NV); const bf16* NQ = (const bf16*)(fA(F) + A_NQ); bf16* MIX = (bf16*)(fA(F) + A_MIX);
    LAS unsigned char* Vl = F.lds;
    LAS float* mrg = (LAS float*)(F.lds + 832 * VST);
    LAS float* rpbl = (LAS float*)(F.lds + 832 * VST + 4 * 1056 * 4);
    const int lane = F.lane, wave = F.wave, sb = wave & 3, half = wave >> 2, q16 = lane & 15, rq = lane >> 4;
    const int tq = (lane & 15) >> 2, tp = lane & 3;
    const int vcol = F.tid >> 3, vch = F.tid & 7;
    const float L2E = 1.44269504f;
    const int w0 = sb == 0 ? 0 : (sb == 1 ? 8 : (sb == 2 ? 24 : 32));
    for (int tg0 = blockIdx.x; tg0 < 256; tg0 += gridDim.x) {
        const int tg = (gridDim.x == 256) ? ((tg0 & 7) * 32 + (tg0 >> 3)) : tg0;
        const int bh = tg >> 3, b = bh >> 3, h = bh & 7, rbase = (tg & 7) * 8;
        __syncthreads();
#pragma unroll
        for (int pass = 0; pass < 4; ++pass) { const int n = pass * 64 + vcol;
            *(LAS u32x4*)(Vl + (576 + n) * VST + vch * 16) = *(const u32x4*)(NV + ((size_t)(NTOK + b * CTXL + n)) * HW + h * 64 + vch * 8); }
        for (int i = F.tid; i < 465; i += NTHREADS) rpbl[i] = F.a.in[I_RPB][h * 465 + i];
        { int r0 = rbase - 4; r0 = r0 < 0 ? 0 : (r0 > 56 ? 56 : r0);
#pragma unroll
          for (int k8 = 0; k8 < 8; ++k8) { const int kr = r0 + k8;
              *(LAS u32x4*)(Vl + ((kr % 9) * 64 + vcol) * VST + vch * 16) = *(const u32x4*)(NV + ((size_t)(b * SEQ + kr * 64 + vcol)) * HW + h * 64 + vch * 8); } }
        bf16x8 kfc[8][2];
#pragma unroll
        for (int cb = 0; cb < 8; ++cb) { const bf16* kp = NK + ((size_t)(NTOK + b * CTXL + 128 * half + 16 * cb + q16)) * HW + h * 64 + 8 * rq; kfc[cb][0] = *(const bf16x8*)kp; kfc[cb][1] = *(const bf16x8*)(kp + 32); }
        __syncthreads();
#pragma unroll 1
        for (int ti = 0; ti < 8; ++ti) {
            const int r = rbase + ti; int r0 = r - 4; r0 = r0 < 0 ? 0 : (r0 > 56 ? 56 : r0);
            int r0n = r - 3; r0n = r0n < 0 ? 0 : (r0n > 56 ? 56 : r0n);
            const bool newrow = (ti < 7) && (r0n != r0); const int krn = r0n + 7;
            const int c = 16 * sb + q16; const size_t qrow = (size_t)b * SEQ + r * 64 + c;
            int c0 = c - 8; c0 = c0 < 0 ? 0 : (c0 > 48 ? 48 : c0);
            bf16x8 qf[2], kfl[8][2];
#pragma unroll
            for (int ks = 0; ks < 2; ++ks) qf[ks] = *(const bf16x8*)(NQ + qrow * HW + h * 64 + 8 * rq + 32 * ks);
#pragma unroll
            for (int lb = 0; lb < 8; ++lb) { const int kr = r0 + 4 * half + (lb >> 1), cb = w0 + 16 * (lb & 1);
                const bf16* kp = NK + ((size_t)(b * SEQ + kr * 64 + cb + q16)) * HW + h * 64 + 8 * rq; kfl[lb][0] = *(const bf16x8*)kp; kfl[lb][1] = *(const bf16x8*)(kp + 32); }
            u32x4 vnext = {0u, 0u, 0u, 0u};
            if (newrow) vnext = *(const u32x4*)(NV + ((size_t)(b * SEQ + krn * 64 + vcol)) * HW + h * 64 + vch * 8);
            f32x4 sc[16];
#pragma unroll
            for (int cb = 0; cb < 8; ++cb) { f32x4 a = MFMA16(kfc[cb][0], qf[0], ((f32x4){0.f, 0.f, 0.f, 0.f})); a = MFMA16(kfc[cb][1], qf[1], a); sc[8 + cb] = a; }
#pragma unroll
            for (int lb = 0; lb < 8; ++lb) { const int kr = r0 + 4 * half + (lb >> 1), cb = w0 + 16 * (lb & 1);
                f32x4 a = MFMA16(kfl[lb][0], qf[0], ((f32x4){0.f, 0.f, 0.f, 0.f})); a = MFMA16(kfl[lb][1], qf[1], a);
#pragma unroll
                for (int g = 0; g < 4; ++g) { const int kc = cb + 4 * rq + g; const bool valid = (kc >= c0) && (kc <= c0 + 15);
                    const int bi = valid ? ((kr - r + 7) * 31 + (kc - c + 15)) : 0;
                    a[g] = valid ? a[g] + rpbl[bi] : -1e30f; }
                sc[lb] = a; }
            float m = -1e30f;
#pragma unroll
            for (int i = 0; i < 16; ++i) m = fmaxf(fmaxf(m, fmaxf(sc[i].x, sc[i].y)), fmaxf(sc[i].z, sc[i].w));
            m = fmaxf(m, __shfl_xor(m, 16)); m = fmaxf(m, __shfl_xor(m, 32));
            float l = 0.f;
#pragma unroll
            for (int i = 0; i < 16; ++i) {
#pragma unroll
                for (int g = 0; g < 4; ++g) { const float p = __builtin_amdgcn_exp2f((sc[i][g] - m) * L2E); sc[i][g] = p; l += p; } }
            l += __shfl_xor(l, 16); l += __shfl_xor(l, 32);
            f32x4 o[4];
#pragma unroll
            for (int eb = 0; eb < 4; ++eb) o[eb] = (f32x4){0.f, 0.f, 0.f, 0.f};
#pragma unroll
            for (int ks = 0; ks < 8; ++ks) {
                const bf16x8 pf = pk8(sc[2 * ks], sc[2 * ks + 1]);
                int rowA;
                if (ks < 4) { const int kr = r0 + 4 * half + ks; rowA = (kr % 9) * 64 + w0; }
                else rowA = 576 + 128 * half + 32 * (ks - 4);
                const LAS unsigned char* pa = Vl + (rowA + 4 * rq + tq) * VST + 8 * tp; const LAS unsigned char* pb = pa + 16 * VST;
#pragma unroll
                for (int eb = 0; eb < 4; ++eb) { const bf16x8 vf = cat8(tr_read(pa + 32 * eb), tr_read(pb + 32 * eb)); o[eb] = MFMA16(vf, pf, o[eb]); }
            }
            LAS float* mw = mrg + sb * 1056;
            const bool merger = (half == (ti & 1));
            if (!merger) {
                if (rq == 0) { mw[q16] = m; mw[16 + q16] = l; }
#pragma unroll
                for (int eb = 0; eb < 4; ++eb)
#pragma unroll
                    for (int g = 0; g < 4; ++g) mw[32 + (16 * eb + 4 * rq + g) * 16 + q16] = o[eb][g];
            }
            if (newrow) *(LAS u32x4*)(Vl + ((krn % 9) * 64 + vcol) * VST + vch * 16) = vnext;
            __syncthreads();
            if (merger) {
                const float m2 = mw[q16], l2 = mw[16 + q16];
                const float mn = fmaxf(m, m2), a1 = __builtin_amdgcn_exp2f((m - mn) * L2E), a2 = __builtin_amdgcn_exp2f((m2 - mn) * L2E);
                const float inv = 1.f / (l * a1 + l2 * a2);
#pragma unroll
                for (int eb = 0; eb < 4; ++eb) { f32x4 v;
#pragma unroll
                    for (int g = 0; g < 4; ++g) v[g] = (o[eb][g] * a1 + mw[32 + (16 * eb + 4 * rq + g) * 16 + q16] * a2) * inv;
                    u32x2 w; w.x = pg8::cvt_pk_bf16(v.x, v.y); w.y = pg8::cvt_pk_bf16(v.z, v.w);
                    *(u32x2*)(MIX + qrow * D + 512 + h * 64 + 16 * eb + 4 * rq) = w; }
            }
        }
    }
    __syncthreads();
}

__device__ __forceinline__ void ph_kvstate(Frame& F) {
    const bf16* RK = (const bf16*)(fA(F) + A_RK); const bf16* RV = (const bf16*)(fA(F) + A_RV); float* KV = (float*)(fA(F) + A_KV);
    LAS unsigned char* Kt = F.lds; LAS unsigned char* Vf = F.lds + 128 * VST; LAS unsigned char* Vb = F.lds + 256 * VST;
    const int lane = F.lane, wave = F.wave, rq = lane >> 4, tq = (lane & 15) >> 2, tp = lane & 3, db = wave & 3, ep = wave >> 2;
    for (int it = blockIdx.x; it < NB * NH * 34; it += gridDim.x) {
        const int cc = it % 34, bh = it / 34, b = bh >> 3, h = bh & 7;
        const float lgf = ret_gamma_log(F, 0, h) * 1.44269504f, lgb = ret_gamma_log(F, 1, h) * 1.44269504f;
        const size_t row0 = cc < 32 ? (size_t)b * SEQ + cc * 128 : (size_t)NTOK + b * CTXL + (cc - 32) * 128;
        __syncthreads();
#pragma unroll
        for (int pass = 0; pass < 2; ++pass) { const int j = pass * 64 + (F.tid >> 3), ch = F.tid & 7;
            *(LAS u32x4*)(Kt + j * VST + ch * 16) = *(const u32x4*)(RK + (row0 + j) * HW + h * 64 + ch * 8);
            const u32x4 v = *(const u32x4*)(RV + (row0 + j) * HW + h * 64 + ch * 8);
            const float wf = __builtin_amdgcn_exp2f(lgf * (float)(127 - j)), wb = __builtin_amdgcn_exp2f(lgb * (float)j);
            const unsigned vv[4] = { v.x, v.y, v.z, v.w }; u32x4 of, ob; unsigned rf[4], rb[4];
#pragma unroll
            for (int q = 0; q < 4; ++q) { const float lo = bf2f(vv[q] & 0xffffu), hi = bf2f(vv[q] >> 16); rf[q] = pg8::cvt_pk_bf16(lo * wf, hi * wf); rb[q] = pg8::cvt_pk_bf16(lo * wb, hi * wb); }
            of.x = rf[0]; of.y = rf[1]; of.z = rf[2]; of.w = rf[3]; ob.x = rb[0]; ob.y = rb[1]; ob.z = rb[2]; ob.w = rb[3];
            *(LAS u32x4*)(Vf + j * VST + ch * 16) = of; *(LAS u32x4*)(Vb + j * VST + ch * 16) = ob; }
        __syncthreads();
        f32x4 acc[2][2];
#pragma unroll
        for (int d = 0; d < 2; ++d)
#pragma unroll
            for (int e = 0; e < 2; ++e) acc[d][e] = (f32x4){0.f, 0.f, 0.f, 0.f};
#pragma unroll
        for (int ks = 0; ks < 4; ++ks) {
            const int rbase = 32 * ks + 8 * rq + tq;
            const bf16x8 kf = cat8(tr_read(Kt + rbase * VST + (16 * db + 4 * tp) * 2), tr_read(Kt + (rbase + 4) * VST + (16 * db + 4 * tp) * 2));
#pragma unroll
            for (int e2 = 0; e2 < 2; ++e2) { const int eoff = (16 * (2 * ep + e2) + 4 * tp) * 2;
                const bf16x8 vf = cat8(tr_read(Vf + rbase * VST + eoff), tr_read(Vf + (rbase + 4) * VST + eoff));
                const bf16x8 vb = cat8(tr_read(Vb + rbase * VST + eoff), tr_read(Vb + (rbase + 4) * VST + eoff));
                acc[0][e2] = MFMA16(kf, vf, acc[0][e2]); acc[1][e2] = MFMA16(kf, vb, acc[1][e2]); }
        }
        float* kvp = KV + (size_t)it * 2 * 4096;
#pragma unroll
        for (int d = 0; d < 2; ++d)
#pragma unroll
            for (int e2 = 0; e2 < 2; ++e2) *(f32x4*)(kvp + d * 4096 + (16 * (2 * ep + e2) + (lane & 15)) * 64 + 16 * db + 4 * rq) = acc[d][e2];
    }
    __syncthreads();
}

__device__ __forceinline__ void ph_retout(Frame& F, int mode = 0) {
    const bf16* RK = (const bf16*)(fA(F) + A_RK); const bf16* RV = (const bf16*)(fA(F) + A_RV); const bf16* RQ = (const bf16*)(fA(F) + A_RQ); const bf16* GT = (const bf16*)(fA(F) + A_GT);
    const float* KV = (const float*)(fA(F) + A_KV); bf16* MIX = (bf16*)(fA(F) + A_MIX);
    LAS unsigned char* Vl = F.lds;
    LAS unsigned char* SF = F.lds + 4 * 128 * VST;
    LAS unsigned char* SB = SF + 4 * 64 * VST;
    const int lane = F.lane, wave = F.wave, q16 = lane & 15, rq = lane >> 4, tq = (lane & 15) >> 2, tp = lane & 3;
    for (int g0 = blockIdx.x; g0 < 256; g0 += gridDim.x) {
        const int g = (gridDim.x == 256) ? ((g0 & 7) * 32 + (g0 >> 3)) : g0;
        const int bh = g >> 3, b = bh >> 3, h = bh & 7, c0 = (g & 7) * 4;
        const float lnf = ret_gamma_log(F, 0, h), lnb = ret_gamma_log(F, 1, h);
        const float lgf = lnf * 1.44269504f, lgb = lnb * 1.44269504f;
        const float gf128 = __builtin_amdgcn_exp2f(lgf * 128.f), gb128 = __builtin_amdgcn_exp2f(lgb * 128.f);
        const float* kvb = KV + (size_t)bh * 34 * 2 * 4096 + F.tid * 8;
#define KVP(cc, dir) (kvb + ((size_t)(cc) * 2 + (dir)) * 4096)
        f32x4 sf0 = {0.f, 0.f, 0.f, 0.f}, sf1 = sf0, sb0 = sf0, sb1 = sf0;
#pragma unroll 8
        for (int cp = 0; cp < (mode == 2 ? 0 : 32); ++cp) {
            const bool isf = cp < c0, isb = cp >= c0 + 4;
            const float wf_ = isf ? __builtin_amdgcn_exp2f(lgf * 128.f * (float)(c0 - 1 - cp)) : 0.f, wb_ = isb ? __builtin_amdgcn_exp2f(lgb * 128.f * (float)(cp - c0 - 4)) : 0.f;
            const float* p = KVP(cp, isf ? 0 : 1);
            const f32x4 a0 = *(const f32x4*)p, a1 = *(const f32x4*)(p + 4);
            sf0 = sf0 + a0 * wf_; sf1 = sf1 + a1 * wf_; sb0 = sb0 + a0 * wb_; sb1 = sb1 + a1 * wb_;
        }
        { const f32x4 a0 = *(const f32x4*)KVP(32, 0), a1 = *(const f32x4*)(KVP(32, 0) + 4), b0 = *(const f32x4*)KVP(33, 0), b1 = *(const f32x4*)(KVP(33, 0) + 4);
          const float wc = __builtin_amdgcn_exp2f(lgf * 128.f * (float)c0);
          sf0 = sf0 + (a0 * gf128 + b0) * wc; sf1 = sf1 + (a1 * gf128 + b1) * wc; }
        { const f32x4 a0 = *(const f32x4*)KVP(33, 1), a1 = *(const f32x4*)(KVP(33, 1) + 4), b0 = *(const f32x4*)KVP(32, 1), b1 = *(const f32x4*)(KVP(32, 1) + 4);
          const float wc = __builtin_amdgcn_exp2f(lgb * 128.f * (float)(28 - c0));
          sb0 = sb0 + (a0 * gb128 + b0) * wc; sb1 = sb1 + (a1 * gb128 + b1) * wc; }
        __syncthreads();
        const int se = F.tid >> 3, sd = (F.tid & 7) * 8;
#pragma unroll
        for (int k = 3; k >= 0; --k) {
            *(LAS u32x4*)(SB + k * 64 * VST + se * VST + sd * 2) = __builtin_bit_cast(u32x4, pk8(sb0, sb1));
            if (k > 0) { const f32x4 a0 = *(const f32x4*)KVP(c0 + k, 1), a1 = *(const f32x4*)(KVP(c0 + k, 1) + 4); sb0 = sb0 * gb128 + a0; sb1 = sb1 * gb128 + a1; }
        }
#pragma unroll
        for (int k = 0; k < 4; ++k) {
            *(LAS u32x4*)(SF + k * 64 * VST + se * VST + sd * 2) = __builtin_bit_cast(u32x4, pk8(sf0, sf1));
            if (k < 3) { const f32x4 a0 = *(const f32x4*)KVP(c0 + k, 0), a1 = *(const f32x4*)(KVP(c0 + k, 0) + 4); sf0 = sf0 * gf128 + a0; sf1 = sf1 * gf128 + a1; }
        }
        if (mode != 2)
#pragma unroll
        for (int pass = 0; pass < 8; ++pass) { const int j = pass * 64 + (F.tid >> 3), ch = F.tid & 7;
            *(LAS u32x4*)(Vl + j * VST + ch * 16) = *(const u32x4*)(RV + ((size_t)b * SEQ + c0 * 128 + j) * HW + h * 64 + ch * 8); }
        __syncthreads();
        if (mode == 1) continue;
        const int k = wave >> 1; const size_t row0 = (size_t)b * SEQ + (c0 + k) * 128;
        bf16x8 kf[8][2];
#pragma unroll
        for (int jb = 0; jb < 8; ++jb) { const bf16* kp = RK + (row0 + 16 * jb + q16) * HW + h * 64 + 8 * rq; kf[jb][0] = *(const bf16x8*)kp; kf[jb][1] = *(const bf16x8*)(kp + 32); }
        const LAS unsigned char* Vc = Vl + k * 128 * VST; const LAS unsigned char* SFc = SF + k * 64 * VST; const LAS unsigned char* SBc = SB + k * 64 * VST;
#pragma unroll 1
        for (int qb = 0; qb < 4; ++qb) {
            const int i = 64 * (wave & 1) + 16 * qb + q16; const size_t qrow = row0 + i;
            bf16x8 qf[2];
#pragma unroll
            for (int ks = 0; ks < 2; ++ks) qf[ks] = *(const bf16x8*)(RQ + qrow * HW + h * 64 + 8 * rq + 32 * ks);
            const float qfd = __builtin_amdgcn_exp2f(lgf * (float)(i + 1)), qbd = __builtin_amdgcn_exp2f(lgb * (float)(128 - i));
            f32x4 o[4];
#pragma unroll
            for (int eb = 0; eb < 4; ++eb) {
                f32x4 t1 = {0.f, 0.f, 0.f, 0.f}, t2 = {0.f, 0.f, 0.f, 0.f};
#pragma unroll
                for (int ks = 0; ks < 2; ++ks) {
                    const bf16x8 s1 = *(const LAS bf16x8*)(SFc + (16 * eb + q16) * VST + (8 * rq + 32 * ks) * 2);
                    const bf16x8 s2 = *(const LAS bf16x8*)(SBc + (16 * eb + q16) * VST + (8 * rq + 32 * ks) * 2);
                    t1 = MFMA16(s1, qf[ks], t1); t2 = MFMA16(s2, qf[ks], t2); }
                o[eb] = t1 * qfd + t2 * qbd; }
            __builtin_amdgcn_sched_barrier(0);
            f32x4 sc[8];
#pragma unroll
            for (int jb = 0; jb < 8; ++jb) {
                f32x4 a = MFMA16(kf[jb][0], qf[0], ((f32x4){0.f, 0.f, 0.f, 0.f})); a = MFMA16(kf[jb][1], qf[1], a);
#pragma unroll
                for (int gq = 0; gq < 4; ++gq) { const int j = 16 * jb + 4 * rq + gq;
                    const float wgt = j < i ? __builtin_amdgcn_exp2f(lgf * (float)(i - j)) : (j > i ? __builtin_amdgcn_exp2f(lgb * (float)(j - i)) : 2.f);
                    a[gq] *= wgt; }
                sc[jb] = a; }
            __builtin_amdgcn_sched_barrier(0);
#pragma unroll
            for (int ks = 0; ks < 4; ++ks) {
                const bf16x8 pf = pk8(sc[2 * ks], sc[2 * ks + 1]);
                const LAS unsigned char* pa = Vc + (32 * ks + 4 * rq + tq) * VST + 8 * tp; const LAS unsigned char* pb = pa + 16 * VST;
#pragma unroll
                for (int eb = 0; eb < 4; ++eb) { const bf16x8 vf = cat8(tr_read(pa + 32 * eb), tr_read(pb + 32 * eb)); o[eb] = MFMA16(vf, pf, o[eb]); }
            }
            __builtin_amdgcn_sched_barrier(0);
            u32x2 gt[4];
#pragma unroll
            for (int eb = 0; eb < 4; ++eb) gt[eb] = *(const u32x2*)(GT + qrow * HW + h * 64 + 16 * eb + 4 * rq);
            float ss = 0.f;
#pragma unroll
            for (int eb = 0; eb < 4; ++eb) { ss += (o[eb].x * o[eb].x + o[eb].y * o[eb].y) + (o[eb].z * o[eb].z + o[eb].w * o[eb].w); }
            ss += __shfl_xor(ss, 16); ss += __shfl_xor(ss, 32);
            const float rs = rsqrtf(ss * (1.f / 64.f) + EPS);
#pragma unroll
            for (int eb = 0; eb < 4; ++eb) { const int e0 = 16 * eb + 4 * rq;
                const f32x4 gg = *(const f32x4*)(F.a.in[I_RNG] + e0);
                const f32x4 gv = { bf2f(gt[eb].x & 0xffffu), bf2f(gt[eb].x >> 16), bf2f(gt[eb].y & 0xffffu), bf2f(gt[eb].y >> 16) };
                const f32x4 v = o[eb] * rs * gg * gv;
                u32x2 w; w.x = pg8::cvt_pk_bf16(v.x, v.y); w.y = pg8::cvt_pk_bf16(v.z, v.w);
                if (mode == 0) *(u32x2*)(MIX + qrow * D + h * 64 + e0) = w; else asm volatile("" :: "v"(w.x), "v"(w.y)); }
        }
#undef KVP
    }
    __syncthreads();
}

__device__ __forceinline__ void ph_sgumix(Frame& F, bool dry = false) {
    bf16* U = (bf16*)(fA(F) + A_U); const bf16* V = (const bf16*)(fA(F) + A_V); const bf16* WS = (const bf16*)(F.a.ws + WS_WB + WB_WS);
    constexpr int VS2 = 272;
    LAS unsigned char* Vt = F.lds;
    LAS float* rsl = (LAS float*)(F.lds + 128 * VS2);
    const int lane = F.lane, wave = F.wave, q16 = lane & 15, rq = lane >> 4, tq = (lane & 15) >> 2, tp = lane & 3;
    const int ch4 = wave & 1, iq = wave >> 1;
    constexpr int NIT = NB * 32 * 8 * 3;
    const int ipb = (NIT + (int)gridDim.x - 1) / (int)gridDim.x, it0 = (int)blockIdx.x * ipb, it1 = (it0 + ipb) < NIT ? (it0 + ipb) : NIT;
    const int sj = F.tid >> 4, schn = F.tid & 15;
    u32x4 vn[4];
    if (it0 < it1) { const int third = it0 % 3, g = (it0 / 3) & 7, bc = it0 / 24; const size_t row0 = (size_t)bc * 128; const int cg0 = g * 384 + third * 128;
#pragma unroll
        for (int pass = 0; pass < 4; ++pass) vn[pass] = *(const u32x4*)(V + (row0 + pass * 32 + sj) * SGW + cg0 + schn * 8); }
    int prev_bc = -1;
    for (int it = it0; it < it1; ++it) {
        const int third = it % 3, g = (it / 3) & 7, bc = it / 24; const size_t row0 = (size_t)bc * 128; const int cg0 = g * 384 + third * 128;
        __syncthreads();
        if (bc != prev_bc) { prev_bc = bc;
            if (F.tid < 128) { const float* vp = fvss(F) + (row0 + F.tid) * 48; float sacc = 0.f;
#pragma unroll
                for (int j = 0; j < 48; j += 4) { const f32x4 t = *(const f32x4*)(vp + j); sacc += (t.x + t.y) + (t.z + t.w); }
                rsl[F.tid] = rsqrtf(sacc * (1.f / SGW) + EPS); }
            __syncthreads(); }
#pragma unroll
        for (int pass = 0; pass < 4; ++pass) { const int j = pass * 32 + sj; const float rs = rsl[j];
            const unsigned vv[4] = { vn[pass].x, vn[pass].y, vn[pass].z, vn[pass].w }; unsigned ro[4];
#pragma unroll
            for (int q = 0; q < 4; ++q) ro[q] = pg8::cvt_pk_bf16(bf2f(vv[q] & 0xffffu) * rs, bf2f(vv[q] >> 16) * rs);
            u32x4 o; o.x = ro[0]; o.y = ro[1]; o.z = ro[2]; o.w = ro[3];
            *(LAS u32x4*)(Vt + j * VS2 + schn * 16) = o; }
        __syncthreads();
        if (it + 1 < it1) { const int n = it + 1, t2 = n % 3, g2 = (n / 3) & 7, bc2 = n / 24; const size_t r2 = (size_t)bc2 * 128; const int c2 = g2 * 384 + t2 * 128;
#pragma unroll
            for (int pass = 0; pass < 4; ++pass) vn[pass] = *(const u32x4*)(V + (r2 + pass * 32 + sj) * SGW + c2 + schn * 8); }
        u32x4 uu[2][2];
#pragma unroll
        for (int ib = 0; ib < 2; ++ib)
#pragma unroll
            for (int cb2 = 0; cb2 < 2; ++cb2) uu[ib][cb2] = *(const u32x4*)(U + (row0 + 32 * iq + 16 * ib + q16) * SGW + cg0 + 64 * ch4 + 32 * cb2 + 8 * rq);
        f32x4 acc[4][2];
#pragma unroll
        for (int cb = 0; cb < 4; ++cb)
#pragma unroll
            for (int ib = 0; ib < 2; ++ib) acc[cb][ib] = (f32x4){0.f, 0.f, 0.f, 0.f};
#pragma unroll
        for (int ks = 0; ks < 4; ++ks) {
            bf16x8 wf[2];
#pragma unroll
            for (int ib = 0; ib < 2; ++ib) wf[ib] = *(const bf16x8*)(WS + ((size_t)g * 128 + 32 * iq + 16 * ib + q16) * 128 + 32 * ks + 8 * rq);
            const int rb = 32 * ks + 8 * rq + tq;
#pragma unroll
            for (int cb = 0; cb < 4; ++cb) { const int coff = (64 * ch4 + 32 * (cb >> 1) + 8 * tp + 4 * (cb & 1)) * 2;
                const bf16x8 vf = cat8(tr_read(Vt + rb * VS2 + coff), tr_read(Vt + (rb + 4) * VS2 + coff));
#pragma unroll
                for (int ib = 0; ib < 2; ++ib) acc[cb][ib] = MFMA16(vf, wf[ib], acc[cb][ib]); }
        }
#pragma unroll
        for (int ib = 0; ib < 2; ++ib) { const int i = 32 * iq + 16 * ib + q16; const float bs = F.a.in[I_SBS][g * 128 + i];
#pragma unroll
            for (int cb2 = 0; cb2 < 2; ++cb2) { const int cgl = cg0 + 64 * ch4 + 32 * cb2 + 8 * rq;
                const f32x4 ng0 = *(const f32x4*)(F.a.in[I_SNG] + cgl), ng1 = *(const f32x4*)(F.a.in[I_SNG] + cgl + 4); bf16* up = U + (row0 + i) * SGW + cgl; const u32x4 u4 = uu[ib][cb2];
                const f32x4 uv0 = { bf2f(u4.x & 0xffffu), bf2f(u4.x >> 16), bf2f(u4.y & 0xffffu), bf2f(u4.y >> 16) }, uv1 = { bf2f(u4.z & 0xffffu), bf2f(u4.z >> 16), bf2f(u4.w & 0xffffu), bf2f(u4.w >> 16) };
                const f32x4 r0 = dry ? uv0 + acc[2 * cb2][ib] * 0.f : uv0 * (acc[2 * cb2][ib] * ng0 + bs), r1 = dry ? uv1 + acc[2 * cb2 + 1][ib] * 0.f : uv1 * (acc[2 * cb2 + 1][ib] * ng1 + bs);
                u32x4 w; w.x = pg8::cvt_pk_bf16(r0.x, r0.y); w.y = pg8::cvt_pk_bf16(r0.z, r0.w); w.z = pg8::cvt_pk_bf16(r1.x, r1.y); w.w = pg8::cvt_pk_bf16(r1.z, r1.w); *(u32x4*)up = w; } }
    }
    __syncthreads();
}

__device__ __forceinline__ void ph_mod2(Frame& F) {
    LAS float* sv = (LAS float*)F.lds; LAS float* red = sv + 5 * 1024;
    for (int i = F.tid; i < 5 * 1024; i += NTHREADS) { const int r = i >> 10, k = i & 1023; const float c = r < 4 ? F.a.in[I_C][r * 1024 + k] : F.a.in[I_CCTX][k]; sv[i] = siluf(c); }
    __syncthreads();
    for (int item = blockIdx.x; item < 192; item += gridDim.x) {
        const int l = item / 96, n0 = (item % 96) * 64, k0 = F.wave * 128;
        const float* W = F.a.in[I_ADAW] + (size_t)l * D * 6144 + n0 + F.lane + (size_t)k0 * 6144;
        float a0 = 0.f, a1 = 0.f, a2 = 0.f, a3 = 0.f, a4 = 0.f;
#pragma unroll 16
        for (int k = 0; k < 128; ++k) { const float w = W[(size_t)k * 6144];
            a0 += sv[k0 + k] * w; a1 += sv[1024 + k0 + k] * w; a2 += sv[2048 + k0 + k] * w; a3 += sv[3072 + k0 + k] * w; a4 += sv[4096 + k0 + k] * w; }
        red[(F.wave * 5 + 0) * 64 + F.lane] = a0; red[(F.wave * 5 + 1) * 64 + F.lane] = a1; red[(F.wave * 5 + 2) * 64 + F.lane] = a2; red[(F.wave * 5 + 3) * 64 + F.lane] = a3; red[(F.wave * 5 + 4) * 64 + F.lane] = a4;
        __syncthreads();
        if (F.wave < 5) { const int r = F.wave; float sacc = 0.f;
#pragma unroll
            for (int w = 0; w < 8; ++w) sacc += red[(w * 5 + r) * 64 + F.lane];
            sacc += F.a.in[I_ADAB][l * 6144 + n0 + F.lane];
            if (r < 4) fmod(F)[(l * 4 + r) * 6144 + n0 + F.lane] = sacc; else if (l == 0 && n0 < 2048) fmodc(F)[n0 + F.lane] = sacc; }
        __syncthreads();
    }
    const int gt = F.gw * 64 + F.lane, ngt = F.ngw * 64;
    for (int it = gt; it < 64 * 16; it += ngt) {
        const int pos = it >> 4, j = it & 15;
        const float inv = powf(10000.0f, -(float)j / 16.0f);
        const float ang = (float)pos * inv;
        frope(F)[it * 2] = cosf(ang); frope(F)[it * 2 + 1] = sinf(ang);
    }
}
__device__ __forceinline__ void late_convert(Frame& F, int units, int pct_lo, int pct_hi, int set = 1) {
    const int G = (int)gridDim.x, rounds = (units + G - 1) / G, rem = units - (rounds - 1) * G;
    const int first = rem >= G ? 0 : rem, nidle = G - first;
    __syncthreads();
    if ((int)blockIdx.x >= first) ph_convert(F, set, ((int)blockIdx.x - first) * NWAVES + F.wave, nidle * NWAVES, pct_lo, pct_hi);
    __syncthreads();
}
__device__ __forceinline__ void ph_inproj(Frame& F) {
    const DenseSched S{(const char*)fH(F), (const char*)(F.a.ws + WS_WB + WB_WIN), D, 64, 14, (int)gridDim.x, (int)blockIdx.x, 64 * 14, 64, 8, 32, GREP(2)};
    LAS float* ropel = (LAS float*)(F.lds + ROPE_OFF);
    for (int i = F.tid; i < 2048; i += NTHREADS) ropel[i] = frope(F)[i];
    __syncthreads();
    const EpiInproj E{fA(F), ropel, F.a.in[I_KG], F.a.in[I_QG]};
    pg8::gemm_phase<DenseSched, EpiInproj, true>(F.lds, D, S, E);
    late_convert(F, 64 * 14 + 32, EARLY_PCT, 100, 0);
}
__device__ __forceinline__ void ph_outproj(Frame& F) {
    const DenseSched S{(const char*)(fA(F) + A_MIX), (const char*)(F.a.ws + WS_WB + WB_WOUT), D, 64, 4, (int)gridDim.x, (int)blockIdx.x, 64 * 4, 0, 1, 0, GREP(5)};
    const EpiRes<false> E{F.a.in[I_X], (bf16*)(fA(F) + A_X1), fmod(F) + 2 * D};
    pg8::gemm_phase<DenseSched, EpiRes<false>, false>(F.lds, D, S, E);
}
__device__ __forceinline__ void ph_sguin(Frame& F) {
    const DenseSched S{(const char*)fH(F), (const char*)(F.a.ws + WS_WB + WB_SWIN), D, 64, 24, (int)gridDim.x, (int)blockIdx.x, 64 * 24, 0, 1, 0, GREP(10)};
    const EpiSguIn E{(bf16*)(fA(F) + A_U), (bf16*)(fA(F) + A_V), F.a.in[I_SBIN], fvss(F)};
    pg8::gemm_phase<DenseSched, EpiSguIn, true>(F.lds, D, S, E);
}
__device__ __forceinline__ void ph_sguout(Frame& F) {
    const DenseSched S{(const char*)(fA(F) + A_U), (const char*)(F.a.ws + WS_WB + WB_SWOUT), SGW, 64, 4, (int)gridDim.x, (int)blockIdx.x, 64 * 4, 0, 1, 0, GREP(12)};
    const EpiRes<true> E{F.a.out, (bf16*)(fA(F) + A_X3), fmod(F) + 4 * 6144 + 2 * D};
    pg8::gemm_phase<DenseSched, EpiRes<true>, false>(F.lds, SGW, S, E);
}

__device__ __forceinline__ void ph_moe_gu(Frame& F, int l) {
    LAS int* tab = (LAS int*)(F.lds + TAB_OFF);
    const int tiles = moe_tab(F, l, tab);
    const MoeSched S{(const char*)fH(F), (const char*)(F.a.ws + WS_WB + WB_GU) + (size_t)l * NE * 1024 * D * 2, D, (int)gridDim.x, (int)blockIdx.x, tiles * 4, tab, flist(F), 1, GREP(7)};
    const EpiMoeGU E{(bf16*)(fA(F) + A_ACT)};
    pg8::gemm_phase<MoeSched, EpiMoeGU, true>(F.lds, D, S, E);
    if (l == 0) late_convert(F, tiles * 4, 0, 58);
}
__device__ __forceinline__ void ph_moe_dn(Frame& F, int l) {
    LAS int* tab = (LAS int*)(F.lds + TAB_OFF);
    const int tiles = moe_tab(F, l, tab);
    const MoeSched S{(const char*)(fA(F) + A_ACT), (const char*)(F.a.ws + WS_WB + WB_DN) + (size_t)l * NE * D * EW * 2, EW, (int)gridDim.x, (int)blockIdx.x, tiles * 4, tab, flist(F), 0, GREP(8)};
    const EpiMoeDn E{(bf16*)(fA(F) + A_Y), flist(F), fwt(F)};
    pg8::gemm_phase<MoeSched, EpiMoeDn, true>(F.lds, EW, S, E);
    if (l == 0) late_convert(F, tiles * 4, 58, 100);
}

constexpr int NPHASE = 18;
__global__ void __launch_bounds__(NTHREADS, 2) fwd_kernel(Args args) {
    extern __shared__ __attribute__((aligned(16))) unsigned char lds[];
    const int tid_ = threadIdx.x, wave_ = __builtin_amdgcn_readfirstlane(tid_ >> 6);
    Frame F{(LAS unsigned char*)lds, tid_, tid_ & 63, wave_, (int)blockIdx.x * NWAVES + wave_, (int)gridDim.x * NWAVES, args};
    volatile LAS unsigned* MISC = (volatile LAS unsigned*)(F.lds + MISC_OFF);
    for (int u = F.tid; u < (LDS_BYTES - LDSCTL_OFF) / 4; u += NTHREADS) ((LAS unsigned*)(F.lds + LDSCTL_OFF))[u] = 0u;
    __syncthreads();
    XcdBarrier bar; bar.bar = fctl(F) + CW_BAR; bar.x = 0; bar.st = nullptr;
    if (MK_ONE_LAUNCH) bar = xcd_barrier_post(fctl(F) + CW_BAR, MISC + 8);
    const int lo = args.ph_lo, hi = args.ph_hi;
#define IN(k) (lo <= (k) && (k) < hi)
#define REP(k) for (int _r##k = 0, _r = 0; _r##k < ((k) == REP_PHASE ? REP_N : 1); ++_r##k, _r = _r##k)
#ifdef ONLY_PHASE
#define PHON(k) ((k) == ONLY_PHASE)
#else
#define PHON(k) true
#endif
#define SEAM(k) do { if (IN(k) && IN((k) + 1)) xcd_barrier(bar); } while (0)
    if (PHON(0) && IN(0)) REP(0) { ph_mod2(F); __syncthreads(); ph_convert(F, 0, F.gw, F.ngw, 0, EARLY_PCT); __syncthreads(); } SEAM(0);
    if (PHON(1) && IN(1)) REP(1) { ph_norm0(F); } SEAM(1);
    if (PHON(2) && IN(2)) REP(2) { if (NV_INPROJ) ph_inproj_naive(F); else ph_inproj(F); } SEAM(2);
    if (PHON(3) && IN(3)) REP(3) { REP(30) { if (NV_RET) ph_scan_naive(F); else ph_kvstate(F); } REP(31) { if (NV_NA) ph_na_naive(F); else ph_na(F); } } SEAM(3);
    if (PHON(4) && IN(4)) REP(4) { if (NV_RET) ph_retout_naive(F); else ph_retout(F, _r > 0 ? RET_MODE : 0); } SEAM(4);
    if (PHON(5) && IN(5)) REP(5) { if (NV_OUTPROJ) ph_gemm_res_naive(F, (const bf16*)(fA(F) + A_MIX), D, D, F.a.in[I_WOUT], F.a.in[I_X], fmod(F) + 2 * D); else ph_outproj(F); } SEAM(5);
    if (PHON(6) && IN(6)) REP(6) { ph_route(F, 0, _r > 0); } SEAM(6);
    if (PHON(7) && IN(7)) REP(7) { if (NV_MOEGU) ph_moe_gu_naive(F, 0); else ph_moe_gu(F, 0); } SEAM(7);
    if (PHON(8) && IN(8)) REP(8) { if (NV_MOEDN) ph_moe_dn_naive(F, 0); else ph_moe_dn(F, 0); } SEAM(8);
    if (PHON(9) && IN(9)) REP(9) { ph_combine(F, 0, true, _r > 0); } SEAM(9);
    if (PHON(10) && IN(10)) REP(10) { if (NV_SGUIN) ph_sguin_naive(F); else ph_sguin(F); } SEAM(10);
    if (PHON(11) && IN(11)) REP(11) { if (NV_SGUMIX) ph_sgumix_naive(F); else ph_sgumix(F, _r > 0); } SEAM(11);
    if (PHON(12) && IN(12)) REP(12) { if (NV_SGUOUT) ph_gemm_res_naive(F, (const bf16*)(fA(F) + A_U), SGW, SGW, F.a.in[I_SWOUT], F.a.out, fmod(F) + 4 * 6144 + 2 * D); else ph_sguout(F); } SEAM(12);
    if (PHON(13) && IN(13)) REP(13) { ph_route(F, 1, _r > 0); } SEAM(13);
    if (PHON(14) && IN(14)) REP(14) { if (NV_MOEGU) ph_moe_gu_naive(F, 1); else ph_moe_gu(F, 1); } SEAM(14);
    if (PHON(15) && IN(15)) REP(15) { if (NV_MOEDN) ph_moe_dn_naive(F, 1); else ph_moe_dn(F, 1); } SEAM(15);
    if (PHON(16) && IN(16)) REP(16) { ph_combine(F, 1, false, _r > 0); }
    for (int xb = 0; xb < XBAR; ++xb) xcd_barrier(bar);
#undef IN
#undef SEAM
}

extern "C" void kernel_launch(void* const* d_in, const int* in_sizes, int n_in, void* d_out, int out_size, void* d_ws, size_t ws_size, hipStream_t stream) {
    static int grid = 0;
    if (grid == 0) {
        if (n_in != 26 || out_size != NTOK * D || ws_size < WS_END) { fprintf(stderr, "kernel_launch: unexpected shapes n_in %d out %d ws %zu (need %zu)\n", n_in, out_size, ws_size, (size_t)WS_END); grid = -1; return; }
        int dev = 0, cus = 0, per_cu = 0;
        hipGetDevice(&dev); hipDeviceGetAttribute(&cus, hipDeviceAttributeMultiprocessorCount, dev);
        hipFuncSetAttribute((const void*)fwd_kernel, hipFuncAttributeMaxDynamicSharedMemorySize, LDS_BYTES);
        hipOccupancyMaxActiveBlocksPerMultiprocessor(&per_cu, (const void*)fwd_kernel, NTHREADS, LDS_BYTES);
        (void)hipGetLastError();
        if (per_cu < 1) { fprintf(stderr, "kernel_launch: occupancy query says %d blocks/CU\n", per_cu); per_cu = 1; }
        grid = cus;
    }
    if (grid < 0) return;
    hipMemsetAsync((char*)d_ws + WS_CTL, 0, CTL_ZERO_BYTES, stream);
    Args a{};
    for (int i = 0; i < 26; ++i) a.in[i] = (const float*)d_in[i];
    a.out = (float*)d_out; a.ws = (unsigned char*)d_ws;
#if MK_ONE_LAUNCH
    a.ph_lo = 0; a.ph_hi = 17; a.li = 0;
    void* kargs[] = { &a };
    hipError_t e = hipLaunchCooperativeKernel((const void*)fwd_kernel, dim3(grid), dim3(NTHREADS), kargs, LDS_BYTES, stream);
    if (e != hipSuccess) fprintf(stderr, "cooperative launch failed: %s\n", hipGetErrorString(e));
#else
    for (int p = 0; p < 17; ++p) { a.ph_lo = p; a.ph_hi = p + 1; a.li = p; hipLaunchKernelGGL(fwd_kernel, dim3(grid), dim3(NTHREADS), LDS_BYTES, stream, a); }
#endif
}
```

```cpp
#include <hip/hip_runtime.h>
#include <cstdio>
#include <cstdint>

#ifndef NV_INPROJ
#define NV_INPROJ 0
#endif
#ifndef NV_OUTPROJ
#define NV_OUTPROJ 0
#endif
#ifndef NV_MOEGU
#define NV_MOEGU 0
#endif
#ifndef NV_MOEDN
#define NV_MOEDN 0
#endif
#ifndef NV_SGUIN
#define NV_SGUIN 0
#endif
#ifndef NV_SGUOUT
#define NV_SGUOUT 0
#endif
#ifndef NV_NA
#define NV_NA 0
#endif
#ifndef NV_RET
#define NV_RET 0
#endif
#ifndef NV_SGUMIX
#define NV_SGUMIX 0
#endif
#ifndef REP_PHASE
#define REP_PHASE -1
#endif
#ifndef REP_N
#define REP_N 2
#endif
#ifndef XBAR
#define XBAR 0
#endif
#ifndef GREP_PHASE
#define GREP_PHASE -1
#endif
#define GREP(k) ((k) == GREP_PHASE ? 2 : 1)
#ifndef RET_MODE
#define RET_MODE 0
#endif
#ifndef EARLY_PCT
#define EARLY_PCT 54
#endif
#ifndef STAGGER_US
#define STAGGER_US 0
#endif
#ifndef TPROBE_A
#define TPROBE_A -1
#endif
#ifndef TPROBE_DIV
#define TPROBE_DIV 16.f
#endif
#ifndef TPROBE_OFF
#define TPROBE_OFF 0.f
#endif
#ifndef TPROBE_B
#define TPROBE_B TPROBE_A
#endif
#ifndef MK_ONE_LAUNCH
#define MK_ONE_LAUNCH 1
#endif

constexpr int D = 1024, NB = 4, SEQ = 4096, NTOK = NB * SEQ, CTXL = 256, NCTX = NB * CTXL, NROW = NTOK + NCTX;
constexpr int HD = 64, NH = 8, HW = NH * HD;
constexpr int ABW = 3584;
constexpr int SGW = 3072;
constexpr int NE = 16, EW = 512;
constexpr float EPS = 1e-6f;
constexpr int NWAVES = 8, NTHREADS = 512;

constexpr size_t MiB = 1u << 20;
constexpr size_t WS_CTL = 0, CTL_ZERO_BYTES = 1 * MiB;
constexpr size_t WS_MOD = 1 * MiB;
constexpr size_t WS_ROUTE = 2 * MiB;
constexpr size_t WS_VSS = 4 * MiB;
constexpr size_t WS_WB = 8 * MiB;
constexpr size_t WS_H = 132 * MiB;
constexpr size_t WS_A = 166 * MiB;
constexpr size_t WS_END = 358 * MiB;
constexpr size_t A_RK = 0, A_RV = 17 * MiB, A_NK = 34 * MiB, A_NV = 51 * MiB, A_RQ = 68 * MiB, A_GT = 84 * MiB, A_NQ = 100 * MiB, A_MIX = 116 * MiB, A_SST = 148 * MiB;
constexpr size_t A_ACT = 32 * MiB, A_Y = 68 * MiB;
constexpr size_t A_X1 = 0, A_X3 = 132 * MiB;
constexpr size_t A_U = 0, A_V = 96 * MiB;

constexpr int CW_BAR = 4096;
constexpr int CW_CNT = 8192;

typedef unsigned short bf16;
typedef unsigned u32x4 __attribute__((ext_vector_type(4)));
typedef float f32x4 __attribute__((ext_vector_type(4)));
typedef unsigned u32x2 __attribute__((ext_vector_type(2)));
#define LAS __attribute__((address_space(3)))
#define RLX_AGENT __ATOMIC_RELAXED, __HIP_MEMORY_SCOPE_AGENT

__device__ __forceinline__ unsigned f2bf(float f) { unsigned u = __builtin_bit_cast(unsigned, f); return (u + 0x7fffu + ((u >> 16) & 1u)) >> 16; }
__device__ __forceinline__ float bf2f(unsigned h) { return __builtin_bit_cast(float, h << 16); }
__device__ __forceinline__ unsigned pk2(float lo, float hi) { return f2bf(lo) | (f2bf(hi) << 16); }
__device__ __forceinline__ float siluf(float v) { return v / (1.f + __expf(-v)); }
__device__ __forceinline__ float gelu_tanh(float v) { const float u = 0.7978845608028654f * (v + 0.044715f * v * v * v); return 0.5f * v * (1.f + tanhf(u)); }
__device__ __forceinline__ float wave_sum(float v) {
#pragma unroll
    for (int o = 1; o < 64; o <<= 1) v += __shfl_xor(v, o);
    return v;
}


__device__ __forceinline__ int lane_id_v() { int l; asm volatile("v_mbcnt_lo_u32_b32 %0, -1, 0\n\tv_mbcnt_hi_u32_b32 %0, -1, %0" : "=v"(l)); return l; }
#define XB_TMO      128
#define XB_XCNT(j)  (256  + 64 * (j))
#define XB_XSUB(j)  (1280 + 64 * (j))
#define XB_XGEN(j)  (2304 + 64 * (j))
#define XB_TOP      3328
#define XB_TOPGEN   3392
#define XCD_BAR_WORDS 3456
#define XB_SPIN_CAP (1u << 18)
__device__ __forceinline__ unsigned xb_ld(unsigned* p)              { return __hip_atomic_load(p, __ATOMIC_RELAXED, __HIP_MEMORY_SCOPE_AGENT); }
__device__ __forceinline__ unsigned xb_add(unsigned* p, unsigned v) { return __hip_atomic_fetch_add(p, v, __ATOMIC_RELAXED, __HIP_MEMORY_SCOPE_AGENT); }
__device__ __forceinline__ unsigned xb_xcc_id() { return (unsigned)__builtin_amdgcn_s_getreg((3 << 11) | 20) & 0xFu; }
#define XB_SPIN(cond, bar) do { unsigned _sp = 0; while (cond) { __builtin_amdgcn_s_sleep(1); \
    if ((++_sp & 255u) == 0u) { if (xb_ld(&(bar)[XB_TMO])) break; if (_sp > XB_SPIN_CAP) { atomicAdd(&(bar)[XB_TMO], 1u); break; } } } } while (0)
struct XcdBarrier { unsigned* bar; unsigned x; volatile LAS unsigned* st; int wave; };
__device__ __forceinline__ XcdBarrier xcd_barrier_post(unsigned* bar, volatile LAS unsigned* st) {
    XcdBarrier b; b.bar = bar; b.x = xb_xcc_id(); b.st = st;
    if (threadIdx.x == 0) (void)xb_add(&bar[XB_XCNT(b.x)], 1u);
    return b;
}
__device__ __forceinline__ void xcd_barrier_complete(unsigned* bar, unsigned x, unsigned& nloc, unsigned& nx) {
    const unsigned G = gridDim.x * gridDim.y * gridDim.z;
    unsigned sum, cnt, mine, sp = 0u;
    for (;;) {
        sum = 0u; cnt = 0u; mine = 0u;
#pragma unroll
        for (unsigned j = 0; j < 16; ++j) { const unsigned c = xb_ld(&bar[XB_XCNT(j)]); sum += c; cnt += (c > 0u) ? 1u : 0u; mine = (j == x) ? c : mine; }
        if (sum == G) break;
        __builtin_amdgcn_s_sleep(1);
        if ((++sp & 255u) == 0u) { if (xb_ld(&bar[XB_TMO])) break; if (sp > XB_SPIN_CAP) { atomicAdd(&bar[XB_TMO], 1u); break; } }
    }
    nloc = mine > 0u ? mine : 1u; nx = cnt > 0u ? cnt : 1u;
}
__device__ __forceinline__ void xcd_barrier(const XcdBarrier& b) {
    asm volatile("s_waitcnt vmcnt(0)" ::: "memory");
    __syncthreads();
    if (b.wave == 0 && lane_id_v() == 0) {
        unsigned* bar = b.bar;
        __builtin_amdgcn_s_waitcnt(0);
        unsigned nloc = b.st[0], nx = b.st[1];
        if (nloc == 0u) { xcd_barrier_complete(bar, b.x, nloc, nx); b.st[0] = nloc; b.st[1] = nx; }
        const unsigned old = xb_add(&bar[XB_XSUB(b.x)], 1u);
        const unsigned gen = old / nloc;
        if (old + 1u == (gen + 1u) * nloc) {
            __builtin_amdgcn_fence(__ATOMIC_RELEASE, "agent");
            asm volatile("s_waitcnt vmcnt(0)" ::: "memory");
            const unsigned og = xb_add(&bar[XB_TOP], 1u);
            const unsigned tg = og / nx;
            if (og + 1u == (tg + 1u) * nx) xb_add(&bar[XB_TOPGEN], 1u);
            else XB_SPIN(xb_ld(&bar[XB_TOPGEN]) == tg, bar);
            __builtin_amdgcn_fence(__ATOMIC_ACQUIRE, "agent");
            xb_add(&bar[XB_XGEN(b.x)], 1u);
            asm volatile("s_waitcnt vmcnt(0)" ::: "memory");
        } else {
            XB_SPIN(xb_ld(&bar[XB_XGEN(b.x)]) == gen, bar);
            __builtin_amdgcn_fence(__ATOMIC_ACQUIRE, "agent");
            asm volatile("s_waitcnt vmcnt(0)" ::: "memory");
        }
    }
    __syncthreads();
}

constexpr int LDS_BYTES = 163840;
constexpr int LDSCTL_OFF = 147456, MISC_OFF = LDSCTL_OFF + 320, TAB_OFF = LDSCTL_OFF + 1024, ROPE_OFF = LDSCTL_OFF + 2048;

struct Args { const float* in[26]; float* out; unsigned char* ws; int ph_lo, ph_hi, li, pad; };

struct Frame {
    LAS unsigned char* lds;
    int tid, lane, wave, gw, ngw;
    const Args& a;
};
__device__ __forceinline__ unsigned* fctl(const Frame& F) { return (unsigned*)(F.a.ws + WS_CTL); }
__device__ __forceinline__ float* fmod(const Frame& F) { return (float*)(F.a.ws + WS_MOD); }
__device__ __forceinline__ float* fmodc(const Frame& F) { return (float*)(F.a.ws + WS_MOD) + 2 * 4 * 6144; }
__device__ __forceinline__ float* frope(const Frame& F) { return (float*)(F.a.ws + WS_MOD) + 2 * 4 * 6144 + 2048; }
__device__ __forceinline__ int* flist(const Frame& F) { return (int*)(F.a.ws + WS_ROUTE); }
__device__ __forceinline__ float* fwt(const Frame& F) { return (float*)(F.a.ws + WS_ROUTE + 1 * MiB); }
__device__ __forceinline__ float* fvss(const Frame& F) { return (float*)(F.a.ws + WS_VSS); }
__device__ __forceinline__ bf16* fH(const Frame& F) { return (bf16*)(F.a.ws + WS_H); }
__device__ __forceinline__ unsigned char* fA(const Frame& F) { return F.a.ws + WS_A; }
enum { I_X = 0, I_C, I_CTX, I_CCTX, I_ADAW, I_ADAB, I_NMG, I_NFG, I_RW, I_RB, I_WG, I_WU, I_WD, I_WIN, I_WOUT, I_RDEC, I_RNG, I_QG, I_KG, I_RPB, I_SWIN, I_SBIN, I_SNG, I_SWS, I_SBS, I_SWOUT };

template <int NC> __device__ __forceinline__ void naive_dot(const bf16* arow, const float* W, int ldw, int K, float (&acc)[NC]) {
#pragma unroll 1
    for (int k = 0; k < K; k += 2) {
        const unsigned a2 = *(const unsigned*)(arow + k);
        const float a0 = bf2f(a2 & 0xffffu), a1 = bf2f(a2 >> 16);
        const float* w = W + (size_t)k * ldw;
#pragma unroll
        for (int j = 0; j < NC; ++j) acc[j] = __builtin_fmaf(a0, w[j], acc[j]);
        asm volatile("" ::: "memory");
        w += ldw;
#pragma unroll
        for (int j = 0; j < NC; ++j) acc[j] = __builtin_fmaf(a1, w[j], acc[j]);
        asm volatile("" ::: "memory");
    }
}
template <int NC> __device__ __forceinline__ void store_row_bf16(bf16* dst, const float (&v)[NC]) {
#pragma unroll
    for (int j = 0; j < NC; j += 8) { u32x4 w; w.x = pk2(v[j], v[j + 1]); w.y = pk2(v[j + 2], v[j + 3]); w.z = pk2(v[j + 4], v[j + 5]); w.w = pk2(v[j + 6], v[j + 7]); *(u32x4*)(dst + j) = w; }
}

__device__ __forceinline__ void ph_mod(Frame& F) {
    const int gt = F.gw * 64 + F.lane, ngt = F.ngw * 64;
    for (int it = gt; it < 2 * 6144; it += ngt) {
        const int l = it / 6144, n = it % 6144;
        const float* W = F.a.in[I_ADAW] + (size_t)l * D * 6144 + n;
        float a0 = 0.f, a1 = 0.f, a2 = 0.f, a3 = 0.f, a4 = 0.f;
        const float* c = F.a.in[I_C]; const float* cc = F.a.in[I_CCTX];
        for (int k = 0; k < D; ++k) { const float w = W[(size_t)k * 6144];
            a0 += siluf(c[k]) * w; a1 += siluf(c[D + k]) * w; a2 += siluf(c[2 * D + k]) * w; a3 += siluf(c[3 * D + k]) * w; a4 += siluf(cc[k]) * w; }
        const float bb = F.a.in[I_ADAB][l * 6144 + n];
        fmod(F)[(l * 4 + 0) * 6144 + n] = a0 + bb; fmod(F)[(l * 4 + 1) * 6144 + n] = a1 + bb; fmod(F)[(l * 4 + 2) * 6144 + n] = a2 + bb; fmod(F)[(l * 4 + 3) * 6144 + n] = a3 + bb;
        if (l == 0 && n < 2048) fmodc(F)[n] = a4 + bb;
    }
    for (int it = gt; it < 64 * 16; it += ngt) {
        const int pos = it >> 4, j = it & 15;
        const float inv = powf(10000.0f, -(float)j / 16.0f);
        const float ang = (float)pos * inv;
        frope(F)[it * 2] = cosf(ang); frope(F)[it * 2 + 1] = sinf(ang);
    }
}

__device__ __forceinline__ void norm_row(Frame& F, const float* xrow, const float* g, const float* sh, const float* sc, bf16* hrow) {
    const f32x4* xr = (const f32x4*)xrow + F.lane;
    f32x4 v[4]; float s = 0.f;
#pragma unroll
    for (int j = 0; j < 4; ++j) { v[j] = xr[64 * j]; s += (v[j].x * v[j].x + v[j].y * v[j].y) + (v[j].z * v[j].z + v[j].w * v[j].w); }
    const float rstd = rsqrtf(wave_sum(s) * (1.f / D) + EPS);
    unsigned long long* o8 = (unsigned long long*)hrow + F.lane;
#pragma unroll
    for (int j = 0; j < 4; ++j) {
        const f32x4 gg = ((const f32x4*)g)[F.lane + 64 * j], s1 = ((const f32x4*)sh)[F.lane + 64 * j], s2 = ((const f32x4*)sc)[F.lane + 64 * j];
        const f32x4 y = (v[j] * rstd * gg) * (s2 + 1.f) + s1;
        o8[64 * j] = (unsigned long long)pk2(y.x, y.y) | ((unsigned long long)pk2(y.z, y.w) << 32);
    }
}
__device__ __forceinline__ void ph_norm0(Frame& F) {
    const int r_lo = (int)(((long)F.gw * NROW) / F.ngw), r_hi = (int)(((long)(F.gw + 1) * NROW) / F.ngw);
    if (r_lo >= r_hi) return;
    auto rowp = [&](int r) -> const f32x4* { return (const f32x4*)(r < NTOK ? F.a.in[I_X] + (size_t)r * D : F.a.in[I_CTX] + (size_t)(r - NTOK) * D) + F.lane; };
    f32x4 vn[4];
    { const f32x4* xr = rowp(r_lo);
#pragma unroll
      for (int j = 0; j < 4; ++j) vn[j] = xr[64 * j]; }
#pragma unroll 1
    for (int r = r_lo; r < r_hi; ++r) {
        f32x4 v[4]; float s = 0.f;
#pragma unroll
        for (int j = 0; j < 4; ++j) { v[j] = vn[j]; s += (v[j].x * v[j].x + v[j].y * v[j].y) + (v[j].z * v[j].z + v[j].w * v[j].w); }
        if (r + 1 < r_hi) { const f32x4* xr = rowp(r + 1);
#pragma unroll
            for (int j = 0; j < 4; ++j) vn[j] = xr[64 * j]; }
        const float* sh; const float* sc;
        if (r < NTOK) { const int b = r >> 12; sh = fmod(F) + (0 * 4 + b) * 6144; sc = sh + D; } else { sh = fmodc(F); sc = sh + D; }
        const float* g = F.a.in[I_NMG];
        const float rstd = rsqrtf(wave_sum(s) * (1.f / D) + EPS);
        unsigned long long* o8 = (unsigned long long*)(fH(F) + (size_t)r * D) + F.lane;
#pragma unroll
        for (int j = 0; j < 4; ++j) {
            const f32x4 gg = ((const f32x4*)g)[F.lane + 64 * j], s1 = ((const f32x4*)sh)[F.lane + 64 * j], s2 = ((const f32x4*)sc)[F.lane + 64 * j];
            const f32x4 y = (v[j] * rstd * gg) * (s2 + 1.f) + s1;
            o8[64 * j] = (unsigned long long)pk2(y.x, y.y) | ((unsigned long long)pk2(y.z, y.w) << 32);
        }
    }
}

__device__ __forceinline__ void ph_inproj_naive(Frame& F) {
    const float* W = F.a.in[I_WIN];
    for (int it = F.gw; it < 272 * 56; it += F.ngw) {
        const int rg = it / 56, u = it % 56; if (rg >= 256 && u >= 32) continue;
        const int row = rg * 64 + F.lane;
        float acc[64];
#pragma unroll
        for (int j = 0; j < 64; ++j) acc[j] = 0.f;
        naive_dot<64>(fH(F) + (size_t)row * D, W + u * 64, ABW, D, acc);
        const int t = u >> 3, h = u & 7;
        if ((t == 0 || t == 4) && row < NTOK) {
            const int tt = row & 4095, pr = tt >> 6, pc = tt & 63;
#pragma unroll
            for (int j = 0; j < 16; ++j) {
                const float c1 = frope(F)[(pr * 16 + j) * 2], s1 = frope(F)[(pr * 16 + j) * 2 + 1], c2 = frope(F)[(pc * 16 + j) * 2], s2 = frope(F)[(pc * 16 + j) * 2 + 1];
                const float a = acc[j], b = acc[j + 16], c = acc[32 + j], d = acc[48 + j];
                acc[j] = a * c1 - b * s1; acc[j + 16] = a * s1 + b * c1; acc[32 + j] = c * c2 - d * s2; acc[48 + j] = c * s2 + d * c2;
            }
        }
        if (t == 0) {
#pragma unroll
            for (int j = 0; j < 64; ++j) acc[j] *= 0.125f;
        }
        if (t == 2 || t == 6) {
            float ss = 0.f;
#pragma unroll
            for (int j = 0; j < 64; ++j) ss += acc[j] * acc[j];
            const float r = rsqrtf(ss * (1.f / 64.f) + EPS) * (t == 6 ? 0.125f : 1.f);
            const float* g = t == 2 ? F.a.in[I_KG] : F.a.in[I_QG];
#pragma unroll
            for (int j = 0; j < 64; ++j) acc[j] = acc[j] * r * g[j];
        }
        if (t == 5) {
#pragma unroll
            for (int j = 0; j < 64; ++j) acc[j] = siluf(acc[j]);
        }
        const size_t off_t = t < 4 ? (size_t)t * 17 * MiB : (size_t)(68 + (t - 4) * 16) * MiB;
        bf16* dst = (bf16*)(fA(F) + off_t) + (size_t)row * HW + h * 64;
        store_row_bf16<64>(dst, acc);
    }
}

__device__ __forceinline__ float ret_gamma_log(Frame& F, int dir, int h) {
    const float th = F.a.in[I_RDEC][dir * 8 + h];
    return -(th > 0.f ? th + log1pf(__expf(-th)) : log1pf(__expf(th)));
}
__device__ __forceinline__ void ph_scan_naive(Frame& F) {
    const bf16* RK = (const bf16*)(fA(F) + A_RK); const bf16* RV = (const bf16*)(fA(F) + A_RV); bf16* SST = (bf16*)(fA(F) + A_SST);
    const int gt = F.gw * 64 + F.lane, ngt = F.ngw * 64;
    for (int it = gt; it < 64 * 4096; it += ngt) {
        const int bhd = it >> 12, ed = it & 4095, e = ed >> 6, d = ed & 63;
        const int dir = bhd & 1, h = (bhd >> 1) & 7, b = bhd >> 4;
        const float gam = __expf(ret_gamma_log(F, dir, h));
        float S = 0.f;
        bf16* sst = SST + ((size_t)((b * 8 + h) * 2 + dir) * 32) * 4096 + ed;
        for (int n = 0; n < CTXL; ++n) { const int nn = dir ? (CTXL - 1 - n) : n; const size_t row = NTOK + b * CTXL + nn;
            S = gam * S + bf2f(RK[row * HW + h * 64 + d]) * bf2f(RV[row * HW + h * 64 + e]); }
        for (int n = 0; n < SEQ; ++n) { const int t = dir ? (SEQ - 1 - n) : n; const size_t row = (size_t)b * SEQ + t;
            if ((n & 127) == 0) sst[(size_t)(t >> 7) * 4096] = (bf16)f2bf(S);
            S = gam * S + bf2f(RK[row * HW + h * 64 + d]) * bf2f(RV[row * HW + h * 64 + e]); }
    }
}
__device__ __forceinline__ void ph_na_naive(Frame& F) {
    const bf16* NK = (const bf16*)(fA(F) + A_NK); const bf16* NV = (const bf16*)(fA(F) + A_NV); const bf16* NQ = (const bf16*)(fA(F) + A_NQ); bf16* MIX = (bf16*)(fA(F) + A_MIX);
    const int gt = F.gw * 64 + F.lane, ngt = F.ngw * 64;
    for (int it = gt; it < NB * NH * SEQ; it += ngt) {
        const int t = it & 4095, h = (it >> 12) & 7, b = it >> 15;
        const int r = t >> 6, c = t & 63;
        int r0 = r - 4; r0 = r0 < 0 ? 0 : (r0 > 56 ? 56 : r0); int c0 = c - 8; c0 = c0 < 0 ? 0 : (c0 > 48 ? 48 : c0);
        const size_t qrow = (size_t)b * SEQ + t;
        unsigned q[32]; float o[64];
#pragma unroll
        for (int j = 0; j < 32; ++j) q[j] = *(const unsigned*)(NQ + qrow * HW + h * 64 + 2 * j);
#pragma unroll
        for (int j = 0; j < 64; ++j) o[j] = 0.f;
        float m = -1e30f, l = 0.f;
        const float* rpb = F.a.in[I_RPB] + h * 15 * 31;
#pragma unroll 1
        for (int kk = 0; kk < 384; ++kk) {
            size_t krow; float bias = 0.f;
            if (kk < 128) { const int kr = r0 + (kk >> 4), kc = c0 + (kk & 15); krow = (size_t)b * SEQ + kr * 64 + kc; bias = rpb[(kr - r + 7) * 31 + (kc - c + 15)]; }
            else krow = NTOK + b * CTXL + (kk - 128);
            float s = 0.f;
#pragma unroll
            for (int j = 0; j < 64; j += 2) { const unsigned w = *(const unsigned*)(NK + krow * HW + h * 64 + j); s += bf2f(q[j >> 1] & 0xffffu) * bf2f(w & 0xffffu) + bf2f(q[j >> 1] >> 16) * bf2f(w >> 16); }
            s += bias;
            asm volatile("" ::: "memory");
            const float mn = fmaxf(m, s), al = __expf(m - mn), p = __expf(s - mn);
            l = l * al + p; m = mn;
#pragma unroll
            for (int j = 0; j < 64; j += 2) { const unsigned w = *(const unsigned*)(NV + krow * HW + h * 64 + j); o[j] = o[j] * al + p * bf2f(w & 0xffffu); o[j + 1] = o[j + 1] * al + p * bf2f(w >> 16); }
        }
        const float il = 1.f / l;
#pragma unroll
        for (int j = 0; j < 64; ++j) o[j] *= il;
        store_row_bf16<64>(MIX + qrow * D + 512 + h * 64, o);
    }
}
__device__ __forceinline__ void ph_retout_naive(Frame& F) {
    const bf16* RK = (const bf16*)(fA(F) + A_RK); const bf16* RV = (const bf16*)(fA(F) + A_RV); const bf16* RQ = (const bf16*)(fA(F) + A_RQ); const bf16* GT = (const bf16*)(fA(F) + A_GT);
    const bf16* SST = (const bf16*)(fA(F) + A_SST); bf16* MIX = (bf16*)(fA(F) + A_MIX);
    const int gt = F.gw * 64 + F.lane, ngt = F.ngw * 64;
    for (int it = gt; it < NB * NH * SEQ * 2; it += ngt) {
        const int hf = it & 1, t = (it >> 1) & 4095, h = (it >> 13) & 7, b = it >> 16;
        const int i = t & 127, ch = t >> 7;
        const size_t qrow = (size_t)b * SEQ + t;
        const float lgf = ret_gamma_log(F, 0, h), lgb = ret_gamma_log(F, 1, h);
        unsigned q[32]; float o[32];
#pragma unroll
        for (int j = 0; j < 32; ++j) q[j] = *(const unsigned*)(RQ + qrow * HW + h * 64 + 2 * j);
#pragma unroll
        for (int j = 0; j < 32; ++j) o[j] = 0.f;
#pragma unroll 1
        for (int jj = 0; jj < 128; ++jj) {
            const size_t krow = (size_t)b * SEQ + ch * 128 + jj;
            float s = 0.f;
#pragma unroll
            for (int j = 0; j < 64; j += 2) { const unsigned w = *(const unsigned*)(RK + krow * HW + h * 64 + j); s += bf2f(q[j >> 1] & 0xffffu) * bf2f(w & 0xffffu) + bf2f(q[j >> 1] >> 16) * bf2f(w >> 16); }
            asm volatile("" ::: "memory");
            const float wgt = jj < i ? __expf(lgf * (float)(i - jj)) : (jj > i ? __expf(lgb * (float)(jj - i)) : 2.f);
            s *= wgt;
#pragma unroll
            for (int j = 0; j < 32; j += 2) { const unsigned w = *(const unsigned*)(RV + krow * HW + h * 64 + hf * 32 + j); o[j] += s * bf2f(w & 0xffffu); o[j + 1] += s * bf2f(w >> 16); }
            asm volatile("" ::: "memory");
        }
        const float qf = __expf(lgf * (float)(i + 1)), qb = __expf(lgb * (float)(128 - i));
        const bf16* Sf = SST + ((size_t)((b * 8 + h) * 2 + 0) * 32 + ch) * 4096 + hf * 32 * 64; const bf16* Sb = SST + ((size_t)((b * 8 + h) * 2 + 1) * 32 + ch) * 4096 + hf * 32 * 64;
#pragma unroll 1
        for (int d = 0; d < 64; ++d) {
            const float qd = bf2f(RQ[qrow * HW + h * 64 + d]); const float qfd = qf * qd, qbd = qb * qd;
#pragma unroll
            for (int e = 0; e < 32; ++e) o[e] += qfd * bf2f(Sf[e * 64 + d]) + qbd * bf2f(Sb[e * 64 + d]);
            asm volatile("" ::: "memory");
        }
        float ss = 0.f;
#pragma unroll
        for (int j = 0; j < 32; ++j) ss += o[j] * o[j];
        ss += __shfl_xor(ss, 1);
        const float rs = rsqrtf(ss * (1.f / 64.f) + EPS);
        const float* g = F.a.in[I_RNG] + hf * 32;
#pragma unroll
        for (int j = 0; j < 32; j += 2) { const unsigned w = *(const unsigned*)(GT + qrow * HW + h * 64 + hf * 32 + j); o[j] = o[j] * rs * g[j] * bf2f(w & 0xffffu); o[j + 1] = o[j + 1] * rs * g[j + 1] * bf2f(w >> 16); }
        store_row_bf16<32>(MIX + qrow * D + h * 64 + hf * 32, o);
    }
}
__device__ __forceinline__ void ph_gemm_res_naive(Frame& F, const bf16* A, int lda, int K, const float* W, const float* base, const float* gate  ) {
    for (int it = F.gw; it < 256 * 16; it += F.ngw) {
        const int rg = it >> 4, u = it & 15, row = rg * 64 + F.lane, b = row >> 12;
        float acc[64];
#pragma unroll
        for (int j = 0; j < 64; ++j) acc[j] = 0.f;
        naive_dot<64>(A + (size_t)row * lda, W + u * 64, D, K, acc);
        const float* gp = gate + b * 6144 + u * 64; const float* bp = base + (size_t)row * D + u * 64; float* op = F.a.out + (size_t)row * D + u * 64;
#pragma unroll
        for (int j = 0; j < 64; j += 4) { const f32x4 bv = *(const f32x4*)(bp + j), gv = *(const f32x4*)(gp + j);
            *(f32x4*)(op + j) = bv + gv * (f32x4){acc[j], acc[j + 1], acc[j + 2], acc[j + 3]}; }
    }
}
__device__ __forceinline__ void ph_route(Frame& F, int l, bool dry = false) {
    typedef short bf16x8_ __attribute__((ext_vector_type(8)));
    LAS bf16* wh = (LAS bf16*)F.lds;
    LAS bf16* wl = wh + 16 * 1024;
    LAS float* gsb = (LAS float*)(F.lds + 65536);
    LAS float* shb = gsb + 4 * 1024;
    for (int i = F.tid; i < D * NE; i += NTHREADS) { const int e = i >> 10, k = i & 1023; const float w = F.a.in[I_RW][k * 16 + e]; const unsigned h = f2bf(w); const float rem = w - bf2f(h);
        wh[i] = (bf16)h; wl[i] = (bf16)f2bf(rem); }
    for (int i = F.tid; i < 4 * D; i += NTHREADS) { const int b = i >> 10, k = i & 1023; const float* md = fmod(F) + (l * 4 + b) * 6144;
        gsb[i] = F.a.in[I_NFG][l * D + k] * (md[4 * D + k] + 1.f); shb[i] = md[3 * D + k]; }
    __syncthreads();
    unsigned* cnt = fctl(F) + CW_CNT + l * 1024;
    const int row16 = F.lane & 15, kq = F.lane >> 4;
    LAS float* xss = (LAS float*)(F.lds + 65536 + 32768);
    LAS float* xlg = xss + 128;
    const int kh = F.wave >> 2, wi = F.wave & 3;
    for (int item0 = (int)blockIdx.x * 4; item0 < NTOK / 16; item0 += (int)gridDim.x * 4) {
        const int item = item0 + wi;
        const int r = item * 16 + row16, b = (item * 16) >> 12;
        const bf16* xrow = (const bf16*)(l == 0 ? fA(F) + A_X1 : fA(F) + A_X3) + (size_t)r * D + 512 * kh + 8 * kq;
        float ss;
        { const f32x4 t = *(const f32x4*)(fvss(F) + (size_t)r * 16 + 4 * kq); ss = (t.x + t.y) + (t.z + t.w); }
        ss += __shfl_xor(ss, 16); ss += __shfl_xor(ss, 32);
        __syncthreads();
        const float rstd = rsqrtf(ss * (1.f / D) + EPS);
        f32x4 acc = {0.f, 0.f, 0.f, 0.f};
        bf16* hrow = fH(F) + (size_t)r * D + 512 * kh + 8 * kq;
        const LAS float* gp = gsb + b * 1024 + 512 * kh + 8 * kq; const LAS float* sp = shb + b * 1024 + 512 * kh + 8 * kq;
        const LAS bf16* whp = wh + row16 * 1024 + 512 * kh + 8 * kq; const LAS bf16* wlp = wl + row16 * 1024 + 512 * kh + 8 * kq;
#pragma unroll 4
        for (int s2 = 0; s2 < 16; ++s2) {
            const u32x4 t = *(const u32x4*)(xrow + 32 * s2);
            const f32x4 a = { bf2f(t.x & 0xffffu), bf2f(t.x >> 16), bf2f(t.y & 0xffffu), bf2f(t.y >> 16) }, c = { bf2f(t.z & 0xffffu), bf2f(t.z >> 16), bf2f(t.w & 0xffffu), bf2f(t.w >> 16) };
            const f32x4 g0 = *(const LAS f32x4*)(gp + 32 * s2), g1 = *(const LAS f32x4*)(gp + 32 * s2 + 4), h0 = *(const LAS f32x4*)(sp + 32 * s2), h1 = *(const LAS f32x4*)(sp + 32 * s2 + 4);
            const f32x4 y0 = (a * rstd) * g0 + h0, y1 = (c * rstd) * g1 + h1;
            u32x4 yh; yh.x = pk2(y0.x, y0.y); yh.y = pk2(y0.z, y0.w); yh.z = pk2(y1.x, y1.y); yh.w = pk2(y1.z, y1.w);
            *(u32x4*)(hrow + 32 * s2) = yh;
            const f32x4 r0 = { y0.x - bf2f(yh.x & 0xffffu), y0.y - bf2f(yh.x >> 16), y0.z - bf2f(yh.y & 0xffffu), y0.w - bf2f(yh.y >> 16) };
            const f32x4 r1 = { y1.x - bf2f(yh.z & 0xffffu), y1.y - bf2f(yh.z >> 16), y1.z - bf2f(yh.w & 0xffffu), y1.w - bf2f(yh.w >> 16) };
            u32x4 yl; yl.x = pk2(r0.x, r0.y); yl.y = pk2(r0.z, r0.w); yl.z = pk2(r1.x, r1.y); yl.w = pk2(r1.z, r1.w);
            const bf16x8_ wfh = *(const LAS bf16x8_*)(whp + 32 * s2), wfl = *(const LAS bf16x8_*)(wlp + 32 * s2);
            const bf16x8_ yfh = __builtin_bit_cast(bf16x8_, yh), yfl = __builtin_bit_cast(bf16x8_, yl);
            acc = __builtin_amdgcn_mfma_f32_16x16x32_bf16(wfh, yfh, acc, 0, 0, 0);
            acc = __builtin_amdgcn_mfma_f32_16x16x32_bf16(wfl, yfh, acc, 0, 0, 0);
            acc = __builtin_amdgcn_mfma_f32_16x16x32_bf16(wfh, yfl, acc, 0, 0, 0);
        }
        if (kh == 1) *(LAS f32x4*)(xlg + (wi * 64 + F.lane) * 4) = acc;
        __syncthreads();
        if (kh == 1) continue;
        acc = acc + *(const LAS f32x4*)(xlg + (wi * 64 + F.lane) * 4);
        float m1 = -1e30f, m2 = -1e30f, w1 = 0.f, w2 = 0.f; int i1 = 0, i2 = 0;
#pragma unroll
        for (int g = 0; g < 4; ++g) { const float af = 1.f / (1.f + __expf(-acc[g])); const float x = af + F.a.in[I_RB][4 * kq + g]; const int id = 4 * kq + g;
            if (x > m1) { m2 = m1; i2 = i1; w2 = w1; m1 = x; i1 = id; w1 = af; } else if (x > m2) { m2 = x; i2 = id; w2 = af; } }
        const float gsc = m1 + m2;
        const float s0 = __shfl(gsc, row16), s1 = __shfl(gsc, row16 + 16), s2_ = __shfl(gsc, row16 + 32), s3 = __shfl(gsc, row16 + 48);
        int best = 0; float bs = s0; if (s1 > bs) { bs = s1; best = 1; } if (s2_ > bs) { bs = s2_; best = 2; } if (s3 > bs) { bs = s3; best = 3; }
        const bool writer = (kq == best) && !dry;
        int mycount = 0; unsigned long long below1 = 0ull, below2 = 0ull;
        const unsigned long long ltmask = (1ull << F.lane) - 1ull;
#pragma unroll
        for (int e = 0; e < 16; ++e) { const unsigned long long m = __ballot(writer && (i1 == e || i2 == e));
            if (F.lane == e) mycount = __popcll(m);
            if (i1 == e) below1 = m & ltmask; if (i2 == e) below2 = m & ltmask; }
        int base = 0;
        if (F.lane < 16 && mycount > 0) base = (int)__hip_atomic_fetch_add(cnt + F.lane * 64, (unsigned)mycount, RLX_AGENT);
        const int b1 = __shfl(base, i1), b2 = __shfl(base, i2);
        if (writer) { const float inv = 1.f / (w1 + w2);
            u32x2 r1_, r2_; r1_.x = (unsigned)(2 * r); r1_.y = __builtin_bit_cast(unsigned, w1 * inv); r2_.x = (unsigned)(2 * r + 1); r2_.y = __builtin_bit_cast(unsigned, w2 * inv);
            ((u32x2*)flist(F))[i1 * 16384 + b1 + __popcll(below1)] = r1_; ((u32x2*)flist(F))[i2 * 16384 + b2 + __popcll(below2)] = r2_; }
    }
    __syncthreads();
}
struct Seg { int cnt[16]; int base[16]; };
__device__ __forceinline__ void load_seg(Frame& F, int l, int (&cnt)[16], int (&base)[16]) {
    int acc = 0;
#pragma unroll
    for (int e = 0; e < 16; ++e) { cnt[e] = (int)__hip_atomic_load(fctl(F) + CW_CNT + l * 1024 + e * 64, RLX_AGENT); base[e] = acc; acc += (cnt[e] + 255) & ~255; }
}
__device__ __forceinline__ void ph_moe_gu_naive(Frame& F, int l) {
    int cnt[16], base[16]; load_seg(F, l, cnt, base);
    bf16* ACT = (bf16*)(fA(F) + A_ACT);
    int tot = 0;
#pragma unroll
    for (int i = 0; i < 16; ++i) tot += (cnt[i] + 63) >> 6;
    for (int it = F.gw; it < tot * 16; it += F.ngw) {
        const int gi_all = it >> 4, u = it & 15;
        int ee = 0, gs = 0;
#pragma unroll
        for (int i = 0, cum = 0; i < 16; ++i) { cum += (cnt[i] + 63) >> 6; if (gi_all >= cum) { gs = cum; ee = i + 1; } }
        int ce = 0, be = 0;
#pragma unroll
        for (int i = 0; i < 16; ++i) if (i == ee) { ce = cnt[i]; be = base[i]; }
        const int pos = (gi_all - gs) * 64 + F.lane; const bool valid = pos < ce;
        const int ent = flist(F)[(ee * 16384 + (valid ? pos : 0)) * 2]; const int tok = ent >> 1;
        float ag[32], au[32];
#pragma unroll
        for (int j = 0; j < 32; ++j) { ag[j] = 0.f; au[j] = 0.f; }
        const float* Wg = F.a.in[I_WG] + ((size_t)(l * NE + ee) * D) * EW + u * 32; const float* Wu = F.a.in[I_WU] + ((size_t)(l * NE + ee) * D) * EW + u * 32;
        naive_dot<32>(fH(F) + (size_t)tok * D, Wg, EW, D, ag);
        naive_dot<32>(fH(F) + (size_t)tok * D, Wu, EW, D, au);
#pragma unroll
        for (int j = 0; j < 32; ++j) ag[j] = siluf(ag[j]) * au[j];
        if (valid) store_row_bf16<32>(ACT + (size_t)(be + pos) * EW + u * 32, ag);
    }
}
__device__ __forceinline__ void ph_moe_dn_naive(Frame& F, int l) {
    int cnt[16], base[16]; load_seg(F, l, cnt, base);
    const bf16* ACT = (const bf16*)(fA(F) + A_ACT); bf16* Y = (bf16*)(fA(F) + A_Y);
    int tot = 0;
#pragma unroll
    for (int i = 0; i < 16; ++i) tot += (cnt[i] + 63) >> 6;
    for (int it = F.gw; it < tot * 16; it += F.ngw) {
        const int gi_all = it >> 4, u = it & 15;
        int ee = 0, gs = 0;
#pragma unroll
        for (int i = 0, cum = 0; i < 16; ++i) { cum += (cnt[i] + 63) >> 6; if (gi_all >= cum) { gs = cum; ee = i + 1; } }
        int ce = 0, be = 0;
#pragma unroll
        for (int i = 0; i < 16; ++i) if (i == ee) { ce = cnt[i]; be = base[i]; }
        const int pos = (gi_all - gs) * 64 + F.lane; const bool valid = pos < ce;
        const int ent = flist(F)[(ee * 16384 + (valid ? pos : 0)) * 2];
        float acc[64];
#pragma unroll
        for (int j = 0; j < 64; ++j) acc[j] = 0.f;
        const float* Wd = F.a.in[I_WD] + ((size_t)(l * NE + ee) * EW) * D + u * 64;
        naive_dot<64>(ACT + (size_t)(be + (valid ? pos : 0)) * EW, Wd, D, EW, acc);
        const float w = __builtin_bit_cast(float, flist(F)[(ee * 16384 + (valid ? pos : 0)) * 2 + 1]);
#pragma unroll
        for (int j = 0; j < 64; ++j) acc[j] *= w;
        if (valid) store_row_bf16<64>(Y + (size_t)ent * D + u * 64, acc);
    }
}
__device__ __forceinline__ void ph_combine(Frame& F, int l, bool do_norm, bool dry = false) {
    const float dsc = dry ? 0.f : 1.f;
    const bf16* Y = (const bf16*)(fA(F) + A_Y);
    const bf16* X = (const bf16*)(l == 0 ? fA(F) + A_X1 : fA(F) + A_X3);
    const int r_lo = (int)(((long)F.gw * NTOK) / F.ngw), r_hi = (int)(((long)(F.gw + 1) * NTOK) / F.ngw);
    if (r_lo >= r_hi) return;
    unsigned long long xa[4], ya_[4], yb_[4];
    { const unsigned long long* xr = (const unsigned long long*)(X + (size_t)r_lo * D) + F.lane; const unsigned long long* ya = (const unsigned long long*)(Y + (size_t)(2 * r_lo) * D) + F.lane; const unsigned long long* yb = ya + D / 4;
#pragma unroll
      for (int j = 0; j < 4; ++j) { xa[j] = xr[64 * j]; ya_[j] = ya[64 * j]; yb_[j] = yb[64 * j]; } }
#pragma unroll 1
    for (int r = r_lo; r < r_hi; ++r) {
        const int b = r >> 12;
        const float* gf = fmod(F) + (l * 4 + b) * 6144 + 5 * D;
        unsigned long long xc[4], yac[4], ybc[4];
#pragma unroll
        for (int j = 0; j < 4; ++j) { xc[j] = xa[j]; yac[j] = ya_[j]; ybc[j] = yb_[j]; }
        if (r + 1 < r_hi) { const unsigned long long* xr = (const unsigned long long*)(X + (size_t)(r + 1) * D) + F.lane; const unsigned long long* ya = (const unsigned long long*)(Y + (size_t)(2 * r + 2) * D) + F.lane; const unsigned long long* yb = ya + D / 4;
#pragma unroll
            for (int j = 0; j < 4; ++j) { xa[j] = xr[64 * j]; ya_[j] = ya[64 * j]; yb_[j] = yb[64 * j]; } }
        f32x4 v[4]; float s = 0.f;
#pragma unroll
        for (int j = 0; j < 4; ++j) {
            const unsigned long long a = yac[j], bq = ybc[j], xq = xc[j];
            const f32x4 yy = { bf2f((unsigned)a & 0xffffu) + bf2f((unsigned)bq & 0xffffu), bf2f(((unsigned)a) >> 16) + bf2f(((unsigned)bq) >> 16),
                               bf2f((unsigned)(a >> 32) & 0xffffu) + bf2f((unsigned)(bq >> 32) & 0xffffu), bf2f((unsigned)(a >> 48)) + bf2f((unsigned)(bq >> 48)) };
            const f32x4 xv = { bf2f((unsigned)xq & 0xffffu), bf2f(((unsigned)xq) >> 16), bf2f((unsigned)(xq >> 32) & 0xffffu), bf2f((unsigned)(xq >> 48)) };
            v[j] = xv + ((const f32x4*)gf)[F.lane + 64 * j] * yy * dsc;
            if (do_norm) ((unsigned long long*)((bf16*)F.a.out + (size_t)r * D))[F.lane + 64 * j] = (unsigned long long)pk2(v[j].x, v[j].y) | ((unsigned long long)pk2(v[j].z, v[j].w) << 32);
            else ((f32x4*)(F.a.out + (size_t)r * D))[F.lane + 64 * j] = v[j];
            s += (v[j].x * v[j].x + v[j].y * v[j].y) + (v[j].z * v[j].z + v[j].w * v[j].w);
        }
        if (do_norm) {
            const float rstd = rsqrtf(wave_sum(s) * (1.f / D) + EPS);
            const float* g = F.a.in[I_NMG] + (l + 1) * D; const float* sh = fmod(F) + ((l + 1) * 4 + b) * 6144; const float* sc = sh + D;
            unsigned long long* o8 = (unsigned long long*)(fH(F) + (size_t)r * D) + F.lane;
#pragma unroll
            for (int j = 0; j < 4; ++j) {
                const f32x4 gg = ((const f32x4*)g)[F.lane + 64 * j], s1 = ((const f32x4*)sh)[F.lane + 64 * j], s2 = ((const f32x4*)sc)[F.lane + 64 * j];
                const f32x4 y = (v[j] * rstd * gg) * (s2 + 1.f) + s1;
                o8[64 * j] = (unsigned long long)pk2(y.x, y.y) | ((unsigned long long)pk2(y.z, y.w) << 32);
            }
        }
    }
}
__device__ __forceinline__ void ph_sguin_naive(Frame& F) {
    bf16* U = (bf16*)(fA(F) + A_U); bf16* V = (bf16*)(fA(F) + A_V);
    for (int it = F.gw; it < 256 * 96; it += F.ngw) {
        const int rg = it / 96, u = it % 96, row = rg * 64 + F.lane;
        float acc[64];
#pragma unroll
        for (int j = 0; j < 64; ++j) acc[j] = 0.f;
        naive_dot<64>(fH(F) + (size_t)row * D, F.a.in[I_SWIN] + u * 64, 2 * SGW, D, acc);
        const float* bi = F.a.in[I_SBIN] + u * 64; float ss = 0.f;
#pragma unroll
        for (int j = 0; j < 64; ++j) { acc[j] = gelu_tanh(acc[j] + bi[j]); ss += acc[j] * acc[j]; }
        if (u < 48) store_row_bf16<64>(U + (size_t)row * SGW + u * 64, acc);
        else { store_row_bf16<64>(V + (size_t)row * SGW + (u - 48) * 64, acc); fvss(F)[(size_t)row * 48 + (u - 48)] = ss; }
    }
}
__device__ __forceinline__ void ph_sgumix_naive(Frame& F) {
    bf16* U = (bf16*)(fA(F) + A_U); const bf16* V = (const bf16*)(fA(F) + A_V);
    LAS float* rs = (LAS float*)F.lds;
    for (int bc = blockIdx.x; bc < NB * 32; bc += gridDim.x) {
        const size_t row0 = (size_t)bc * 128;
        __syncthreads();
        if (F.tid < 128) { float s = 0.f; for (int j = 0; j < 48; ++j) s += fvss(F)[(row0 + F.tid) * 48 + j]; rs[F.tid] = rsqrtf(s * (1.f / SGW) + EPS); }
        __syncthreads();
        for (int o = F.tid; o < 128 * SGW; o += NTHREADS) {
            const int i = o / SGW, c = o % SGW, g = c / 384;
            const float* ws = F.a.in[I_SWS] + ((size_t)g * 128 + i) * 128;
            float acc = 0.f;
            for (int j = 0; j < 128; ++j) acc += ws[j] * (bf2f(V[(row0 + j) * SGW + c]) * rs[j]);
            const float mixed = acc * F.a.in[I_SNG][c] + F.a.in[I_SBS][g * 128 + i];
            const size_t idx = (row0 + i) * SGW + c;
            U[idx] = (bf16)f2bf(bf2f(U[idx]) * mixed);
        }
    }
    __syncthreads();
}


namespace pg8 {
typedef short bf16x8 __attribute__((ext_vector_type(8)));
constexpr int BM = 256, BK = 64, HALF = 128, HTB = HALF * BK * 2, STAGE_BYTES = 8 * HTB;
__host__ __device__ __forceinline__ int lds_byte(int r, int c) { const int st = (r >> 4) * 2 + (c >> 5), rr = r & 15, cc = c & 31, ob = rr * 64 + cc * 2; return st * 1024 + (ob ^ (((ob >> 9) & 1) << 5)); }
__host__ __device__ __forceinline__ void stage_rc(int b, int& R, int& C) { const int st = b / 1024, sb = b % 1024, swz = sb ^ (((sb >> 9) & 1) << 5); R = (st >> 1) * 16 + swz / 64; C = (st & 1) * 32 + (swz % 64) / 2; }
struct Unit { int pm, pn; const char* Ab; const char* Bb; int x0, x1, x2; };
__device__ __forceinline__ unsigned cvt_pk_bf16(float lo, float hi) { unsigned r; asm volatile("v_cvt_pk_bf16_f32 %0, %1, %2" : "=v"(r) : "v"(lo), "v"(hi)); return r; }

template <class Sched, class Epi, bool ALIGN_EPI>
__device__ __forceinline__ void gemm_phase(LAS unsigned char* lds, const int K, const Sched& S, const Epi& E, const int wid) {
    const int lane = lane_id_v(), tid = wid * 64 + lane, wr = wid >> 2, wc = wid & 3, fr = lane & 15, fq = lane >> 4;
    const int nt = K / BK;
    unsigned voffB[2];
#pragma unroll
    for (int i = 0; i < 2; ++i) { int R_, C_; stage_rc(tid * 16 + i * 8192, R_, C_); voffB[i] = (unsigned)(R_ * K + C_) * 2u; }
    const size_t kstep = (size_t)(BK * 2);
    const size_t hstep = (size_t)HALF * K * 2;
    const unsigned ldsw = (unsigned)wid * 1024u;
    const int aoff = lds_byte(wr * 64 + fr, fq * 8), boff = lds_byte(wc * 32 + fr, fq * 8);
#define PG8_SA(b, h) (((b) * 2 + (h)) * HTB)
#define PG8_SB(b, h) ((4 + (b) * 2 + (h)) * HTB)
#define PG8_STAGE(bufoff, gbase, voff) do { _Pragma("unroll") for (int _i = 0; _i < 2; ++_i) \
        __builtin_amdgcn_global_load_lds((const unsigned*)((const char*)(gbase) + (voff)[_i]), (LAS unsigned*)(lds + (bufoff) + ldsw + _i * 8192), 16, 0, 0); } while (0)
#define PG8_LDA(dst, b, h) do { _Pragma("unroll") for (int m = 0; m < 4; ++m) _Pragma("unroll") for (int k = 0; k < 2; ++k) dst[m][k] = *(const LAS bf16x8*)(lds + PG8_SA(b, h) + aoff + m * 2048 + k * 1024); } while (0)
#define PG8_LDB(dst, b, h) do { _Pragma("unroll") for (int n = 0; n < 2; ++n) _Pragma("unroll") for (int k = 0; k < 2; ++k) dst[n][k] = *(const LAS bf16x8*)(lds + PG8_SB(b, h) + boff + n * 2048 + k * 1024); } while (0)
#define PG8_MMA(ai, bj, At, Bt) do { __builtin_amdgcn_s_setprio(1); _Pragma("unroll") for (int m = 0; m < 4; ++m) _Pragma("unroll") for (int n = 0; n < 2; ++n) _Pragma("unroll") for (int k = 0; k < 2; ++k) \
        acc[ai][bj][m][n] = __builtin_amdgcn_mfma_f32_16x16x32_bf16(Bt[n][k], At[m][k], acc[ai][bj][m][n], 0, 0, 0); __builtin_amdgcn_s_setprio(0); } while (0)
#define PG8_WAIT_V(n) asm volatile("s_waitcnt vmcnt(" #n ")" ::: "memory")
#define PG8_WAIT_L(n) asm volatile("s_waitcnt lgkmcnt(" #n ")" ::: "memory")
#define PG8_BAR __builtin_amdgcn_s_barrier()
#define PG8_SCHED __builtin_amdgcn_sched_barrier(0)
    Unit cur, nxt; int ui = 0;
    if (!S.next(0, cur)) return;
    constexpr int REC_OFF = STAGE_BYTES;
#define PG8_REC_DMA(u, buf) do { if constexpr (Sched::REC) { const unsigned* _src = S.rec_src(u) + wid * 64 + lane; \
        __builtin_amdgcn_global_load_lds(_src, (LAS unsigned*)(lds + REC_OFF + (buf) * 2048 + wid * 256), 4, 0, 0); } } while (0)
#define PG8_REC_PTR(i) ((const LAS unsigned*)(lds + REC_OFF + ((i) % 3) * 2048))
    PG8_REC_DMA(cur, 0);
    unsigned vA[2][2];
    S.arows0(cur, vA, tid);
    asm volatile("" : "+v"(vA[0][0]), "+v"(vA[0][1]), "+v"(vA[1][0]), "+v"(vA[1][1]));
    f32x4 acc[2][2][4][2];
#pragma unroll
    for (int a = 0; a < 2; ++a)
#pragma unroll
        for (int b = 0; b < 2; ++b)
#pragma unroll
            for (int m = 0; m < 4; ++m)
#pragma unroll
                for (int n = 0; n < 2; ++n) acc[a][b][m][n] = (f32x4){0.f, 0.f, 0.f, 0.f};
    bf16x8 At[4][2], B0[2][2], B1[2][2];
    const char* cA = cur.Ab; const char* cB = cur.Bb;
    PG8_STAGE(PG8_SB(0, 0), cB, voffB); PG8_STAGE(PG8_SB(0, 1), cB + hstep, voffB); PG8_STAGE(PG8_SA(0, 0), cA, vA[0]); PG8_STAGE(PG8_SA(0, 1), cA, vA[1]);
    if (wr == 1) PG8_BAR;
    PG8_WAIT_V(2); PG8_BAR;
    PG8_STAGE(PG8_SB(1, 0), cB + kstep, voffB); PG8_STAGE(PG8_SA(1, 0), cA + kstep, vA[0]); PG8_STAGE(PG8_SB(1, 1), cB + hstep + kstep, voffB);
    PG8_WAIT_V(6); PG8_BAR;
    for (;;) {
        const bool has_next = S.next(ui + 1, nxt);
        if (has_next) PG8_REC_DMA(nxt, (ui + 1) % 3);
        const char* nA = has_next ? nxt.Ab : cA; const char* nB = has_next ? nxt.Bb : cB;
        for (int t = 0; t < nt; t += 2) {
            const bool last = (t == nt - 2);
            const char* a1 = cA + (size_t)(t + 1) * kstep;
            const char* a2 = last ? nA : cA + (size_t)(t + 2) * kstep; const char* b2 = last ? nB : cB + (size_t)(t + 2) * kstep;
            const char* a3 = a2 + kstep; const char* b3 = b2 + kstep;
            unsigned w0[2], w1[2];
            w0[0] = vA[0][0]; w0[1] = vA[0][1]; w1[0] = vA[1][0]; w1[1] = vA[1][1];
            if (last && has_next) { unsigned nv[2][2]; pg8::Unit tu = nxt; asm volatile("" : "+v"(tu.pm)); S.arows(tu, nv, PG8_REC_PTR(ui + 1), tid);
                w0[0] = nv[0][0]; w0[1] = nv[0][1]; w1[0] = nv[1][0]; w1[1] = nv[1][1]; }
            PG8_LDB(B0, 0, 0); PG8_LDB(B1, 0, 1); PG8_SCHED; PG8_LDA(At, 0, 0); PG8_STAGE(PG8_SA(1, 1), a1, vA[1]);
            PG8_WAIT_V(8); PG8_WAIT_L(0); PG8_BAR; PG8_MMA(0, 0, At, B0); PG8_MMA(0, 1, At, B1); PG8_BAR; PG8_SCHED;
            PG8_LDA(At, 0, 1); PG8_STAGE(PG8_SB(0, 0), b2, voffB); PG8_STAGE(PG8_SB(0, 1), b2 + hstep, voffB); PG8_STAGE(PG8_SA(0, 0), a2, w0);
            PG8_WAIT_V(8); PG8_WAIT_L(0); PG8_BAR; PG8_MMA(1, 0, At, B0); PG8_MMA(1, 1, At, B1); PG8_BAR; PG8_SCHED;
            PG8_LDB(B0, 1, 0); PG8_LDB(B1, 1, 1); PG8_SCHED; PG8_LDA(At, 1, 0); PG8_STAGE(PG8_SA(0, 1), a2, w1);
            PG8_WAIT_V(8); PG8_WAIT_L(0); PG8_BAR; PG8_MMA(0, 0, At, B0); PG8_MMA(0, 1, At, B1); PG8_BAR; PG8_SCHED;
            PG8_LDA(At, 1, 1); PG8_STAGE(PG8_SB(1, 0), b3, voffB); PG8_STAGE(PG8_SB(1, 1), b3 + hstep, voffB); PG8_STAGE(PG8_SA(1, 0), a3, w0);
            PG8_WAIT_V(8); PG8_WAIT_L(0); PG8_BAR; PG8_MMA(1, 0, At, B0); PG8_MMA(1, 1, At, B1); PG8_BAR; PG8_SCHED;
        }
        if constexpr (ALIGN_EPI) { if (wr == 0) PG8_BAR; }
        E(acc, cur, wr, wc, fr, fq, PG8_REC_PTR(ui));
        if (!has_next) break;
#pragma unroll
        for (int a = 0; a < 2; ++a)
#pragma unroll
            for (int b = 0; b < 2; ++b)
#pragma unroll
                for (int m = 0; m < 4; ++m)
#pragma unroll
                    for (int n = 0; n < 2; ++n) acc[a][b][m][n] = (f32x4){0.f, 0.f, 0.f, 0.f};
        cur = nxt; cA = nA; cB = nB; ++ui;
        S.arows(cur, vA, PG8_REC_PTR(ui), tid);
        if constexpr (ALIGN_EPI) { if (wr == 1) PG8_BAR; }
    }
    PG8_WAIT_V(0);
    if constexpr (!ALIGN_EPI) { if (wr == 0) PG8_BAR; }
    PG8_BAR;
#undef PG8_REC_DMA
#undef PG8_REC_PTR
#undef PG8_SA
#undef PG8_SB
#undef PG8_STAGE
#undef PG8_LDA
#undef PG8_LDB
#undef PG8_MMA
#undef PG8_WAIT_V
#undef PG8_WAIT_L
#undef PG8_BAR
#undef PG8_SCHED
}
}

constexpr size_t WB_WIN = 0;
constexpr size_t WB_WOUT = WB_WIN + (size_t)ABW * D * 2;
constexpr size_t WB_SWIN = WB_WOUT + (size_t)D * D * 2;
constexpr size_t WB_SWOUT = WB_SWIN + (size_t)2 * SGW * D * 2;
constexpr size_t WB_GU = WB_SWOUT + (size_t)D * SGW * 2;
constexpr size_t WB_DN = WB_GU + (size_t)2 * NE * 1024 * D * 2;
constexpr size_t WB_WS = WB_DN + (size_t)2 * NE * D * EW * 2;
constexpr size_t WB_END = WB_WS + (size_t)8 * 128 * 128 * 2;
static_assert(WB_END <= 124 * MiB, "bf16 weights fit");

__device__ __forceinline__ int slot_of(int mode, int c) {
    if (mode == 0) { const int bj = (c >> 7) & 1, wc = (c >> 5) & 3, fq = (c >> 3) & 3, nn = (c >> 2) & 1, rg = c & 3; return 128 * bj + 32 * wc + 16 * nn + 4 * fq + rg; }
    if (mode == 1) { const int wc = (c >> 6) & 3, bj = (c >> 5) & 1, nn = (c >> 4) & 1, fq = (c >> 2) & 3, rg = c & 3; return 128 * bj + 32 * wc + 16 * nn + 4 * fq + rg; }
    const int wc = (c >> 6) & 3, bj = (c >> 5) & 1, fq = (c >> 3) & 3, nn = (c >> 2) & 1, rg = c & 3; return 128 * bj + 32 * wc + 16 * nn + 4 * fq + rg;
}
template <class RowFn> __device__ __forceinline__ void conv_item(const float* W, int ldw, int k0, int n0, bf16* WT, int Kp, LAS float* scr, int lane, const RowFn& rowfn) {
    f32x4 v[8];
#pragma unroll
    for (int i = 0; i < 8; ++i) { const int kk = 8 * i + (lane >> 3); v[i] = *(const f32x4*)(W + (size_t)(k0 + kk) * ldw + n0 + 4 * (lane & 7)); }
#pragma unroll
    for (int i = 0; i < 8; ++i) { const int kk = 8 * i + (lane >> 3); LAS float* p = scr + kk * 33 + 4 * (lane & 7); p[0] = v[i].x; p[1] = v[i].y; p[2] = v[i].z; p[3] = v[i].w; }
    asm volatile("s_waitcnt lgkmcnt(0)" ::: "memory");
    const int c = lane & 7;
#pragma unroll
    for (int j = 0; j < 4; ++j) { const int n = (lane >> 3) + 8 * j; const LAS float* sp = scr + (8 * c) * 33 + n;
        u32x4 o; o.x = pk2(sp[0 * 33], sp[1 * 33]); o.y = pk2(sp[2 * 33], sp[3 * 33]); o.z = pk2(sp[4 * 33], sp[5 * 33]); o.w = pk2(sp[6 * 33], sp[7 * 33]);
        *(u32x4*)(WT + (size_t)rowfn(n0 + n) * Kp + k0 + 8 * c) = o; }
    asm volatile("s_waitcnt lgkmcnt(0)" ::: "memory");
}
__device__ __forceinline__ void ph_convert(Frame& F, int set, int wj, int nw, int pct_lo = 0, int pct_hi = 100) {
    LAS float* scr = (LAS float*)(F.lds + F.wave * 16384);
    bf16* WB = (bf16*)(F.a.ws + WS_WB);
    constexpr int I_1 = 16 * 112, I_2 = 16 * 32, I_3 = 16 * 192, I_4 = 48 * 32, I_5 = 32 * 512, I_6 = 32 * 256, I_7 = 8 * 128 * 128 / 512;
    constexpr int B5 = I_1 + I_2 + I_3 + I_4, B6 = B5 + I_5, B7 = B6 + I_6;
    constexpr int N_EARLY = I_1 + I_2 + I_5 / 2 + I_6 / 2, N_LATE = I_3 + I_4 + I_5 / 2 + I_6 / 2 + I_7;
    const int nset = set == 0 ? N_EARLY : N_LATE; const int jlo = nset * pct_lo / 100, jhi = nset * pct_hi / 100;
    for (int j = jlo + wj; j < jhi; j += nw) {
        int r;
        if (set == 0) { if (j < I_1 + I_2) r = j; else if (j < I_1 + I_2 + I_5 / 2) r = B5 + (j - (I_1 + I_2)); else r = B6 + (j - (I_1 + I_2 + I_5 / 2)); }
        else { if (j < I_3 + I_4) r = I_1 + I_2 + j; else if (j < I_3 + I_4 + I_5 / 2) r = B5 + I_5 / 2 + (j - (I_3 + I_4)); else if (j < I_3 + I_4 + I_5 / 2 + I_6 / 2) r = B6 + I_6 / 2 + (j - (I_3 + I_4 + I_5 / 2)); else r = B7 + (j - (I_3 + I_4 + I_5 / 2 + I_6 / 2)); }
        if (r < I_1) { const int kb = r / 112, nb = r % 112, n0 = nb * 32; const int tile = n0 >> 8, ty = tile >> 1; const int mode = (ty == 0 || ty == 4) ? 1 : 2;
            conv_item(F.a.in[I_WIN], ABW, kb * 64, n0, (bf16*)((char*)WB + WB_WIN), D, scr, F.lane, [=](int n) { return (n & ~255) + slot_of(mode, n & 255); }); continue; } r -= I_1;
        if (r < I_2) { const int kb = r / 32, nb = r % 32;
            conv_item(F.a.in[I_WOUT], D, kb * 64, nb * 32, (bf16*)((char*)WB + WB_WOUT), D, scr, F.lane, [=](int n) { return (n & ~255) + slot_of(0, n & 255); }); continue; } r -= I_2;
        if (r < I_3) { const int kb = r / 192, nb = r % 192;
            conv_item(F.a.in[I_SWIN], 2 * SGW, kb * 64, nb * 32, (bf16*)((char*)WB + WB_SWIN), D, scr, F.lane, [=](int n) { return (n & ~255) + slot_of(0, n & 255); }); continue; } r -= I_3;
        if (r < I_4) { const int kb = r / 32, nb = r % 32;
            conv_item(F.a.in[I_SWOUT], D, kb * 64, nb * 32, (bf16*)((char*)WB + WB_SWOUT), SGW, scr, F.lane, [=](int n) { return (n & ~255) + slot_of(0, n & 255); }); continue; } r -= I_4;
        if (r < I_5) { const int le = r / 512, q = r % 512, which = q >> 8, kb = (q & 255) / 16, nb = q % 16;
            const float* W = (which ? F.a.in[I_WU] : F.a.in[I_WG]) + (size_t)le * D * EW;
            conv_item(W, EW, kb * 64, nb * 32, (bf16*)((char*)WB + WB_GU) + (size_t)le * 1024 * D, D, scr, F.lane,
                      [=](int jc) { const int w = jc & 127; return (jc >> 7) * 256 + 128 * which + 32 * ((w >> 5) & 3) + 16 * ((w >> 2) & 1) + 4 * ((w >> 3) & 3) + (w & 3); }); continue; } r -= I_5;
        if (r < I_6) { const int le = r / 256, q = r % 256, kb = q / 32, nb = q % 32;
            conv_item(F.a.in[I_WD] + (size_t)le * EW * D, D, kb * 64, nb * 32, (bf16*)((char*)WB + WB_DN) + (size_t)le * D * EW, EW, scr, F.lane, [=](int n) { return (n & ~255) + slot_of(0, n & 255); }); continue; } r -= I_6;
        {
            const float* src = F.a.in[I_SWS] + (size_t)r * 512 + F.lane * 8; const f32x4 a = *(const f32x4*)src, b2 = *(const f32x4*)(src + 4);
            u32x4 o; o.x = pk2(a.x, a.y); o.y = pk2(a.z, a.w); o.z = pk2(b2.x, b2.y); o.w = pk2(b2.z, b2.w);
            *(u32x4*)((bf16*)((char*)WB + WB_WS) + (size_t)r * 512 + F.lane * 8) = o; }
    }
}

struct DenseSched {
    static constexpr bool REC = false;
    __device__ __forceinline__ const unsigned* rec_src(const pg8::Unit&) const { return nullptr; }
    const char* A; const char* Bt; int K, nM, nN, G, c, nwg, xM0, xN, nx;
    __device__ __forceinline__ bool next(int i, pg8::Unit& u) const {
        const int L = i * G + c; if (L >= nwg + nx) return false;
        if (L < nwg) { int wgid = L; { const int q = nwg / 8, r = nwg % 8, xcd = wgid % 8, off = wgid / 8; wgid = (xcd < r ? xcd * (q + 1) : r * (q + 1) + (xcd - r) * q) + off; }
            const int nig = 8 * nN, gid = wgid / nig, fm = gid * 8, gsz = (nM - fm) < 8 ? (nM - fm) : 8;
            u.pm = fm + ((wgid % nig) % gsz); u.pn = (wgid % nig) / gsz; }
        else { const int j = L - nwg; u.pm = xM0 + j / xN; u.pn = j % xN; }
        u.Ab = A; u.Bb = Bt + (size_t)u.pn * 256 * K * 2; u.x0 = 0; u.x1 = 0; u.x2 = 0; return true;
    }
    __device__ __forceinline__ void arows(const pg8::Unit& u, unsigned (&v)[2][2], const LAS unsigned*, int tid) const {
#pragma unroll
        for (int i = 0; i < 2; ++i) { int R, C; pg8::stage_rc(tid * 16 + i * 8192, R, C);
#pragma unroll
            for (int h = 0; h < 2; ++h) v[h][i] = (unsigned)((u.pm * 256 + h * 128 + R) * K + C) * 2u; }
    }
    __device__ __forceinline__ void arows0(const pg8::Unit& u, unsigned (&v)[2][2], int tid) const { arows(u, v, nullptr, tid); }
};
struct MoeSched {
    static constexpr bool REC = true;
    __device__ __forceinline__ const unsigned* rec_src(const pg8::Unit& u) const { return (const unsigned*)LIST + ((size_t)u.x0 * 16384 + u.pm * 256) * 2; }
    const char* A; const char* Bt; int K, G, c, total; const LAS int* tab; const int* LIST; int gather;
    __device__ __forceinline__ bool next(int i, pg8::Unit& u) const {
        int L = i * G + c; if (L >= total) return false;
        if ((G & 7) == 0) { const int q = total / 8, r8 = total % 8, xcd = L % 8, off = L / 8; L = (xcd < r8 ? xcd * (q + 1) : r8 * (q + 1) + (xcd - r8) * q) + off; }
        const int rt = L >> 2; u.pn = L & 3; int ee = 0;
#pragma unroll
        for (int e = 0; e < 16; ++e) { if (tab[e * 4] <= rt && tab[e * 4 + 1] > 0) ee = e; }
        u.pm = rt - tab[ee * 4]; u.x0 = ee; u.x1 = tab[ee * 4 + 1]; u.x2 = tab[ee * 4 + 2];
        u.Ab = A; u.Bb = Bt + ((size_t)ee * 1024 + u.pn * 256) * K * 2; return true;
    }
    __device__ __forceinline__ void arows(const pg8::Unit& u, unsigned (&v)[2][2], const LAS unsigned* rec, int tid) const {
#pragma unroll
        for (int i = 0; i < 2; ++i) { int R, C; pg8::stage_rc(tid * 16 + i * 8192, R, C);
#pragma unroll
            for (int h = 0; h < 2; ++h) { const int pit = h * 128 + R, pos = u.pm * 256 + pit; int row;
                if (gather) { const int ent = (int)rec[(pos < u.x1 ? pit : 0) * 2]; row = ent >> 1; } else row = u.x2 + pos;
                v[h][i] = (unsigned)(row * K + C) * 2u; } }
    }
    __device__ __forceinline__ void arows0(const pg8::Unit& u, unsigned (&v)[2][2], int tid) const {
#pragma unroll
        for (int i = 0; i < 2; ++i) { int R, C; pg8::stage_rc(tid * 16 + i * 8192, R, C);
#pragma unroll
            for (int h = 0; h < 2; ++h) { const int pos = u.pm * 256 + h * 128 + R; int row;
                if (gather) { const int ent = LIST[(u.x0 * 16384 + (pos < u.x1 ? pos : u.pm * 256)) * 2]; row = ent >> 1; } else row = u.x2 + pos;
                v[h][i] = (unsigned)(row * K + C) * 2u; } }
    }
};

struct EpiInproj {
    unsigned char* Areg; const LAS float* ROPE; const float* kg; const float* qg;
    __device__ __forceinline__ void operator()(f32x4 (&acc)[2][2][4][2], const pg8::Unit& u, int wr, int wc, int fr, int fq, const LAS unsigned* rec = nullptr) const {
        const int ty = u.pn >> 1, head = (u.pn & 1) * 4 + wc;
        const size_t off_t = ty < 4 ? (size_t)ty * 17 * MiB : (size_t)(68 + (ty - 4) * 16) * MiB;
        bf16* dst = (bf16*)(Areg + off_t);
        const int row0 = u.pm * 256 + wr * 64 + fr;
        if (ty == 0 || ty == 4) {
            const float sc = ty == 0 ? 0.125f : 1.f;
#pragma unroll
            for (int ai = 0; ai < 2; ++ai)
#pragma unroll
                for (int m = 0; m < 4; ++m) { const int row = row0 + ai * 128 + m * 16; const int tt = row & 4095; const bool lat = row < NTOK;
#pragma unroll
                    for (int bj = 0; bj < 2; ++bj) { const int pos = bj ? (tt & 63) : (tt >> 6);
                        f32x4 u1 = acc[ai][bj][m][0], u2 = acc[ai][bj][m][1];
                        if (lat) { const f32x4 cs0 = *(const LAS f32x4*)(ROPE + (pos * 16 + 4 * fq) * 2), cs1 = *(const LAS f32x4*)(ROPE + (pos * 16 + 4 * fq) * 2 + 4);
                            const f32x4 co = { cs0.x, cs0.z, cs1.x, cs1.z }, si = { cs0.y, cs0.w, cs1.y, cs1.w };
                            const f32x4 a = u1 * co - u2 * si, b = u1 * si + u2 * co; u1 = a; u2 = b; }
                        u1 = u1 * sc; u2 = u2 * sc;
                        bf16* p = dst + (size_t)row * HW + head * 64 + 32 * bj + 4 * fq;
                        u32x2 w; w.x = pg8::cvt_pk_bf16(u1.x, u1.y); w.y = pg8::cvt_pk_bf16(u1.z, u1.w); *(u32x2*)p = w;
                        w.x = pg8::cvt_pk_bf16(u2.x, u2.y); w.y = pg8::cvt_pk_bf16(u2.z, u2.w); *(u32x2*)(p + 16) = w; } }
        } else {
            const bool nrm = (ty == 2 || ty == 6);
            f32x4 g[2][2];
            if (nrm) { const float* gp = ty == 2 ? kg : qg;
#pragma unroll
                for (int bj = 0; bj < 2; ++bj)
#pragma unroll
                    for (int n = 0; n < 2; ++n) g[bj][n] = *(const f32x4*)(gp + 32 * bj + 8 * fq + 4 * n) * (ty == 6 ? 0.125f : 1.f); }
#pragma unroll
            for (int ai = 0; ai < 2; ++ai)
#pragma unroll
                for (int m = 0; m < 4; ++m) { const int row = row0 + ai * 128 + m * 16;
                    f32x4 v[2][2];
#pragma unroll
                    for (int bj = 0; bj < 2; ++bj)
#pragma unroll
                        for (int n = 0; n < 2; ++n) v[bj][n] = acc[ai][bj][m][n];
                    if (nrm) { float ss = 0.f;
#pragma unroll
                        for (int bj = 0; bj < 2; ++bj)
#pragma unroll
                            for (int n = 0; n < 2; ++n) ss += (v[bj][n].x * v[bj][n].x + v[bj][n].y * v[bj][n].y) + (v[bj][n].z * v[bj][n].z + v[bj][n].w * v[bj][n].w);
                        ss += __shfl_xor(ss, 16); ss += __shfl_xor(ss, 32);
                        const float rs = rsqrtf(ss * (1.f / 64.f) + EPS);
#pragma unroll
                        for (int bj = 0; bj < 2; ++bj)
#pragma unroll
                            for (int n = 0; n < 2; ++n) v[bj][n] = v[bj][n] * rs * g[bj][n]; }
                    if (ty == 5) {
#pragma unroll
                        for (int bj = 0; bj < 2; ++bj)
#pragma unroll
                            for (int n = 0; n < 2; ++n)
#pragma unroll
                                for (int q = 0; q < 4; ++q) v[bj][n][q] = siluf(v[bj][n][q]); }
#pragma unroll
                    for (int bj = 0; bj < 2; ++bj) { u32x4 w; w.x = pg8::cvt_pk_bf16(v[bj][0].x, v[bj][0].y); w.y = pg8::cvt_pk_bf16(v[bj][0].z, v[bj][0].w); w.z = pg8::cvt_pk_bf16(v[bj][1].x, v[bj][1].y); w.w = pg8::cvt_pk_bf16(v[bj][1].z, v[bj][1].w);
                        *(u32x4*)(dst + (size_t)row * HW + head * 64 + 32 * bj + 8 * fq) = w; } }
        }
    }
};
template <bool BF> struct EpiRes {
    const void* base; bf16* out; const float* gate; float* xss;
    __device__ __forceinline__ void operator()(f32x4 (&acc)[2][2][4][2], const pg8::Unit& u, int wr, int wc, int fr, int fq, const LAS unsigned* rec = nullptr) const {
        const int b = u.pm >> 4, col0 = u.pn * 256 + wc * 32 + 8 * fq, row0 = u.pm * 256 + wr * 64 + fr;
        f32x4 gv[2][2];
#pragma unroll
        for (int bj = 0; bj < 2; ++bj)
#pragma unroll
            for (int n = 0; n < 2; ++n) gv[bj][n] = *(const f32x4*)(gate + b * 6144 + col0 + bj * 128 + 4 * n);
#pragma unroll
        for (int ai = 0; ai < 2; ++ai)
#pragma unroll
            for (int m = 0; m < 4; ++m) { const size_t off = (size_t)(row0 + ai * 128 + m * 16) * D + col0; float ssq = 0.f;
#pragma unroll
                for (int bj = 0; bj < 2; ++bj) { f32x4 b0, b1;
                    if (BF) { const u32x4 t = *(const u32x4*)((const bf16*)base + off + bj * 128);
                        b0 = (f32x4){ bf2f(t.x & 0xffffu), bf2f(t.x >> 16), bf2f(t.y & 0xffffu), bf2f(t.y >> 16) }; b1 = (f32x4){ bf2f(t.z & 0xffffu), bf2f(t.z >> 16), bf2f(t.w & 0xffffu), bf2f(t.w >> 16) }; }
                    else { b0 = *(const f32x4*)((const float*)base + off + bj * 128); b1 = *(const f32x4*)((const float*)base + off + bj * 128 + 4); }
                    const f32x4 r0 = b0 + gv[bj][0] * acc[ai][bj][m][0], r1 = b1 + gv[bj][1] * acc[ai][bj][m][1];
                    u32x4 w; w.x = pg8::cvt_pk_bf16(r0.x, r0.y); w.y = pg8::cvt_pk_bf16(r0.z, r0.w); w.z = pg8::cvt_pk_bf16(r1.x, r1.y); w.w = pg8::cvt_pk_bf16(r1.z, r1.w);
                    { const f32x4 q0 = { bf2f(w.x & 0xffffu), bf2f(w.x >> 16), bf2f(w.y & 0xffffu), bf2f(w.y >> 16) }, q1 = { bf2f(w.z & 0xffffu), bf2f(w.z >> 16), bf2f(w.w & 0xffffu), bf2f(w.w >> 16) };
                      const f32x4 qq = q0 * q0 + q1 * q1; ssq += (qq.x + qq.y) + (qq.z + qq.w); }
                    *(u32x4*)(out + off + bj * 128) = w; }
                ssq += __shfl_xor(ssq, 16); ssq += __shfl_xor(ssq, 32);
                if (fq == 0) xss[(size_t)(row0 + ai * 128 + m * 16) * 16 + u.pn * 4 + wc] = ssq; }
    }
};
__device__ __forceinline__ float gelu_fast(float v) { const float u2 = -2.302208198f * (v + 0.044715f * v * v * v); return v * __builtin_amdgcn_rcpf(1.f + __builtin_amdgcn_exp2f(u2)); }
__device__ __forceinline__ f32x4 gelu4(f32x4 v) {
    const f32x4 t = (v * v) * 0.044715f + 1.f; const f32x4 u2 = (t * v) * -2.302208198f;
    f32x4 e; e.x = __builtin_amdgcn_exp2f(u2.x); e.y = __builtin_amdgcn_exp2f(u2.y); e.z = __builtin_amdgcn_exp2f(u2.z); e.w = __builtin_amdgcn_exp2f(u2.w);
    const f32x4 d = e + 1.f; f32x4 r; r.x = __builtin_amdgcn_rcpf(d.x); r.y = __builtin_amdgcn_rcpf(d.y); r.z = __builtin_amdgcn_rcpf(d.z); r.w = __builtin_amdgcn_rcpf(d.w);
    return v * r; }
__device__ __forceinline__ f32x4 silu_mul4(f32x4 a, f32x4 b) {
    const f32x4 u2 = a * -1.44269504f;
    f32x4 e; e.x = __builtin_amdgcn_exp2f(u2.x); e.y = __builtin_amdgcn_exp2f(u2.y); e.z = __builtin_amdgcn_exp2f(u2.z); e.w = __builtin_amdgcn_exp2f(u2.w);
    const f32x4 d = e + 1.f; f32x4 r; r.x = __builtin_amdgcn_rcpf(d.x); r.y = __builtin_amdgcn_rcpf(d.y); r.z = __builtin_amdgcn_rcpf(d.z); r.w = __builtin_amdgcn_rcpf(d.w);
    return (a * r) * b; }
struct EpiSguIn {
    bf16* U; bf16* V; const float* bias; float* VSS;
    __device__ __forceinline__ void operator()(f32x4 (&acc)[2][2][4][2], const pg8::Unit& u, int wr, int wc, int fr, int fq, const LAS unsigned* rec = nullptr) const {
        const int col0 = u.pn * 256 + wc * 32 + 8 * fq, row0 = u.pm * 256 + wr * 64 + fr; const bool isv = u.pn >= 12;
        bf16* dstb = isv ? V + (col0 - SGW) : U + col0;
        f32x4 bv[2][2];
#pragma unroll
        for (int bj = 0; bj < 2; ++bj)
#pragma unroll
            for (int n = 0; n < 2; ++n) bv[bj][n] = *(const f32x4*)(bias + col0 + bj * 128 + 4 * n);
#pragma unroll
        for (int ai = 0; ai < 2; ++ai)
#pragma unroll
            for (int m = 0; m < 4; ++m) { const int row = row0 + ai * 128 + m * 16; float ss = 0.f;
#pragma unroll
                for (int bj = 0; bj < 2; ++bj) { const f32x4 z0 = gelu4(acc[ai][bj][m][0] + bv[bj][0]), z1 = gelu4(acc[ai][bj][m][1] + bv[bj][1]);
                    { const f32x4 q2 = z0 * z0 + z1 * z1; ss += (q2.x + q2.y) + (q2.z + q2.w); }
                    u32x4 w; w.x = pg8::cvt_pk_bf16(z0.x, z0.y); w.y = pg8::cvt_pk_bf16(z0.z, z0.w); w.z = pg8::cvt_pk_bf16(z1.x, z1.y); w.w = pg8::cvt_pk_bf16(z1.z, z1.w);
                    *(u32x4*)(dstb + (size_t)row * SGW + bj * 128) = w; }
                if (isv) { ss += __shfl_xor(ss, 16); ss += __shfl_xor(ss, 32); if (fq == 0) VSS[(size_t)row * 48 + (u.pn - 12) * 4 + wc] = ss; } }
    }
};
struct EpiMoeGU {
    bf16* ACT;
    __device__ __forceinline__ void operator()(f32x4 (&acc)[2][2][4][2], const pg8::Unit& u, int wr, int wc, int fr, int fq, const LAS unsigned* rec = nullptr) const {
        const int col0 = u.pn * 128 + wc * 32 + 8 * fq, row0 = u.x2 + u.pm * 256 + wr * 64 + fr;
#pragma unroll
        for (int ai = 0; ai < 2; ++ai)
#pragma unroll
            for (int m = 0; m < 4; ++m) { const f32x4 a0 = silu_mul4(acc[ai][0][m][0], acc[ai][1][m][0]), a1 = silu_mul4(acc[ai][0][m][1], acc[ai][1][m][1]);
                u32x4 w; w.x = pg8::cvt_pk_bf16(a0.x, a0.y); w.y = pg8::cvt_pk_bf16(a0.z, a0.w); w.z = pg8::cvt_pk_bf16(a1.x, a1.y); w.w = pg8::cvt_pk_bf16(a1.z, a1.w);
                *(u32x4*)(ACT + (size_t)(row0 + ai * 128 + m * 16) * EW + col0) = w; }
    }
};
struct EpiMoeDn {
    bf16* Y; const int* LIST; const float* WT;
    __device__ __forceinline__ void operator()(f32x4 (&acc)[2][2][4][2], const pg8::Unit& u, int wr, int wc, int fr, int fq, const LAS unsigned* rec = nullptr) const {
        const int col0 = u.pn * 256 + wc * 32 + 8 * fq;
        const LAS unsigned long long* rl = (const LAS unsigned long long*)rec;
#pragma unroll
        for (int ai = 0; ai < 2; ++ai) {
#pragma unroll
            for (int m = 0; m < 4; ++m) { const int pit = ai * 128 + wr * 64 + m * 16 + fr, pos = u.pm * 256 + pit; const unsigned long long rc = rl[pit]; const int ent = pos < u.x1 ? (int)(unsigned)rc : -1;
                if (ent >= 0) { const float w8 = __builtin_bit_cast(float, (unsigned)(rc >> 32));
#pragma unroll
                    for (int bj = 0; bj < 2; ++bj) { const f32x4 a0 = acc[ai][bj][m][0] * w8, a1 = acc[ai][bj][m][1] * w8;
                        u32x4 w; w.x = pg8::cvt_pk_bf16(a0.x, a0.y); w.y = pg8::cvt_pk_bf16(a0.z, a0.w); w.z = pg8::cvt_pk_bf16(a1.x, a1.y); w.w = pg8::cvt_pk_bf16(a1.z, a1.w);
                        *(u32x4*)(Y + (size_t)ent * D + col0 + bj * 128) = w; } } }
        }
    }
};
__device__ __forceinline__ int moe_tab(Frame& F, int l, LAS int* tab) {
    __syncthreads();
    if (F.tid == 0) { int tiles = 0, base = 0;
        for (int e = 0; e < 16; ++e) { const int c = (int)__hip_atomic_load(fctl(F) + CW_CNT + l * 1024 + e * 64, RLX_AGENT); tab[e * 4] = tiles; tab[e * 4 + 1] = c; tab[e * 4 + 2] = base; tab[e * 4 + 3] = 0; tiles += (c + 255) >> 8; base += (c + 255) & ~255; }
        tab[64] = tiles; }
    __syncthreads();
    return tab[64];
}


typedef short bf16x8 __attribute__((ext_vector_type(8)));
typedef short s16x4 __attribute__((ext_vector_type(4)));
typedef short v4i16_t __attribute__((ext_vector_type(4)));
__device__ __forceinline__ s16x4 tr_read(const LAS unsigned char* p) { return __builtin_bit_cast(s16x4, __builtin_amdgcn_ds_read_tr16_b64_v4i16((LAS v4i16_t*)p)); }
__device__ __forceinline__ bf16x8 cat8(s16x4 a, s16x4 b) { return (bf16x8){a[0], a[1], a[2], a[3], b[0], b[1], b[2], b[3]}; }
__device__ __forceinline__ bf16x8 pk8(f32x4 a, f32x4 b) { u32x4 w; w.x = pg8::cvt_pk_bf16(a.x, a.y); w.y = pg8::cvt_pk_bf16(a.z, a.w); w.z = pg8::cvt_pk_bf16(b.x, b.y); w.w = pg8::cvt_pk_bf16(b.z, b.w); return __builtin_bit_cast(bf16x8, w); }
#define MFMA16(a, b, c) __builtin_amdgcn_mfma_f32_16x16x32_bf16((a), (b), (c), 0, 0, 0)
constexpr int VST = 144;
constexpr size_t A_KV = 148 * MiB;

__device__ __forceinline__ void ph_na(Frame& F) {
    const bf16* NK = (const bf16*)(fA(F) + A_NK); const bf16* NV = (const bf16*)(fA(F) + A_NV); const bf16* NQ = (const bf16*)(fA(F) + A_NQ); bf16* MIX = (bf16*)(fA(F) + A_MIX);
    LAS unsigned char* Vl = F.lds;
    LAS float* mrg = (LAS float*)(F.lds + 832 * VST);
    LAS float* rpbl = (LAS float*)(F.lds + 832 * VST + 4 * 1056 * 4);
    const int lane = F.lane, wave = F.wave, sb = wave & 3, half = wave >> 2, q16 = lane & 15, rq = lane >> 4;
    const int tq = (lane & 15) >> 2, tp = lane & 3;
    const int vcol = F.tid >> 3, vch = F.tid & 7;
    const float L2E = 1.44269504f;
    const int w0 = sb == 0 ? 0 : (sb == 1 ? 8 : (sb == 2 ? 24 : 32));
    for (int tg0 = blockIdx.x; tg0 < 256; tg0 += gridDim.x) {
        const int tg = (gridDim.x == 256) ? ((tg0 & 7) * 32 + (tg0 >> 3)) : tg0;
        const int bh = tg >> 3, b = bh >> 3, h = bh & 7, rbase = (tg & 7) * 8;
        __syncthreads();
#pragma unroll
        for (int pass = 0; pass < 4; ++pass) { const int n = pass * 64 + vcol;
            *(LAS u32x4*)(Vl + (576 + n) * VST + vch * 16) = *(const u32x4*)(NV + ((size_t)(NTOK + b * CTXL + n)) * HW + h * 64 + vch * 8); }
        for (int i = F.tid; i < 465; i += NTHREADS) rpbl[i] = F.a.in[I_RPB][h * 465 + i];
        { int r0 = rbase - 4; r0 = r0 < 0 ? 0 : (r0 > 56 ? 56 : r0);
#pragma unroll
          for (int k8 = 0; k8 < 8; ++k8) { const int kr = r0 + k8;
              *(LAS u32x4*)(Vl + ((kr % 9) * 64 + vcol) * VST + vch * 16) = *(const u32x4*)(NV + ((size_t)(b * SEQ + kr * 64 + vcol)) * HW + h * 64 + vch * 8); } }
        bf16x8 kfc[8][2];
#pragma unroll
        for (int cb = 0; cb < 8; ++cb) { const bf16* kp = NK + ((size_t)(NTOK + b * CTXL + 128 * half + 16 * cb + q16)) * HW + h * 64 + 8 * rq; kfc[cb][0] = *(const bf16x8*)kp; kfc[cb][1] = *(const bf16x8*)(kp + 32); }
        __syncthreads();
#pragma unroll 1
        for (int ti = 0; ti < 8; ++ti) {
            const int r = rbase + ti; int r0 = r - 4; r0 = r0 < 0 ? 0 : (r0 > 56 ? 56 : r0);
            int r0n = r - 3; r0n = r0n < 0 ? 0 : (r0n > 56 ? 56 : r0n);
            const bool newrow = (ti < 7) && (r0n != r0); const int krn = r0n + 7;
            const int c = 16 * sb + q16; const size_t qrow = (size_t)b * SEQ + r * 64 + c;
            int c0 = c - 8; c0 = c0 < 0 ? 0 : (c0 > 48 ? 48 : c0);
            bf16x8 qf[2], kfl[8][2];
#pragma unroll
            for (int ks = 0; ks < 2; ++ks) qf[ks] = *(const bf16x8*)(NQ + qrow * HW + h * 64 + 8 * rq + 32 * ks);
#pragma unroll
            for (int lb = 0; lb < 8; ++lb) { const int kr = r0 + 4 * half + (lb >> 1), cb = w0 + 16 * (lb & 1);
                const bf16* kp = NK + ((size_t)(b * SEQ + kr * 64 + cb + q16)) * HW + h * 64 + 8 * rq; kfl[lb][0] = *(const bf16x8*)kp; kfl[lb][1] = *(const bf16x8*)(kp + 32); }
            u32x4 vnext = {0u, 0u, 0u, 0u};
            if (newrow) vnext = *(const u32x4*)(NV + ((size_t)(b * SEQ + krn * 64 + vcol)) * HW + h * 64 + vch * 8);
            f32x4 sc[16];
#pragma unroll
            for (int cb = 0; cb < 8; ++cb) { f32x4 a = MFMA16(kfc[cb][0], qf[0], ((f32x4){0.f, 0.f, 0.f, 0.f})); a = MFMA16(kfc[cb][1], qf[1], a); sc[8 + cb] = a; }
#pragma unroll
            for (int lb = 0; lb < 8; ++lb) { const int kr = r0 + 4 * half + (lb >> 1), cb = w0 + 16 * (lb & 1);
                f32x4 a = MFMA16(kfl[lb][0], qf[0], ((f32x4){0.f, 0.f, 0.f, 0.f})); a = MFMA16(kfl[lb][1], qf[1], a);
#pragma unroll
                for (int g = 0; g < 4; ++g) { const int kc = cb + 4 * rq + g; const bool valid = (kc >= c0) && (kc <= c0 + 15);
                    const int bi = valid ? ((kr - r + 7) * 31 + (kc - c + 15)) : 0;
                    a[g] = valid ? a[g] + rpbl[bi] : -1e30f; }
                sc[lb] = a; }
            float m = -1e30f;
#pragma unroll
            for (int i = 0; i < 16; ++i) m = fmaxf(fmaxf(m, fmaxf(sc[i].x, sc[i].y)), fmaxf(sc[i].z, sc[i].w));
            m = fmaxf(m, __shfl_xor(m, 16)); m = fmaxf(m, __shfl_xor(m, 32));
            float l = 0.f;
#pragma unroll
            for (int i = 0; i < 16; ++i) {
#pragma unroll
                for (int g = 0; g < 4; ++g) { const float p = __builtin_amdgcn_exp2f((sc[i][g] - m) * L2E); sc[i][g] = p; l += p; } }
            l += __shfl_xor(l, 16); l += __shfl_xor(l, 32);
            f32x4 o[4];
#pragma unroll
            for (int eb = 0; eb < 4; ++eb) o[eb] = (f32x4){0.f, 0.f, 0.f, 0.f};
#pragma unroll
            for (int ks = 0; ks < 8; ++ks) {
                const bf16x8 pf = pk8(sc[2 * ks], sc[2 * ks + 1]);
                int rowA;
                if (ks < 4) { const int kr = r0 + 4 * half + ks; rowA = (kr % 9) * 64 + w0; }
                else rowA = 576 + 128 * half + 32 * (ks - 4);
                const LAS unsigned char* pa = Vl + (rowA + 4 * rq + tq) * VST + 8 * tp; const LAS unsigned char* pb = pa + 16 * VST;
#pragma unroll
                for (int eb = 0; eb < 4; ++eb) { const bf16x8 vf = cat8(tr_read(pa + 32 * eb), tr_read(pb + 32 * eb)); o[eb] = MFMA16(vf, pf, o[eb]); }
            }
            LAS float* mw = mrg + sb * 1056;
            const bool merger = (half == (ti & 1));
            if (!merger) {
                if (rq == 0) { mw[q16] = m; mw[16 + q16] = l; }
#pragma unroll
                for (int eb = 0; eb < 4; ++eb)
#pragma unroll
                    for (int g = 0; g < 4; ++g) mw[32 + (16 * eb + 4 * rq + g) * 16 + q16] = o[eb][g];
            }
            if (newrow) *(LAS u32x4*)(Vl + ((krn % 9) * 64 + vcol) * VST + vch * 16) = vnext;
            __syncthreads();
            if (merger) {
                const float m2 = mw[q16], l2 = mw[16 + q16];
                const float mn = fmaxf(m, m2), a1 = __builtin_amdgcn_exp2f((m - mn) * L2E), a2 = __builtin_amdgcn_exp2f((m2 - mn) * L2E);
                const float inv = 1.f / (l * a1 + l2 * a2);
#pragma unroll
                for (int eb = 0; eb < 4; ++eb) { f32x4 v;
#pragma unroll
                    for (int g = 0; g < 4; ++g) v[g] = (o[eb][g] * a1 + mw[32 + (16 * eb + 4 * rq + g) * 16 + q16] * a2) * inv;
                    u32x2 w; w.x = pg8::cvt_pk_bf16(v.x, v.y); w.y = pg8::cvt_pk_bf16(v.z, v.w);
                    *(u32x2*)(MIX + qrow * D + 512 + h * 64 + 16 * eb + 4 * rq) = w; }
            }
        }
    }
    __syncthreads();
}

__device__ __forceinline__ void ph_kvstate(Frame& F) {
    const bf16* RK = (const bf16*)(fA(F) + A_RK); const bf16* RV = (const bf16*)(fA(F) + A_RV); float* KV = (float*)(fA(F) + A_KV);
    LAS unsigned char* Kt = F.lds; LAS unsigned char* Vf = F.lds + 128 * VST; LAS unsigned char* Vb = F.lds + 256 * VST;
    const int lane = F.lane, wave = F.wave, rq = lane >> 4, tq = (lane & 15) >> 2, tp = lane & 3, db = wave & 3, ep = wave >> 2;
    for (int it = blockIdx.x; it < NB * NH * 34; it += gridDim.x) {
        const int cc = it % 34, bh = it / 34, b = bh >> 3, h = bh & 7;
        const float lgf = ret_gamma_log(F, 0, h) * 1.44269504f, lgb = ret_gamma_log(F, 1, h) * 1.44269504f;
        const size_t row0 = cc < 32 ? (size_t)b * SEQ + cc * 128 : (size_t)NTOK + b * CTXL + (cc - 32) * 128;
        __syncthreads();
#pragma unroll
        for (int pass = 0; pass < 2; ++pass) { const int j = pass * 64 + (F.tid >> 3), ch = F.tid & 7;
            *(LAS u32x4*)(Kt + j * VST + ch * 16) = *(const u32x4*)(RK + (row0 + j) * HW + h * 64 + ch * 8);
            const u32x4 v = *(const u32x4*)(RV + (row0 + j) * HW + h * 64 + ch * 8);
            const float wf = __builtin_amdgcn_exp2f(lgf * (float)(127 - j)), wb = __builtin_amdgcn_exp2f(lgb * (float)j);
            const unsigned vv[4] = { v.x, v.y, v.z, v.w }; u32x4 of, ob; unsigned rf[4], rb[4];
#pragma unroll
            for (int q = 0; q < 4; ++q) { const float lo = bf2f(vv[q] & 0xffffu), hi = bf2f(vv[q] >> 16); rf[q] = pg8::cvt_pk_bf16(lo * wf, hi * wf); rb[q] = pg8::cvt_pk_bf16(lo * wb, hi * wb); }
            of.x = rf[0]; of.y = rf[1]; of.z = rf[2]; of.w = rf[3]; ob.x = rb[0]; ob.y = rb[1]; ob.z = rb[2]; ob.w = rb[3];
            *(LAS u32x4*)(Vf + j * VST + ch * 16) = of; *(LAS u32x4*)(Vb + j * VST + ch * 16) = ob; }
        __syncthreads();
        f32x4 acc[2][2];
#pragma unroll
        for (int d = 0; d < 2; ++d)
#pragma unroll
            for (int e = 0; e < 2; ++e) acc[d][e] = (f32x4){0.f, 0.f, 0.f, 0.f};
#pragma unroll
        for (int ks = 0; ks < 4; ++ks) {
            const int rbase = 32 * ks + 8 * rq + tq;
            const bf16x8 kf = cat8(tr_read(Kt + rbase * VST + (16 * db + 4 * tp) * 2), tr_read(Kt + (rbase + 4) * VST + (16 * db + 4 * tp) * 2));
#pragma unroll
            for (int e2 = 0; e2 < 2; ++e2) { const int eoff = (16 * (2 * ep + e2) + 4 * tp) * 2;
                const bf16x8 vf = cat8(tr_read(Vf + rbase * VST + eoff), tr_read(Vf + (rbase + 4) * VST + eoff));
                const bf16x8 vb = cat8(tr_read(Vb + rbase * VST + eoff), tr_read(Vb + (rbase + 4) * VST + eoff));
                acc[0][e2] = MFMA16(kf, vf, acc[0][e2]); acc[1][e2] = MFMA16(kf, vb, acc[1][e2]); }
        }
        float* kvp = KV + (size_t)it * 2 * 4096;
#pragma unroll
        for (int d = 0; d < 2; ++d)
#pragma unroll
            for (int e2 = 0; e2 < 2; ++e2) *(f32x4*)(kvp + d * 4096 + (16 * (2 * ep + e2) + (lane & 15)) * 64 + 16 * db + 4 * rq) = acc[d][e2];
    }
    __syncthreads();
}

__device__ __forceinline__ void ph_retout(Frame& F, int mode = 0) {
    const bf16* RK = (const bf16*)(fA(F) + A_RK); const bf16* RV = (const bf16*)(fA(F) + A_RV); const bf16* RQ = (const bf16*)(fA(F) + A_RQ); const bf16* GT = (const bf16*)(fA(F) + A_GT);
    const float* KV = (const float*)(fA(F) + A_KV); bf16* MIX = (bf16*)(fA(F) + A_MIX);
    LAS unsigned char* Vl = F.lds;
    LAS unsigned char* SF = F.lds + 4 * 128 * VST;
    LAS unsigned char* SB = SF + 4 * 64 * VST;
    const int lane = F.lane, wave = F.wave, q16 = lane & 15, rq = lane >> 4, tq = (lane & 15) >> 2, tp = lane & 3;
    for (int g0 = blockIdx.x; g0 < 256; g0 += gridDim.x) {
        const int g = (gridDim.x == 256) ? ((g0 & 7) * 32 + (g0 >> 3)) : g0;
        const int bh = g >> 3, b = bh >> 3, h = bh & 7, c0 = (g & 7) * 4;
        const float lnf = ret_gamma_log(F, 0, h), lnb = ret_gamma_log(F, 1, h);
        const float lgf = lnf * 1.44269504f, lgb = lnb * 1.44269504f;
        const float gf128 = __builtin_amdgcn_exp2f(lgf * 128.f), gb128 = __builtin_amdgcn_exp2f(lgb * 128.f);
        const float* kvb = KV + (size_t)bh * 34 * 2 * 4096 + F.tid * 8;
#define KVP(cc, dir) (kvb + ((size_t)(cc) * 2 + (dir)) * 4096)
        f32x4 sf0 = {0.f, 0.f, 0.f, 0.f}, sf1 = sf0, sb0 = sf0, sb1 = sf0;
#pragma unroll 8
        for (int cp = 0; cp < (mode == 2 ? 0 : 32); ++cp) {
            const bool isf = cp < c0, isb = cp >= c0 + 4;
            const float wf_ = isf ? __builtin_amdgcn_exp2f(lgf * 128.f * (float)(c0 - 1 - cp)) : 0.f, wb_ = isb ? __builtin_amdgcn_exp2f(lgb * 128.f * (float)(cp - c0 - 4)) : 0.f;
            const float* p = KVP(cp, isf ? 0 : 1);
            const f32x4 a0 = *(const f32x4*)p, a1 = *(const f32x4*)(p + 4);
            sf0 = sf0 + a0 * wf_; sf1 = sf1 + a1 * wf_; sb0 = sb0 + a0 * wb_; sb1 = sb1 + a1 * wb_;
        }
        { const f32x4 a0 = *(const f32x4*)KVP(32, 0), a1 = *(const f32x4*)(KVP(32, 0) + 4), b0 = *(const f32x4*)KVP(33, 0), b1 = *(const f32x4*)(KVP(33, 0) + 4);
          const float wc = __builtin_amdgcn_exp2f(lgf * 128.f * (float)c0);
          sf0 = sf0 + (a0 * gf128 + b0) * wc; sf1 = sf1 + (a1 * gf128 + b1) * wc; }
        { const f32x4 a0 = *(const f32x4*)KVP(33, 1), a1 = *(const f32x4*)(KVP(33, 1) + 4), b0 = *(const f32x4*)KVP(32, 1), b1 = *(const f32x4*)(KVP(32, 1) + 4);
          const float wc = __builtin_amdgcn_exp2f(lgb * 128.f * (float)(28 - c0));
          sb0 = sb0 + (a0 * gb128 + b0) * wc; sb1 = sb1 + (a1 * gb128 + b1) * wc; }
        __syncthreads();
        const int se = F.tid >> 3, sd = (F.tid & 7) * 8;
#pragma unroll
        for (int k = 3; k >= 0; --k) {
            *(LAS u32x4*)(SB + k * 64 * VST + se * VST + sd * 2) = __builtin_bit_cast(u32x4, pk8(sb0, sb1));
            if (k > 0) { const f32x4 a0 = *(const f32x4*)KVP(c0 + k, 1), a1 = *(const f32x4*)(KVP(c0 + k, 1) + 4); sb0 = sb0 * gb128 + a0; sb1 = sb1 * gb128 + a1; }
        }
#pragma unroll
        for (int k = 0; k < 4; ++k) {
            *(LAS u32x4*)(SF + k * 64 * VST + se * VST + sd * 2) = __builtin_bit_cast(u32x4, pk8(sf0, sf1));
            if (k < 3) { const f32x4 a0 = *(const f32x4*)KVP(c0 + k, 0), a1 = *(const f32x4*)(KVP(c0 + k, 0) + 4); sf0 = sf0 * gf128 + a0; sf1 = sf1 * gf128 + a1; }
        }
        if (mode != 2)
#pragma unroll
        for (int pass = 0; pass < 8; ++pass) { const int j = pass * 64 + (F.tid >> 3), ch = F.tid & 7;
            *(LAS u32x4*)(Vl + j * VST + ch * 16) = *(const u32x4*)(RV + ((size_t)b * SEQ + c0 * 128 + j) * HW + h * 64 + ch * 8); }
        __syncthreads();
        if (mode == 1) continue;
        const int k = wave >> 1; const size_t row0 = (size_t)b * SEQ + (c0 + k) * 128;
        bf16x8 kf[8][2];
#pragma unroll
        for (int jb = 0; jb < 8; ++jb) { const bf16* kp = RK + (row0 + 16 * jb + q16) * HW + h * 64 + 8 * rq; kf[jb][0] = *(const bf16x8*)kp; kf[jb][1] = *(const bf16x8*)(kp + 32); }
        const LAS unsigned char* Vc = Vl + k * 128 * VST; const LAS unsigned char* SFc = SF + k * 64 * VST; const LAS unsigned char* SBc = SB + k * 64 * VST;
#pragma unroll 1
        for (int qb = 0; qb < 4; ++qb) {
            const int i = 64 * (wave & 1) + 16 * qb + q16; const size_t qrow = row0 + i;
            bf16x8 qf[2];
#pragma unroll
            for (int ks = 0; ks < 2; ++ks) qf[ks] = *(const bf16x8*)(RQ + qrow * HW + h * 64 + 8 * rq + 32 * ks);
            const float qfd = __builtin_amdgcn_exp2f(lgf * (float)(i + 1)), qbd = __builtin_amdgcn_exp2f(lgb * (float)(128 - i));
            f32x4 o[4];
#pragma unroll
            for (int eb = 0; eb < 4; ++eb) {
                f32x4 t1 = {0.f, 0.f, 0.f, 0.f}, t2 = {0.f, 0.f, 0.f, 0.f};
#pragma unroll
                for (int ks = 0; ks < 2; ++ks) {
                    const bf16x8 s1 = *(const LAS bf16x8*)(SFc + (16 * eb + q16) * VST + (8 * rq + 32 * ks) * 2);
                    const bf16x8 s2 = *(const LAS bf16x8*)(SBc + (16 * eb + q16) * VST + (8 * rq + 32 * ks) * 2);
                    t1 = MFMA16(s1, qf[ks], t1); t2 = MFMA16(s2, qf[ks], t2); }
                o[eb] = t1 * qfd + t2 * qbd; }
            __builtin_amdgcn_sched_barrier(0);
            f32x4 sc[8];
#pragma unroll
            for (int jb = 0; jb < 8; ++jb) {
                f32x4 a = MFMA16(kf[jb][0], qf[0], ((f32x4){0.f, 0.f, 0.f, 0.f})); a = MFMA16(kf[jb][1], qf[1], a);
#pragma unroll
                for (int gq = 0; gq < 4; ++gq) { const int j = 16 * jb + 4 * rq + gq;
                    const float wgt = j < i ? __builtin_amdgcn_exp2f(lgf * (float)(i - j)) : (j > i ? __builtin_amdgcn_exp2f(lgb * (float)(j - i)) : 2.f);
                    a[gq] *= wgt; }
                sc[jb] = a; }
            __builtin_amdgcn_sched_barrier(0);
#pragma unroll
            for (int ks = 0; ks < 4; ++ks) {
                const bf16x8 pf = pk8(sc[2 * ks], sc[2 * ks + 1]);
                const LAS unsigned char* pa = Vc + (32 * ks + 4 * rq + tq) * VST + 8 * tp; const LAS unsigned char* pb = pa + 16 * VST;
#pragma unroll
                for (int eb = 0; eb < 4; ++eb) { const bf16x8 vf = cat8(tr_read(pa + 32 * eb), tr_read(pb + 32 * eb)); o[eb] = MFMA16(vf, pf, o[eb]); }
            }
            __builtin_amdgcn_sched_barrier(0);
            u32x2 gt[4];
#pragma unroll
            for (int eb = 0; eb < 4; ++eb) gt[eb] = *(const u32x2*)(GT + qrow * HW + h * 64 + 16 * eb + 4 * rq);
            float ss = 0.f;
#pragma unroll
            for (int eb = 0; eb < 4; ++eb) { ss += (o[eb].x * o[eb].x + o[eb].y * o[eb].y) + (o[eb].z * o[eb].z + o[eb].w * o[eb].w); }
            ss += __shfl_xor(ss, 16); ss += __shfl_xor(ss, 32);
            const float rs = rsqrtf(ss * (1.f / 64.f) + EPS);
#pragma unroll
            for (int eb = 0; eb < 4; ++eb) { const int e0 = 16 * eb + 4 * rq;
                const f32x4 gg = *(const f32x4*)(F.a.in[I_RNG] + e0);
                const f32x4 gv = { bf2f(gt[eb].x & 0xffffu), bf2f(gt[eb].x >> 16), bf2f(gt[eb].y & 0xffffu), bf2f(gt[eb].y >> 16) };
                const f32x4 v = o[eb] * rs * gg * gv;
                u32x2 w; w.x = pg8::cvt_pk_bf16(v.x, v.y); w.y = pg8::cvt_pk_bf16(v.z, v.w);
                if (mode == 0) *(u32x2*)(MIX + qrow * D + h * 64 + e0) = w; else asm volatile("" :: "v"(w.x), "v"(w.y)); }
        }
#undef KVP
    }
    __syncthreads();
}

__device__ __forceinline__ void ph_sgumix(Frame& F, bool dry = false) {
    bf16* U = (bf16*)(fA(F) + A_U); const bf16* V = (const bf16*)(fA(F) + A_V); const bf16* WS = (const bf16*)(F.a.ws + WS_WB + WB_WS);
    constexpr int VS2 = 272;
    LAS unsigned char* Vt = F.lds;
    LAS float* rsl = (LAS float*)(F.lds + 128 * VS2);
    const int lane = F.lane, wave = F.wave, q16 = lane & 15, rq = lane >> 4, tq = (lane & 15) >> 2, tp = lane & 3;
    const int ch4 = wave & 1, iq = wave >> 1;
    constexpr int NIT = NB * 32 * 8 * 3;
    const int ipb = (NIT + (int)gridDim.x - 1) / (int)gridDim.x, it0 = (int)blockIdx.x * ipb, it1 = (it0 + ipb) < NIT ? (it0 + ipb) : NIT;
    const int sj = F.tid >> 4, schn = F.tid & 15;
    u32x4 vn[4];
    if (it0 < it1) { const int third = it0 % 3, g = (it0 / 3) & 7, bc = it0 / 24; const size_t row0 = (size_t)bc * 128; const int cg0 = g * 384 + third * 128;
#pragma unroll
        for (int pass = 0; pass < 4; ++pass) vn[pass] = *(const u32x4*)(V + (row0 + pass * 32 + sj) * SGW + cg0 + schn * 8); }
    int prev_bc = -1, prev_g = -1;
    bf16x8 wf[4][2];
    for (int it = it0; it < it1; ++it) {
        const int third = it % 3, g = (it / 3) & 7, bc = it / 24; const size_t row0 = (size_t)bc * 128; const int cg0 = g * 384 + third * 128;
        if (g != prev_g) { prev_g = g;
#pragma unroll
            for (int ks = 0; ks < 4; ++ks)
#pragma unroll
                for (int ib = 0; ib < 2; ++ib) wf[ks][ib] = *(const bf16x8*)(WS + ((size_t)g * 128 + 32 * iq + 16 * ib + q16) * 128 + 32 * ks + 8 * rq); }
        __syncthreads();
        if (bc != prev_bc) { prev_bc = bc;
            if (F.tid < 128) { const float* vp = fvss(F) + (row0 + F.tid) * 48; float sacc = 0.f;
#pragma unroll
                for (int j = 0; j < 48; j += 4) { const f32x4 t = *(const f32x4*)(vp + j); sacc += (t.x + t.y) + (t.z + t.w); }
                rsl[F.tid] = rsqrtf(sacc * (1.f / SGW) + EPS); }
            __syncthreads(); }
#pragma unroll
        for (int pass = 0; pass < 4; ++pass) { const int j = pass * 32 + sj; const float rs = rsl[j];
            const unsigned vv[4] = { vn[pass].x, vn[pass].y, vn[pass].z, vn[pass].w }; unsigned ro[4];
#pragma unroll
            for (int q = 0; q < 4; ++q) ro[q] = pg8::cvt_pk_bf16(bf2f(vv[q] & 0xffffu) * rs, bf2f(vv[q] >> 16) * rs);
            u32x4 o; o.x = ro[0]; o.y = ro[1]; o.z = ro[2]; o.w = ro[3];
            *(LAS u32x4*)(Vt + j * VS2 + schn * 16) = o; }
        __syncthreads();
        if (it + 1 < it1) { const int n = it + 1, t2 = n % 3, g2 = (n / 3) & 7, bc2 = n / 24; const size_t r2 = (size_t)bc2 * 128; const int c2 = g2 * 384 + t2 * 128;
#pragma unroll
            for (int pass = 0; pass < 4; ++pass) vn[pass] = *(const u32x4*)(V + (r2 + pass * 32 + sj) * SGW + c2 + schn * 8); }
        u32x4 uu[2][2];
#pragma unroll
        for (int ib = 0; ib < 2; ++ib)
#pragma unroll
            for (int cb2 = 0; cb2 < 2; ++cb2) uu[ib][cb2] = *(const u32x4*)(U + (row0 + 32 * iq + 16 * ib + q16) * SGW + cg0 + 64 * ch4 + 32 * cb2 + 8 * rq);
        f32x4 ngv[2][2]; float bsv[2];
#pragma unroll
        for (int cb2 = 0; cb2 < 2; ++cb2) { const int cgl = cg0 + 64 * ch4 + 32 * cb2 + 8 * rq; ngv[cb2][0] = *(const f32x4*)(F.a.in[I_SNG] + cgl); ngv[cb2][1] = *(const f32x4*)(F.a.in[I_SNG] + cgl + 4); }
#pragma unroll
        for (int ib = 0; ib < 2; ++ib) bsv[ib] = F.a.in[I_SBS][g * 128 + 32 * iq + 16 * ib + q16];
        f32x4 acc[4][2];
#pragma unroll
        for (int cb = 0; cb < 4; ++cb)
#pragma unroll
            for (int ib = 0; ib < 2; ++ib) acc[cb][ib] = (f32x4){0.f, 0.f, 0.f, 0.f};
#pragma unroll
        for (int ks = 0; ks < 4; ++ks) {
            const int rb = 32 * ks + 8 * rq + tq;
#pragma unroll
            for (int cb = 0; cb < 4; ++cb) { const int coff = (64 * ch4 + 32 * (cb >> 1) + 8 * tp + 4 * (cb & 1)) * 2;
                const bf16x8 vf = cat8(tr_read(Vt + rb * VS2 + coff), tr_read(Vt + (rb + 4) * VS2 + coff));
#pragma unroll
                for (int ib = 0; ib < 2; ++ib) acc[cb][ib] = MFMA16(vf, wf[ks][ib], acc[cb][ib]); }
        }
#pragma unroll
        for (int ib = 0; ib < 2; ++ib) { const int i = 32 * iq + 16 * ib + q16; const float bs = bsv[ib];
#pragma unroll
            for (int cb2 = 0; cb2 < 2; ++cb2) { const int cgl = cg0 + 64 * ch4 + 32 * cb2 + 8 * rq;
                const f32x4 ng0 = ngv[cb2][0], ng1 = ngv[cb2][1]; bf16* up = U + (row0 + i) * SGW + cgl; const u32x4 u4 = uu[ib][cb2];
                const f32x4 uv0 = { bf2f(u4.x & 0xffffu), bf2f(u4.x >> 16), bf2f(u4.y & 0xffffu), bf2f(u4.y >> 16) }, uv1 = { bf2f(u4.z & 0xffffu), bf2f(u4.z >> 16), bf2f(u4.w & 0xffffu), bf2f(u4.w >> 16) };
                const f32x4 r0 = dry ? uv0 + acc[2 * cb2][ib] * 0.f : uv0 * (acc[2 * cb2][ib] * ng0 + bs), r1 = dry ? uv1 + acc[2 * cb2 + 1][ib] * 0.f : uv1 * (acc[2 * cb2 + 1][ib] * ng1 + bs);
                u32x4 w; w.x = pg8::cvt_pk_bf16(r0.x, r0.y); w.y = pg8::cvt_pk_bf16(r0.z, r0.w); w.z = pg8::cvt_pk_bf16(r1.x, r1.y); w.w = pg8::cvt_pk_bf16(r1.z, r1.w); *(u32x4*)up = w; } }
    }
    __syncthreads();
}

__device__ __forceinline__ void ph_mod2(Frame& F) {
    LAS float* sv = (LAS float*)F.lds; LAS float* red = sv + 5 * 1024;
    for (int i = F.tid; i < 5 * 1024; i += NTHREADS) { const int r = i >> 10, k = i & 1023; const float c = r < 4 ? F.a.in[I_C][r * 1024 + k] : F.a.in[I_CCTX][k]; sv[i] = siluf(c); }
    __syncthreads();
    for (int item = blockIdx.x; item < 192; item += gridDim.x) {
        const int l = item / 96, n0 = (item % 96) * 64, k0 = F.wave * 128;
        const float* W = F.a.in[I_ADAW] + (size_t)l * D * 6144 + n0 + F.lane + (size_t)k0 * 6144;
        float a0 = 0.f, a1 = 0.f, a2 = 0.f, a3 = 0.f, a4 = 0.f;
#pragma unroll 16
        for (int k = 0; k < 128; ++k) { const float w = W[(size_t)k * 6144];
            a0 += sv[k0 + k] * w; a1 += sv[1024 + k0 + k] * w; a2 += sv[2048 + k0 + k] * w; a3 += sv[3072 + k0 + k] * w; a4 += sv[4096 + k0 + k] * w; }
        red[(F.wave * 5 + 0) * 64 + F.lane] = a0; red[(F.wave * 5 + 1) * 64 + F.lane] = a1; red[(F.wave * 5 + 2) * 64 + F.lane] = a2; red[(F.wave * 5 + 3) * 64 + F.lane] = a3; red[(F.wave * 5 + 4) * 64 + F.lane] = a4;
        __syncthreads();
        if (F.wave < 5) { const int r = F.wave; float sacc = 0.f;
#pragma unroll
            for (int w = 0; w < 8; ++w) sacc += red[(w * 5 + r) * 64 + F.lane];
            sacc += F.a.in[I_ADAB][l * 6144 + n0 + F.lane];
            if (r < 4) fmod(F)[(l * 4 + r) * 6144 + n0 + F.lane] = sacc; else if (l == 0 && n0 < 2048) fmodc(F)[n0 + F.lane] = sacc; }
        __syncthreads();
    }
    const int gt = F.gw * 64 + F.lane, ngt = F.ngw * 64;
    for (int it = gt; it < 64 * 16; it += ngt) {
        const int pos = it >> 4, j = it & 15;
        const float inv = powf(10000.0f, -(float)j / 16.0f);
        const float ang = (float)pos * inv;
        frope(F)[it * 2] = cosf(ang); frope(F)[it * 2 + 1] = sinf(ang);
    }
}
__device__ __forceinline__ void late_convert(Frame& F, int units, int pct_lo, int pct_hi, int set = 1) {
    const int G = (int)gridDim.x, rounds = (units + G - 1) / G, rem = units - (rounds - 1) * G;
    const int first = rem >= G ? 0 : rem, nidle = G - first;
    __syncthreads();
    if ((int)blockIdx.x >= first) ph_convert(F, set, ((int)blockIdx.x - first) * NWAVES + F.wave, nidle * NWAVES, pct_lo, pct_hi);
    __syncthreads();
}
__device__ __forceinline__ void ph_inproj(Frame& F) {
    const DenseSched S{(const char*)fH(F), (const char*)(F.a.ws + WS_WB + WB_WIN), D, 64, 14, (int)gridDim.x, (int)blockIdx.x, 64 * 14, 64, 8, 32};
    LAS float* ropel = (LAS float*)(F.lds + ROPE_OFF);
    for (int i = F.tid; i < 2048; i += NTHREADS) ropel[i] = frope(F)[i];
    __syncthreads();
    const EpiInproj E{fA(F), ropel, F.a.in[I_KG], F.a.in[I_QG]};
    pg8::gemm_phase<DenseSched, EpiInproj, true>(F.lds, D, S, E, F.wave);
    late_convert(F, 64 * 14 + 32, EARLY_PCT, 100, 0);
}
__device__ __forceinline__ void ph_outproj(Frame& F) {
    const DenseSched S{(const char*)(fA(F) + A_MIX), (const char*)(F.a.ws + WS_WB + WB_WOUT), D, 64, 4, (int)gridDim.x, (int)blockIdx.x, 64 * 4, 0, 1, 0};
    const EpiRes<false> E{F.a.in[I_X], (bf16*)(fA(F) + A_X1), fmod(F) + 2 * D, fvss(F)};
    pg8::gemm_phase<DenseSched, EpiRes<false>, false>(F.lds, D, S, E, F.wave);
}
__device__ __forceinline__ void ph_sguin(Frame& F) {
#if STAGGER_US
    if (blockIdx.x & 1) { const unsigned long long t0 = __builtin_amdgcn_s_memrealtime(); while (__builtin_amdgcn_s_memrealtime() - t0 < (unsigned long long)(STAGGER_US * 100)) __builtin_amdgcn_s_sleep(32); }
#endif
    const DenseSched S{(const char*)fH(F), (const char*)(F.a.ws + WS_WB + WB_SWIN), D, 64, 24, (int)gridDim.x, (int)blockIdx.x, 64 * 24, 0, 1, 0};
    const EpiSguIn E{(bf16*)(fA(F) + A_U), (bf16*)(fA(F) + A_V), F.a.in[I_SBIN], fvss(F)};
    pg8::gemm_phase<DenseSched, EpiSguIn, true>(F.lds, D, S, E, F.wave);
}
__device__ __forceinline__ void ph_sguout(Frame& F) {
    const DenseSched S{(const char*)(fA(F) + A_U), (const char*)(F.a.ws + WS_WB + WB_SWOUT), SGW, 64, 4, (int)gridDim.x, (int)blockIdx.x, 64 * 4, 0, 1, 0};
    const EpiRes<true> E{F.a.out, (bf16*)(fA(F) + A_X3), fmod(F) + 4 * 6144 + 2 * D, fvss(F)};
    pg8::gemm_phase<DenseSched, EpiRes<true>, false>(F.lds, SGW, S, E, F.wave);
}

__device__ __forceinline__ void ph_moe_gu(Frame& F, int l) {
    LAS int* tab = (LAS int*)(F.lds + TAB_OFF);
    const int tiles = moe_tab(F, l, tab);
    const MoeSched S{(const char*)fH(F), (const char*)(F.a.ws + WS_WB + WB_GU) + (size_t)l * NE * 1024 * D * 2, D, (int)gridDim.x, (int)blockIdx.x, tiles * 4, tab, flist(F), 1};
    const EpiMoeGU E{(bf16*)(fA(F) + A_ACT)};
    pg8::gemm_phase<MoeSched, EpiMoeGU, true>(F.lds, D, S, E, F.wave);
    if (l == 0) late_convert(F, tiles * 4, 0, 58);
}
__device__ __forceinline__ void ph_moe_dn(Frame& F, int l) {
    LAS int* tab = (LAS int*)(F.lds + TAB_OFF);
    const int tiles = moe_tab(F, l, tab);
    const MoeSched S{(const char*)(fA(F) + A_ACT), (const char*)(F.a.ws + WS_WB + WB_DN) + (size_t)l * NE * D * EW * 2, EW, (int)gridDim.x, (int)blockIdx.x, tiles * 4, tab, flist(F), 0};
    const EpiMoeDn E{(bf16*)(fA(F) + A_Y), flist(F), fwt(F)};
    pg8::gemm_phase<MoeSched, EpiMoeDn, true>(F.lds, EW, S, E, F.wave);
    if (l == 0) late_convert(F, tiles * 4, 58, 100);
}

constexpr int NPHASE = 18;
__global__ void __launch_bounds__(NTHREADS, 2) fwd_kernel(Args args) {
    extern __shared__ __attribute__((aligned(16))) unsigned char lds[];
    const int wave_ = __builtin_amdgcn_readfirstlane((int)threadIdx.x >> 6);
#define MKF() const int lane__ = lane_id_v(); Frame F{(LAS unsigned char*)lds, wave_ * 64 + lane__, lane__, wave_, (int)blockIdx.x * NWAVES + wave_, (int)gridDim.x * NWAVES, args}
    { MKF(); for (int u = F.tid; u < (LDS_BYTES - LDSCTL_OFF) / 4; u += NTHREADS) ((LAS unsigned*)(F.lds + LDSCTL_OFF))[u] = 0u; }
    volatile LAS unsigned* MISC = (volatile LAS unsigned*)((LAS unsigned char*)lds + MISC_OFF);
    __syncthreads();
    unsigned* const ctl_ = (unsigned*)(args.ws + WS_CTL);
    XcdBarrier bar; bar.bar = ctl_ + CW_BAR; bar.x = 0; bar.st = nullptr; bar.wave = wave_;
    if (MK_ONE_LAUNCH) { bar = xcd_barrier_post(ctl_ + CW_BAR, MISC + 8); bar.wave = wave_; }
    const int lo = args.ph_lo, hi = args.ph_hi;
    unsigned long long* TSP = (unsigned long long*)(args.ws + WS_MOD + 512 * 1024);
#define IN(k) (lo <= (k) && (k) < hi)
#define REP(k) for (int _r##k = 0, _r = 0; _r##k < ((k) == REP_PHASE ? REP_N : 1); ++_r##k, _r = _r##k)
#ifdef ONLY_PHASE
#define PHON(k) ((k) == ONLY_PHASE)
#else
#define PHON(k) true
#endif
#define STAMP(k) do { if (TPROBE_A >= 0 && blockIdx.x == 0 && wave_ == 0 && lane_id_v() == 0) TSP[k] = __builtin_amdgcn_s_memrealtime(); } while (0)
#define SEAM(k) do { if (IN(k) && IN((k) + 1)) { xcd_barrier(bar); STAMP((k) + 1); } } while (0)
    STAMP(0);
    if (PHON(0) && IN(0)) REP(0) { MKF(); ph_mod2(F); __syncthreads(); ph_convert(F, 0, F.gw, F.ngw, 0, EARLY_PCT); __syncthreads(); } SEAM(0);
    if (PHON(1) && IN(1)) REP(1) { MKF(); ph_norm0(F); } SEAM(1);
    if (PHON(2) && IN(2)) REP(2) { MKF(); if (NV_INPROJ) ph_inproj_naive(F); else ph_inproj(F); } SEAM(2);
    if (PHON(3) && IN(3)) REP(3) { MKF(); REP(30) { if (NV_RET) ph_scan_naive(F); else ph_kvstate(F); } REP(31) { if (NV_NA) ph_na_naive(F); else ph_na(F); } } SEAM(3);
    if (PHON(4) && IN(4)) REP(4) { MKF(); if (NV_RET) ph_retout_naive(F); else ph_retout(F, _r > 0 ? RET_MODE : 0); } SEAM(4);
    if (PHON(5) && IN(5)) REP(5) { MKF(); if (NV_OUTPROJ) ph_gemm_res_naive(F, (const bf16*)(fA(F) + A_MIX), D, D, F.a.in[I_WOUT], F.a.in[I_X], fmod(F) + 2 * D); else ph_outproj(F); } SEAM(5);
    if (PHON(6) && IN(6)) REP(6) { MKF(); ph_route(F, 0, _r > 0); } SEAM(6);
    if (PHON(7) && IN(7)) REP(7) { MKF(); if (NV_MOEGU) ph_moe_gu_naive(F, 0); else ph_moe_gu(F, 0); } SEAM(7);
    if (PHON(8) && IN(8)) REP(8) { MKF(); if (NV_MOEDN) ph_moe_dn_naive(F, 0); else ph_moe_dn(F, 0); } SEAM(8);
    if (PHON(9) && IN(9)) REP(9) { MKF(); ph_combine(F, 0, true, _r > 0); } SEAM(9);
    if (PHON(10) && IN(10)) REP(10) { MKF(); if (NV_SGUIN) ph_sguin_naive(F); else ph_sguin(F); } SEAM(10);
    if (PHON(11) && IN(11)) REP(11) { MKF(); if (NV_SGUMIX) ph_sgumix_naive(F); else ph_sgumix(F, _r > 0); } SEAM(11);
    if (PHON(12) && IN(12)) REP(12) { MKF(); if (NV_SGUOUT) ph_gemm_res_naive(F, (const bf16*)(fA(F) + A_U), SGW, SGW, F.a.in[I_SWOUT], F.a.out, fmod(F) + 4 * 6144 + 2 * D); else ph_sguout(F); } SEAM(12);
    if (PHON(13) && IN(13)) REP(13) { MKF(); ph_route(F, 1, _r > 0); } SEAM(13);
    if (PHON(14) && IN(14)) REP(14) { MKF(); if (NV_MOEGU) ph_moe_gu_naive(F, 1); else ph_moe_gu(F, 1); } SEAM(14);
    if (PHON(15) && IN(15)) REP(15) { MKF(); if (NV_MOEDN) ph_moe_dn_naive(F, 1); else ph_moe_dn(F, 1); } SEAM(15);
    if (PHON(16) && IN(16)) REP(16) { MKF(); ph_combine(F, 1, false, _r > 0); }
    for (int xb = 0; xb < XBAR; ++xb) xcd_barrier(bar);
    if (TPROBE_A >= 0) {
        xcd_barrier(bar); STAMP(17); xcd_barrier(bar);
        const float usA = (float)(TSP[TPROBE_B + 1] - TSP[TPROBE_A]) * 0.01f, usB = (float)(TSP[TPROBE_B + 1] - TSP[TPROBE_B]) * 0.01f;
        const float sc_ = 1.f + 0.02f * floorf((usA + TPROBE_OFF) * (1.f / TPROBE_DIV));
        MKF();
        for (size_t i = (size_t)blockIdx.x * NTHREADS + F.tid; i < (size_t)NTOK * D / 4; i += (size_t)gridDim.x * NTHREADS) { f32x4 v = ((f32x4*)F.a.out)[i]; v = v * sc_; (void)usB; ((f32x4*)F.a.out)[i] = v; }
    }
#undef IN
#undef SEAM
}

extern "C" void kernel_launch(void* const* d_in, const int* in_sizes, int n_in, void* d_out, int out_size, void* d_ws, size_t ws_size, hipStream_t stream) {
    static int grid = 0;
    if (grid == 0) {
        if (n_in != 26 || out_size != NTOK * D || ws_size < WS_END) { fprintf(stderr, "kernel_launch: unexpected shapes n_in %d out %d ws %zu (need %zu)\n", n_in, out_size, ws_size, (size_t)WS_END); grid = -1; return; }
        int dev = 0, cus = 0, per_cu = 0;
        hipGetDevice(&dev); hipDeviceGetAttribute(&cus, hipDeviceAttributeMultiprocessorCount, dev);
        hipFuncSetAttribute((const void*)fwd_kernel, hipFuncAttributeMaxDynamicSharedMemorySize, LDS_BYTES);
        hipOccupancyMaxActiveBlocksPerMultiprocessor(&per_cu, (const void*)fwd_kernel, NTHREADS, LDS_BYTES);
        (void)hipGetLastError();
        if (per_cu < 1) { fprintf(stderr, "kernel_launch: occupancy query says %d blocks/CU\n", per_cu); per_cu = 1; }
        grid = cus;
    }
    if (grid < 0) return;
    hipMemsetAsync((char*)d_ws + WS_CTL, 0, CTL_ZERO_BYTES, stream);
    Args a{};
    for (int i = 0; i < 26; ++i) a.in[i] = (const float*)d_in[i];
    a.out = (float*)d_out; a.ws = (unsigned char*)d_ws;
#if MK_ONE_LAUNCH
    a.ph_lo = 0; a.ph_hi = 17; a.li = 0;
    void* kargs[] = { &a };
    hipError_t e = hipLaunchCooperativeKernel((const void*)fwd_kernel, dim3(grid), dim3(NTHREADS), kargs, LDS_BYTES, stream);
    if (e != hipSuccess) fprintf(stderr, "cooperative launch failed: %s\n", hipGetErrorString(e));
#else
    for (int p = 0; p < 17; ++p) { a.ph_lo = p; a.ph_hi = p + 1; a.li = p; hipLaunchKernelGGL(fwd_kernel, dim3(grid), dim3(NTHREADS), LDS_BYTES, stream, a); }
#endif
}
```

```cpp
#include <hip/hip_runtime.h>
#include <cstdio>
#include <cstdint>

#ifndef NV_INPROJ
#define NV_INPROJ 0
#endif
#ifndef NV_OUTPROJ
#define NV_OUTPROJ 0
#endif
#ifndef NV_MOEGU
#define NV_MOEGU 0
#endif
#ifndef NV_MOEDN
#define NV_MOEDN 0
#endif
#ifndef NV_SGUIN
#define NV_SGUIN 0
#endif
#ifndef NV_SGUOUT
#define NV_SGUOUT 0
#endif
#ifndef NV_NA
#define NV_NA 0
#endif
#ifndef NV_RET
#define NV_RET 0
#endif
#ifndef NV_SGUMIX
#define NV_SGUMIX 0
#endif
#ifndef REP_PHASE
#define REP_PHASE -1
#endif
#ifndef REP_N
#define REP_N 2
#endif
#ifndef XBAR
#define XBAR 0
#endif
#ifndef GREP_PHASE
#define GREP_PHASE -1
#endif
#define GREP(k) ((k) == GREP_PHASE ? 2 : 1)
#ifndef RET_MODE
#define RET_MODE 0
#endif
#ifndef P0_PCT
#define P0_PCT 16
#endif
#ifndef EARLY_PCT
#define EARLY_PCT 54
#endif
#ifndef STAGGER_US
#define STAGGER_US 0
#endif
#ifndef TPROBE_A
#define TPROBE_A -1
#endif
#ifndef TPROBE_DIV
#define TPROBE_DIV 16.f
#endif
#ifndef TPROBE_OFF
#define TPROBE_OFF 0.f
#endif
#ifndef TPROBE_B
#define TPROBE_B TPROBE_A
#endif
#ifndef MK_ONE_LAUNCH
#define MK_ONE_LAUNCH 1
#endif

constexpr int D = 1024, NB = 4, SEQ = 4096, NTOK = NB * SEQ, CTXL = 256, NCTX = NB * CTXL, NROW = NTOK + NCTX;
constexpr int HD = 64, NH = 8, HW = NH * HD;
constexpr int ABW = 3584;
constexpr int SGW = 3072;
constexpr int NE = 16, EW = 512;
constexpr float EPS = 1e-6f;
constexpr int NWAVES = 8, NTHREADS = 512;

constexpr size_t MiB = 1u << 20;
constexpr size_t WS_CTL = 0, CTL_ZERO_BYTES = 1 * MiB;
constexpr size_t WS_MOD = 1 * MiB;
constexpr size_t WS_ROUTE = 2 * MiB;
constexpr size_t WS_VSS = 4 * MiB;
constexpr size_t WS_WB = 8 * MiB;
constexpr size_t WS_H = 132 * MiB;
constexpr size_t WS_A = 166 * MiB;
constexpr size_t WS_END = 358 * MiB;
constexpr size_t A_RK = 0, A_RV = 17 * MiB, A_NK = 34 * MiB, A_NV = 51 * MiB, A_RQ = 68 * MiB, A_GT = 84 * MiB, A_NQ = 100 * MiB, A_MIX = 116 * MiB, A_SST = 148 * MiB;
constexpr size_t A_ACT = 32 * MiB, A_Y = 68 * MiB;
constexpr size_t A_X1 = 0, A_X3 = 132 * MiB;
constexpr size_t A_U = 0, A_V = 96 * MiB;

constexpr int CW_BAR = 4096;
constexpr int CW_CNT = 8192;

typedef unsigned short bf16;
typedef unsigned u32x4 __attribute__((ext_vector_type(4)));
typedef float f32x4 __attribute__((ext_vector_type(4)));
typedef unsigned u32x2 __attribute__((ext_vector_type(2)));
#define LAS __attribute__((address_space(3)))
#define RLX_AGENT __ATOMIC_RELAXED, __HIP_MEMORY_SCOPE_AGENT

__device__ __forceinline__ unsigned f2bf(float f) { unsigned u = __builtin_bit_cast(unsigned, f); return (u + 0x7fffu + ((u >> 16) & 1u)) >> 16; }
__device__ __forceinline__ float bf2f(unsigned h) { return __builtin_bit_cast(float, h << 16); }
__device__ __forceinline__ unsigned pk2(float lo, float hi) { return f2bf(lo) | (f2bf(hi) << 16); }
__device__ __forceinline__ float siluf(float v) { return v / (1.f + __expf(-v)); }
__device__ __forceinline__ float gelu_tanh(float v) { const float u = 0.7978845608028654f * (v + 0.044715f * v * v * v); return 0.5f * v * (1.f + tanhf(u)); }
__device__ __forceinline__ float wave_sum(float v) {
#pragma unroll
    for (int o = 1; o < 64; o <<= 1) v += __shfl_xor(v, o);
    return v;
}


__device__ __forceinline__ int lane_id_v() { int l; asm volatile("v_mbcnt_lo_u32_b32 %0, -1, 0\n\tv_mbcnt_hi_u32_b32 %0, -1, %0" : "=v"(l)); return l; }
#define XB_TMO      128
#define XB_XCNT(j)  (256  + 64 * (j))
#define XB_XSUB(j)  (1280 + 64 * (j))
#define XB_XGEN(j)  (2304 + 64 * (j))
#define XB_TOP      3328
#define XB_TOPGEN   3392
#define XCD_BAR_WORDS 3456
#define XB_SPIN_CAP (1u << 18)
__device__ __forceinline__ unsigned xb_ld(unsigned* p)              { return __hip_atomic_load(p, __ATOMIC_RELAXED, __HIP_MEMORY_SCOPE_AGENT); }
__device__ __forceinline__ unsigned xb_add(unsigned* p, unsigned v) { return __hip_atomic_fetch_add(p, v, __ATOMIC_RELAXED, __HIP_MEMORY_SCOPE_AGENT); }
__device__ __forceinline__ unsigned xb_xcc_id() { return (unsigned)__builtin_amdgcn_s_getreg((3 << 11) | 20) & 0xFu; }
#define XB_SPIN(cond, bar) do { unsigned _sp = 0; while (cond) { __builtin_amdgcn_s_sleep(1); \
    if ((++_sp & 255u) == 0u) { if (xb_ld(&(bar)[XB_TMO])) break; if (_sp > XB_SPIN_CAP) { atomicAdd(&(bar)[XB_TMO], 1u); break; } } } } while (0)
struct XcdBarrier { unsigned* bar; unsigned x; volatile LAS unsigned* st; int wave; };
__device__ __forceinline__ XcdBarrier xcd_barrier_post(unsigned* bar, volatile LAS unsigned* st) {
    XcdBarrier b; b.bar = bar; b.x = xb_xcc_id(); b.st = st;
    if (threadIdx.x == 0) (void)xb_add(&bar[XB_XCNT(b.x)], 1u);
    return b;
}
__device__ __forceinline__ void xcd_barrier_complete(unsigned* bar, unsigned x, unsigned& nloc, unsigned& nx) {
    const unsigned G = gridDim.x * gridDim.y * gridDim.z;
    unsigned sum, cnt, mine, sp = 0u;
    for (;;) {
        sum = 0u; cnt = 0u; mine = 0u;
#pragma unroll
        for (unsigned j = 0; j < 16; ++j) { const unsigned c = xb_ld(&bar[XB_XCNT(j)]); sum += c; cnt += (c > 0u) ? 1u : 0u; mine = (j == x) ? c : mine; }
        if (sum == G) break;
        __builtin_amdgcn_s_sleep(1);
        if ((++sp & 255u) == 0u) { if (xb_ld(&bar[XB_TMO])) break; if (sp > XB_SPIN_CAP) { atomicAdd(&bar[XB_TMO], 1u); break; } }
    }
    nloc = mine > 0u ? mine : 1u; nx = cnt > 0u ? cnt : 1u;
}
__device__ __forceinline__ void xcd_barrier(const XcdBarrier& b) {
    asm volatile("s_waitcnt vmcnt(0)" ::: "memory");
    __syncthreads();
    if (b.wave == 0 && lane_id_v() == 0) {
        unsigned* bar = b.bar;
        __builtin_amdgcn_s_waitcnt(0);
        unsigned nloc = b.st[0], nx = b.st[1];
        if (nloc == 0u) { xcd_barrier_complete(bar, b.x, nloc, nx); b.st[0] = nloc; b.st[1] = nx; }
        const unsigned old = xb_add(&bar[XB_XSUB(b.x)], 1u);
        const unsigned gen = old / nloc;
        if (old + 1u == (gen + 1u) * nloc) {
            __builtin_amdgcn_fence(__ATOMIC_RELEASE, "agent");
            asm volatile("s_waitcnt vmcnt(0)" ::: "memory");
            const unsigned og = xb_add(&bar[XB_TOP], 1u);
            const unsigned tg = og / nx;
            if (og + 1u == (tg + 1u) * nx) xb_add(&bar[XB_TOPGEN], 1u);
            else XB_SPIN(xb_ld(&bar[XB_TOPGEN]) == tg, bar);
            __builtin_amdgcn_fence(__ATOMIC_ACQUIRE, "agent");
            xb_add(&bar[XB_XGEN(b.x)], 1u);
            asm volatile("s_waitcnt vmcnt(0)" ::: "memory");
        } else {
            XB_SPIN(xb_ld(&bar[XB_XGEN(b.x)]) == gen, bar);
            __builtin_amdgcn_fence(__ATOMIC_ACQUIRE, "agent");
            asm volatile("s_waitcnt vmcnt(0)" ::: "memory");
        }
    }
    __syncthreads();
}

constexpr int LDS_BYTES = 163840;
constexpr int LDSCTL_OFF = 147456, MISC_OFF = LDSCTL_OFF + 320, TAB_OFF = LDSCTL_OFF + 1024, ROPE_OFF = LDSCTL_OFF + 2048;

struct Args { const float* in[26]; float* out; unsigned char* ws; int ph_lo, ph_hi, li, pad; };

struct Frame {
    LAS unsigned char* lds;
    int tid, lane, wave, gw, ngw;
    const Args& a;
};
__device__ __forceinline__ unsigned* fctl(const Frame& F) { return (unsigned*)(F.a.ws + WS_CTL); }
__device__ __forceinline__ float* fmod(const Frame& F) { return (float*)(F.a.ws + WS_MOD); }
__device__ __forceinline__ float* fmodc(const Frame& F) { return (float*)(F.a.ws + WS_MOD) + 2 * 4 * 6144; }
__device__ __forceinline__ float* frope(const Frame& F) { return (float*)(F.a.ws + WS_MOD) + 2 * 4 * 6144 + 2048; }
__device__ __forceinline__ int* flist(const Frame& F) { return (int*)(F.a.ws + WS_ROUTE); }
__device__ __forceinline__ float* fwt(const Frame& F) { return (float*)(F.a.ws + WS_ROUTE + 1 * MiB); }
__device__ __forceinline__ float* fvss(const Frame& F) { return (float*)(F.a.ws + WS_VSS); }
__device__ __forceinline__ bf16* fH(const Frame& F) { return (bf16*)(F.a.ws + WS_H); }
__device__ __forceinline__ unsigned char* fA(const Frame& F) { return F.a.ws + WS_A; }
enum { I_X = 0, I_C, I_CTX, I_CCTX, I_ADAW, I_ADAB, I_NMG, I_NFG, I_RW, I_RB, I_WG, I_WU, I_WD, I_WIN, I_WOUT, I_RDEC, I_RNG, I_QG, I_KG, I_RPB, I_SWIN, I_SBIN, I_SNG, I_SWS, I_SBS, I_SWOUT };

template <int NC> __device__ __forceinline__ void naive_dot(const bf16* arow, const float* W, int ldw, int K, float (&acc)[NC]) {
#pragma unroll 1
    for (int k = 0; k < K; k += 2) {
        const unsigned a2 = *(const unsigned*)(arow + k);
        const float a0 = bf2f(a2 & 0xffffu), a1 = bf2f(a2 >> 16);
        const float* w = W + (size_t)k * ldw;
#pragma unroll
        for (int j = 0; j < NC; ++j) acc[j] = __builtin_fmaf(a0, w[j], acc[j]);
        asm volatile("" ::: "memory");
        w += ldw;
#pragma unroll
        for (int j = 0; j < NC; ++j) acc[j] = __builtin_fmaf(a1, w[j], acc[j]);
        asm volatile("" ::: "memory");
    }
}
template <int NC> __device__ __forceinline__ void store_row_bf16(bf16* dst, const float (&v)[NC]) {
#pragma unroll
    for (int j = 0; j < NC; j += 8) { u32x4 w; w.x = pk2(v[j], v[j + 1]); w.y = pk2(v[j + 2], v[j + 3]); w.z = pk2(v[j + 4], v[j + 5]); w.w = pk2(v[j + 6], v[j + 7]); *(u32x4*)(dst + j) = w; }
}

__device__ __forceinline__ void ph_mod(Frame& F) {
    const int gt = F.gw * 64 + F.lane, ngt = F.ngw * 64;
    for (int it = gt; it < 2 * 6144; it += ngt) {
        const int l = it / 6144, n = it % 6144;
        const float* W = F.a.in[I_ADAW] + (size_t)l * D * 6144 + n;
        float a0 = 0.f, a1 = 0.f, a2 = 0.f, a3 = 0.f, a4 = 0.f;
        const float* c = F.a.in[I_C]; const float* cc = F.a.in[I_CCTX];
        for (int k = 0; k < D; ++k) { const float w = W[(size_t)k * 6144];
            a0 += siluf(c[k]) * w; a1 += siluf(c[D + k]) * w; a2 += siluf(c[2 * D + k]) * w; a3 += siluf(c[3 * D + k]) * w; a4 += siluf(cc[k]) * w; }
        const float bb = F.a.in[I_ADAB][l * 6144 + n];
        fmod(F)[(l * 4 + 0) * 6144 + n] = a0 + bb; fmod(F)[(l * 4 + 1) * 6144 + n] = a1 + bb; fmod(F)[(l * 4 + 2) * 6144 + n] = a2 + bb; fmod(F)[(l * 4 + 3) * 6144 + n] = a3 + bb;
        if (l == 0 && n < 2048) fmodc(F)[n] = a4 + bb;
    }
    for (int it = gt; it < 64 * 16; it += ngt) {
        const int pos = it >> 4, j = it & 15;
        const float inv = powf(10000.0f, -(float)j / 16.0f);
        const float ang = (float)pos * inv;
        frope(F)[it * 2] = cosf(ang); frope(F)[it * 2 + 1] = sinf(ang);
    }
}

__device__ __forceinline__ void norm_row(Frame& F, const float* xrow, const float* g, const float* sh, const float* sc, bf16* hrow) {
    const f32x4* xr = (const f32x4*)xrow + F.lane;
    f32x4 v[4]; float s = 0.f;
#pragma unroll
    for (int j = 0; j < 4; ++j) { v[j] = xr[64 * j]; s += (v[j].x * v[j].x + v[j].y * v[j].y) + (v[j].z * v[j].z + v[j].w * v[j].w); }
    const float rstd = rsqrtf(wave_sum(s) * (1.f / D) + EPS);
    unsigned long long* o8 = (unsigned long long*)hrow + F.lane;
#pragma unroll
    for (int j = 0; j < 4; ++j) {
        const f32x4 gg = ((const f32x4*)g)[F.lane + 64 * j], s1 = ((const f32x4*)sh)[F.lane + 64 * j], s2 = ((const f32x4*)sc)[F.lane + 64 * j];
        const f32x4 y = (v[j] * rstd * gg) * (s2 + 1.f) + s1;
        o8[64 * j] = (unsigned long long)pk2(y.x, y.y) | ((unsigned long long)pk2(y.z, y.w) << 32);
    }
}
__device__ __forceinline__ void ph_norm0(Frame& F) {
    const int r_lo = (int)(((long)F.gw * NROW) / F.ngw), r_hi = (int)(((long)(F.gw + 1) * NROW) / F.ngw);
    if (r_lo >= r_hi) return;
    auto rowp = [&](int r) -> const f32x4* { return (const f32x4*)(r < NTOK ? F.a.in[I_X] + (size_t)r * D : F.a.in[I_CTX] + (size_t)(r - NTOK) * D) + F.lane; };
    f32x4 vn[4];
    { const f32x4* xr = rowp(r_lo);
#pragma unroll
      for (int j = 0; j < 4; ++j) vn[j] = xr[64 * j]; }
#pragma unroll 1
    for (int r = r_lo; r < r_hi; ++r) {
        f32x4 v[4]; float s = 0.f;
#pragma unroll
        for (int j = 0; j < 4; ++j) { v[j] = vn[j]; s += (v[j].x * v[j].x + v[j].y * v[j].y) + (v[j].z * v[j].z + v[j].w * v[j].w); }
        if (r + 1 < r_hi) { const f32x4* xr = rowp(r + 1);
#pragma unroll
            for (int j = 0; j < 4; ++j) vn[j] = xr[64 * j]; }
        const float* sh; const float* sc;
        if (r < NTOK) { const int b = r >> 12; sh = fmod(F) + (0 * 4 + b) * 6144; sc = sh + D; } else { sh = fmodc(F); sc = sh + D; }
        const float* g = F.a.in[I_NMG];
        const float rstd = rsqrtf(wave_sum(s) * (1.f / D) + EPS);
        unsigned long long* o8 = (unsigned long long*)(fH(F) + (size_t)r * D) + F.lane;
#pragma unroll
        for (int j = 0; j < 4; ++j) {
            const f32x4 gg = ((const f32x4*)g)[F.lane + 64 * j], s1 = ((const f32x4*)sh)[F.lane + 64 * j], s2 = ((const f32x4*)sc)[F.lane + 64 * j];
            const f32x4 y = (v[j] * rstd * gg) * (s2 + 1.f) + s1;
            o8[64 * j] = (unsigned long long)pk2(y.x, y.y) | ((unsigned long long)pk2(y.z, y.w) << 32);
        }
    }
}

__device__ __forceinline__ void ph_inproj_naive(Frame& F) {
    const float* W = F.a.in[I_WIN];
    for (int it = F.gw; it < 272 * 56; it += F.ngw) {
        const int rg = it / 56, u = it % 56; if (rg >= 256 && u >= 32) continue;
        const int row = rg * 64 + F.lane;
        float acc[64];
#pragma unroll
        for (int j = 0; j < 64; ++j) acc[j] = 0.f;
        naive_dot<64>(fH(F) + (size_t)row * D, W + u * 64, ABW, D, acc);
        const int t = u >> 3, h = u & 7;
        if ((t == 0 || t == 4) && row < NTOK) {
            const int tt = row & 4095, pr = tt >> 6, pc = tt & 63;
#pragma unroll
            for (int j = 0; j < 16; ++j) {
                const float c1 = frope(F)[(pr * 16 + j) * 2], s1 = frope(F)[(pr * 16 + j) * 2 + 1], c2 = frope(F)[(pc * 16 + j) * 2], s2 = frope(F)[(pc * 16 + j) * 2 + 1];
                const float a = acc[j], b = acc[j + 16], c = acc[32 + j], d = acc[48 + j];
                acc[j] = a * c1 - b * s1; acc[j + 16] = a * s1 + b * c1; acc[32 + j] = c * c2 - d * s2; acc[48 + j] = c * s2 + d * c2;
            }
        }
        if (t == 0) {
#pragma unroll
            for (int j = 0; j < 64; ++j) acc[j] *= 0.125f;
        }
        if (t == 2 || t == 6) {
            float ss = 0.f;
#pragma unroll
            for (int j = 0; j < 64; ++j) ss += acc[j] * acc[j];
            const float r = rsqrtf(ss * (1.f / 64.f) + EPS) * (t == 6 ? 0.125f : 1.f);
            const float* g = t == 2 ? F.a.in[I_KG] : F.a.in[I_QG];
#pragma unroll
            for (int j = 0; j < 64; ++j) acc[j] = acc[j] * r * g[j];
        }
        if (t == 5) {
#pragma unroll
            for (int j = 0; j < 64; ++j) acc[j] = siluf(acc[j]);
        }
        const size_t off_t = t < 4 ? (size_t)t * 17 * MiB : (size_t)(68 + (t - 4) * 16) * MiB;
        bf16* dst = (bf16*)(fA(F) + off_t) + (size_t)row * HW + h * 64;
        store_row_bf16<64>(dst, acc);
    }
}

__device__ __forceinline__ float ret_gamma_log(Frame& F, int dir, int h) {
    const float th = F.a.in[I_RDEC][dir * 8 + h];
    return -(th > 0.f ? th + log1pf(__expf(-th)) : log1pf(__expf(th)));
}
__device__ __forceinline__ void ph_scan_naive(Frame& F) {
    const bf16* RK = (const bf16*)(fA(F) + A_RK); const bf16* RV = (const bf16*)(fA(F) + A_RV); bf16* SST = (bf16*)(fA(F) + A_SST);
    const int gt = F.gw * 64 + F.lane, ngt = F.ngw * 64;
    for (int it = gt; it < 64 * 4096; it += ngt) {
        const int bhd = it >> 12, ed = it & 4095, e = ed >> 6, d = ed & 63;
        const int dir = bhd & 1, h = (bhd >> 1) & 7, b = bhd >> 4;
        const float gam = __expf(ret_gamma_log(F, dir, h));
        float S = 0.f;
        bf16* sst = SST + ((size_t)((b * 8 + h) * 2 + dir) * 32) * 4096 + ed;
        for (int n = 0; n < CTXL; ++n) { const int nn = dir ? (CTXL - 1 - n) : n; const size_t row = NTOK + b * CTXL + nn;
            S = gam * S + bf2f(RK[row * HW + h * 64 + d]) * bf2f(RV[row * HW + h * 64 + e]); }
        for (int n = 0; n < SEQ; ++n) { const int t = dir ? (SEQ - 1 - n) : n; const size_t row = (size_t)b * SEQ + t;
            if ((n & 127) == 0) sst[(size_t)(t >> 7) * 4096] = (bf16)f2bf(S);
            S = gam * S + bf2f(RK[row * HW + h * 64 + d]) * bf2f(RV[row * HW + h * 64 + e]); }
    }
}
__device__ __forceinline__ void ph_na_naive(Frame& F) {
    const bf16* NK = (const bf16*)(fA(F) + A_NK); const bf16* NV = (const bf16*)(fA(F) + A_NV); const bf16* NQ = (const bf16*)(fA(F) + A_NQ); bf16* MIX = (bf16*)(fA(F) + A_MIX);
    const int gt = F.gw * 64 + F.lane, ngt = F.ngw * 64;
    for (int it = gt; it < NB * NH * SEQ; it += ngt) {
        const int t = it & 4095, h = (it >> 12) & 7, b = it >> 15;
        const int r = t >> 6, c = t & 63;
        int r0 = r - 4; r0 = r0 < 0 ? 0 : (r0 > 56 ? 56 : r0); int c0 = c - 8; c0 = c0 < 0 ? 0 : (c0 > 48 ? 48 : c0);
        const size_t qrow = (size_t)b * SEQ + t;
        unsigned q[32]; float o[64];
#pragma unroll
        for (int j = 0; j < 32; ++j) q[j] = *(const unsigned*)(NQ + qrow * HW + h * 64 + 2 * j);
#pragma unroll
        for (int j = 0; j < 64; ++j) o[j] = 0.f;
        float m = -1e30f, l = 0.f;
        const float* rpb = F.a.in[I_RPB] + h * 15 * 31;
#pragma unroll 1
        for (int kk = 0; kk < 384; ++kk) {
            size_t krow; float bias = 0.f;
            if (kk < 128) { const int kr = r0 + (kk >> 4), kc = c0 + (kk & 15); krow = (size_t)b * SEQ + kr * 64 + kc; bias = rpb[(kr - r + 7) * 31 + (kc - c + 15)]; }
            else krow = NTOK + b * CTXL + (kk - 128);
            float s = 0.f;
#pragma unroll
            for (int j = 0; j < 64; j += 2) { const unsigned w = *(const unsigned*)(NK + krow * HW + h * 64 + j); s += bf2f(q[j >> 1] & 0xffffu) * bf2f(w & 0xffffu) + bf2f(q[j >> 1] >> 16) * bf2f(w >> 16); }
            s += bias;
            asm volatile("" ::: "memory");
            const float mn = fmaxf(m, s), al = __expf(m - mn), p = __expf(s - mn);
            l = l * al + p; m = mn;
#pragma unroll
            for (int j = 0; j < 64; j += 2) { const unsigned w = *(const unsigned*)(NV + krow * HW + h * 64 + j); o[j] = o[j] * al + p * bf2f(w & 0xffffu); o[j + 1] = o[j + 1] * al + p * bf2f(w >> 16); }
        }
        const float il = 1.f / l;
#pragma unroll
        for (int j = 0; j < 64; ++j) o[j] *= il;
        store_row_bf16<64>(MIX + qrow * D + 512 + h * 64, o);
    }
}
__device__ __forceinline__ void ph_retout_naive(Frame& F) {
    const bf16* RK = (const bf16*)(fA(F) + A_RK); const bf16* RV = (const bf16*)(fA(F) + A_RV); const bf16* RQ = (const bf16*)(fA(F) + A_RQ); const bf16* GT = (const bf16*)(fA(F) + A_GT);
    const bf16* SST = (const bf16*)(fA(F) + A_SST); bf16* MIX = (bf16*)(fA(F) + A_MIX);
    const int gt = F.gw * 64 + F.lane, ngt = F.ngw * 64;
    for (int it = gt; it < NB * NH * SEQ * 2; it += ngt) {
        const int hf = it & 1, t = (it >> 1) & 4095, h = (it >> 13) & 7, b = it >> 16;
        const int i = t & 127, ch = t >> 7;
        const size_t qrow = (size_t)b * SEQ + t;
        const float lgf = ret_gamma_log(F, 0, h), lgb = ret_gamma_log(F, 1, h);
        unsigned q[32]; float o[32];
#pragma unroll
        for (int j = 0; j < 32; ++j) q[j] = *(const unsigned*)(RQ + qrow * HW + h * 64 + 2 * j);
#pragma unroll
        for (int j = 0; j < 32; ++j) o[j] = 0.f;
#pragma unroll 1
        for (int jj = 0; jj < 128; ++jj) {
            const size_t krow = (size_t)b * SEQ + ch * 128 + jj;
            float s = 0.f;
#pragma unroll
            for (int j = 0; j < 64; j += 2) { const unsigned w = *(const unsigned*)(RK + krow * HW + h * 64 + j); s += bf2f(q[j >> 1] & 0xffffu) * bf2f(w & 0xffffu) + bf2f(q[j >> 1] >> 16) * bf2f(w >> 16); }
            asm volatile("" ::: "memory");
            const float wgt = jj < i ? __expf(lgf * (float)(i - jj)) : (jj > i ? __expf(lgb * (float)(jj - i)) : 2.f);
            s *= wgt;
#pragma unroll
            for (int j = 0; j < 32; j += 2) { const unsigned w = *(const unsigned*)(RV + krow * HW + h * 64 + hf * 32 + j); o[j] += s * bf2f(w & 0xffffu); o[j + 1] += s * bf2f(w >> 16); }
            asm volatile("" ::: "memory");
        }
        const float qf = __expf(lgf * (float)(i + 1)), qb = __expf(lgb * (float)(128 - i));
        const bf16* Sf = SST + ((size_t)((b * 8 + h) * 2 + 0) * 32 + ch) * 4096 + hf * 32 * 64; const bf16* Sb = SST + ((size_t)((b * 8 + h) * 2 + 1) * 32 + ch) * 4096 + hf * 32 * 64;
#pragma unroll 1
        for (int d = 0; d < 64; ++d) {
            const float qd = bf2f(RQ[qrow * HW + h * 64 + d]); const float qfd = qf * qd, qbd = qb * qd;
#pragma unroll
            for (int e = 0; e < 32; ++e) o[e] += qfd * bf2f(Sf[e * 64 + d]) + qbd * bf2f(Sb[e * 64 + d]);
            asm volatile("" ::: "memory");
        }
        float ss = 0.f;
#pragma unroll
        for (int j = 0; j < 32; ++j) ss += o[j] * o[j];
        ss += __shfl_xor(ss, 1);
        const float rs = rsqrtf(ss * (1.f / 64.f) + EPS);
        const float* g = F.a.in[I_RNG] + hf * 32;
#pragma unroll
        for (int j = 0; j < 32; j += 2) { const unsigned w = *(const unsigned*)(GT + qrow * HW + h * 64 + hf * 32 + j); o[j] = o[j] * rs * g[j] * bf2f(w & 0xffffu); o[j + 1] = o[j + 1] * rs * g[j + 1] * bf2f(w >> 16); }
        store_row_bf16<32>(MIX + qrow * D + h * 64 + hf * 32, o);
    }
}
__device__ __forceinline__ void ph_gemm_res_naive(Frame& F, const bf16* A, int lda, int K, const float* W, const float* base, const float* gate  ) {
    for (int it = F.gw; it < 256 * 16; it += F.ngw) {
        const int rg = it >> 4, u = it & 15, row = rg * 64 + F.lane, b = row >> 12;
        float acc[64];
#pragma unroll
        for (int j = 0; j < 64; ++j) acc[j] = 0.f;
        naive_dot<64>(A + (size_t)row * lda, W + u * 64, D, K, acc);
        const float* gp = gate + b * 6144 + u * 64; const float* bp = base + (size_t)row * D + u * 64; float* op = F.a.out + (size_t)row * D + u * 64;
#pragma unroll
        for (int j = 0; j < 64; j += 4) { const f32x4 bv = *(const f32x4*)(bp + j), gv = *(const f32x4*)(gp + j);
            *(f32x4*)(op + j) = bv + gv * (f32x4){acc[j], acc[j + 1], acc[j + 2], acc[j + 3]}; }
    }
}
__device__ __forceinline__ void ph_route(Frame& F, int l, bool dry = false) {
    typedef short bf16x8_ __attribute__((ext_vector_type(8)));
    LAS bf16* wh = (LAS bf16*)F.lds;
    LAS bf16* wl = wh + 16 * 1024;
    LAS float* gsb = (LAS float*)(F.lds + 65536);
    LAS float* shb = gsb + 4 * 1024;
    for (int i = F.tid; i < D * NE; i += NTHREADS) { const int e = i >> 10, k = i & 1023; const float w = F.a.in[I_RW][k * 16 + e]; const unsigned h = f2bf(w); const float rem = w - bf2f(h);
        wh[i] = (bf16)h; wl[i] = (bf16)f2bf(rem); }
    for (int i = F.tid; i < 4 * D; i += NTHREADS) { const int b = i >> 10, k = i & 1023; const float* md = fmod(F) + (l * 4 + b) * 6144;
        gsb[i] = F.a.in[I_NFG][l * D + k] * (md[4 * D + k] + 1.f); shb[i] = md[3 * D + k]; }
    __syncthreads();
    unsigned* cnt = fctl(F) + CW_CNT + l * 1024;
    const int row16 = F.lane & 15, kq = F.lane >> 4;
    LAS float* xss = (LAS float*)(F.lds + 65536 + 32768);
    LAS float* xlg = xss + 128;
    const int kh = F.wave >> 2, wi = F.wave & 3;
    for (int item0 = (int)blockIdx.x * 4; item0 < NTOK / 16; item0 += (int)gridDim.x * 4) {
        const int item = item0 + wi;
        const int r = item * 16 + row16, b = (item * 16) >> 12;
        const bf16* xrow = (const bf16*)(l == 0 ? fA(F) + A_X1 : fA(F) + A_X3) + (size_t)r * D + 512 * kh + 8 * kq;
        float ss;
        { const f32x4 t = *(const f32x4*)(fvss(F) + (size_t)r * 16 + 4 * kq); ss = (t.x + t.y) + (t.z + t.w); }
        ss += __shfl_xor(ss, 16); ss += __shfl_xor(ss, 32);
        __syncthreads();
        const float rstd = rsqrtf(ss * (1.f / D) + EPS);
        f32x4 acc = {0.f, 0.f, 0.f, 0.f};
        bf16* hrow = fH(F) + (size_t)r * D + 512 * kh + 8 * kq;
        const LAS float* gp = gsb + b * 1024 + 512 * kh + 8 * kq; const LAS float* sp = shb + b * 1024 + 512 * kh + 8 * kq;
        const LAS bf16* whp = wh + row16 * 1024 + 512 * kh + 8 * kq; const LAS bf16* wlp = wl + row16 * 1024 + 512 * kh + 8 * kq;
#pragma unroll 4
        for (int s2 = 0; s2 < 16; ++s2) {
            const u32x4 t = *(const u32x4*)(xrow + 32 * s2);
            const f32x4 a = { bf2f(t.x & 0xffffu), bf2f(t.x >> 16), bf2f(t.y & 0xffffu), bf2f(t.y >> 16) }, c = { bf2f(t.z & 0xffffu), bf2f(t.z >> 16), bf2f(t.w & 0xffffu), bf2f(t.w >> 16) };
            const f32x4 g0 = *(const LAS f32x4*)(gp + 32 * s2), g1 = *(const LAS f32x4*)(gp + 32 * s2 + 4), h0 = *(const LAS f32x4*)(sp + 32 * s2), h1 = *(const LAS f32x4*)(sp + 32 * s2 + 4);
            const f32x4 y0 = (a * rstd) * g0 + h0, y1 = (c * rstd) * g1 + h1;
            u32x4 yh; yh.x = pk2(y0.x, y0.y); yh.y = pk2(y0.z, y0.w); yh.z = pk2(y1.x, y1.y); yh.w = pk2(y1.z, y1.w);
            *(u32x4*)(hrow + 32 * s2) = yh;
            const f32x4 r0 = { y0.x - bf2f(yh.x & 0xffffu), y0.y - bf2f(yh.x >> 16), y0.z - bf2f(yh.y & 0xffffu), y0.w - bf2f(yh.y >> 16) };
            const f32x4 r1 = { y1.x - bf2f(yh.z & 0xffffu), y1.y - bf2f(yh.z >> 16), y1.z - bf2f(yh.w & 0xffffu), y1.w - bf2f(yh.w >> 16) };
            u32x4 yl; yl.x = pk2(r0.x, r0.y); yl.y = pk2(r0.z, r0.w); yl.z = pk2(r1.x, r1.y); yl.w = pk2(r1.z, r1.w);
            const bf16x8_ wfh = *(const LAS bf16x8_*)(whp + 32 * s2), wfl = *(const LAS bf16x8_*)(wlp + 32 * s2);
            const bf16x8_ yfh = __builtin_bit_cast(bf16x8_, yh), yfl = __builtin_bit_cast(bf16x8_, yl);
            acc = __builtin_amdgcn_mfma_f32_16x16x32_bf16(wfh, yfh, acc, 0, 0, 0);
            acc = __builtin_amdgcn_mfma_f32_16x16x32_bf16(wfl, yfh, acc, 0, 0, 0);
            acc = __builtin_amdgcn_mfma_f32_16x16x32_bf16(wfh, yfl, acc, 0, 0, 0);
        }
        if (kh == 1) *(LAS f32x4*)(xlg + (wi * 64 + F.lane) * 4) = acc;
        __syncthreads();
        if (kh == 1) continue;
        acc = acc + *(const LAS f32x4*)(xlg + (wi * 64 + F.lane) * 4);
        float m1 = -1e30f, m2 = -1e30f, w1 = 0.f, w2 = 0.f; int i1 = 0, i2 = 0;
#pragma unroll
        for (int g = 0; g < 4; ++g) { const float af = 1.f / (1.f + __expf(-acc[g])); const float x = af + F.a.in[I_RB][4 * kq + g]; const int id = 4 * kq + g;
            if (x > m1) { m2 = m1; i2 = i1; w2 = w1; m1 = x; i1 = id; w1 = af; } else if (x > m2) { m2 = x; i2 = id; w2 = af; } }
        const float gsc = m1 + m2;
        const float s0 = __shfl(gsc, row16), s1 = __shfl(gsc, row16 + 16), s2_ = __shfl(gsc, row16 + 32), s3 = __shfl(gsc, row16 + 48);
        int best = 0; float bs = s0; if (s1 > bs) { bs = s1; best = 1; } if (s2_ > bs) { bs = s2_; best = 2; } if (s3 > bs) { bs = s3; best = 3; }
        const bool writer = (kq == best) && !dry;
        int mycount = 0; unsigned long long below1 = 0ull, below2 = 0ull;
        const unsigned long long ltmask = (1ull << F.lane) - 1ull;
#pragma unroll
        for (int e = 0; e < 16; ++e) { const unsigned long long m = __ballot(writer && (i1 == e || i2 == e));
            if (F.lane == e) mycount = __popcll(m);
            if (i1 == e) below1 = m & ltmask; if (i2 == e) below2 = m & ltmask; }
        int base = 0;
        if (F.lane < 16 && mycount > 0) base = (int)__hip_atomic_fetch_add(cnt + F.lane * 64, (unsigned)mycount, RLX_AGENT);
        const int b1 = __shfl(base, i1), b2 = __shfl(base, i2);
        if (writer) { const float inv = 1.f / (w1 + w2);
            u32x2 r1_, r2_; r1_.x = (unsigned)(2 * r); r1_.y = __builtin_bit_cast(unsigned, w1 * inv); r2_.x = (unsigned)(2 * r + 1); r2_.y = __builtin_bit_cast(unsigned, w2 * inv);
            ((u32x2*)flist(F))[i1 * 16384 + b1 + __popcll(below1)] = r1_; ((u32x2*)flist(F))[i2 * 16384 + b2 + __popcll(below2)] = r2_; }
    }
    __syncthreads();
}
struct Seg { int cnt[16]; int base[16]; };
__device__ __forceinline__ void load_seg(Frame& F, int l, int (&cnt)[16], int (&base)[16]) {
    int acc = 0;
#pragma unroll
    for (int e = 0; e < 16; ++e) { cnt[e] = (int)__hip_atomic_load(fctl(F) + CW_CNT + l * 1024 + e * 64, RLX_AGENT); base[e] = acc; acc += (cnt[e] + 255) & ~255; }
}
__device__ __forceinline__ void ph_moe_gu_naive(Frame& F, int l) {
    int cnt[16], base[16]; load_seg(F, l, cnt, base);
    bf16* ACT = (bf16*)(fA(F) + A_ACT);
    int tot = 0;
#pragma unroll
    for (int i = 0; i < 16; ++i) tot += (cnt[i] + 63) >> 6;
    for (int it = F.gw; it < tot * 16; it += F.ngw) {
        const int gi_all = it >> 4, u = it & 15;
        int ee = 0, gs = 0;
#pragma unroll
        for (int i = 0, cum = 0; i < 16; ++i) { cum += (cnt[i] + 63) >> 6; if (gi_all >= cum) { gs = cum; ee = i + 1; } }
        int ce = 0, be = 0;
#pragma unroll
        for (int i = 0; i < 16; ++i) if (i == ee) { ce = cnt[i]; be = base[i]; }
        const int pos = (gi_all - gs) * 64 + F.lane; const bool valid = pos < ce;
        const int ent = flist(F)[(ee * 16384 + (valid ? pos : 0)) * 2]; const int tok = ent >> 1;
        float ag[32], au[32];
#pragma unroll
        for (int j = 0; j < 32; ++j) { ag[j] = 0.f; au[j] = 0.f; }
        const float* Wg = F.a.in[I_WG] + ((size_t)(l * NE + ee) * D) * EW + u * 32; const float* Wu = F.a.in[I_WU] + ((size_t)(l * NE + ee) * D) * EW + u * 32;
        naive_dot<32>(fH(F) + (size_t)tok * D, Wg, EW, D, ag);
        naive_dot<32>(fH(F) + (size_t)tok * D, Wu, EW, D, au);
#pragma unroll
        for (int j = 0; j < 32; ++j) ag[j] = siluf(ag[j]) * au[j];
        if (valid) store_row_bf16<32>(ACT + (size_t)(be + pos) * EW + u * 32, ag);
    }
}
__device__ __forceinline__ void ph_moe_dn_naive(Frame& F, int l) {
    int cnt[16], base[16]; load_seg(F, l, cnt, base);
    const bf16* ACT = (const bf16*)(fA(F) + A_ACT); bf16* Y = (bf16*)(fA(F) + A_Y);
    int tot = 0;
#pragma unroll
    for (int i = 0; i < 16; ++i) tot += (cnt[i] + 63) >> 6;
    for (int it = F.gw; it < tot * 16; it += F.ngw) {
        const int gi_all = it >> 4, u = it & 15;
        int ee = 0, gs = 0;
#pragma unroll
        for (int i = 0, cum = 0; i < 16; ++i) { cum += (cnt[i] + 63) >> 6; if (gi_all >= cum) { gs = cum; ee = i + 1; } }
        int ce = 0, be = 0;
#pragma unroll
        for (int i = 0; i < 16; ++i) if (i == ee) { ce = cnt[i]; be = base[i]; }
        const int pos = (gi_all - gs) * 64 + F.lane; const bool valid = pos < ce;
        const int ent = flist(F)[(ee * 16384 + (valid ? pos : 0)) * 2];
        float acc[64];
#pragma unroll
        for (int j = 0; j < 64; ++j) acc[j] = 0.f;
        const float* Wd = F.a.in[I_WD] + ((size_t)(l * NE + ee) * EW) * D + u * 64;
        naive_dot<64>(ACT + (size_t)(be + (valid ? pos : 0)) * EW, Wd, D, EW, acc);
        const float w = __builtin_bit_cast(float, flist(F)[(ee * 16384 + (valid ? pos : 0)) * 2 + 1]);
#pragma unroll
        for (int j = 0; j < 64; ++j) acc[j] *= w;
        if (valid) store_row_bf16<64>(Y + (size_t)ent * D + u * 64, acc);
    }
}
__device__ __forceinline__ void ph_combine(Frame& F, int l, bool do_norm, bool dry = false) {
    const float dsc = dry ? 0.f : 1.f;
    const bf16* Y = (const bf16*)(fA(F) + A_Y);
    const bf16* X = (const bf16*)(l == 0 ? fA(F) + A_X1 : fA(F) + A_X3);
    const int r_lo = (int)(((long)F.gw * NTOK) / F.ngw), r_hi = (int)(((long)(F.gw + 1) * NTOK) / F.ngw);
    if (r_lo >= r_hi) return;
    unsigned long long xa[4], ya_[4], yb_[4];
    { const unsigned long long* xr = (const unsigned long long*)(X + (size_t)r_lo * D) + F.lane; const unsigned long long* ya = (const unsigned long long*)(Y + (size_t)(2 * r_lo) * D) + F.lane; const unsigned long long* yb = ya + D / 4;
#pragma unroll
      for (int j = 0; j < 4; ++j) { xa[j] = xr[64 * j]; ya_[j] = ya[64 * j]; yb_[j] = yb[64 * j]; } }
#pragma unroll 1
    for (int r = r_lo; r < r_hi; ++r) {
        const int b = r >> 12;
        const float* gf = fmod(F) + (l * 4 + b) * 6144 + 5 * D;
        unsigned long long xc[4], yac[4], ybc[4];
#pragma unroll
        for (int j = 0; j < 4; ++j) { xc[j] = xa[j]; yac[j] = ya_[j]; ybc[j] = yb_[j]; }
        if (r + 1 < r_hi) { const unsigned long long* xr = (const unsigned long long*)(X + (size_t)(r + 1) * D) + F.lane; const unsigned long long* ya = (const unsigned long long*)(Y + (size_t)(2 * r + 2) * D) + F.lane; const unsigned long long* yb = ya + D / 4;
#pragma unroll
            for (int j = 0; j < 4; ++j) { xa[j] = xr[64 * j]; ya_[j] = ya[64 * j]; yb_[j] = yb[64 * j]; } }
        f32x4 v[4]; float s = 0.f;
#pragma unroll
        for (int j = 0; j < 4; ++j) {
            const unsigned long long a = yac[j], bq = ybc[j], xq = xc[j];
            const f32x4 yy = { bf2f((unsigned)a & 0xffffu) + bf2f((unsigned)bq & 0xffffu), bf2f(((unsigned)a) >> 16) + bf2f(((unsigned)bq) >> 16),
                               bf2f((unsigned)(a >> 32) & 0xffffu) + bf2f((unsigned)(bq >> 32) & 0xffffu), bf2f((unsigned)(a >> 48)) + bf2f((unsigned)(bq >> 48)) };
            const f32x4 xv = { bf2f((unsigned)xq & 0xffffu), bf2f(((unsigned)xq) >> 16), bf2f((unsigned)(xq >> 32) & 0xffffu), bf2f((unsigned)(xq >> 48)) };
            v[j] = xv + ((const f32x4*)gf)[F.lane + 64 * j] * yy * dsc;
            if (do_norm) ((unsigned long long*)((bf16*)F.a.out + (size_t)r * D))[F.lane + 64 * j] = (unsigned long long)pk2(v[j].x, v[j].y) | ((unsigned long long)pk2(v[j].z, v[j].w) << 32);
            else ((f32x4*)(F.a.out + (size_t)r * D))[F.lane + 64 * j] = v[j];
            s += (v[j].x * v[j].x + v[j].y * v[j].y) + (v[j].z * v[j].z + v[j].w * v[j].w);
        }
        if (do_norm) {
            const float rstd = rsqrtf(wave_sum(s) * (1.f / D) + EPS);
            const float* g = F.a.in[I_NMG] + (l + 1) * D; const float* sh = fmod(F) + ((l + 1) * 4 + b) * 6144; const float* sc = sh + D;
            unsigned long long* o8 = (unsigned long long*)(fH(F) + (size_t)r * D) + F.lane;
#pragma unroll
            for (int j = 0; j < 4; ++j) {
                const f32x4 gg = ((const f32x4*)g)[F.lane + 64 * j], s1 = ((const f32x4*)sh)[F.lane + 64 * j], s2 = ((const f32x4*)sc)[F.lane + 64 * j];
                const f32x4 y = (v[j] * rstd * gg) * (s2 + 1.f) + s1;
                o8[64 * j] = (unsigned long long)pk2(y.x, y.y) | ((unsigned long long)pk2(y.z, y.w) << 32);
            }
        }
    }
}
__device__ __forceinline__ void ph_sguin_naive(Frame& F) {
    bf16* U = (bf16*)(fA(F) + A_U); bf16* V = (bf16*)(fA(F) + A_V);
    for (int it = F.gw; it < 256 * 96; it += F.ngw) {
        const int rg = it / 96, u = it % 96, row = rg * 64 + F.lane;
        float acc[64];
#pragma unroll
        for (int j = 0; j < 64; ++j) acc[j] = 0.f;
        naive_dot<64>(fH(F) + (size_t)row * D, F.a.in[I_SWIN] + u * 64, 2 * SGW, D, acc);
        const float* bi = F.a.in[I_SBIN] + u * 64; float ss = 0.f;
#pragma unroll
        for (int j = 0; j < 64; ++j) { acc[j] = gelu_tanh(acc[j] + bi[j]); ss += acc[j] * acc[j]; }
        if (u < 48) store_row_bf16<64>(U + (size_t)row * SGW + u * 64, acc);
        else { store_row_bf16<64>(V + (size_t)row * SGW + (u - 48) * 64, acc); fvss(F)[(size_t)row * 48 + (u - 48)] = ss; }
    }
}
__device__ __forceinline__ void ph_sgumix_naive(Frame& F) {
    bf16* U = (bf16*)(fA(F) + A_U); const bf16* V = (const bf16*)(fA(F) + A_V);
    LAS float* rs = (LAS float*)F.lds;
    for (int bc = blockIdx.x; bc < NB * 32; bc += gridDim.x) {
        const size_t row0 = (size_t)bc * 128;
        __syncthreads();
        if (F.tid < 128) { float s = 0.f; for (int j = 0; j < 48; ++j) s += fvss(F)[(row0 + F.tid) * 48 + j]; rs[F.tid] = rsqrtf(s * (1.f / SGW) + EPS); }
        __syncthreads();
        for (int o = F.tid; o < 128 * SGW; o += NTHREADS) {
            const int i = o / SGW, c = o % SGW, g = c / 384;
            const float* ws = F.a.in[I_SWS] + ((size_t)g * 128 + i) * 128;
            float acc = 0.f;
            for (int j = 0; j < 128; ++j) acc += ws[j] * (bf2f(V[(row0 + j) * SGW + c]) * rs[j]);
            const float mixed = acc * F.a.in[I_SNG][c] + F.a.in[I_SBS][g * 128 + i];
            const size_t idx = (row0 + i) * SGW + c;
            U[idx] = (bf16)f2bf(bf2f(U[idx]) * mixed);
        }
    }
    __syncthreads();
}


namespace pg8 {
typedef short bf16x8 __attribute__((ext_vector_type(8)));
constexpr int BM = 256, BK = 64, HALF = 128, HTB = HALF * BK * 2, STAGE_BYTES = 8 * HTB;
__host__ __device__ __forceinline__ int lds_byte(int r, int c) { const int st = (r >> 4) * 2 + (c >> 5), rr = r & 15, cc = c & 31, ob = rr * 64 + cc * 2; return st * 1024 + (ob ^ (((ob >> 9) & 1) << 5)); }
__host__ __device__ __forceinline__ void stage_rc(int b, int& R, int& C) { const int st = b / 1024, sb = b % 1024, swz = sb ^ (((sb >> 9) & 1) << 5); R = (st >> 1) * 16 + swz / 64; C = (st & 1) * 32 + (swz % 64) / 2; }
struct Unit { int pm, pn; const char* Ab; const char* Bb; int x0, x1, x2; };
__device__ __forceinline__ unsigned cvt_pk_bf16(float lo, float hi) { unsigned r; asm volatile("v_cvt_pk_bf16_f32 %0, %1, %2" : "=v"(r) : "v"(lo), "v"(hi)); return r; }

template <class Sched, class Epi, bool ALIGN_EPI>
__device__ __forceinline__ void gemm_phase(LAS unsigned char* lds, const int K, const Sched& S, const Epi& E, const int wid) {
    const int lane = lane_id_v(), tid = wid * 64 + lane, wr = wid >> 2, wc = wid & 3, fr = lane & 15, fq = lane >> 4;
    const int nt = K / BK;
    unsigned voffB[2];
#pragma unroll
    for (int i = 0; i < 2; ++i) { int R_, C_; stage_rc(tid * 16 + i * 8192, R_, C_); voffB[i] = (unsigned)(R_ * K + C_) * 2u; }
    const size_t kstep = (size_t)(BK * 2);
    const size_t hstep = (size_t)HALF * K * 2;
    const unsigned ldsw = (unsigned)wid * 1024u;
    const int aoff = lds_byte(wr * 64 + fr, fq * 8), boff = lds_byte(wc * 32 + fr, fq * 8);
#define PG8_SA(b, h) (((b) * 2 + (h)) * HTB)
#define PG8_SB(b, h) ((4 + (b) * 2 + (h)) * HTB)
#define PG8_STAGE(bufoff, gbase, voff) do { _Pragma("unroll") for (int _i = 0; _i < 2; ++_i) \
        __builtin_amdgcn_global_load_lds((const unsigned*)((const char*)(gbase) + (voff)[_i]), (LAS unsigned*)(lds + (bufoff) + ldsw + _i * 8192), 16, 0, 0); } while (0)
#define PG8_LDA(dst, b, h) do { _Pragma("unroll") for (int m = 0; m < 4; ++m) _Pragma("unroll") for (int k = 0; k < 2; ++k) dst[m][k] = *(const LAS bf16x8*)(lds + PG8_SA(b, h) + aoff + m * 2048 + k * 1024); } while (0)
#define PG8_LDB(dst, b, h) do { _Pragma("unroll") for (int n = 0; n < 2; ++n) _Pragma("unroll") for (int k = 0; k < 2; ++k) dst[n][k] = *(const LAS bf16x8*)(lds + PG8_SB(b, h) + boff + n * 2048 + k * 1024); } while (0)
#define PG8_MMA(ai, bj, At, Bt) do { __builtin_amdgcn_s_setprio(1); _Pragma("unroll") for (int m = 0; m < 4; ++m) _Pragma("unroll") for (int n = 0; n < 2; ++n) _Pragma("unroll") for (int k = 0; k < 2; ++k) \
        acc[ai][bj][m][n] = __builtin_amdgcn_mfma_f32_16x16x32_bf16(Bt[n][k], At[m][k], acc[ai][bj][m][n], 0, 0, 0); __builtin_amdgcn_s_setprio(0); } while (0)
#define PG8_WAIT_V(n) asm volatile("s_waitcnt vmcnt(" #n ")" ::: "memory")
#define PG8_WAIT_L(n) asm volatile("s_waitcnt lgkmcnt(" #n ")" ::: "memory")
#define PG8_BAR __builtin_amdgcn_s_barrier()
#define PG8_SCHED __builtin_amdgcn_sched_barrier(0)
    Unit cur, nxt; int ui = 0;
    if (!S.next(0, cur)) return;
    constexpr int REC_OFF = STAGE_BYTES;
#define PG8_REC_DMA(u, buf) do { if constexpr (Sched::REC) { const unsigned* _src = S.rec_src(u) + wid * 64 + lane; \
        __builtin_amdgcn_global_load_lds(_src, (LAS unsigned*)(lds + REC_OFF + (buf) * 2048 + wid * 256), 4, 0, 0); } } while (0)
#define PG8_REC_PTR(i) ((const LAS unsigned*)(lds + REC_OFF + ((i) % 3) * 2048))
    PG8_REC_DMA(cur, 0);
    unsigned vA[2][2];
    S.arows0(cur, vA, tid);
    asm volatile("" : "+v"(vA[0][0]), "+v"(vA[0][1]), "+v"(vA[1][0]), "+v"(vA[1][1]));
    f32x4 acc[2][2][4][2];
#pragma unroll
    for (int a = 0; a < 2; ++a)
#pragma unroll
        for (int b = 0; b < 2; ++b)
#pragma unroll
            for (int m = 0; m < 4; ++m)
#pragma unroll
                for (int n = 0; n < 2; ++n) acc[a][b][m][n] = (f32x4){0.f, 0.f, 0.f, 0.f};
    bf16x8 At[4][2], B0[2][2], B1[2][2];
    const char* cA = cur.Ab; const char* cB = cur.Bb;
    PG8_STAGE(PG8_SB(0, 0), cB, voffB); PG8_STAGE(PG8_SB(0, 1), cB + hstep, voffB); PG8_STAGE(PG8_SA(0, 0), cA, vA[0]); PG8_STAGE(PG8_SA(0, 1), cA, vA[1]);
    if (wr == 1) PG8_BAR;
    PG8_WAIT_V(2); PG8_BAR;
    PG8_STAGE(PG8_SB(1, 0), cB + kstep, voffB); PG8_STAGE(PG8_SA(1, 0), cA + kstep, vA[0]); PG8_STAGE(PG8_SB(1, 1), cB + hstep + kstep, voffB);
    PG8_WAIT_V(6); PG8_BAR;
    for (;;) {
        const bool has_next = S.next(ui + 1, nxt);
        if (has_next) PG8_REC_DMA(nxt, (ui + 1) % 3);
        const char* nA = has_next ? nxt.Ab : cA; const char* nB = has_next ? nxt.Bb : cB;
        for (int t = 0; t < nt; t += 2) {
            const bool last = (t == nt - 2);
            const char* a1 = cA + (size_t)(t + 1) * kstep;
            const char* a2 = last ? nA : cA + (size_t)(t + 2) * kstep; const char* b2 = last ? nB : cB + (size_t)(t + 2) * kstep;
            const char* a3 = a2 + kstep; const char* b3 = b2 + kstep;
            unsigned w0[2], w1[2];
            w0[0] = vA[0][0]; w0[1] = vA[0][1]; w1[0] = vA[1][0]; w1[1] = vA[1][1];
            if (last && has_next) { unsigned nv[2][2]; pg8::Unit tu = nxt; asm volatile("" : "+v"(tu.pm)); S.arows(tu, nv, PG8_REC_PTR(ui + 1), tid);
                w0[0] = nv[0][0]; w0[1] = nv[0][1]; w1[0] = nv[1][0]; w1[1] = nv[1][1]; }
            PG8_LDB(B0, 0, 0); PG8_LDB(B1, 0, 1); PG8_SCHED; PG8_LDA(At, 0, 0); PG8_STAGE(PG8_SA(1, 1), a1, vA[1]);
            PG8_WAIT_V(8); PG8_WAIT_L(0); PG8_BAR; PG8_MMA(0, 0, At, B0); PG8_MMA(0, 1, At, B1); PG8_BAR; PG8_SCHED;
            PG8_LDA(At, 0, 1); PG8_STAGE(PG8_SB(0, 0), b2, voffB); PG8_STAGE(PG8_SB(0, 1), b2 + hstep, voffB); PG8_STAGE(PG8_SA(0, 0), a2, w0);
            PG8_WAIT_V(8); PG8_WAIT_L(0); PG8_BAR; PG8_MMA(1, 0, At, B0); PG8_MMA(1, 1, At, B1); PG8_BAR; PG8_SCHED;
            PG8_LDB(B0, 1, 0); PG8_LDB(B1, 1, 1); PG8_SCHED; PG8_LDA(At, 1, 0); PG8_STAGE(PG8_SA(0, 1), a2, w1);
            PG8_WAIT_V(8); PG8_WAIT_L(0); PG8_BAR; PG8_MMA(0, 0, At, B0); PG8_MMA(0, 1, At, B1); PG8_BAR; PG8_SCHED;
            PG8_LDA(At, 1, 1); PG8_STAGE(PG8_SB(1, 0), b3, voffB); PG8_STAGE(PG8_SB(1, 1), b3 + hstep, voffB); PG8_STAGE(PG8_SA(1, 0), a3, w0);
            PG8_WAIT_V(8); PG8_WAIT_L(0); PG8_BAR; PG8_MMA(1, 0, At, B0); PG8_MMA(1, 1, At, B1); PG8_BAR; PG8_SCHED;
        }
        if constexpr (ALIGN_EPI) { if (wr == 0) PG8_BAR; }
        E(acc, cur, wr, wc, fr, fq, PG8_REC_PTR(ui));
        if (!has_next) break;
#pragma unroll
        for (int a = 0; a < 2; ++a)
#pragma unroll
            for (int b = 0; b < 2; ++b)
#pragma unroll
                for (int m = 0; m < 4; ++m)
#pragma unroll
                    for (int n = 0; n < 2; ++n) acc[a][b][m][n] = (f32x4){0.f, 0.f, 0.f, 0.f};
        cur = nxt; cA = nA; cB = nB; ++ui;
        S.arows(cur, vA, PG8_REC_PTR(ui), tid);
        if constexpr (ALIGN_EPI) { if (wr == 1) PG8_BAR; }
    }
    PG8_WAIT_V(0);
    if constexpr (!ALIGN_EPI) { if (wr == 0) PG8_BAR; }
    PG8_BAR;
#undef PG8_REC_DMA
#undef PG8_REC_PTR
#undef PG8_SA
#undef PG8_SB
#undef PG8_STAGE
#undef PG8_LDA
#undef PG8_LDB
#undef PG8_MMA
#undef PG8_WAIT_V
#undef PG8_WAIT_L
#undef PG8_BAR
#undef PG8_SCHED
}
}

constexpr size_t WB_WIN = 0;
constexpr size_t WB_WOUT = WB_WIN + (size_t)ABW * D * 2;
constexpr size_t WB_SWIN = WB_WOUT + (size_t)D * D * 2;
constexpr size_t WB_SWOUT = WB_SWIN + (size_t)2 * SGW * D * 2;
constexpr size_t WB_GU = WB_SWOUT + (size_t)D * SGW * 2;
constexpr size_t WB_DN = WB_GU + (size_t)2 * NE * 1024 * D * 2;
constexpr size_t WB_WS = WB_DN + (size_t)2 * NE * D * EW * 2;
constexpr size_t WB_END = WB_WS + (size_t)8 * 128 * 128 * 2;
static_assert(WB_END <= 124 * MiB, "bf16 weights fit");

__device__ __forceinline__ int slot_of(int mode, int c) {
    if (mode == 0) { const int bj = (c >> 7) & 1, wc = (c >> 5) & 3, fq = (c >> 3) & 3, nn = (c >> 2) & 1, rg = c & 3; return 128 * bj + 32 * wc + 16 * nn + 4 * fq + rg; }
    if (mode == 1) { const int wc = (c >> 6) & 3, bj = (c >> 5) & 1, nn = (c >> 4) & 1, fq = (c >> 2) & 3, rg = c & 3; return 128 * bj + 32 * wc + 16 * nn + 4 * fq + rg; }
    const int wc = (c >> 6) & 3, bj = (c >> 5) & 1, fq = (c >> 3) & 3, nn = (c >> 2) & 1, rg = c & 3; return 128 * bj + 32 * wc + 16 * nn + 4 * fq + rg;
}
template <class RowFn> __device__ __forceinline__ void conv_item(const float* W, int ldw, int k0, int n0, bf16* WT, int Kp, LAS float* scr, int lane, const RowFn& rowfn) {
    f32x4 v[8];
#pragma unroll
    for (int i = 0; i < 8; ++i) { const int kk = 8 * i + (lane >> 3); v[i] = *(const f32x4*)(W + (size_t)(k0 + kk) * ldw + n0 + 4 * (lane & 7)); }
#pragma unroll
    for (int i = 0; i < 8; ++i) { const int kk = 8 * i + (lane >> 3); LAS float* p = scr + kk * 33 + 4 * (lane & 7); p[0] = v[i].x; p[1] = v[i].y; p[2] = v[i].z; p[3] = v[i].w; }
    asm volatile("s_waitcnt lgkmcnt(0)" ::: "memory");
    const int c = lane & 7;
#pragma unroll
    for (int j = 0; j < 4; ++j) { const int n = (lane >> 3) + 8 * j; const LAS float* sp = scr + (8 * c) * 33 + n;
        u32x4 o; o.x = pk2(sp[0 * 33], sp[1 * 33]); o.y = pk2(sp[2 * 33], sp[3 * 33]); o.z = pk2(sp[4 * 33], sp[5 * 33]); o.w = pk2(sp[6 * 33], sp[7 * 33]);
        *(u32x4*)(WT + (size_t)rowfn(n0 + n) * Kp + k0 + 8 * c) = o; }
    asm volatile("s_waitcnt lgkmcnt(0)" ::: "memory");
}
__device__ __forceinline__ void ph_convert(Frame& F, int set, int wj, int nw, int pct_lo = 0, int pct_hi = 100) {
    LAS float* scr = (LAS float*)(F.lds + F.wave * 16384);
    bf16* WB = (bf16*)(F.a.ws + WS_WB);
    constexpr int I_1 = 16 * 112, I_2 = 16 * 32, I_3 = 16 * 192, I_4 = 48 * 32, I_5 = 32 * 512, I_6 = 32 * 256, I_7 = 8 * 128 * 128 / 512;
    constexpr int B5 = I_1 + I_2 + I_3 + I_4, B6 = B5 + I_5, B7 = B6 + I_6;
    constexpr int N_EARLY = I_1 + I_2 + I_5 / 2 + I_6 / 2, N_LATE = I_3 + I_4 + I_5 / 2 + I_6 / 2 + I_7;
    const int nset = set == 0 ? N_EARLY : N_LATE; const int jlo = nset * pct_lo / 100, jhi = nset * pct_hi / 100;
    for (int j = jlo + wj; j < jhi; j += nw) {
        int r;
        if (set == 0) { if (j < I_1 + I_2) r = j; else if (j < I_1 + I_2 + I_5 / 2) r = B5 + (j - (I_1 + I_2)); else r = B6 + (j - (I_1 + I_2 + I_5 / 2)); }
        else { if (j < I_3 + I_4) r = I_1 + I_2 + j; else if (j < I_3 + I_4 + I_5 / 2) r = B5 + I_5 / 2 + (j - (I_3 + I_4)); else if (j < I_3 + I_4 + I_5 / 2 + I_6 / 2) r = B6 + I_6 / 2 + (j - (I_3 + I_4 + I_5 / 2)); else r = B7 + (j - (I_3 + I_4 + I_5 / 2 + I_6 / 2)); }
        if (r < I_1) { const int kb = r / 112, nb = r % 112, n0 = nb * 32; const int tile = n0 >> 8, ty = tile >> 1; const int mode = (ty == 0 || ty == 4) ? 1 : 2;
            conv_item(F.a.in[I_WIN], ABW, kb * 64, n0, (bf16*)((char*)WB + WB_WIN), D, scr, F.lane, [=](int n) { return (n & ~255) + slot_of(mode, n & 255); }); continue; } r -= I_1;
        if (r < I_2) { const int kb = r / 32, nb = r % 32;
            conv_item(F.a.in[I_WOUT], D, kb * 64, nb * 32, (bf16*)((char*)WB + WB_WOUT), D, scr, F.lane, [=](int n) { return (n & ~255) + slot_of(0, n & 255); }); continue; } r -= I_2;
        if (r < I_3) { const int kb = r / 192, nb = r % 192;
            conv_item(F.a.in[I_SWIN], 2 * SGW, kb * 64, nb * 32, (bf16*)((char*)WB + WB_SWIN), D, scr, F.lane, [=](int n) { return (n & ~255) + slot_of(0, n & 255); }); continue; } r -= I_3;
        if (r < I_4) { const int kb = r / 32, nb = r % 32;
            conv_item(F.a.in[I_SWOUT], D, kb * 64, nb * 32, (bf16*)((char*)WB + WB_SWOUT), SGW, scr, F.lane, [=](int n) { return (n & ~255) + slot_of(0, n & 255); }); continue; } r -= I_4;
        if (r < I_5) { const int le = r / 512, q = r % 512, which = q >> 8, kb = (q & 255) / 16, nb = q % 16;
            const float* W = (which ? F.a.in[I_WU] : F.a.in[I_WG]) + (size_t)le * D * EW;
            conv_item(W, EW, kb * 64, nb * 32, (bf16*)((char*)WB + WB_GU) + (size_t)le * 1024 * D, D, scr, F.lane,
                      [=](int jc) { const int w = jc & 127; return (jc >> 7) * 256 + 128 * which + 32 * ((w >> 5) & 3) + 16 * ((w >> 2) & 1) + 4 * ((w >> 3) & 3) + (w & 3); }); continue; } r -= I_5;
        if (r < I_6) { const int le = r / 256, q = r % 256, kb = q / 32, nb = q % 32;
            conv_item(F.a.in[I_WD] + (size_t)le * EW * D, D, kb * 64, nb * 32, (bf16*)((char*)WB + WB_DN) + (size_t)le * D * EW, EW, scr, F.lane, [=](int n) { return (n & ~255) + slot_of(0, n & 255); }); continue; } r -= I_6;
        {
            const float* src = F.a.in[I_SWS] + (size_t)r * 512 + F.lane * 8; const f32x4 a = *(const f32x4*)src, b2 = *(const f32x4*)(src + 4);
            u32x4 o; o.x = pk2(a.x, a.y); o.y = pk2(a.z, a.w); o.z = pk2(b2.x, b2.y); o.w = pk2(b2.z, b2.w);
            *(u32x4*)((bf16*)((char*)WB + WB_WS) + (size_t)r * 512 + F.lane * 8) = o; }
    }
}

struct DenseSched {
    static constexpr bool REC = false;
    __device__ __forceinline__ const unsigned* rec_src(const pg8::Unit&) const { return nullptr; }
    const char* A; const char* Bt; int K, nM, nN, G, c, nwg, xM0, xN, nx;
    __device__ __forceinline__ bool next(int i, pg8::Unit& u) const {
        const int L = i * G + c; if (L >= nwg + nx) return false;
        if (L < nwg) { int wgid = L; { const int q = nwg / 8, r = nwg % 8, xcd = wgid % 8, off = wgid / 8; wgid = (xcd < r ? xcd * (q + 1) : r * (q + 1) + (xcd - r) * q) + off; }
            const int nig = 8 * nN, gid = wgid / nig, fm = gid * 8, gsz = (nM - fm) < 8 ? (nM - fm) : 8;
            u.pm = fm + ((wgid % nig) % gsz); u.pn = (wgid % nig) / gsz; }
        else { const int j = L - nwg; u.pm = xM0 + j / xN; u.pn = j % xN; }
        u.Ab = A; u.Bb = Bt + (size_t)u.pn * 256 * K * 2; u.x0 = 0; u.x1 = 0; u.x2 = 0; return true;
    }
    __device__ __forceinline__ void arows(const pg8::Unit& u, unsigned (&v)[2][2], const LAS unsigned*, int tid) const {
#pragma unroll
        for (int i = 0; i < 2; ++i) { int R, C; pg8::stage_rc(tid * 16 + i * 8192, R, C);
#pragma unroll
            for (int h = 0; h < 2; ++h) v[h][i] = (unsigned)((u.pm * 256 + h * 128 + R) * K + C) * 2u; }
    }
    __device__ __forceinline__ void arows0(const pg8::Unit& u, unsigned (&v)[2][2], int tid) const { arows(u, v, nullptr, tid); }
};
struct MoeSched {
    static constexpr bool REC = true;
    __device__ __forceinline__ const unsigned* rec_src(const pg8::Unit& u) const { return (const unsigned*)LIST + ((size_t)u.x0 * 16384 + u.pm * 256) * 2; }
    const char* A; const char* Bt; int K, G, c, total; const LAS int* tab; const int* LIST; int gather;
    __device__ __forceinline__ bool next(int i, pg8::Unit& u) const {
        int L = i * G + c; if (L >= total) return false;
        if ((G & 7) == 0) { const int q = total / 8, r8 = total % 8, xcd = L % 8, off = L / 8; L = (xcd < r8 ? xcd * (q + 1) : r8 * (q + 1) + (xcd - r8) * q) + off; }
        const int rt = L >> 2; u.pn = L & 3; int ee = 0;
#pragma unroll
        for (int e = 0; e < 16; ++e) { if (tab[e * 4] <= rt && tab[e * 4 + 1] > 0) ee = e; }
        u.pm = rt - tab[ee * 4]; u.x0 = ee; u.x1 = tab[ee * 4 + 1]; u.x2 = tab[ee * 4 + 2];
        u.Ab = A; u.Bb = Bt + ((size_t)ee * 1024 + u.pn * 256) * K * 2; return true;
    }
    __device__ __forceinline__ void arows(const pg8::Unit& u, unsigned (&v)[2][2], const LAS unsigned* rec, int tid) const {
#pragma unroll
        for (int i = 0; i < 2; ++i) { int R, C; pg8::stage_rc(tid * 16 + i * 8192, R, C);
#pragma unroll
            for (int h = 0; h < 2; ++h) { const int pit = h * 128 + R, pos = u.pm * 256 + pit; int row;
                if (gather) { const int ent = (int)rec[(pos < u.x1 ? pit : 0) * 2]; row = ent >> 1; } else row = u.x2 + pos;
                v[h][i] = (unsigned)(row * K + C) * 2u; } }
    }
    __device__ __forceinline__ void arows0(const pg8::Unit& u, unsigned (&v)[2][2], int tid) const {
#pragma unroll
        for (int i = 0; i < 2; ++i) { int R, C; pg8::stage_rc(tid * 16 + i * 8192, R, C);
#pragma unroll
            for (int h = 0; h < 2; ++h) { const int pos = u.pm * 256 + h * 128 + R; int row;
                if (gather) { const int ent = LIST[(u.x0 * 16384 + (pos < u.x1 ? pos : u.pm * 256)) * 2]; row = ent >> 1; } else row = u.x2 + pos;
                v[h][i] = (unsigned)(row * K + C) * 2u; } }
    }
};

struct EpiInproj {
    unsigned char* Areg; const LAS float* ROPE; const float* kg; const float* qg;
    __device__ __forceinline__ void operator()(f32x4 (&acc)[2][2][4][2], const pg8::Unit& u, int wr, int wc, int fr, int fq, const LAS unsigned* rec = nullptr) const {
        const int ty = u.pn >> 1, head = (u.pn & 1) * 4 + wc;
        const size_t off_t = ty < 4 ? (size_t)ty * 17 * MiB : (size_t)(68 + (ty - 4) * 16) * MiB;
        bf16* dst = (bf16*)(Areg + off_t);
        const int row0 = u.pm * 256 + wr * 64 + fr;
        if (ty == 0 || ty == 4) {
            const float sc = ty == 0 ? 0.125f : 1.f;
#pragma unroll
            for (int ai = 0; ai < 2; ++ai)
#pragma unroll
                for (int m = 0; m < 4; ++m) { const int row = row0 + ai * 128 + m * 16; const int tt = row & 4095; const bool lat = row < NTOK;
#pragma unroll
                    for (int bj = 0; bj < 2; ++bj) { const int pos = bj ? (tt & 63) : (tt >> 6);
                        f32x4 u1 = acc[ai][bj][m][0], u2 = acc[ai][bj][m][1];
                        if (lat) { const f32x4 cs0 = *(const LAS f32x4*)(ROPE + (pos * 16 + 4 * fq) * 2), cs1 = *(const LAS f32x4*)(ROPE + (pos * 16 + 4 * fq) * 2 + 4);
                            const f32x4 co = { cs0.x, cs0.z, cs1.x, cs1.z }, si = { cs0.y, cs0.w, cs1.y, cs1.w };
                            const f32x4 a = u1 * co - u2 * si, b = u1 * si + u2 * co; u1 = a; u2 = b; }
                        u1 = u1 * sc; u2 = u2 * sc;
                        bf16* p = dst + (size_t)row * HW + head * 64 + 32 * bj + 4 * fq;
                        u32x2 w; w.x = pg8::cvt_pk_bf16(u1.x, u1.y); w.y = pg8::cvt_pk_bf16(u1.z, u1.w); *(u32x2*)p = w;
                        w.x = pg8::cvt_pk_bf16(u2.x, u2.y); w.y = pg8::cvt_pk_bf16(u2.z, u2.w); *(u32x2*)(p + 16) = w; } }
        } else {
            const bool nrm = (ty == 2 || ty == 6);
            f32x4 g[2][2];
            if (nrm) { const float* gp = ty == 2 ? kg : qg;
#pragma unroll
                for (int bj = 0; bj < 2; ++bj)
#pragma unroll
                    for (int n = 0; n < 2; ++n) g[bj][n] = *(const f32x4*)(gp + 32 * bj + 8 * fq + 4 * n) * (ty == 6 ? 0.125f : 1.f); }
#pragma unroll
            for (int ai = 0; ai < 2; ++ai)
#pragma unroll
                for (int m = 0; m < 4; ++m) { const int row = row0 + ai * 128 + m * 16;
                    f32x4 v[2][2];
#pragma unroll
                    for (int bj = 0; bj < 2; ++bj)
#pragma unroll
                        for (int n = 0; n < 2; ++n) v[bj][n] = acc[ai][bj][m][n];
                    if (nrm) { float ss = 0.f;
#pragma unroll
                        for (int bj = 0; bj < 2; ++bj)
#pragma unroll
                            for (int n = 0; n < 2; ++n) ss += (v[bj][n].x * v[bj][n].x + v[bj][n].y * v[bj][n].y) + (v[bj][n].z * v[bj][n].z + v[bj][n].w * v[bj][n].w);
                        ss += __shfl_xor(ss, 16); ss += __shfl_xor(ss, 32);
                        const float rs = rsqrtf(ss * (1.f / 64.f) + EPS);
#pragma unroll
                        for (int bj = 0; bj < 2; ++bj)
#pragma unroll
                            for (int n = 0; n < 2; ++n) v[bj][n] = v[bj][n] * rs * g[bj][n]; }
                    if (ty == 5) {
#pragma unroll
                        for (int bj = 0; bj < 2; ++bj)
#pragma unroll
                            for (int n = 0; n < 2; ++n)
#pragma unroll
                                for (int q = 0; q < 4; ++q) v[bj][n][q] = siluf(v[bj][n][q]); }
#pragma unroll
                    for (int bj = 0; bj < 2; ++bj) { u32x4 w; w.x = pg8::cvt_pk_bf16(v[bj][0].x, v[bj][0].y); w.y = pg8::cvt_pk_bf16(v[bj][0].z, v[bj][0].w); w.z = pg8::cvt_pk_bf16(v[bj][1].x, v[bj][1].y); w.w = pg8::cvt_pk_bf16(v[bj][1].z, v[bj][1].w);
                        *(u32x4*)(dst + (size_t)row * HW + head * 64 + 32 * bj + 8 * fq) = w; } }
        }
    }
};
template <bool BF> struct EpiRes {
    const void* base; bf16* out; const float* gate; float* xss;
    __device__ __forceinline__ void operator()(f32x4 (&acc)[2][2][4][2], const pg8::Unit& u, int wr, int wc, int fr, int fq, const LAS unsigned* rec = nullptr) const {
        const int b = u.pm >> 4, col0 = u.pn * 256 + wc * 32 + 8 * fq, row0 = u.pm * 256 + wr * 64 + fr;
        f32x4 gv[2][2];
#pragma unroll
        for (int bj = 0; bj < 2; ++bj)
#pragma unroll
            for (int n = 0; n < 2; ++n) gv[bj][n] = *(const f32x4*)(gate + b * 6144 + col0 + bj * 128 + 4 * n);
#pragma unroll
        for (int ai = 0; ai < 2; ++ai)
#pragma unroll
            for (int m = 0; m < 4; ++m) { const size_t off = (size_t)(row0 + ai * 128 + m * 16) * D + col0; float ssq = 0.f;
#pragma unroll
                for (int bj = 0; bj < 2; ++bj) { f32x4 b0, b1;
                    if (BF) { const u32x4 t = *(const u32x4*)((const bf16*)base + off + bj * 128);
                        b0 = (f32x4){ bf2f(t.x & 0xffffu), bf2f(t.x >> 16), bf2f(t.y & 0xffffu), bf2f(t.y >> 16) }; b1 = (f32x4){ bf2f(t.z & 0xffffu), bf2f(t.z >> 16), bf2f(t.w & 0xffffu), bf2f(t.w >> 16) }; }
                    else { b0 = *(const f32x4*)((const float*)base + off + bj * 128); b1 = *(const f32x4*)((const float*)base + off + bj * 128 + 4); }
                    const f32x4 r0 = b0 + gv[bj][0] * acc[ai][bj][m][0], r1 = b1 + gv[bj][1] * acc[ai][bj][m][1];
                    u32x4 w; w.x = pg8::cvt_pk_bf16(r0.x, r0.y); w.y = pg8::cvt_pk_bf16(r0.z, r0.w); w.z = pg8::cvt_pk_bf16(r1.x, r1.y); w.w = pg8::cvt_pk_bf16(r1.z, r1.w);
                    { const f32x4 q0 = { bf2f(w.x & 0xffffu), bf2f(w.x >> 16), bf2f(w.y & 0xffffu), bf2f(w.y >> 16) }, q1 = { bf2f(w.z & 0xffffu), bf2f(w.z >> 16), bf2f(w.w & 0xffffu), bf2f(w.w >> 16) };
                      const f32x4 qq = q0 * q0 + q1 * q1; ssq += (qq.x + qq.y) + (qq.z + qq.w); }
                    *(u32x4*)(out + off + bj * 128) = w; }
                ssq += __shfl_xor(ssq, 16); ssq += __shfl_xor(ssq, 32);
                if (fq == 0) xss[(size_t)(row0 + ai * 128 + m * 16) * 16 + u.pn * 4 + wc] = ssq; }
    }
};
__device__ __forceinline__ float gelu_fast(float v) { const float u2 = -2.302208198f * (v + 0.044715f * v * v * v); return v * __builtin_amdgcn_rcpf(1.f + __builtin_amdgcn_exp2f(u2)); }
__device__ __forceinline__ f32x4 gelu4(f32x4 v) {
    const f32x4 t = (v * v) * 0.044715f + 1.f; const f32x4 u2 = (t * v) * -2.302208198f;
    f32x4 e; e.x = __builtin_amdgcn_exp2f(u2.x); e.y = __builtin_amdgcn_exp2f(u2.y); e.z = __builtin_amdgcn_exp2f(u2.z); e.w = __builtin_amdgcn_exp2f(u2.w);
    const f32x4 d = e + 1.f; f32x4 r; r.x = __builtin_amdgcn_rcpf(d.x); r.y = __builtin_amdgcn_rcpf(d.y); r.z = __builtin_amdgcn_rcpf(d.z); r.w = __builtin_amdgcn_rcpf(d.w);
    return v * r; }
__device__ __forceinline__ f32x4 silu_mul4(f32x4 a, f32x4 b) {
    const f32x4 u2 = a * -1.44269504f;
    f32x4 e; e.x = __builtin_amdgcn_exp2f(u2.x); e.y = __builtin_amdgcn_exp2f(u2.y); e.z = __builtin_amdgcn_exp2f(u2.z); e.w = __builtin_amdgcn_exp2f(u2.w);
    const f32x4 d = e + 1.f; f32x4 r; r.x = __builtin_amdgcn_rcpf(d.x); r.y = __builtin_amdgcn_rcpf(d.y); r.z = __builtin_amdgcn_rcpf(d.z); r.w = __builtin_amdgcn_rcpf(d.w);
    return (a * r) * b; }
struct EpiSguIn {
    bf16* U; bf16* V; const float* bias; float* VSS;
    __device__ __forceinline__ void operator()(f32x4 (&acc)[2][2][4][2], const pg8::Unit& u, int wr, int wc, int fr, int fq, const LAS unsigned* rec = nullptr) const {
        const int col0 = u.pn * 256 + wc * 32 + 8 * fq, row0 = u.pm * 256 + wr * 64 + fr; const bool isv = u.pn >= 12;
        bf16* dstb = isv ? V + (col0 - SGW) : U + col0;
        f32x4 bv[2][2];
#pragma unroll
        for (int bj = 0; bj < 2; ++bj)
#pragma unroll
            for (int n = 0; n < 2; ++n) bv[bj][n] = *(const f32x4*)(bias + col0 + bj * 128 + 4 * n);
#pragma unroll
        for (int ai = 0; ai < 2; ++ai)
#pragma unroll
            for (int m = 0; m < 4; ++m) { const int row = row0 + ai * 128 + m * 16; float ss = 0.f;
#pragma unroll
                for (int bj = 0; bj < 2; ++bj) { const f32x4 z0 = gelu4(acc[ai][bj][m][0] + bv[bj][0]), z1 = gelu4(acc[ai][bj][m][1] + bv[bj][1]);
                    { const f32x4 q2 = z0 * z0 + z1 * z1; ss += (q2.x + q2.y) + (q2.z + q2.w); }
                    u32x4 w; w.x = pg8::cvt_pk_bf16(z0.x, z0.y); w.y = pg8::cvt_pk_bf16(z0.z, z0.w); w.z = pg8::cvt_pk_bf16(z1.x, z1.y); w.w = pg8::cvt_pk_bf16(z1.z, z1.w);
                    *(u32x4*)(dstb + (size_t)row * SGW + bj * 128) = w; }
                if (isv) { ss += __shfl_xor(ss, 16); ss += __shfl_xor(ss, 32); if (fq == 0) VSS[(size_t)row * 48 + (u.pn - 12) * 4 + wc] = ss; } }
    }
};
struct EpiMoeGU {
    bf16* ACT;
    __device__ __forceinline__ void operator()(f32x4 (&acc)[2][2][4][2], const pg8::Unit& u, int wr, int wc, int fr, int fq, const LAS unsigned* rec = nullptr) const {
        const int col0 = u.pn * 128 + wc * 32 + 8 * fq, row0 = u.x2 + u.pm * 256 + wr * 64 + fr;
#pragma unroll
        for (int ai = 0; ai < 2; ++ai)
#pragma unroll
            for (int m = 0; m < 4; ++m) { const f32x4 a0 = silu_mul4(acc[ai][0][m][0], acc[ai][1][m][0]), a1 = silu_mul4(acc[ai][0][m][1], acc[ai][1][m][1]);
                u32x4 w; w.x = pg8::cvt_pk_bf16(a0.x, a0.y); w.y = pg8::cvt_pk_bf16(a0.z, a0.w); w.z = pg8::cvt_pk_bf16(a1.x, a1.y); w.w = pg8::cvt_pk_bf16(a1.z, a1.w);
                *(u32x4*)(ACT + (size_t)(row0 + ai * 128 + m * 16) * EW + col0) = w; }
    }
};
struct EpiMoeDn {
    bf16* Y; const int* LIST; const float* WT;
    __device__ __forceinline__ void operator()(f32x4 (&acc)[2][2][4][2], const pg8::Unit& u, int wr, int wc, int fr, int fq, const LAS unsigned* rec = nullptr) const {
        const int col0 = u.pn * 256 + wc * 32 + 8 * fq;
        const LAS unsigned long long* rl = (const LAS unsigned long long*)rec;
#pragma unroll
        for (int ai = 0; ai < 2; ++ai) {
#pragma unroll
            for (int m = 0; m < 4; ++m) { const int pit = ai * 128 + wr * 64 + m * 16 + fr, pos = u.pm * 256 + pit; const unsigned long long rc = rl[pit]; const int ent = pos < u.x1 ? (int)(unsigned)rc : -1;
                if (ent >= 0) { const float w8 = __builtin_bit_cast(float, (unsigned)(rc >> 32));
#pragma unroll
                    for (int bj = 0; bj < 2; ++bj) { const f32x4 a0 = acc[ai][bj][m][0] * w8, a1 = acc[ai][bj][m][1] * w8;
                        u32x4 w; w.x = pg8::cvt_pk_bf16(a0.x, a0.y); w.y = pg8::cvt_pk_bf16(a0.z, a0.w); w.z = pg8::cvt_pk_bf16(a1.x, a1.y); w.w = pg8::cvt_pk_bf16(a1.z, a1.w);
                        *(u32x4*)(Y + (size_t)ent * D + col0 + bj * 128) = w; } } }
        }
    }
};
__device__ __forceinline__ int moe_tab(Frame& F, int l, LAS int* tab) {
    __syncthreads();
    if (F.tid == 0) { int tiles = 0, base = 0;
        for (int e = 0; e < 16; ++e) { const int c = (int)__hip_atomic_load(fctl(F) + CW_CNT + l * 1024 + e * 64, RLX_AGENT); tab[e * 4] = tiles; tab[e * 4 + 1] = c; tab[e * 4 + 2] = base; tab[e * 4 + 3] = 0; tiles += (c + 255) >> 8; base += (c + 255) & ~255; }
        tab[64] = tiles; }
    __syncthreads();
    return tab[64];
}


typedef short bf16x8 __attribute__((ext_vector_type(8)));
typedef short s16x4 __attribute__((ext_vector_type(4)));
typedef short v4i16_t __attribute__((ext_vector_type(4)));
__device__ __forceinline__ s16x4 tr_read(const LAS unsigned char* p) { return __builtin_bit_cast(s16x4, __builtin_amdgcn_ds_read_tr16_b64_v4i16((LAS v4i16_t*)p)); }
__device__ __forceinline__ bf16x8 cat8(s16x4 a, s16x4 b) { return (bf16x8){a[0], a[1], a[2], a[3], b[0], b[1], b[2], b[3]}; }
__device__ __forceinline__ bf16x8 pk8(f32x4 a, f32x4 b) { u32x4 w; w.x = pg8::cvt_pk_bf16(a.x, a.y); w.y = pg8::cvt_pk_bf16(a.z, a.w); w.z = pg8::cvt_pk_bf16(b.x, b.y); w.w = pg8::cvt_pk_bf16(b.z, b.w); return __builtin_bit_cast(bf16x8, w); }
#define MFMA16(a, b, c) __builtin_amdgcn_mfma_f32_16x16x32_bf16((a), (b), (c), 0, 0, 0)
constexpr int VST = 144;
constexpr size_t A_KV = 148 * MiB;

__device__ __forceinline__ void ph_na(Frame& F) {
    const bf16* NK = (const bf16*)(fA(F) + A_NK); const bf16* NV = (const bf16*)(fA(F) + A_NV); const bf16* NQ = (const bf16*)(fA(F) + A_NQ); bf16* MIX = (bf16*)(fA(F) + A_MIX);
    LAS unsigned char* Vl = F.lds;
    LAS float* mrg = (LAS float*)(F.lds + 832 * VST);
    LAS float* rpbl = (LAS float*)(F.lds + 832 * VST + 4 * 1056 * 4);
    const int lane = F.lane, wave = F.wave, sb = wave & 3, half = wave >> 2, q16 = lane & 15, rq = lane >> 4;
    const int tq = (lane & 15) >> 2, tp = lane & 3;
    const int vcol = F.tid >> 3, vch = F.tid & 7;
    const float L2E = 1.44269504f;
    const int w0 = sb == 0 ? 0 : (sb == 1 ? 8 : (sb == 2 ? 24 : 32));
    for (int tg0 = blockIdx.x; tg0 < 256; tg0 += gridDim.x) {
        const int tg = (gridDim.x == 256) ? ((tg0 & 7) * 32 + (tg0 >> 3)) : tg0;
        const int bh = tg >> 3, b = bh >> 3, h = bh & 7, rbase = (tg & 7) * 8;
        __syncthreads();
#pragma unroll
        for (int pass = 0; pass < 4; ++pass) { const int n = pass * 64 + vcol;
            *(LAS u32x4*)(Vl + (576 + n) * VST + vch * 16) = *(const u32x4*)(NV + ((size_t)(NTOK + b * CTXL + n)) * HW + h * 64 + vch * 8); }
        for (int i = F.tid; i < 465; i += NTHREADS) rpbl[i] = F.a.in[I_RPB][h * 465 + i];
        { int r0 = rbase - 4; r0 = r0 < 0 ? 0 : (r0 > 56 ? 56 : r0);
#pragma unroll
          for (int k8 = 0; k8 < 8; ++k8) { const int kr = r0 + k8;
              *(LAS u32x4*)(Vl + ((kr % 9) * 64 + vcol) * VST + vch * 16) = *(const u32x4*)(NV + ((size_t)(b * SEQ + kr * 64 + vcol)) * HW + h * 64 + vch * 8); } }
        bf16x8 kfc[8][2];
#pragma unroll
        for (int cb = 0; cb < 8; ++cb) { const bf16* kp = NK + ((size_t)(NTOK + b * CTXL + 128 * half + 16 * cb + q16)) * HW + h * 64 + 8 * rq; kfc[cb][0] = *(const bf16x8*)kp; kfc[cb][1] = *(const bf16x8*)(kp + 32); }
        __syncthreads();
#pragma unroll 1
        for (int ti = 0; ti < 8; ++ti) {
            const int r = rbase + ti; int r0 = r - 4; r0 = r0 < 0 ? 0 : (r0 > 56 ? 56 : r0);
            int r0n = r - 3; r0n = r0n < 0 ? 0 : (r0n > 56 ? 56 : r0n);
            const bool newrow = (ti < 7) && (r0n != r0); const int krn = r0n + 7;
            const int c = 16 * sb + q16; const size_t qrow = (size_t)b * SEQ + r * 64 + c;
            int c0 = c - 8; c0 = c0 < 0 ? 0 : (c0 > 48 ? 48 : c0);
            bf16x8 qf[2], kfl[8][2];
#pragma unroll
            for (int ks = 0; ks < 2; ++ks) qf[ks] = *(const bf16x8*)(NQ + qrow * HW + h * 64 + 8 * rq + 32 * ks);
#pragma unroll
            for (int lb = 0; lb < 8; ++lb) { const int kr = r0 + 4 * half + (lb >> 1), cb = w0 + 16 * (lb & 1);
                const bf16* kp = NK + ((size_t)(b * SEQ + kr * 64 + cb + q16)) * HW + h * 64 + 8 * rq; kfl[lb][0] = *(const bf16x8*)kp; kfl[lb][1] = *(const bf16x8*)(kp + 32); }
            u32x4 vnext = {0u, 0u, 0u, 0u};
            if (newrow) vnext = *(const u32x4*)(NV + ((size_t)(b * SEQ + krn * 64 + vcol)) * HW + h * 64 + vch * 8);
            f32x4 sc[16];
#pragma unroll
            for (int cb = 0; cb < 8; ++cb) { f32x4 a = MFMA16(kfc[cb][0], qf[0], ((f32x4){0.f, 0.f, 0.f, 0.f})); a = MFMA16(kfc[cb][1], qf[1], a); sc[8 + cb] = a; }
#pragma unroll
            for (int lb = 0; lb < 8; ++lb) { const int kr = r0 + 4 * half + (lb >> 1), cb = w0 + 16 * (lb & 1);
                f32x4 a = MFMA16(kfl[lb][0], qf[0], ((f32x4){0.f, 0.f, 0.f, 0.f})); a = MFMA16(kfl[lb][1], qf[1], a);
#pragma unroll
                for (int g = 0; g < 4; ++g) { const int kc = cb + 4 * rq + g; const bool valid = (kc >= c0) && (kc <= c0 + 15);
                    const int bi = valid ? ((kr - r + 7) * 31 + (kc - c + 15)) : 0;
                    a[g] = valid ? a[g] + rpbl[bi] : -1e30f; }
                sc[lb] = a; }
            float m = -1e30f;
#pragma unroll
            for (int i = 0; i < 16; ++i) m = fmaxf(fmaxf(m, fmaxf(sc[i].x, sc[i].y)), fmaxf(sc[i].z, sc[i].w));
            m = fmaxf(m, __shfl_xor(m, 16)); m = fmaxf(m, __shfl_xor(m, 32));
            float l = 0.f;
#pragma unroll
            for (int i = 0; i < 16; ++i) {
#pragma unroll
                for (int g = 0; g < 4; ++g) { const float p = __builtin_amdgcn_exp2f((sc[i][g] - m) * L2E); sc[i][g] = p; l += p; } }
            l += __shfl_xor(l, 16); l += __shfl_xor(l, 32);
            f32x4 o[4];
#pragma unroll
            for (int eb = 0; eb < 4; ++eb) o[eb] = (f32x4){0.f, 0.f, 0.f, 0.f};
#pragma unroll
            for (int ks = 0; ks < 8; ++ks) {
                const bf16x8 pf = pk8(sc[2 * ks], sc[2 * ks + 1]);
                int rowA;
                if (ks < 4) { const int kr = r0 + 4 * half + ks; rowA = (kr % 9) * 64 + w0; }
                else rowA = 576 + 128 * half + 32 * (ks - 4);
                const LAS unsigned char* pa = Vl + (rowA + 4 * rq + tq) * VST + 8 * tp; const LAS unsigned char* pb = pa + 16 * VST;
#pragma unroll
                for (int eb = 0; eb < 4; ++eb) { const bf16x8 vf = cat8(tr_read(pa + 32 * eb), tr_read(pb + 32 * eb)); o[eb] = MFMA16(vf, pf, o[eb]); }
            }
            LAS float* mw = mrg + sb * 1056;
            const bool merger = (half == (ti & 1));
            if (!merger) {
                if (rq == 0) { mw[q16] = m; mw[16 + q16] = l; }
#pragma unroll
                for (int eb = 0; eb < 4; ++eb)
#pragma unroll
                    for (int g = 0; g < 4; ++g) mw[32 + (16 * eb + 4 * rq + g) * 16 + q16] = o[eb][g];
            }
            if (newrow) *(LAS u32x4*)(Vl + ((krn % 9) * 64 + vcol) * VST + vch * 16) = vnext;
            __syncthreads();
            if (merger) {
                const float m2 = mw[q16], l2 = mw[16 + q16];
                const float mn = fmaxf(m, m2), a1 = __builtin_amdgcn_exp2f((m - mn) * L2E), a2 = __builtin_amdgcn_exp2f((m2 - mn) * L2E);
                const float inv = 1.f / (l * a1 + l2 * a2);
#pragma unroll
                for (int eb = 0; eb < 4; ++eb) { f32x4 v;
#pragma unroll
                    for (int g = 0; g < 4; ++g) v[g] = (o[eb][g] * a1 + mw[32 + (16 * eb + 4 * rq + g) * 16 + q16] * a2) * inv;
                    u32x2 w; w.x = pg8::cvt_pk_bf16(v.x, v.y); w.y = pg8::cvt_pk_bf16(v.z, v.w);
                    *(u32x2*)(MIX + qrow * D + 512 + h * 64 + 16 * eb + 4 * rq) = w; }
            }
        }
    }
    __syncthreads();
}

__device__ __forceinline__ void ph_kvstate(Frame& F) {
    const bf16* RK = (const bf16*)(fA(F) + A_RK); const bf16* RV = (const bf16*)(fA(F) + A_RV); float* KV = (float*)(fA(F) + A_KV);
    LAS unsigned char* Kt = F.lds; LAS unsigned char* Vf = F.lds + 128 * VST; LAS unsigned char* Vb = F.lds + 256 * VST;
    const int lane = F.lane, wave = F.wave, rq = lane >> 4, tq = (lane & 15) >> 2, tp = lane & 3, db = wave & 3, ep = wave >> 2;
    for (int it = blockIdx.x; it < NB * NH * 34; it += gridDim.x) {
        const int cc = it % 34, bh = it / 34, b = bh >> 3, h = bh & 7;
        const float lgf = ret_gamma_log(F, 0, h) * 1.44269504f, lgb = ret_gamma_log(F, 1, h) * 1.44269504f;
        const size_t row0 = cc < 32 ? (size_t)b * SEQ + cc * 128 : (size_t)NTOK + b * CTXL + (cc - 32) * 128;
        __syncthreads();
#pragma unroll
        for (int pass = 0; pass < 2; ++pass) { const int j = pass * 64 + (F.tid >> 3), ch = F.tid & 7;
            *(LAS u32x4*)(Kt + j * VST + ch * 16) = *(const u32x4*)(RK + (row0 + j) * HW + h * 64 + ch * 8);
            const u32x4 v = *(const u32x4*)(RV + (row0 + j) * HW + h * 64 + ch * 8);
            const float wf = __builtin_amdgcn_exp2f(lgf * (float)(127 - j)), wb = __builtin_amdgcn_exp2f(lgb * (float)j);
            const unsigned vv[4] = { v.x, v.y, v.z, v.w }; u32x4 of, ob; unsigned rf[4], rb[4];
#pragma unroll
            for (int q = 0; q < 4; ++q) { const float lo = bf2f(vv[q] & 0xffffu), hi = bf2f(vv[q] >> 16); rf[q] = pg8::cvt_pk_bf16(lo * wf, hi * wf); rb[q] = pg8::cvt_pk_bf16(lo * wb, hi * wb); }
            of.x = rf[0]; of.y = rf[1]; of.z = rf[2]; of.w = rf[3]; ob.x = rb[0]; ob.y = rb[1]; ob.z = rb[2]; ob.w = rb[3];
            *(LAS u32x4*)(Vf + j * VST + ch * 16) = of; *(LAS u32x4*)(Vb + j * VST + ch * 16) = ob; }
        __syncthreads();
        f32x4 acc[2][2];
#pragma unroll
        for (int d = 0; d < 2; ++d)
#pragma unroll
            for (int e = 0; e < 2; ++e) acc[d][e] = (f32x4){0.f, 0.f, 0.f, 0.f};
#pragma unroll
        for (int ks = 0; ks < 4; ++ks) {
            const int rbase = 32 * ks + 8 * rq + tq;
            const bf16x8 kf = cat8(tr_read(Kt + rbase * VST + (16 * db + 4 * tp) * 2), tr_read(Kt + (rbase + 4) * VST + (16 * db + 4 * tp) * 2));
#pragma unroll
            for (int e2 = 0; e2 < 2; ++e2) { const int eoff = (16 * (2 * ep + e2) + 4 * tp) * 2;
                const bf16x8 vf = cat8(tr_read(Vf + rbase * VST + eoff), tr_read(Vf + (rbase + 4) * VST + eoff));
                const bf16x8 vb = cat8(tr_read(Vb + rbase * VST + eoff), tr_read(Vb + (rbase + 4) * VST + eoff));
                acc[0][e2] = MFMA16(kf, vf, acc[0][e2]); acc[1][e2] = MFMA16(kf, vb, acc[1][e2]); }
        }
        float* kvp = KV + (size_t)it * 2 * 4096;
#pragma unroll
        for (int d = 0; d < 2; ++d)
#pragma unroll
            for (int e2 = 0; e2 < 2; ++e2) *(f32x4*)(kvp + d * 4096 + (16 * (2 * ep + e2) + (lane & 15)) * 64 + 16 * db + 4 * rq) = acc[d][e2];
    }
    __syncthreads();
}

__device__ __forceinline__ void ph_retout(Frame& F, int mode = 0) {
    const bf16* RK = (const bf16*)(fA(F) + A_RK); const bf16* RV = (const bf16*)(fA(F) + A_RV); const bf16* RQ = (const bf16*)(fA(F) + A_RQ); const bf16* GT = (const bf16*)(fA(F) + A_GT);
    const float* KV = (const float*)(fA(F) + A_KV); bf16* MIX = (bf16*)(fA(F) + A_MIX);
    LAS unsigned char* Vl = F.lds;
    LAS unsigned char* SF = F.lds + 4 * 128 * VST;
    LAS unsigned char* SB = SF + 4 * 64 * VST;
    const int lane = F.lane, wave = F.wave, q16 = lane & 15, rq = lane >> 4, tq = (lane & 15) >> 2, tp = lane & 3;
    for (int g0 = blockIdx.x; g0 < 256; g0 += gridDim.x) {
        const int g = (gridDim.x == 256) ? ((g0 & 7) * 32 + (g0 >> 3)) : g0;
        const int bh = g >> 3, b = bh >> 3, h = bh & 7, c0 = (g & 7) * 4;
        const float lnf = ret_gamma_log(F, 0, h), lnb = ret_gamma_log(F, 1, h);
        const float lgf = lnf * 1.44269504f, lgb = lnb * 1.44269504f;
        const float gf128 = __builtin_amdgcn_exp2f(lgf * 128.f), gb128 = __builtin_amdgcn_exp2f(lgb * 128.f);
        const float* kvb = KV + (size_t)bh * 34 * 2 * 4096 + F.tid * 8;
#define KVP(cc, dir) (kvb + ((size_t)(cc) * 2 + (dir)) * 4096)
        f32x4 sf0 = {0.f, 0.f, 0.f, 0.f}, sf1 = sf0, sb0 = sf0, sb1 = sf0;
#pragma unroll 8
        for (int cp = 0; cp < (mode == 2 ? 0 : 32); ++cp) {
            const bool isf = cp < c0, isb = cp >= c0 + 4;
            const float wf_ = isf ? __builtin_amdgcn_exp2f(lgf * 128.f * (float)(c0 - 1 - cp)) : 0.f, wb_ = isb ? __builtin_amdgcn_exp2f(lgb * 128.f * (float)(cp - c0 - 4)) : 0.f;
            const float* p = KVP(cp, isf ? 0 : 1);
            const f32x4 a0 = *(const f32x4*)p, a1 = *(const f32x4*)(p + 4);
            sf0 = sf0 + a0 * wf_; sf1 = sf1 + a1 * wf_; sb0 = sb0 + a0 * wb_; sb1 = sb1 + a1 * wb_;
        }
        { const f32x4 a0 = *(const f32x4*)KVP(32, 0), a1 = *(const f32x4*)(KVP(32, 0) + 4), b0 = *(const f32x4*)KVP(33, 0), b1 = *(const f32x4*)(KVP(33, 0) + 4);
          const float wc = __builtin_amdgcn_exp2f(lgf * 128.f * (float)c0);
          sf0 = sf0 + (a0 * gf128 + b0) * wc; sf1 = sf1 + (a1 * gf128 + b1) * wc; }
        { const f32x4 a0 = *(const f32x4*)KVP(33, 1), a1 = *(const f32x4*)(KVP(33, 1) + 4), b0 = *(const f32x4*)KVP(32, 1), b1 = *(const f32x4*)(KVP(32, 1) + 4);
          const float wc = __builtin_amdgcn_exp2f(lgb * 128.f * (float)(28 - c0));
          sb0 = sb0 + (a0 * gb128 + b0) * wc; sb1 = sb1 + (a1 * gb128 + b1) * wc; }
        __syncthreads();
        const int se = F.tid >> 3, sd = (F.tid & 7) * 8;
#pragma unroll
        for (int k = 3; k >= 0; --k) {
            *(LAS u32x4*)(SB + k * 64 * VST + se * VST + sd * 2) = __builtin_bit_cast(u32x4, pk8(sb0, sb1));
            if (k > 0) { const f32x4 a0 = *(const f32x4*)KVP(c0 + k, 1), a1 = *(const f32x4*)(KVP(c0 + k, 1) + 4); sb0 = sb0 * gb128 + a0; sb1 = sb1 * gb128 + a1; }
        }
#pragma unroll
        for (int k = 0; k < 4; ++k) {
            *(LAS u32x4*)(SF + k * 64 * VST + se * VST + sd * 2) = __builtin_bit_cast(u32x4, pk8(sf0, sf1));
            if (k < 3) { const f32x4 a0 = *(const f32x4*)KVP(c0 + k, 0), a1 = *(const f32x4*)(KVP(c0 + k, 0) + 4); sf0 = sf0 * gf128 + a0; sf1 = sf1 * gf128 + a1; }
        }
        if (mode != 2)
#pragma unroll
        for (int pass = 0; pass < 8; ++pass) { const int j = pass * 64 + (F.tid >> 3), ch = F.tid & 7;
            *(LAS u32x4*)(Vl + j * VST + ch * 16) = *(const u32x4*)(RV + ((size_t)b * SEQ + c0 * 128 + j) * HW + h * 64 + ch * 8); }
        __syncthreads();
        if (mode == 1) continue;
        const int k = wave >> 1; const size_t row0 = (size_t)b * SEQ + (c0 + k) * 128;
        bf16x8 kf[8][2];
#pragma unroll
        for (int jb = 0; jb < 8; ++jb) { const bf16* kp = RK + (row0 + 16 * jb + q16) * HW + h * 64 + 8 * rq; kf[jb][0] = *(const bf16x8*)kp; kf[jb][1] = *(const bf16x8*)(kp + 32); }
        const LAS unsigned char* Vc = Vl + k * 128 * VST; const LAS unsigned char* SFc = SF + k * 64 * VST; const LAS unsigned char* SBc = SB + k * 64 * VST;
#pragma unroll 1
        for (int qb = 0; qb < 4; ++qb) {
            const int i = 64 * (wave & 1) + 16 * qb + q16; const size_t qrow = row0 + i;
            bf16x8 qf[2];
#pragma unroll
            for (int ks = 0; ks < 2; ++ks) qf[ks] = *(const bf16x8*)(RQ + qrow * HW + h * 64 + 8 * rq + 32 * ks);
            const float qfd = __builtin_amdgcn_exp2f(lgf * (float)(i + 1)), qbd = __builtin_amdgcn_exp2f(lgb * (float)(128 - i));
            f32x4 o[4];
#pragma unroll
            for (int eb = 0; eb < 4; ++eb) {
                f32x4 t1 = {0.f, 0.f, 0.f, 0.f}, t2 = {0.f, 0.f, 0.f, 0.f};
#pragma unroll
                for (int ks = 0; ks < 2; ++ks) {
                    const bf16x8 s1 = *(const LAS bf16x8*)(SFc + (16 * eb + q16) * VST + (8 * rq + 32 * ks) * 2);
                    const bf16x8 s2 = *(const LAS bf16x8*)(SBc + (16 * eb + q16) * VST + (8 * rq + 32 * ks) * 2);
                    t1 = MFMA16(s1, qf[ks], t1); t2 = MFMA16(s2, qf[ks], t2); }
                o[eb] = t1 * qfd + t2 * qbd; }
            __builtin_amdgcn_sched_barrier(0);
            f32x4 sc[8];
#pragma unroll
            for (int jb = 0; jb < 8; ++jb) {
                f32x4 a = MFMA16(kf[jb][0], qf[0], ((f32x4){0.f, 0.f, 0.f, 0.f})); a = MFMA16(kf[jb][1], qf[1], a);
#pragma unroll
                for (int gq = 0; gq < 4; ++gq) { const int j = 16 * jb + 4 * rq + gq;
                    const float wgt = j < i ? __builtin_amdgcn_exp2f(lgf * (float)(i - j)) : (j > i ? __builtin_amdgcn_exp2f(lgb * (float)(j - i)) : 2.f);
                    a[gq] *= wgt; }
                sc[jb] = a; }
            __builtin_amdgcn_sched_barrier(0);
#pragma unroll
            for (int ks = 0; ks < 4; ++ks) {
                const bf16x8 pf = pk8(sc[2 * ks], sc[2 * ks + 1]);
                const LAS unsigned char* pa = Vc + (32 * ks + 4 * rq + tq) * VST + 8 * tp; const LAS unsigned char* pb = pa + 16 * VST;
#pragma unroll
                for (int eb = 0; eb < 4; ++eb) { const bf16x8 vf = cat8(tr_read(pa + 32 * eb), tr_read(pb + 32 * eb)); o[eb] = MFMA16(vf, pf, o[eb]); }
            }
            __builtin_amdgcn_sched_barrier(0);
            u32x2 gt[4];
#pragma unroll
            for (int eb = 0; eb < 4; ++eb) gt[eb] = *(const u32x2*)(GT + qrow * HW + h * 64 + 16 * eb + 4 * rq);
            float ss = 0.f;
#pragma unroll
            for (int eb = 0; eb < 4; ++eb) { ss += (o[eb].x * o[eb].x + o[eb].y * o[eb].y) + (o[eb].z * o[eb].z + o[eb].w * o[eb].w); }
            ss += __shfl_xor(ss, 16); ss += __shfl_xor(ss, 32);
            const float rs = rsqrtf(ss * (1.f / 64.f) + EPS);
#pragma unroll
            for (int eb = 0; eb < 4; ++eb) { const int e0 = 16 * eb + 4 * rq;
                const f32x4 gg = *(const f32x4*)(F.a.in[I_RNG] + e0);
                const f32x4 gv = { bf2f(gt[eb].x & 0xffffu), bf2f(gt[eb].x >> 16), bf2f(gt[eb].y & 0xffffu), bf2f(gt[eb].y >> 16) };
                const f32x4 v = o[eb] * rs * gg * gv;
                u32x2 w; w.x = pg8::cvt_pk_bf16(v.x, v.y); w.y = pg8::cvt_pk_bf16(v.z, v.w);
                if (mode == 0) *(u32x2*)(MIX + qrow * D + h * 64 + e0) = w; else asm volatile("" :: "v"(w.x), "v"(w.y)); }
        }
#undef KVP
    }
    __syncthreads();
}

__device__ __forceinline__ void ph_sgumix(Frame& F, bool dry = false) {
    bf16* U = (bf16*)(fA(F) + A_U); const bf16* V = (const bf16*)(fA(F) + A_V); const bf16* WS = (const bf16*)(F.a.ws + WS_WB + WB_WS);
    constexpr int VS2 = 272;
    LAS unsigned char* Vt = F.lds;
    LAS float* rsl = (LAS float*)(F.lds + 128 * VS2);
    const int lane = F.lane, wave = F.wave, q16 = lane & 15, rq = lane >> 4, tq = (lane & 15) >> 2, tp = lane & 3;
    const int ch4 = wave & 1, iq = wave >> 1;
    constexpr int NIT = NB * 32 * 8 * 3;
    const int ipb = (NIT + (int)gridDim.x - 1) / (int)gridDim.x, it0 = (int)blockIdx.x * ipb, it1 = (it0 + ipb) < NIT ? (it0 + ipb) : NIT;
    const int sj = F.tid >> 4, schn = F.tid & 15;
    u32x4 vn[4];
    if (it0 < it1) { const int third = it0 % 3, g = (it0 / 3) & 7, bc = it0 / 24; const size_t row0 = (size_t)bc * 128; const int cg0 = g * 384 + third * 128;
#pragma unroll
        for (int pass = 0; pass < 4; ++pass) vn[pass] = *(const u32x4*)(V + (row0 + pass * 32 + sj) * SGW + cg0 + schn * 8); }
    int prev_bc = -1, prev_g = -1;
    bf16x8 wf[4][2];
    for (int it = it0; it < it1; ++it) {
        const int third = it % 3, g = (it / 3) & 7, bc = it / 24; const size_t row0 = (size_t)bc * 128; const int cg0 = g * 384 + third * 128;
        if (g != prev_g) { prev_g = g;
#pragma unroll
            for (int ks = 0; ks < 4; ++ks)
#pragma unroll
                for (int ib = 0; ib < 2; ++ib) wf[ks][ib] = *(const bf16x8*)(WS + ((size_t)g * 128 + 32 * iq + 16 * ib + q16) * 128 + 32 * ks + 8 * rq); }
        __syncthreads();
        if (bc != prev_bc) { prev_bc = bc;
            if (F.tid < 128) { const float* vp = fvss(F) + (row0 + F.tid) * 48; float sacc = 0.f;
#pragma unroll
                for (int j = 0; j < 48; j += 4) { const f32x4 t = *(const f32x4*)(vp + j); sacc += (t.x + t.y) + (t.z + t.w); }
                rsl[F.tid] = rsqrtf(sacc * (1.f / SGW) + EPS); }
            __syncthreads(); }
#pragma unroll
        for (int pass = 0; pass < 4; ++pass) { const int j = pass * 32 + sj; const float rs = rsl[j];
            const unsigned vv[4] = { vn[pass].x, vn[pass].y, vn[pass].z, vn[pass].w }; unsigned ro[4];
#pragma unroll
            for (int q = 0; q < 4; ++q) ro[q] = pg8::cvt_pk_bf16(bf2f(vv[q] & 0xffffu) * rs, bf2f(vv[q] >> 16) * rs);
            u32x4 o; o.x = ro[0]; o.y = ro[1]; o.z = ro[2]; o.w = ro[3];
            *(LAS u32x4*)(Vt + j * VS2 + schn * 16) = o; }
        __syncthreads();
        if (it + 1 < it1) { const int n = it + 1, t2 = n % 3, g2 = (n / 3) & 7, bc2 = n / 24; const size_t r2 = (size_t)bc2 * 128; const int c2 = g2 * 384 + t2 * 128;
#pragma unroll
            for (int pass = 0; pass < 4; ++pass) vn[pass] = *(const u32x4*)(V + (r2 + pass * 32 + sj) * SGW + c2 + schn * 8); }
        u32x4 uu[2][2];
#pragma unroll
        for (int ib = 0; ib < 2; ++ib)
#pragma unroll
            for (int cb2 = 0; cb2 < 2; ++cb2) uu[ib][cb2] = *(const u32x4*)(U + (row0 + 32 * iq + 16 * ib + q16) * SGW + cg0 + 64 * ch4 + 32 * cb2 + 8 * rq);
        f32x4 ngv[2][2]; float bsv[2];
#pragma unroll
        for (int cb2 = 0; cb2 < 2; ++cb2) { const int cgl = cg0 + 64 * ch4 + 32 * cb2 + 8 * rq; ngv[cb2][0] = *(const f32x4*)(F.a.in[I_SNG] + cgl); ngv[cb2][1] = *(const f32x4*)(F.a.in[I_SNG] + cgl + 4); }
#pragma unroll
        for (int ib = 0; ib < 2; ++ib) bsv[ib] = F.a.in[I_SBS][g * 128 + 32 * iq + 16 * ib + q16];
        f32x4 acc[4][2];
#pragma unroll
        for (int cb = 0; cb < 4; ++cb)
#pragma unroll
            for (int ib = 0; ib < 2; ++ib) acc[cb][ib] = (f32x4){0.f, 0.f, 0.f, 0.f};
#pragma unroll
        for (int ks = 0; ks < 4; ++ks) {
            const int rb = 32 * ks + 8 * rq + tq;
#pragma unroll
            for (int cb = 0; cb < 4; ++cb) { const int coff = (64 * ch4 + 32 * (cb >> 1) + 8 * tp + 4 * (cb & 1)) * 2;
                const bf16x8 vf = cat8(tr_read(Vt + rb * VS2 + coff), tr_read(Vt + (rb + 4) * VS2 + coff));
#pragma unroll
                for (int ib = 0; ib < 2; ++ib) acc[cb][ib] = MFMA16(vf, wf[ks][ib], acc[cb][ib]); }
        }
#pragma unroll
        for (int ib = 0; ib < 2; ++ib) { const int i = 32 * iq + 16 * ib + q16; const float bs = bsv[ib];
#pragma unroll
            for (int cb2 = 0; cb2 < 2; ++cb2) { const int cgl = cg0 + 64 * ch4 + 32 * cb2 + 8 * rq;
                const f32x4 ng0 = ngv[cb2][0], ng1 = ngv[cb2][1]; bf16* up = U + (row0 + i) * SGW + cgl; const u32x4 u4 = uu[ib][cb2];
                const f32x4 uv0 = { bf2f(u4.x & 0xffffu), bf2f(u4.x >> 16), bf2f(u4.y & 0xffffu), bf2f(u4.y >> 16) }, uv1 = { bf2f(u4.z & 0xffffu), bf2f(u4.z >> 16), bf2f(u4.w & 0xffffu), bf2f(u4.w >> 16) };
                const f32x4 r0 = dry ? uv0 + acc[2 * cb2][ib] * 0.f : uv0 * (acc[2 * cb2][ib] * ng0 + bs), r1 = dry ? uv1 + acc[2 * cb2 + 1][ib] * 0.f : uv1 * (acc[2 * cb2 + 1][ib] * ng1 + bs);
                u32x4 w; w.x = pg8::cvt_pk_bf16(r0.x, r0.y); w.y = pg8::cvt_pk_bf16(r0.z, r0.w); w.z = pg8::cvt_pk_bf16(r1.x, r1.y); w.w = pg8::cvt_pk_bf16(r1.z, r1.w); *(u32x4*)up = w; } }
    }
    __syncthreads();
}

__device__ __forceinline__ void ph_mod2(Frame& F) {
    LAS float* sv = (LAS float*)F.lds; LAS float* red = sv + 5 * 1024;
    for (int i = F.tid; i < 5 * 1024; i += NTHREADS) { const int r = i >> 10, k = i & 1023; const float c = r < 4 ? F.a.in[I_C][r * 1024 + k] : F.a.in[I_CCTX][k]; sv[i] = siluf(c); }
    __syncthreads();
    for (int item = blockIdx.x; item < 192; item += gridDim.x) {
        const int l = item / 96, n0 = (item % 96) * 64, k0 = F.wave * 128;
        const float* W = F.a.in[I_ADAW] + (size_t)l * D * 6144 + n0 + F.lane + (size_t)k0 * 6144;
        float a0 = 0.f, a1 = 0.f, a2 = 0.f, a3 = 0.f, a4 = 0.f;
#pragma unroll 16
        for (int k = 0; k < 128; ++k) { const float w = W[(size_t)k * 6144];
            a0 += sv[k0 + k] * w; a1 += sv[1024 + k0 + k] * w; a2 += sv[2048 + k0 + k] * w; a3 += sv[3072 + k0 + k] * w; a4 += sv[4096 + k0 + k] * w; }
        red[(F.wave * 5 + 0) * 64 + F.lane] = a0; red[(F.wave * 5 + 1) * 64 + F.lane] = a1; red[(F.wave * 5 + 2) * 64 + F.lane] = a2; red[(F.wave * 5 + 3) * 64 + F.lane] = a3; red[(F.wave * 5 + 4) * 64 + F.lane] = a4;
        __syncthreads();
        if (F.wave < 5) { const int r = F.wave; float sacc = 0.f;
#pragma unroll
            for (int w = 0; w < 8; ++w) sacc += red[(w * 5 + r) * 64 + F.lane];
            sacc += F.a.in[I_ADAB][l * 6144 + n0 + F.lane];
            if (r < 4) fmod(F)[(l * 4 + r) * 6144 + n0 + F.lane] = sacc; else if (l == 0 && n0 < 2048) fmodc(F)[n0 + F.lane] = sacc; }
        __syncthreads();
    }
    const int gt = F.gw * 64 + F.lane, ngt = F.ngw * 64;
    for (int it = gt; it < 64 * 16; it += ngt) {
        const int pos = it >> 4, j = it & 15;
        const float inv = powf(10000.0f, -(float)j / 16.0f);
        const float ang = (float)pos * inv;
        frope(F)[it * 2] = cosf(ang); frope(F)[it * 2 + 1] = sinf(ang);
    }
}
__device__ __forceinline__ void late_convert(Frame& F, int units, int pct_lo, int pct_hi, int set = 1) {
    const int G = (int)gridDim.x, rounds = (units + G - 1) / G, rem = units - (rounds - 1) * G;
    const int first = rem >= G ? 0 : rem, nidle = G - first;
    __syncthreads();
    if ((int)blockIdx.x >= first) ph_convert(F, set, ((int)blockIdx.x - first) * NWAVES + F.wave, nidle * NWAVES, pct_lo, pct_hi);
    __syncthreads();
}
__device__ __forceinline__ void ph_inproj(Frame& F) {
    const DenseSched S{(const char*)fH(F), (const char*)(F.a.ws + WS_WB + WB_WIN), D, 64, 14, (int)gridDim.x, (int)blockIdx.x, 64 * 14, 64, 8, 32};
    LAS float* ropel = (LAS float*)(F.lds + ROPE_OFF);
    for (int i = F.tid; i < 2048; i += NTHREADS) ropel[i] = frope(F)[i];
    __syncthreads();
    const EpiInproj E{fA(F), ropel, F.a.in[I_KG], F.a.in[I_QG]};
    pg8::gemm_phase<DenseSched, EpiInproj, true>(F.lds, D, S, E, F.wave);
    late_convert(F, 64 * 14 + 32, EARLY_PCT, 100, 0);
}
__device__ __forceinline__ void ph_outproj(Frame& F) {
    const DenseSched S{(const char*)(fA(F) + A_MIX), (const char*)(F.a.ws + WS_WB + WB_WOUT), D, 64, 4, (int)gridDim.x, (int)blockIdx.x, 64 * 4, 0, 1, 0};
    const EpiRes<false> E{F.a.in[I_X], (bf16*)(fA(F) + A_X1), fmod(F) + 2 * D, fvss(F)};
    pg8::gemm_phase<DenseSched, EpiRes<false>, false>(F.lds, D, S, E, F.wave);
}
__device__ __forceinline__ void ph_sguin(Frame& F) {
#if STAGGER_US
    if (blockIdx.x & 1) { const unsigned long long t0 = __builtin_amdgcn_s_memrealtime(); while (__builtin_amdgcn_s_memrealtime() - t0 < (unsigned long long)(STAGGER_US * 100)) __builtin_amdgcn_s_sleep(32); }
#endif
    const DenseSched S{(const char*)fH(F), (const char*)(F.a.ws + WS_WB + WB_SWIN), D, 64, 24, (int)gridDim.x, (int)blockIdx.x, 64 * 24, 0, 1, 0};
    const EpiSguIn E{(bf16*)(fA(F) + A_U), (bf16*)(fA(F) + A_V), F.a.in[I_SBIN], fvss(F)};
    pg8::gemm_phase<DenseSched, EpiSguIn, true>(F.lds, D, S, E, F.wave);
}
__device__ __forceinline__ void ph_sguout(Frame& F) {
    const DenseSched S{(const char*)(fA(F) + A_U), (const char*)(F.a.ws + WS_WB + WB_SWOUT), SGW, 64, 4, (int)gridDim.x, (int)blockIdx.x, 64 * 4, 0, 1, 0};
    const EpiRes<true> E{F.a.out, (bf16*)(fA(F) + A_X3), fmod(F) + 4 * 6144 + 2 * D, fvss(F)};
    pg8::gemm_phase<DenseSched, EpiRes<true>, false>(F.lds, SGW, S, E, F.wave);
}

__device__ __forceinline__ void ph_moe_gu(Frame& F, int l) {
    LAS int* tab = (LAS int*)(F.lds + TAB_OFF);
    const int tiles = moe_tab(F, l, tab);
    const MoeSched S{(const char*)fH(F), (const char*)(F.a.ws + WS_WB + WB_GU) + (size_t)l * NE * 1024 * D * 2, D, (int)gridDim.x, (int)blockIdx.x, tiles * 4, tab, flist(F), 1};
    const EpiMoeGU E{(bf16*)(fA(F) + A_ACT)};
    pg8::gemm_phase<MoeSched, EpiMoeGU, true>(F.lds, D, S, E, F.wave);
    if (l == 0) late_convert(F, tiles * 4, 0, 58);
}
__device__ __forceinline__ void ph_moe_dn(Frame& F, int l) {
    LAS int* tab = (LAS int*)(F.lds + TAB_OFF);
    const int tiles = moe_tab(F, l, tab);
    const MoeSched S{(const char*)(fA(F) + A_ACT), (const char*)(F.a.ws + WS_WB + WB_DN) + (size_t)l * NE * D * EW * 2, EW, (int)gridDim.x, (int)blockIdx.x, tiles * 4, tab, flist(F), 0};
    const EpiMoeDn E{(bf16*)(fA(F) + A_Y), flist(F), fwt(F)};
    pg8::gemm_phase<MoeSched, EpiMoeDn, true>(F.lds, EW, S, E, F.wave);
    if (l == 0) late_convert(F, tiles * 4, 58, 100);
}

constexpr int NPHASE = 18;
__global__ void __launch_bounds__(NTHREADS, 2) fwd_kernel(Args args) {
    extern __shared__ __attribute__((aligned(16))) unsigned char lds[];
    const int wave_ = __builtin_amdgcn_readfirstlane((int)threadIdx.x >> 6);
#define MKF() const int lane__ = lane_id_v(); Frame F{(LAS unsigned char*)lds, wave_ * 64 + lane__, lane__, wave_, (int)blockIdx.x * NWAVES + wave_, (int)gridDim.x * NWAVES, args}
    { MKF(); for (int u = F.tid; u < (LDS_BYTES - LDSCTL_OFF) / 4; u += NTHREADS) ((LAS unsigned*)(F.lds + LDSCTL_OFF))[u] = 0u; }
    volatile LAS unsigned* MISC = (volatile LAS unsigned*)((LAS unsigned char*)lds + MISC_OFF);
    __syncthreads();
    unsigned* const ctl_ = (unsigned*)(args.ws + WS_CTL);
    XcdBarrier bar; bar.bar = ctl_ + CW_BAR; bar.x = 0; bar.st = nullptr; bar.wave = wave_;
    if (MK_ONE_LAUNCH) { bar = xcd_barrier_post(ctl_ + CW_BAR, MISC + 8); bar.wave = wave_; }
    const int lo = args.ph_lo, hi = args.ph_hi;
    unsigned long long* TSP = (unsigned long long*)(args.ws + WS_MOD + 512 * 1024);
#define IN(k) (lo <= (k) && (k) < hi)
#define REP(k) for (int _r##k = 0, _r = 0; _r##k < ((k) == REP_PHASE ? REP_N : 1); ++_r##k, _r = _r##k)
#ifdef ONLY_PHASE
#define PHON(k) ((k) == ONLY_PHASE)
#else
#define PHON(k) true
#endif
#define STAMP(k) do { if (TPROBE_A >= 0 && blockIdx.x == 0 && wave_ == 0 && lane_id_v() == 0) TSP[k] = __builtin_amdgcn_s_memrealtime(); } while (0)
#define SEAM(k) do { if (IN(k) && IN((k) + 1)) { xcd_barrier(bar); STAMP((k) + 1); } } while (0)
    STAMP(0);
    if (PHON(0) && IN(0)) REP(0) { MKF(); ph_mod2(F); __syncthreads(); ph_convert(F, 0, F.gw, F.ngw, 0, P0_PCT); __syncthreads(); } SEAM(0);
    if (PHON(1) && IN(1)) REP(1) { MKF(); ph_norm0(F); } SEAM(1);
    if (PHON(2) && IN(2)) REP(2) { MKF(); if (NV_INPROJ) ph_inproj_naive(F); else ph_inproj(F); } SEAM(2);
    if (PHON(3) && IN(3)) REP(3) { MKF(); REP(30) { if (NV_RET) ph_scan_naive(F); else ph_kvstate(F); } REP(31) { if (NV_NA) ph_na_naive(F); else ph_na(F); } } SEAM(3);
    if (PHON(4) && IN(4)) REP(4) { MKF(); if (NV_RET) ph_retout_naive(F); else ph_retout(F, _r > 0 ? RET_MODE : 0); } SEAM(4);
    if (PHON(5) && IN(5)) REP(5) { MKF(); if (NV_OUTPROJ) ph_gemm_res_naive(F, (const bf16*)(fA(F) + A_MIX), D, D, F.a.in[I_WOUT], F.a.in[I_X], fmod(F) + 2 * D); else ph_outproj(F); } SEAM(5);
    if (PHON(6) && IN(6)) REP(6) { MKF(); ph_route(F, 0, _r > 0); ph_convert(F, 0, F.gw, F.ngw, P0_PCT, EARLY_PCT); __syncthreads(); } SEAM(6);
    if (PHON(7) && IN(7)) REP(7) { MKF(); if (NV_MOEGU) ph_moe_gu_naive(F, 0); else ph_moe_gu(F, 0); } SEAM(7);
    if (PHON(8) && IN(8)) REP(8) { MKF(); if (NV_MOEDN) ph_moe_dn_naive(F, 0); else ph_moe_dn(F, 0); } SEAM(8);
    if (PHON(9) && IN(9)) REP(9) { MKF(); ph_combine(F, 0, true, _r > 0); } SEAM(9);
    if (PHON(10) && IN(10)) REP(10) { MKF(); if (NV_SGUIN) ph_sguin_naive(F); else ph_sguin(F); } SEAM(10);
    if (PHON(11) && IN(11)) REP(11) { MKF(); if (NV_SGUMIX) ph_sgumix_naive(F); else ph_sgumix(F, _r > 0); } SEAM(11);
    if (PHON(12) && IN(12)) REP(12) { MKF(); if (NV_SGUOUT) ph_gemm_res_naive(F, (const bf16*)(fA(F) + A_U), SGW, SGW, F.a.in[I_SWOUT], F.a.out, fmod(F) + 4 * 6144 + 2 * D); else ph_sguout(F); } SEAM(12);
    if (PHON(13) && IN(13)) REP(13) { MKF(); ph_route(F, 1, _r > 0); } SEAM(13);
    if (PHON(14) && IN(14)) REP(14) { MKF(); if (NV_MOEGU) ph_moe_gu_naive(F, 1); else ph_moe_gu(F, 1); } SEAM(14);
    if (PHON(15) && IN(15)) REP(15) { MKF(); if (NV_MOEDN) ph_moe_dn_naive(F, 1); else ph_moe_dn(F, 1); } SEAM(15);
    if (PHON(16) && IN(16)) REP(16) { MKF(); ph_combine(F, 1, false, _r > 0); }
    for (int xb = 0; xb < XBAR; ++xb) xcd_barrier(bar);
    if (TPROBE_A >= 0) {
        xcd_barrier(bar); STAMP(17); xcd_barrier(bar);
        const float usA = (float)(TSP[TPROBE_B + 1] - TSP[TPROBE_A]) * 0.01f, usB = (float)(TSP[TPROBE_B + 1] - TSP[TPROBE_B]) * 0.01f;
        const float sc_ = 1.f + 0.02f * floorf((usA + TPROBE_OFF) * (1.f / TPROBE_DIV));
        MKF();
        for (size_t i = (size_t)blockIdx.x * NTHREADS + F.tid; i < (size_t)NTOK * D / 4; i += (size_t)gridDim.x * NTHREADS) { f32x4 v = ((f32x4*)F.a.out)[i]; v = v * sc_; (void)usB; ((f32x4*)F.a.out)[i] = v; }
    }
#undef IN
#undef SEAM
}

extern "C" void kernel_launch(void* const* d_in, const int* in_sizes, int n_in, void* d_out, int out_size, void* d_ws, size_t ws_size, hipStream_t stream) {
    static int grid = 0;
    if (grid == 0) {
        if (n_in != 26 || out_size != NTOK * D || ws_size < WS_END) { fprintf(stderr, "kernel_launch: unexpected shapes n_in %d out %d ws %zu (need %zu)\n", n_in, out_size, ws_size, (size_t)WS_END); grid = -1; return; }
        int dev = 0, cus = 0, per_cu = 0;
        hipGetDevice(&dev); hipDeviceGetAttribute(&cus, hipDeviceAttributeMultiprocessorCount, dev);
        hipFuncSetAttribute((const void*)fwd_kernel, hipFuncAttributeMaxDynamicSharedMemorySize, LDS_BYTES);
        hipOccupancyMaxActiveBlocksPerMultiprocessor(&per_cu, (const void*)fwd_kernel, NTHREADS, LDS_BYTES);
        (void)hipGetLastError();
        if (per_cu < 1) { fprintf(stderr, "kernel_launch: occupancy query says %d blocks/CU\n", per_cu); per_cu = 1; }
        grid = cus;
    }
    if (grid < 0) return;
    hipMemsetAsync((char*)d_ws + WS_CTL, 0, CTL_ZERO_BYTES, stream);
    Args a{};
    for (int i = 0; i < 26; ++i) a.in[i] = (const float*)d_in[i];
    a.out = (float*)d_out; a.ws = (unsigned char*)d_ws;
#if MK_ONE_LAUNCH
    a.ph_lo = 0; a.ph_hi = 17; a.li = 0;
    void* kargs[] = { &a };
    hipError_t e = hipLaunchCooperativeKernel((const void*)fwd_kernel, dim3(grid), dim3(NTHREADS), kargs, LDS_BYTES, stream);
    if (e != hipSuccess) fprintf(stderr, "cooperative launch failed: %s\n", hipGetErrorString(e));
#else
    for (int p = 0; p < 17; ++p) { a.ph_lo = p; a.ph_hi = p + 1; a.li = p; hipLaunchKernelGGL(fwd_kernel, dim3(grid), dim3(NTHREADS), LDS_BYTES, stream, a); }
#endif
}
```
